# Optimizing an MI355X kernel written in HIP

```python
import jax, jax.numpy as jnp
from jax import lax
import numpy as np

D_MODEL = 1024
BATCH = 8
SEQ = 4096
DEPTH = 1

GRID_W = 64
CTX_LEN = 256
MLA_HEADS = 8
MLA_Q_RANK = 256
MLA_KV_RANK = 128
MLA_NOPE = 64
MLA_ROPE = 32
MLA_V = 64
RET_HEADS = 8
RET_DK = 64
RET_DV = 64
RET_CHUNK = 128
N_EXPERTS = 16
EC_CAPACITY = 2
D_EXPERT = 768
Q_BLOCK = 128
ROPE_BASE = 10000.0
EPS = 1e-6
MIX_WIDTH = MLA_HEADS * MLA_V + RET_HEADS * RET_DV
IN_SIZES = (MLA_Q_RANK, MLA_KV_RANK, MLA_ROPE, RET_HEADS * RET_DK, RET_HEADS * RET_DK, RET_HEADS * RET_DV, RET_HEADS * RET_DV)
IN_SPLITS = tuple(int(s) for s in np.cumsum(IN_SIZES)[:-1])
D_IN = int(sum(IN_SIZES))

kernel_name = 'hybrid_mla_retention_ec_dit'


def rmsnorm(x, g):
    xf = x.astype(jnp.float32)
    y = xf * lax.rsqrt(jnp.mean(xf * xf, axis=-1, keepdims=True) + EPS)
    return (y * g.astype(jnp.float32)).astype(x.dtype)


def rope_2d(x, row, col):
    d = x.shape[-1]
    nf = d // 4
    inv = ROPE_BASE ** (-jnp.arange(nf, dtype=jnp.float32) / nf)
    ang = jnp.concatenate([row[:, None] * inv, col[:, None] * inv], axis=-1)
    cos = jnp.cos(ang)[None, :, None, :].astype(x.dtype)
    sin = jnp.sin(ang)[None, :, None, :].astype(x.dtype)
    x1, x2 = x[..., : d // 2], x[..., d // 2:]
    return jnp.concatenate([x1 * cos - x2 * sin, x1 * sin + x2 * cos], axis=-1)


def mla_qkv(cq, ckv, kr, g_q, g_kv, w_uq, w_ukv, row, col):
    B, L, _ = cq.shape
    q = (rmsnorm(cq, g_q) @ w_uq).reshape(B, L, MLA_HEADS, MLA_NOPE + MLA_ROPE)
    kv = (rmsnorm(ckv, g_kv) @ w_ukv).reshape(B, L, MLA_HEADS, MLA_NOPE + MLA_V)
    q_nope, q_rope = q[..., :MLA_NOPE], q[..., MLA_NOPE:]
    k_nope, v = kv[..., :MLA_NOPE], kv[..., MLA_NOPE:]
    k_rope = kr[:, :, None, :]
    if row is not None:
        q_rope = rope_2d(q_rope, row, col)
        k_rope = rope_2d(k_rope, row, col)
    k_rope = jnp.broadcast_to(k_rope, (B, L, MLA_HEADS, MLA_ROPE))
    return (jnp.concatenate([q_nope, q_rope], axis=-1),
            jnp.concatenate([k_nope, k_rope], axis=-1), v)


def block_attention(q, k, v):
    B, L, H, dk = q.shape
    nb = L // Q_BLOCK
    scale = dk ** -0.5
    qb = q.reshape(B, nb, Q_BLOCK, H, dk).transpose(1, 0, 2, 3, 4)

    def one_block(qblk):
        s = jnp.einsum('bqhd,bkhd->bhqk', qblk, k).astype(jnp.float32) * scale
        p = jax.nn.softmax(s, axis=-1).astype(v.dtype)
        return jnp.einsum('bhqk,bkhd->bqhd', p, v)

    out = lax.map(one_block, qb)
    return out.transpose(1, 0, 2, 3, 4).reshape(B, L, H, v.shape[-1])


def retention_qkv(rq, rk, rv, row, col):
    B, L, _ = rq.shape
    q = rq.reshape(B, L, RET_HEADS, RET_DK)
    k = rk.reshape(B, L, RET_HEADS, RET_DK) * (RET_DK ** -0.5)
    v = rv.reshape(B, L, RET_HEADS, RET_DV)
    if row is not None:
        q = rope_2d(q, row, col)
        k = rope_2d(k, row, col)
    return q, k, v


def retention_chunks(q, k, v, log_gamma, r0, inclusive):
    B, L, H, dk = q.shape
    dv = v.shape[-1]
    C = RET_CHUNK
    nc = L // C
    dt = q.dtype
    idx = jnp.arange(C, dtype=jnp.float32)
    diff = idx[:, None] - idx[None, :]
    mask = (diff >= 0) if inclusive else (diff > 0)
    decay_in = jnp.where(mask[None], jnp.exp(log_gamma[:, None, None] * jnp.maximum(diff, 0.0)[None]), 0.0)
    xi = jnp.exp(log_gamma[None, :] * (idx[:, None] + 1.0))
    zeta = jnp.exp(log_gamma[None, :] * (C - 1.0 - idx)[:, None])
    decay_chunk = jnp.exp(log_gamma * C)[None, :, None, None]
    qc = q.reshape(B, nc, C, H, dk)
    kc = k.reshape(B, nc, C, H, dk)
    vc = v.reshape(B, nc, C, H, dv)
    s = jnp.einsum('bnihd,bnjhd->bnhij', qc, kc) * decay_in.astype(dt)
    y_inner = jnp.einsum('bnhij,bnjhe->bnihe', s, vc)
    u = jnp.einsum('bnjhd,bnjhe->bnhde', kc * zeta[:, :, None].astype(dt), vc).astype(jnp.float32)

    def step(r, u_c):
        return decay_chunk * r + u_c, r

    r_fin, r_prev = lax.scan(step, r0, u.transpose(1, 0, 2, 3, 4))
    r_prev = r_prev.transpose(1, 0, 2, 3, 4).astype(dt)
    y_cross = jnp.einsum('bnihd,bnhde->bnihe', qc * xi[:, :, None].astype(dt), r_prev)
    return (y_inner + y_cross).reshape(B, L, H, dv), r_fin


def bidirectional_retention(q, k, v, qc, kc, vc, lg_f, lg_b):
    B = q.shape[0]
    r0 = jnp.zeros((B, RET_HEADS, RET_DK, RET_DV), jnp.float32)
    flip = lambda t: t[:, ::-1]
    yc_f, rc_f = retention_chunks(qc, kc, vc, lg_f, r0, True)
    y_f, _ = retention_chunks(q, k, v, lg_f, rc_f, True)
    yc_b, rc_b = retention_chunks(flip(qc), flip(kc), flip(vc), lg_b, r0, False)
    y_b, _ = retention_chunks(flip(q), flip(k), flip(v), lg_b, rc_b, False)
    return y_f + flip(y_b), yc_f + flip(yc_b)


def retention_out(y, gate, g_ret):
    B, L, H, dv = y.shape
    yf = y.astype(jnp.float32)
    mu = jnp.mean(yf, axis=-1, keepdims=True)
    var = jnp.mean(jnp.square(yf - mu), axis=-1, keepdims=True)
    yn = ((yf - mu) * lax.rsqrt(var + EPS)).reshape(B, L, H * dv) * g_ret.astype(jnp.float32)
    return yn.astype(y.dtype) * jax.nn.silu(gate)


def hybrid_mixer(h, hc, row, col, w_in, g_q, g_kv, w_uq, w_ukv, exp_f, exp_b, g_ret, w_o, want_ctx):
    B, S, _ = h.shape
    Lc = hc.shape[1]
    cq, ckv, kr, rq, rk, rv, rg = jnp.split(h @ w_in, IN_SPLITS, axis=-1)
    cq_c, ckv_c, kr_c, rq_c, rk_c, rv_c, rg_c = jnp.split(hc @ w_in, IN_SPLITS, axis=-1)
    q_a, k_a, v_a = mla_qkv(cq, ckv, kr, g_q, g_kv, w_uq, w_ukv, row, col)
    q_ac, k_ac, v_ac = mla_qkv(cq_c, ckv_c, kr_c, g_q, g_kv, w_uq, w_ukv, None, None)
    o_att = block_attention(q_a, jnp.concatenate([k_a, k_ac], axis=1), jnp.concatenate([v_a, v_ac], axis=1))
    lg_f = jnp.log1p(-jnp.exp2(-exp_f.astype(jnp.float32)))
    lg_b = jnp.log1p(-jnp.exp2(-exp_b.astype(jnp.float32)))
    q_r, k_r, v_r = retention_qkv(rq, rk, rv, row, col)
    q_rc, k_rc, v_rc = retention_qkv(rq_c, rk_c, rv_c, None, None)
    y_r, y_rc = bidirectional_retention(q_r, k_r, v_r, q_rc, k_rc, v_rc, lg_f, lg_b)
    y_lat = jnp.concatenate([o_att.reshape(B, S, MLA_HEADS * MLA_V), retention_out(y_r, rg, g_ret)], axis=-1) @ w_o
    if not want_ctx:
        return y_lat, None
    o_att_c = block_attention(q_ac, k_ac, v_ac)
    y_ctx = jnp.concatenate([o_att_c.reshape(B, Lc, MLA_HEADS * MLA_V), retention_out(y_rc, rg_c, g_ret)], axis=-1) @ w_o
    return y_lat, y_ctx


def expert_choice_ffn(h, w_router, w_gate, w_up, w_down):
    B, L, D = h.shape
    cap = EC_CAPACITY * L // N_EXPERTS
    aff = jax.nn.softmax((h @ w_router).astype(jnp.float32), axis=-1)
    g, idx = lax.top_k(jnp.swapaxes(aff, 1, 2), cap)
    xs = jax.vmap(lambda hb, ib: hb[ib])(h, idx)
    a = jnp.einsum('becd,edf->becf', xs, w_gate)
    u = jnp.einsum('becd,edf->becf', xs, w_up)
    y = jnp.einsum('becf,efd->becd', jax.nn.silu(a) * u, w_down) * g[..., None].astype(h.dtype)
    return jax.vmap(lambda ib, yb: jnp.zeros((L, D), yb.dtype).at[ib.reshape(-1)].add(yb.reshape(-1, D)))(idx, y)


def setup_inputs(seed: int = 0) -> dict:
    key = jax.random.key(seed)
    ks = jax.random.split(key, 24)
    f32 = jnp.float32

    def nrm(k, shape, scale):
        return jax.random.normal(k, shape, f32) * scale

    def gain(k, shape):
        return 1.0 + 0.05 * jax.random.normal(k, shape, f32)

    L = DEPTH
    head_exp = 5.0 + jnp.arange(RET_HEADS, dtype=f32)
    return {
        'x': nrm(ks[0], (BATCH, SEQ, D_MODEL), 1.0),
        'c': nrm(ks[1], (BATCH, D_MODEL), 1.0),
        'ctx': nrm(ks[2], (BATCH, CTX_LEN, D_MODEL), 1.0),
        'c_ctx': nrm(ks[3], (D_MODEL,), 1.0),
        'w_ada': nrm(ks[4], (L, D_MODEL, 6 * D_MODEL), 0.5 * D_MODEL ** -0.5),
        'b_ada': nrm(ks[5], (L, 6 * D_MODEL), 0.02),
        'g_norm_mix': gain(ks[6], (L, D_MODEL)),
        'g_norm_ffn': gain(ks[7], (L, D_MODEL)),
        'w_in': nrm(ks[8], (L, D_MODEL, D_IN), D_MODEL ** -0.5),
        'g_q_lora': gain(ks[9], (L, MLA_Q_RANK)),
        'g_kv_lora': gain(ks[10], (L, MLA_KV_RANK)),
        'w_uq': nrm(ks[11], (L, MLA_Q_RANK, MLA_HEADS * (MLA_NOPE + MLA_ROPE)), MLA_Q_RANK ** -0.5),
        'w_ukv': nrm(ks[12], (L, MLA_KV_RANK, MLA_HEADS * (MLA_NOPE + MLA_V)), MLA_KV_RANK ** -0.5),
        'ret_exp_fwd': head_exp + 0.1 * jax.random.normal(ks[13], (L, RET_HEADS), f32),
        'ret_exp_bwd': head_exp + 0.1 * jax.random.normal(ks[14], (L, RET_HEADS), f32),
        'g_ret': gain(ks[15], (L, RET_HEADS * RET_DV)),
        'w_o': nrm(ks[16], (L, MIX_WIDTH, D_MODEL), MIX_WIDTH ** -0.5),
        'w_router': nrm(ks[17], (L, D_MODEL, N_EXPERTS), D_MODEL ** -0.5),
        'w_exp_gate': nrm(ks[18], (L, N_EXPERTS, D_MODEL, D_EXPERT), D_MODEL ** -0.5),
        'w_exp_up': nrm(ks[19], (L, N_EXPERTS, D_MODEL, D_EXPERT), D_MODEL ** -0.5),
        'w_exp_down': nrm(ks[20], (L, N_EXPERTS, D_EXPERT, D_MODEL), D_EXPERT ** -0.5),
        'g_final': gain(ks[21], (D_MODEL,)),
    }


def reference(x, c, ctx, c_ctx, w_ada, b_ada, g_norm_mix, g_norm_ffn, w_in, g_q_lora, g_kv_lora, w_uq, w_ukv, ret_exp_fwd, ret_exp_bwd, g_ret, w_o, w_router, w_exp_gate, w_exp_up, w_exp_down, g_final):
    S = x.shape[1]
    rows = S // GRID_W
    row = jnp.repeat(jnp.arange(rows, dtype=jnp.float32), GRID_W)
    col = jnp.tile(jnp.arange(GRID_W, dtype=jnp.float32), rows)
    for layer in range(DEPTH):
        last = layer == DEPTH - 1
        mod = jax.nn.silu(c) @ w_ada[layer] + b_ada[layer]
        sh1, sc1, ga1, sh2, sc2, ga2 = (m[:, None, :] for m in jnp.split(mod, 6, axis=-1))
        mod_c = jax.nn.silu(c_ctx) @ w_ada[layer] + b_ada[layer]
        csh1, csc1, cga1, csh2, csc2, cga2 = jnp.split(mod_c, 6)
        h = rmsnorm(x, g_norm_mix[layer]) * (1.0 + sc1) + sh1
        hc = rmsnorm(ctx, g_norm_mix[layer]) * (1.0 + csc1) + csh1
        y, yc = hybrid_mixer(h, hc, row, col, w_in[layer], g_q_lora[layer], g_kv_lora[layer], w_uq[layer], w_ukv[layer], ret_exp_fwd[layer], ret_exp_bwd[layer], g_ret[layer], w_o[layer], not last)
        x = x + ga1 * y
        h = rmsnorm(x, g_norm_ffn[layer]) * (1.0 + sc2) + sh2
        x = x + ga2 * expert_choice_ffn(h, w_router[layer], w_exp_gate[layer], w_exp_up[layer], w_exp_down[layer])
        if not last:
            ctx = ctx + cga1 * yc
            hc = rmsnorm(ctx, g_norm_ffn[layer]) * (1.0 + csc2) + csh2
            ctx = ctx + cga2 * expert_choice_ffn(hc, w_router[layer], w_exp_gate[layer], w_exp_up[layer], w_exp_down[layer])
    return rmsnorm(x, g_final)
```

```cpp
#include <hip/hip_runtime.h>
#include <cstdio>
#include <cstdint>

#ifndef MK_SINGLE
#define MK_SINGLE 1
#endif

typedef unsigned short bf16_t;
typedef float f32x4 __attribute__((ext_vector_type(4)));
typedef unsigned u32x4 __attribute__((ext_vector_type(4)));
typedef unsigned u32x2 __attribute__((ext_vector_type(2)));
#define LAS __attribute__((address_space(3)))

constexpr int D = 1024, NB = 8, SEQ = 4096, LC = 256;
constexpr int RL = NB * SEQ, RC = NB * LC, RT = RL + RC;
constexpr int NPROJ = 2560;
constexpr int PC_CQ = 0, PC_CKV = 256, PC_KR = 384, PC_RQ = 512, PC_RK = 1024, PC_RV = 1536, PC_RG = 2048;
constexpr int NH = 8, QW = 768, KVW = 1024;
constexpr int NE = 16, CAP = 512, DE = 768, NSLOT = NB * NE * CAP;
constexpr int NCH = 32;
constexpr float EPS = 1e-6f;
constexpr float QSCALE = 0.10206207261596577f * 1.4426950408889634f;

constexpr size_t MiB = 1u << 20;
constexpr size_t WS_CTL = 0, CTL_BYTES = 64 * 1024;
constexpr size_t WS_MOD = 1 * MiB;
constexpr size_t WS_TABR = 2 * MiB;
constexpr size_t WS_TABM = 3 * MiB;
constexpr size_t WS_PSTAT = 4 * MiB;
constexpr size_t WS_AFF = 6 * MiB;
constexpr size_t WS_SELI = 8 * MiB;
constexpr size_t WS_SELG = 8 * MiB + 512 * 1024;
constexpr size_t WS_INV = 9 * MiB;
constexpr size_t WS_SELS = 11 * MiB;
constexpr size_t WS_WIN = 12 * MiB;
constexpr size_t WS_WUQ = 17 * MiB;
constexpr size_t WS_WUKV = 17 * MiB + 512 * 1024;
constexpr size_t WS_WO = 18 * MiB;
constexpr size_t WS_WGU = 20 * MiB;
constexpr size_t WS_WDN = 68 * MiB;
constexpr size_t WS_H = 92 * MiB;
constexpr size_t WS_RST = 92 * MiB;
constexpr size_t WS_PROJ = 160 * MiB;
constexpr size_t WS_ACT = 160 * MiB;
constexpr size_t WS_YB = 256 * MiB;
constexpr size_t WS_Q = 330 * MiB;
constexpr size_t WS_KV = 378 * MiB;
constexpr size_t WS_MIX = 446 * MiB;
constexpr size_t WS_END = 510 * MiB;
static_assert(WS_PROJ + (size_t)RT * NPROJ * 2 <= WS_Q && WS_Q + (size_t)RL * QW * 2 <= WS_KV && WS_KV + (size_t)RT * KVW * 2 <= WS_MIX, "ws map");
static_assert(WS_H + (size_t)RT * D * 2 <= WS_PROJ && WS_WDN + (size_t)NE * D * DE * 2 <= WS_H && WS_PSTAT + (size_t)RT * 32 <= WS_AFF, "ws map 2");

constexpr int LDS_BYTES = 147456;
constexpr int NPH = 14;

__device__ __forceinline__ float bf2f(bf16_t v) { return __uint_as_float((unsigned)v << 16); }
__device__ __forceinline__ bf16_t f2bf(float f) { unsigned u = __float_as_uint(f); return (bf16_t)((u + 0x7fffu + ((u >> 16) & 1u)) >> 16); }
__device__ __forceinline__ unsigned pk2(float lo, float hi) { unsigned r; asm("v_cvt_pk_bf16_f32 %0, %1, %2" : "=v"(r) : "v"(lo), "v"(hi)); return r; }
__device__ __forceinline__ float wave_sum(float v) {
#pragma unroll
    for (int o = 1; o < 64; o <<= 1) v += __shfl_xor(v, o);
    return v;
}
__device__ __forceinline__ float silu_f(float v) { return v / (1.f + __expf(-v)); }

struct Args {
    const float* in[22]; float* out; unsigned char* ws; int ph_lo, ph_hi;
};

typedef __attribute__((address_space(4))) const char* kptr_t;
typedef const float* cfp_t; typedef float* fp_t; typedef unsigned char* ucp_t;
typedef __attribute__((address_space(4))) const cfp_t* kcfpp; typedef __attribute__((address_space(4))) const fp_t* kfpp; typedef __attribute__((address_space(4))) const ucp_t* kucpp;
static_assert(sizeof(Args) == 200, "Args layout: in[22] @0, out @176, ws @184, ph_lo @192, ph_hi @196");
struct Ctx {
    kptr_t kp; int tid, lane, wave, gw, ngw;
    __device__ __forceinline__ const float* in(int i) const { return *(kcfpp)(kp + 8 * i); }
    __device__ __forceinline__ unsigned char* wsb() const { return *(kucpp)(kp + 184); }
    __device__ __forceinline__ const float* x() const { return in(0); }
    __device__ __forceinline__ const float* cvec() const { return in(1); }
    __device__ __forceinline__ const float* ctx() const { return in(2); }
    __device__ __forceinline__ const float* c_ctx() const { return in(3); }
    __device__ __forceinline__ const float* w_ada() const { return in(4); }
    __device__ __forceinline__ const float* b_ada() const { return in(5); }
    __device__ __forceinline__ const float* g_mix() const { return in(6); }
    __device__ __forceinline__ const float* g_ffn() const { return in(7); }
    __device__ __forceinline__ const float* w_in() const { return in(8); }
    __device__ __forceinline__ const float* g_q() const { return in(9); }
    __device__ __forceinline__ const float* g_kv() const { return in(10); }
    __device__ __forceinline__ const float* w_uq() const { return in(11); }
    __device__ __forceinline__ const float* w_ukv() const { return in(12); }
    __device__ __forceinline__ const float* exp_f() const { return in(13); }
    __device__ __forceinline__ const float* exp_b() const { return in(14); }
    __device__ __forceinline__ const float* g_ret() const { return in(15); }
    __device__ __forceinline__ const float* w_o() const { return in(16); }
    __device__ __forceinline__ const float* w_router() const { return in(17); }
    __device__ __forceinline__ const float* w_gate() const { return in(18); }
    __device__ __forceinline__ const float* w_up() const { return in(19); }
    __device__ __forceinline__ const float* w_down() const { return in(20); }
    __device__ __forceinline__ const float* g_final() const { return in(21); }
    __device__ __forceinline__ float* out() const { return *(kfpp)(kp + 176); }
    __device__ __forceinline__ float* modv() const { return (float*)(wsb() + WS_MOD); }
    __device__ __forceinline__ float* tabr() const { return (float*)(wsb() + WS_TABR); }
    __device__ __forceinline__ float* tabm() const { return (float*)(wsb() + WS_TABM); }
    __device__ __forceinline__ float* pstat() const { return (float*)(wsb() + WS_PSTAT); }
    __device__ __forceinline__ float* aff() const { return (float*)(wsb() + WS_AFF); }
    __device__ __forceinline__ float* selg() const { return (float*)(wsb() + WS_SELG); }
    __device__ __forceinline__ int* seli() const { return (int*)(wsb() + WS_SELI); }
    __device__ __forceinline__ int* inv() const { return (int*)(wsb() + WS_INV); }
    __device__ __forceinline__ float* sels() const { return (float*)(wsb() + WS_SELS); }
    __device__ __forceinline__ float* rpart() const { return (float*)(wsb() + WS_Q); }
    __device__ __forceinline__ bf16_t* win_t() const { return (bf16_t*)(wsb() + WS_WIN); }
    __device__ __forceinline__ bf16_t* wuq_t() const { return (bf16_t*)(wsb() + WS_WUQ); }
    __device__ __forceinline__ bf16_t* wukv_t() const { return (bf16_t*)(wsb() + WS_WUKV); }
    __device__ __forceinline__ bf16_t* wo_t() const { return (bf16_t*)(wsb() + WS_WO); }
    __device__ __forceinline__ bf16_t* wgu_t() const { return (bf16_t*)(wsb() + WS_WGU); }
    __device__ __forceinline__ bf16_t* wdn_t() const { return (bf16_t*)(wsb() + WS_WDN); }
    __device__ __forceinline__ bf16_t* hb() const { return (bf16_t*)(wsb() + WS_H); }
    __device__ __forceinline__ bf16_t* rst() const { return (bf16_t*)(wsb() + WS_RST); }
    __device__ __forceinline__ bf16_t* proj() const { return (bf16_t*)(wsb() + WS_PROJ); }
    __device__ __forceinline__ bf16_t* act() const { return (bf16_t*)(wsb() + WS_ACT); }
    __device__ __forceinline__ bf16_t* yb() const { return (bf16_t*)(wsb() + WS_YB); }
    __device__ __forceinline__ bf16_t* qb() const { return (bf16_t*)(wsb() + WS_Q); }
    __device__ __forceinline__ bf16_t* kvb() const { return (bf16_t*)(wsb() + WS_KV); }
    __device__ __forceinline__ bf16_t* mix() const { return (bf16_t*)(wsb() + WS_MIX); }
    __device__ __forceinline__ bf16_t* x1b() const { return (bf16_t*)(wsb() + WS_H); }
    __device__ __forceinline__ bf16_t* h2() const { return (bf16_t*)(wsb() + WS_MIX); }
    __device__ __forceinline__ signed char* h2q() const { return (signed char*)(wsb() + WS_MIX); }
    __device__ __forceinline__ float* sa() const { return (float*)(wsb() + WS_MIX + 32 * MiB); }
    __device__ __forceinline__ signed char* wgu_q() const { return (signed char*)(wsb() + WS_WGU); }
    __device__ __forceinline__ float* swgu() const { return (float*)(wsb() + WS_WGU + 24 * MiB); }
};

__device__ __forceinline__ void p0_mod(const Ctx& c, float* lds) {
    float* sc = lds;
    float* red = lds + 9 * 1024;
    for (int i = c.tid; i < 9 * 1024; i += 512) { const int r = i >> 10, k = i & 1023; const float v = r < 8 ? c.cvec()[r * 1024 + k] : c.c_ctx()[k]; sc[i] = silu_f(v); }
    __syncthreads();
    for (int unit = blockIdx.x; unit < 192; unit += gridDim.x) {
        const int nn = c.tid & 31, n = unit * 32 + nn, kg = c.tid >> 5;
        float acc[9];
#pragma unroll
        for (int r = 0; r < 9; ++r) acc[r] = 0.f;
        for (int k0 = kg; k0 < 1024; k0 += 16 * 8) { float w[8];
#pragma unroll
            for (int i = 0; i < 8; ++i) w[i] = __builtin_nontemporal_load(c.w_ada() + (size_t)(k0 + 16 * i) * 6144 + n);
#pragma unroll
            for (int i = 0; i < 8; ++i)
#pragma unroll
                for (int r = 0; r < 9; ++r) acc[r] += sc[r * 1024 + k0 + 16 * i] * w[i]; }
#pragma unroll
        for (int r = 0; r < 9; ++r) red[(kg * 9 + r) * 32 + nn] = acc[r];
        __syncthreads();
        for (int i = c.tid; i < 9 * 32; i += 512) { const int r = i >> 5, n2 = i & 31; float s = 0.f;
#pragma unroll
            for (int g = 0; g < 16; ++g) s += red[(g * 9 + r) * 32 + n2];
            c.modv()[r * 6144 + unit * 32 + n2] = s + c.b_ada()[unit * 32 + n2]; }
        __syncthreads();
    }
}
template <class CM, class GN>
__device__ __forceinline__ void transpose_item(const float* W, int Ksrc, int Nsrc, bf16_t* WT, int Kdst, CM cm, GN gain, float* scr, int kb, int nb, int lane) {
    const int k0 = 64 * kb, n0 = 32 * nb;
    const int srcc = cm(n0 + (lane & 31));
#pragma unroll 8
    for (int i = 0; i < 32; ++i) { const int kk = 2 * i + (lane >> 5), k = k0 + kk;
        float v = 0.f; if (srcc >= 0 && k < Ksrc) v = W[(size_t)k * Nsrc + srcc] * gain(k);
        scr[kk * 33 + (lane & 31)] = v; }
    asm volatile("s_waitcnt lgkmcnt(0)" ::: "memory");
    const int ch = lane & 7;
#pragma unroll
    for (int j = 0; j < 4; ++j) { const int n = (lane >> 3) + 8 * j; const float* s = scr + (8 * ch) * 33 + n;
        u32x4 o; o.x = pk2(s[0 * 33], s[1 * 33]); o.y = pk2(s[2 * 33], s[3 * 33]); o.z = pk2(s[4 * 33], s[5 * 33]); o.w = pk2(s[6 * 33], s[7 * 33]);
        *(u32x4*)(WT + (size_t)(n0 + n) * Kdst + k0 + 8 * ch) = o; }
    asm volatile("s_waitcnt lgkmcnt(0)" ::: "memory");
}
__device__ __forceinline__ int ilv(int p, int half) { const int g = p >> 3, w = p & 7; return w < 4 ? 4 * g + w : half + 4 * g + (w - 4); }
__device__ __forceinline__ int cm_win(int n) {
    if (n < 384) return n;
    if (n < 416) return 384 + ilv(n - 384, 16);
    if (n < 512) return -1;
    if (n < 1024) { const int j = n - 512; return 416 + (j >> 6) * 64 + ilv(j & 63, 32); }
    if (n < 1536) { const int j = n - 1024; return 928 + (j >> 6) * 64 + ilv(j & 63, 32); }
    if (n < 2048) return 1440 + (n - 1536);
    return 1952 + (n - 2048);
}
__device__ __forceinline__ int cm_wuq(int n) { const int h = n / 96, p = n % 96; return p < 64 ? n : h * 96 + 64 + ilv(p - 64, 16); }
__device__ __forceinline__ int cm_wgu(int n) { const int q = n >> 3, w = n & 7; return w < 4 ? 4 * q + w : 768 + 4 * q + (w - 4); }
template <bool NTST = false, class TC>
__device__ __forceinline__ void transpose64(const float* srcA, const float* srcB, int ld, bf16_t* dst, int ldd, TC tcol, float* scr, int lane) {
    const int r = lane >> 3, c4 = (lane & 7) * 4;
    f32x4 va[8], vb[8];
#pragma unroll
    for (int i = 0; i < 8; ++i) { va[i] = srcA ? __builtin_nontemporal_load((const f32x4*)(srcA + (size_t)(8 * i + r) * ld + c4)) : (f32x4){0.f, 0.f, 0.f, 0.f}; vb[i] = srcB ? __builtin_nontemporal_load((const f32x4*)(srcB + (size_t)(8 * i + r) * ld + c4)) : (f32x4){0.f, 0.f, 0.f, 0.f}; }
#pragma unroll
    for (int i = 0; i < 8; ++i) { float* p = scr + (8 * i + r) * 65 + c4; p[0] = va[i].x; p[1] = va[i].y; p[2] = va[i].z; p[3] = va[i].w; p[32] = vb[i].x; p[33] = vb[i].y; p[34] = vb[i].z; p[35] = vb[i].w; }
    asm volatile("s_waitcnt lgkmcnt(0)" ::: "memory");
    const int kc = lane & 7;
#pragma unroll
    for (int j = 0; j < 8; ++j) { const int nl = (lane >> 3) + 8 * j, col = tcol(nl); u32x4 o = {0u, 0u, 0u, 0u};
        if (col >= 0) { const float* sp = scr + (8 * kc) * 65 + col; o.x = pk2(sp[0 * 65], sp[1 * 65]); o.y = pk2(sp[2 * 65], sp[3 * 65]); o.z = pk2(sp[4 * 65], sp[5 * 65]); o.w = pk2(sp[6 * 65], sp[7 * 65]); }
        if (NTST) __builtin_nontemporal_store(o, (u32x4*)(dst + (size_t)nl * ldd + 8 * kc)); else *(u32x4*)(dst + (size_t)nl * ldd + 8 * kc) = o; }
    asm volatile("s_waitcnt lgkmcnt(0)" ::: "memory");
}
typedef int i32x4 __attribute__((ext_vector_type(4)));
constexpr int GU_STRIPS = NE * 24;
__device__ __forceinline__ unsigned q8pack(float a, float b, float c_, float d, float inv) {
    const unsigned q0 = __float_as_uint(__builtin_fmaf(a, inv, 12582912.f)), q1 = __float_as_uint(__builtin_fmaf(b, inv, 12582912.f)), q2 = __float_as_uint(__builtin_fmaf(c_, inv, 12582912.f)), q3 = __float_as_uint(__builtin_fmaf(d, inv, 12582912.f));
    return (q0 & 255u) | ((q1 & 255u) << 8) | ((q2 & 255u) << 16) | (q3 << 24);
}
__device__ __forceinline__ void gu_strip_i8(const Ctx& c, float* lds, int s) {
    const int e = s / 24, nb = s % 24;
    float* scr = lds + c.wave * (64 * 65); float* cm = lds + 8 * 64 * 65; float* fin = cm + 512;
    const int r = c.lane >> 3, c4 = (c.lane & 7) * 4;
    const size_t so = (size_t)e * 1024 * 768 + 32 * nb + c4;
    const float* gA = c.w_gate() + so; const float* gB = c.w_up() + so;
    f32x4 va[2][8], vb[2][8];
#pragma unroll
    for (int t = 0; t < 2; ++t)
#pragma unroll
        for (int i = 0; i < 8; ++i) { const size_t ro = (size_t)(64 * (2 * c.wave + t) + 8 * i + r) * 768; va[t][i] = __builtin_nontemporal_load((const f32x4*)(gA + ro)); vb[t][i] = __builtin_nontemporal_load((const f32x4*)(gB + ro)); }
    f32x4 mA = {0.f, 0.f, 0.f, 0.f}, mB = {0.f, 0.f, 0.f, 0.f};
#pragma unroll
    for (int t = 0; t < 2; ++t)
#pragma unroll
        for (int i = 0; i < 8; ++i) { mA = __builtin_elementwise_max(mA, __builtin_elementwise_abs(va[t][i])); mB = __builtin_elementwise_max(mB, __builtin_elementwise_abs(vb[t][i])); }
#pragma unroll
    for (int o = 8; o < 64; o <<= 1)
#pragma unroll
        for (int j = 0; j < 4; ++j) { mA[j] = fmaxf(mA[j], __shfl_xor(mA[j], o)); mB[j] = fmaxf(mB[j], __shfl_xor(mB[j], o)); }
    __syncthreads();
    if (r == 0) { *(f32x4*)(cm + c.wave * 64 + c4) = mA; *(f32x4*)(cm + c.wave * 64 + 32 + c4) = mB; }
    __syncthreads();
    if (c.tid < 64) { float m = cm[c.tid];
#pragma unroll
        for (int w = 1; w < 8; ++w) m = fmaxf(m, cm[w * 64 + c.tid]);
        fin[c.tid] = fmaxf(m, 1e-30f); }
    __syncthreads();
    const int w8 = c.lane >> 3, kc = c.lane & 7;
    if (c.tid < 64) { const int qq = c.tid >> 3, w = c.tid & 7; c.swgu()[e * 1536 + 64 * nb + c.tid] = fin[w < 4 ? 4 * qq + w : 32 + 4 * qq + (w - 4)] * (1.f / 127.f); }
    signed char* dq = c.wgu_q() + (size_t)e * 1536 * 1024 + (size_t)(64 * nb + w8) * 1024 + 128 * c.wave + 8 * kc;
#pragma unroll
    for (int t = 0; t < 2; ++t) {
#pragma unroll
        for (int i = 0; i < 8; ++i) { float* p = scr + (8 * i + r) * 65 + c4; p[0] = va[t][i].x; p[1] = va[t][i].y; p[2] = va[t][i].z; p[3] = va[t][i].w; p[32] = vb[t][i].x; p[33] = vb[t][i].y; p[34] = vb[t][i].z; p[35] = vb[t][i].w; }
        asm volatile("s_waitcnt lgkmcnt(0)" ::: "memory");
#pragma unroll
        for (int j = 0; j < 8; ++j) { const int col = w8 < 4 ? 4 * j + w8 : 32 + 4 * j + (w8 - 4);
            const float inv = 127.f / fin[col]; const float* sp = scr + (8 * kc) * 65 + col;
            u32x2 o; o.x = q8pack(sp[0 * 65], sp[1 * 65], sp[2 * 65], sp[3 * 65], inv); o.y = q8pack(sp[4 * 65], sp[5 * 65], sp[6 * 65], sp[7 * 65], inv);
            *(u32x2*)(dq + (size_t)(8 * j) * 1024 + 64 * t) = o; }
        asm volatile("s_waitcnt lgkmcnt(0)" ::: "memory");
    }
}
constexpr int QSHORT0 = 80, QSTRIPS = 2, QSTATIC = (256 - QSHORT0) * QSTRIPS;
template <int PART>
__device__ __forceinline__ void p0_weights(const Ctx& c, float* lds, int gw, int ngw) {
    float* scr = lds + c.wave * (64 * 65);
    constexpr int I_WIN = 16 * 40, I_WO = 16 * 16, I_GU = 16 * 24, I_DN = 12 * 16, I_WUQ = 4 * 24, I_WUKV = 4 * 32;
    constexpr int NEXP = NE * I_GU + NE * I_DN, NIT = NEXP + I_WIN + I_WO + I_WUQ + I_WUKV;
    unsigned* qctr = (unsigned*)(c.wsb() + WS_CTL) + 2048; int qbase = 0, qk = 8;
    for (int it = (PART == 1 ? NE * I_GU : NEXP + gw); it < (PART == 1 ? NEXP : NIT); it += (PART == 0 ? ngw : 1)) {
        if (PART == 1) { if (qk == 8) { int p_ = 0; if (c.lane == 0) p_ = (int)__hip_atomic_fetch_add(qctr, 1u, __ATOMIC_RELAXED, __HIP_MEMORY_SCOPE_AGENT); qbase = NE * I_GU + __builtin_amdgcn_readfirstlane(p_) * 8; qk = 0; }
            it = qbase + qk; ++qk; if (it >= NEXP) break; }
        int r = it;
        r -= NE * I_GU;
        if (r < NE * I_DN) { const int e = r / I_DN, q = r % I_DN, kb = q / 16, nb = q % 16;
            const float* src = c.w_down() + (size_t)e * 768 * 1024 + (size_t)(64 * kb) * 1024 + 64 * nb;
            transpose64<true>(src, src + 32, 1024, c.wdn_t() + (size_t)e * 1024 * 768 + (size_t)(64 * nb) * 768 + 64 * kb, 768, [](int nl) { return nl; }, scr, c.lane); continue; } r -= NE * I_DN;
        if (r < I_WIN) { const int kb = r / 40, nb = r % 40; const float* base = c.w_in() + (size_t)(64 * kb) * 2464; bf16_t* dst = c.win_t() + (size_t)(64 * nb) * 1024 + 64 * kb;
            if (nb < 6) { transpose64(base + 64 * nb, base + 64 * nb + 32, 2464, dst, 1024, [](int nl) { return nl; }, scr, c.lane); }
            else if (nb == 6) { transpose64(base + 384, (const float*)nullptr, 2464, dst, 1024, [](int nl) { return nl < 32 ? ilv(nl, 16) : -1; }, scr, c.lane); }
            else if (nb == 7) { transpose64((const float*)nullptr, (const float*)nullptr, 2464, dst, 1024, [](int) { return -1; }, scr, c.lane); }
            else if (nb < 24) { const int s0 = (nb < 16 ? 416 : 928) + 64 * ((nb - 8) & 7); transpose64(base + s0, base + s0 + 32, 2464, dst, 1024, [](int nl) { return ilv(nl, 32); }, scr, c.lane); }
            else { const int s0 = (nb < 32 ? 1440 : 1952) + 64 * (nb & 7); transpose64(base + s0, base + s0 + 32, 2464, dst, 1024, [](int nl) { return nl; }, scr, c.lane); }
            continue; } r -= I_WIN;
        if (r < I_WO) { const int kb = r / 16, nb = r % 16; const float* src = c.w_o() + (size_t)(64 * kb) * 1024 + 64 * nb;
            transpose64(src, src + 32, 1024, c.wo_t() + (size_t)(64 * nb) * 1024 + 64 * kb, 1024, [](int nl) { return nl; }, scr, c.lane); continue; } r -= I_WO;
        if (r < I_WUQ) { const float* g = c.g_q(); transpose_item(c.w_uq(), 256, 768, c.wuq_t(), 256, [](int n) { return cm_wuq(n); }, [g](int k) { return g[k]; }, scr, r / 24, r % 24, c.lane); continue; } r -= I_WUQ;
        { const float* g = c.g_kv(); transpose_item(c.w_ukv(), 128, 1024, c.wukv_t(), 256, [](int n) { return n; }, [g](int k) { return g[k]; }, scr, r / 32, r % 32, c.lane); }
    }
}
__device__ __forceinline__ void sincos_d(double x, double& s, double& co) {
    const double PIO2_HI = 1.5707963267948966, PIO2_LO = 6.123233995736766e-17;
    const double kd = __builtin_rint(x * 0.6366197723675814); const int k = (int)kd;
    const double r = (x - kd * PIO2_HI) - kd * PIO2_LO, r2 = r * r;
    double sr = r - r * r2 * (1.0 / 6.0 - r2 * (1.0 / 120.0 - r2 * (1.0 / 5040.0 - r2 * (1.0 / 362880.0 - r2 * (1.0 / 39916800.0 - r2 * (1.0 / 6227020800.0 - r2 * (1.0 / 1307674368000.0 - r2 * (1.0 / 355687428096000.0))))))));
    double cr = 1.0 - r2 * (0.5 - r2 * (1.0 / 24.0 - r2 * (1.0 / 720.0 - r2 * (1.0 / 40320.0 - r2 * (1.0 / 3628800.0 - r2 * (1.0 / 479001600.0 - r2 * (1.0 / 87178291200.0 - r2 * (1.0 / 20922789888000.0))))))));
    switch (k & 3) { case 0: s = sr; co = cr; break; case 1: s = cr; co = -sr; break; case 2: s = -sr; co = -cr; break; default: s = -cr; co = sr; break; }
}
__device__ __forceinline__ void p0_tables(const Ctx& c) {
    const int gt = blockIdx.x * 512 + c.tid, ngt = gridDim.x * 512;
    const double r16 = 1.0 / __builtin_sqrt(__builtin_sqrt(10.0));
    const double r8 = 1.0 / __builtin_sqrt(10.0);
    for (int i = gt; i < 4096 * 48; i += ngt) {
        const int t = i / 48, j = i % 48; const int prow = t >> 6, pcol = t & 63;
        double ang;
        if (j < 32) { const int jj = j & 15; double inv = 1.0; for (int q = 0; q < jj; ++q) inv *= r16; ang = (double)(j < 16 ? prow : pcol) * inv; }
        else { const int j2 = j - 32, jj = j2 & 7; double inv = 1.0; for (int q = 0; q < jj; ++q) inv *= r8; ang = (double)(j2 < 8 ? prow : pcol) * inv; }
        double s, co; sincos_d(ang, s, co);
        if (j < 32) { c.tabr()[(t * 32 + j) * 2] = (float)co; c.tabr()[(t * 32 + j) * 2 + 1] = (float)s; }
        else { c.tabm()[(t * 16 + j - 32) * 2] = (float)co; c.tabm()[(t * 16 + j - 32) * 2 + 1] = (float)s; }
    }
}

__device__ __forceinline__ void p1_norm(const Ctx& c) {
    for (int r = c.gw * 2; r < RT; r += c.ngw * 2) {
        const float* src = r < RL ? c.x() + (size_t)r * D : c.ctx() + (size_t)(r - RL) * D; const int b = r < RL ? r / SEQ : 8;
        f32x4 v[2][4]; float s0 = 0.f, s1 = 0.f;
#pragma unroll
        for (int j = 0; j < 4; ++j) { v[0][j] = __builtin_nontemporal_load((const f32x4*)src + c.lane + 64 * j); v[1][j] = __builtin_nontemporal_load((const f32x4*)(src + D) + c.lane + 64 * j); }
#pragma unroll
        for (int j = 0; j < 4; ++j) { s0 += v[0][j].x * v[0][j].x + v[0][j].y * v[0][j].y + v[0][j].z * v[0][j].z + v[0][j].w * v[0][j].w; s1 += v[1][j].x * v[1][j].x + v[1][j].y * v[1][j].y + v[1][j].z * v[1][j].z + v[1][j].w * v[1][j].w; }
        const float ri0 = 1.f / sqrtf(wave_sum(s0) * (1.f / D) + EPS), ri1 = 1.f / sqrtf(wave_sum(s1) * (1.f / D) + EPS);
        const float* md = c.modv() + b * 6144;
#pragma unroll
        for (int j = 0; j < 4; ++j) { const int k = 4 * c.lane + 256 * j;
            const f32x4 g = *(const f32x4*)(c.g_mix() + k), sh = *(const f32x4*)(md + k), scv = *(const f32x4*)(md + 1024 + k);
            const f32x4 gs = g * (scv + 1.f); const f32x4 o0 = v[0][j] * ri0 * gs + sh, o1 = v[1][j] * ri1 * gs + sh;
            u32x2 w0, w1; w0.x = pk2(o0.x, o0.y); w0.y = pk2(o0.z, o0.w); w1.x = pk2(o1.x, o1.y); w1.y = pk2(o1.z, o1.w);
            *(u32x2*)(c.hb() + (size_t)r * D + k) = w0; *(u32x2*)(c.hb() + (size_t)(r + 1) * D + k) = w1; }
    }
}

__device__ __forceinline__ void store8_bf16(bf16_t* p, const float (&v)[8]) { u32x4 w; w.x = pk2(v[0], v[1]); w.y = pk2(v[2], v[3]); w.z = pk2(v[4], v[5]); w.w = pk2(v[6], v[7]); *(u32x4*)p = w; }


namespace pg8 {
typedef short bf16x8 __attribute__((ext_vector_type(8)));
constexpr int BM = 256, BK = 64, HALF = 128, HTB = HALF * BK * 2, STAGE_BYTES = 8 * HTB, NXCD = 8, WGM = 8;
__host__ __device__ __forceinline__ int lds_byte(int r, int c) { const int st = (r >> 4) * 2 + (c >> 5), rr = r & 15, cc = c & 31, ob = rr * 64 + cc * 2; return st * 1024 + (ob ^ (((ob >> 9) & 1) << 5)); }
__host__ __device__ __forceinline__ void stage_rc(int b, int& R, int& C) { const int st = b / 1024, sb = b % 1024, swz = sb ^ (((sb >> 9) & 1) << 5); R = (st >> 1) * 16 + swz / 64; C = (st & 1) * 32 + (swz % 64) / 2; }
__host__ __device__ __forceinline__ int perm32(int rho) { const int n = rho >> 4, i = rho & 15; return 8 * (i >> 2) + 4 * n + (i & 3); }
struct Unit { int pm, pn; };
struct Gemm { const bf16_t* A; const bf16_t* Bt; int lda, ldb, K; const int* rowlist; int gshift, gmask; size_t gstride; };
struct StaticOrder {
    int nM, nN, nwg, G, c;
    __host__ __device__ void init(int M, int N, int G_, int c_) { nM = M / BM; nN = N / BM; nwg = nM * nN; G = G_; c = c_; }
    __host__ __device__ bool next(int i, Unit& u) const {
        const long L = (long)i * G + c; if (L >= nwg) return false;
        int wgid = (int)L; { const int q = nwg / NXCD, r = nwg % NXCD, xcd = wgid % NXCD, off = wgid / NXCD; wgid = (xcd < r ? xcd * (q + 1) : r * (q + 1) + (xcd - r) * q) + off; }
        const int nig = WGM * nN, gid = wgid / nig, fm = gid * WGM, gsz = (nM - fm) < WGM ? (nM - fm) : WGM;
        u.pm = fm + ((wgid % nig) % gsz); u.pn = (wgid % nig) / gsz; return true;
    }
};
struct ExpertOrder : StaticOrder {
    __host__ __device__ bool next(int i, Unit& u) const {
        if (!StaticOrder::next(i, u)) return false;
        const int p = u.pm, x = p >> 5, el = (p >> 4) & 1, b = (p >> 1) & 7, j = p & 1; u.pm = 32 * b + 2 * (2 * x + el) + j; return true;
    }
};
template <class F, bool FENCE = false> struct EpiRow8 {
    static constexpr bool PERM = true;
    F f;
    __device__ __forceinline__ void operator()(const f32x4 (&acc)[2][2][4][2], const Unit& u, int wr, int wc, int fr, int fq) const {
        const int row0 = u.pm * BM + wr * 64 + fr, col0 = u.pn * BM + wc * 32 + 8 * fq;
#pragma unroll
        for (int ai = 0; ai < 2; ++ai)
#pragma unroll
            for (int m = 0; m < 4; ++m)
#pragma unroll
                for (int bj = 0; bj < 2; ++bj) { const f32x4 a = acc[ai][bj][m][0], b = acc[ai][bj][m][1]; const float v[8] = {a[0], a[1], a[2], a[3], b[0], b[1], b[2], b[3]};
                    f(row0 + ai * HALF + m * 16, col0 + bj * HALF, v); if (FENCE && bj == 1) asm volatile("" ::: "memory"); }
    }
};
template <bool I8> __device__ __forceinline__ f32x4 mma_step(bf16x8 a, bf16x8 b, f32x4 c) {
    if constexpr (I8) return __builtin_bit_cast(f32x4, __builtin_amdgcn_mfma_i32_16x16x64_i8(__builtin_bit_cast(i32x4, a), __builtin_bit_cast(i32x4, b), __builtin_bit_cast(i32x4, c), 0, 0, 0));
    else return __builtin_amdgcn_mfma_f32_16x16x32_bf16(a, b, c, 0, 0, 0);
}
template <bool I8 = false, class Epi, class Sched>
__device__ __forceinline__ void gemm_phase(LAS unsigned char* lds, const Gemm g, const Sched& S, const Epi& E, int tid) {
    const int wid = __builtin_amdgcn_readfirstlane(tid >> 6), lane = tid & 63, wr = wid >> 2, wc = wid & 3, fr = lane & 15, fq = lane >> 4;
    int Kv_ = g.K; asm volatile("" : "+s"(Kv_)); const int nt = Kv_ / BK;
    unsigned voffB[2];
#pragma unroll
    for (int i = 0; i < 2; ++i) { int R, C; stage_rc(tid * 16 + i * 8192, R, C); const int Rb = Epi::PERM ? ((R & ~31) + perm32(R & 31)) : R;
        voffB[i] = (unsigned)(Rb * g.ldb + C) * 2u; }
    const size_t kstep = (size_t)(BK * 2);
    const size_t hstepB = (size_t)HALF * g.ldb * 2, tstepB = 2 * hstepB;
    const unsigned ldsw = (unsigned)wid * 1024u;
    const int aoff = lds_byte(wr * 64 + fr, fq * 8), boff = lds_byte(wc * 32 + fr, fq * 8);
    const unsigned lda2 = (unsigned)g.lda * 2u;
#define PG8_SA(b, h) (((b) * 2 + (h)) * HTB)
#define PG8_SB(b, h) ((4 + (b) * 2 + (h)) * HTB)
#define PG8_STAGE(bufoff, gbase, voff) do { _Pragma("unroll") for (int _i = 0; _i < 2; ++_i) \
        __builtin_amdgcn_global_load_lds((const unsigned*)((const char*)(gbase) + (voff)[_i]), (LAS unsigned*)(lds + (bufoff) + ldsw + _i * 8192), 16, 0, 0); } while (0)
#define PG8_LDA(dst, b, h) do { _Pragma("unroll") for (int m = 0; m < 4; ++m) _Pragma("unroll") for (int k = 0; k < 2; ++k) dst[m][k] = *(const LAS bf16x8*)(lds + PG8_SA(b, h) + aoff + m * 2048 + k * 1024); } while (0)
#define PG8_LDB(dst, b, h) do { _Pragma("unroll") for (int n = 0; n < 2; ++n) _Pragma("unroll") for (int k = 0; k < 2; ++k) dst[n][k] = *(const LAS bf16x8*)(lds + PG8_SB(b, h) + boff + n * 2048 + k * 1024); } while (0)
#define PG8_MMA(ai, bj, At, Bt) do { __builtin_amdgcn_s_setprio(1); _Pragma("unroll") for (int m = 0; m < 4; ++m) _Pragma("unroll") for (int n = 0; n < 2; ++n) _Pragma("unroll") for (int k = 0; k < 2; ++k) \
        acc[ai][bj][m][n] = mma_step<I8>(Bt[n][k], At[m][k], acc[ai][bj][m][n]); __builtin_amdgcn_s_setprio(0); } while (0)
#define PG8_WAIT_V(n) asm volatile("s_waitcnt vmcnt(" #n ")" ::: "memory")
#define PG8_WAIT_L(n) asm volatile("s_waitcnt lgkmcnt(" #n ")" ::: "memory")
#define PG8_BAR __builtin_amdgcn_s_barrier()
#define PG8_SCHED __builtin_amdgcn_sched_barrier(0)
#define PG8_AOFFS(vo, u) do { _Pragma("unroll") for (int _i = 0; _i < 2; ++_i) { int _R, _C; stage_rc(tid * 16 + _i * 8192, _R, _C); _Pragma("unroll") for (int _h = 0; _h < 2; ++_h) { const int _r = (u).pm * BM + _h * HALF + _R; \
        const int _row = g.rowlist ? g.rowlist[_r] : _r; vo[_h][_i] = (unsigned)_row * lda2 + (unsigned)(_C * 2); } } } while (0)
#define PG8_BBASE(u) ((const char*)g.Bt + ((size_t)(((u).pm >> g.gshift) & g.gmask) * g.gstride) * 2 + (size_t)(u).pn * tstepB)
    Unit cur, nxt; int ui = 0;
    if (!S.next(0, cur)) return;
    f32x4 acc[2][2][4][2];
#pragma unroll
    for (int a = 0; a < 2; ++a)
#pragma unroll
        for (int b = 0; b < 2; ++b)
#pragma unroll
            for (int m = 0; m < 4; ++m)
#pragma unroll
                for (int n = 0; n < 2; ++n) acc[a][b][m][n] = (f32x4){0.f, 0.f, 0.f, 0.f};
    bf16x8 At[4][2], B0[2][2], B1[2][2];
    unsigned voc[2][2], von[2][2];
    PG8_AOFFS(voc, cur);
    const char* const A0 = (const char*)g.A; const char* cB = PG8_BBASE(cur);
    PG8_STAGE(PG8_SB(0, 0), cB, voffB); PG8_STAGE(PG8_SB(0, 1), cB + hstepB, voffB); PG8_STAGE(PG8_SA(0, 0), A0, voc[0]); PG8_STAGE(PG8_SA(0, 1), A0, voc[1]);
    if (wr == 1) PG8_BAR;
    PG8_WAIT_V(2); PG8_BAR;
    PG8_STAGE(PG8_SB(1, 0), cB + kstep, voffB); PG8_STAGE(PG8_SA(1, 0), A0 + kstep, voc[0]); PG8_STAGE(PG8_SB(1, 1), cB + hstepB + kstep, voffB);
    PG8_WAIT_V(6); PG8_BAR;
    for (;;) {
        const bool has_next = S.next(ui + 1, nxt);
        const char* nB = has_next ? PG8_BBASE(nxt) : cB;
        for (int t = 0; t < nt; t += 2) {
            const bool last = (t == nt - 2);
            const char* a1 = A0 + (size_t)(t + 1) * kstep;
            const char* a2 = last ? A0 : A0 + (size_t)(t + 2) * kstep; const char* b2 = last ? nB : cB + (size_t)(t + 2) * kstep;
            const char* a3 = a2 + kstep; const char* b3 = b2 + kstep;
            if (last) { if (has_next) { PG8_AOFFS(von, nxt); } else { _Pragma("unroll") for (int h = 0; h < 2; ++h) _Pragma("unroll") for (int i = 0; i < 2; ++i) von[h][i] = voc[h][i]; } }
            unsigned vo2[2][2];
#pragma unroll
            for (int h = 0; h < 2; ++h)
#pragma unroll
                for (int i = 0; i < 2; ++i) vo2[h][i] = last ? von[h][i] : voc[h][i];
            PG8_LDB(B0, 0, 0); PG8_LDB(B1, 0, 1); PG8_SCHED; PG8_LDA(At, 0, 0); PG8_STAGE(PG8_SA(1, 1), a1, voc[1]);
            PG8_WAIT_V(8); PG8_WAIT_L(0); PG8_BAR; PG8_MMA(0, 0, At, B0); PG8_MMA(0, 1, At, B1); PG8_BAR; PG8_SCHED;
            PG8_LDA(At, 0, 1); PG8_STAGE(PG8_SB(0, 0), b2, voffB); PG8_STAGE(PG8_SB(0, 1), b2 + hstepB, voffB); PG8_STAGE(PG8_SA(0, 0), a2, vo2[0]);
            PG8_WAIT_V(8); PG8_WAIT_L(0); PG8_BAR; PG8_MMA(1, 0, At, B0); PG8_MMA(1, 1, At, B1); PG8_BAR; PG8_SCHED;
            PG8_LDB(B0, 1, 0); PG8_LDB(B1, 1, 1); PG8_SCHED; PG8_LDA(At, 1, 0); PG8_STAGE(PG8_SA(0, 1), a2, vo2[1]);
            PG8_WAIT_V(8); PG8_WAIT_L(0); PG8_BAR; PG8_MMA(0, 0, At, B0); PG8_MMA(0, 1, At, B1); PG8_BAR; PG8_SCHED;
            PG8_LDA(At, 1, 1); PG8_STAGE(PG8_SB(1, 0), b3, voffB); PG8_STAGE(PG8_SB(1, 1), b3 + hstepB, voffB); PG8_STAGE(PG8_SA(1, 0), a3, vo2[0]);
            PG8_WAIT_V(8); PG8_WAIT_L(0); PG8_BAR; PG8_MMA(1, 0, At, B0); PG8_MMA(1, 1, At, B1); PG8_BAR; PG8_SCHED;
        }
        if (wr == 0) PG8_BAR;
        if constexpr (I8) {
#pragma unroll
            for (int a = 0; a < 2; ++a)
#pragma unroll
                for (int b = 0; b < 2; ++b)
#pragma unroll
                    for (int m = 0; m < 4; ++m)
#pragma unroll
                        for (int n = 0; n < 2; ++n) acc[a][b][m][n] = __builtin_convertvector(__builtin_bit_cast(i32x4, acc[a][b][m][n]), f32x4); }
        E(acc, cur, wr, wc, fr, fq);
        if (!has_next) break;
#pragma unroll
        for (int a = 0; a < 2; ++a)
#pragma unroll
            for (int b = 0; b < 2; ++b)
#pragma unroll
                for (int m = 0; m < 4; ++m)
#pragma unroll
                    for (int n = 0; n < 2; ++n) acc[a][b][m][n] = (f32x4){0.f, 0.f, 0.f, 0.f};
        cur = nxt; cB = nB; ++ui;
#pragma unroll
        for (int h = 0; h < 2; ++h)
#pragma unroll
            for (int i = 0; i < 2; ++i) voc[h][i] = von[h][i];
        if (wr == 1) PG8_BAR;
    }
    PG8_WAIT_V(0);
    PG8_BAR;
#undef PG8_SA
#undef PG8_SB
#undef PG8_STAGE
#undef PG8_LDA
#undef PG8_LDB
#undef PG8_MMA
#undef PG8_WAIT_V
#undef PG8_WAIT_L
#undef PG8_BAR
#undef PG8_SCHED
#undef PG8_AOFFS
#undef PG8_BBASE
}
}
template <class F> __device__ __forceinline__ pg8::EpiRow8<F> make_epi(F f) { return pg8::EpiRow8<F>{f}; }
template <class F> __device__ __forceinline__ pg8::EpiRow8<F, true> make_epi_fenced(F f) { return pg8::EpiRow8<F, true>{f}; }

struct EpiProj {
    static constexpr bool PERM = true;
    bf16_t* proj; float* pstat; const float* tabr; const float* tabm;
    __device__ __forceinline__ void operator()(const f32x4 (&acc)[2][2][4][2], const pg8::Unit& u, int wr, int wc, int fr, int fq) const {
        const int row0 = u.pm * 256 + wr * 64 + fr, pn = u.pn; const bool lat = u.pm < RL / 256;
        const bool rope_r = pn >= 2 && pn < 6 && lat, rope_m = pn == 1 && wc == 0 && lat;
        f32x4 tb[8][2];
        if (rope_r || rope_m) { const int g = rope_r ? ((wc * 32 + 8 * fq) & 63) >> 3 : fq; const float* tab = rope_r ? tabr : tabm; const int nf = rope_r ? 32 : 16;
#pragma unroll
            for (int i = 0; i < 8; ++i) { const int t = (row0 + (i >> 2) * 128 + (i & 3) * 16) & (SEQ - 1); tb[i][0] = *(const f32x4*)(tab + (t * nf + 4 * g) * 2); tb[i][1] = *(const f32x4*)(tab + (t * nf + 4 * g) * 2 + 4); } }
        else {
#pragma unroll
            for (int i = 0; i < 8; ++i) { tb[i][0] = (f32x4){1.f, 0.f, 1.f, 0.f}; tb[i][1] = (f32x4){1.f, 0.f, 1.f, 0.f}; } }
#pragma unroll
        for (int ai = 0; ai < 2; ++ai)
#pragma unroll
            for (int m = 0; m < 4; ++m) {
                const int row = row0 + ai * 128 + m * 16;
                bf16_t* pr = proj + (size_t)row * NPROJ + pn * 256 + wc * 32 + 8 * fq;
                const f32x4 c0 = tb[ai * 4 + m][0], c1 = tb[ai * 4 + m][1]; const float co[4] = {c0.x, c0.z, c1.x, c1.z}, si[4] = {c0.y, c0.w, c1.y, c1.w};
                float v[2][8];
#pragma unroll
                for (int bj = 0; bj < 2; ++bj) { const f32x4 a = acc[ai][bj][m][0], b = acc[ai][bj][m][1]; v[bj][0] = a[0]; v[bj][1] = a[1]; v[bj][2] = a[2]; v[bj][3] = a[3]; v[bj][4] = b[0]; v[bj][5] = b[1]; v[bj][6] = b[2]; v[bj][7] = b[3]; }
                if (pn == 0) {
                    float sq = 0.f;
#pragma unroll
                    for (int bj = 0; bj < 2; ++bj)
#pragma unroll
                        for (int j = 0; j < 8; ++j) sq += v[bj][j] * v[bj][j];
                    sq += __shfl_xor(sq, 16); sq += __shfl_xor(sq, 32);
                    if (fq == 0) pstat[(size_t)row * 8 + wc] = sq;
                } else if (pn == 1) {
                    float sq = 0.f;
#pragma unroll
                    for (int j = 0; j < 8; ++j) sq += v[0][j] * v[0][j];
                    sq += __shfl_xor(sq, 16); sq += __shfl_xor(sq, 32);
                    if (fq == 0) pstat[(size_t)row * 8 + 4 + wc] = sq;
                    if (wc == 0) {
#pragma unroll
                        for (int w = 0; w < 4; ++w) { const float x1 = v[1][w], x2 = v[1][4 + w]; v[1][w] = x1 * co[w] - x2 * si[w]; v[1][4 + w] = x1 * si[w] + x2 * co[w]; } }
                } else if (pn < 6) {
                    const float ksc = pn >= 4 ? 0.125f : 1.f;
#pragma unroll
                    for (int bj = 0; bj < 2; ++bj)
#pragma unroll
                        for (int w = 0; w < 4; ++w) { const float x1 = v[bj][w], x2 = v[bj][4 + w]; v[bj][w] = (x1 * co[w] - x2 * si[w]) * ksc; v[bj][4 + w] = (x1 * si[w] + x2 * co[w]) * ksc; }
                } else if (pn >= 8) {
#pragma unroll
                    for (int bj = 0; bj < 2; ++bj)
#pragma unroll
                        for (int j = 0; j < 8; ++j) v[bj][j] = silu_f(v[bj][j]);
                }
                store8_bf16(pr, v[0]); store8_bf16(pr + 128, v[1]);
            }
    }
};
__device__ __forceinline__ void p2_proj(const Ctx& c, float* lds) {
    pg8::Gemm g{c.hb(), c.win_t(), D, D, D, nullptr, 0, 0, 0};
    pg8::StaticOrder S; S.init(RT, NPROJ, (int)gridDim.x, (int)blockIdx.x);
    EpiProj E{c.proj(), c.pstat(), c.tabr(), c.tabm()};
    pg8::gemm_phase((LAS unsigned char*)lds, g, S, E, c.tid);
    if ((int)gridDim.x == 256 && (int)blockIdx.x >= QSHORT0) { __syncthreads();
        for (int q = 0; q < QSTRIPS; ++q) gu_strip_i8(c, lds, ((int)blockIdx.x - QSHORT0) * QSTRIPS + q);
        __syncthreads(); }
}
template <bool ISQ> struct EpiUp {
    static constexpr bool PERM = true;
    bf16_t* out; const float* pstat; const float* tabm;
    __device__ __forceinline__ void operator()(const f32x4 (&acc)[2][2][4][2], const pg8::Unit& u, int wr, int wc, int fr, int fq) const {
        const int row0 = u.pm * 256 + wr * 64 + fr, col00 = u.pn * 256 + wc * 32 + 8 * fq;
        float sc[8];
#pragma unroll
        for (int i = 0; i < 8; ++i) { const f32x4 ps = *(const f32x4*)(pstat + (size_t)(row0 + (i >> 2) * 128 + (i & 3) * 16) * 8 + (ISQ ? 0 : 4));
            sc[i] = (ISQ ? QSCALE : 1.f) / sqrtf((ps.x + ps.y + ps.z + ps.w) * (ISQ ? 1.f / 256.f : 1.f / 128.f) + EPS); }
#pragma unroll
        for (int ai = 0; ai < 2; ++ai)
#pragma unroll
            for (int m = 0; m < 4; ++m) { const int row = row0 + ai * 128 + m * 16; const float s_ = sc[ai * 4 + m];
#pragma unroll
                for (int bj = 0; bj < 2; ++bj) { const int c0 = col00 + bj * 128; const f32x4 a = acc[ai][bj][m][0], b = acc[ai][bj][m][1];
                    float o[8] = {a[0] * s_, a[1] * s_, a[2] * s_, a[3] * s_, b[0] * s_, b[1] * s_, b[2] * s_, b[3] * s_};
                    if (ISQ) { const int p = c0 - 96 * ((c0 * 683) >> 16);
                        if (p >= 64) { const int t = row & (SEQ - 1), g = (p - 64) >> 3;
                            const f32x4 c0v = *(const f32x4*)(tabm + (t * 16 + 4 * g) * 2), c1v = *(const f32x4*)(tabm + (t * 16 + 4 * g) * 2 + 4);
                            const float co[4] = {c0v.x, c0v.z, c1v.x, c1v.z}, si[4] = {c0v.y, c0v.w, c1v.y, c1v.w};
#pragma unroll
                            for (int w = 0; w < 4; ++w) { const float x1 = o[w], x2 = o[4 + w]; o[w] = x1 * co[w] - x2 * si[w]; o[4 + w] = x1 * si[w] + x2 * co[w]; } } }
                    store8_bf16(out + (size_t)row * (ISQ ? QW : KVW) + c0, o); } }
    }
};
__device__ __forceinline__ void p3_upq(const Ctx& c, float* lds) {
    pg8::Gemm g{c.proj() + PC_CQ, c.wuq_t(), NPROJ, 256, 256, nullptr, 0, 0, 0};
    pg8::StaticOrder S; S.init(RL, QW, (int)gridDim.x, (int)blockIdx.x);
    EpiUp<true> E{c.qb(), c.pstat(), c.tabm()};
    pg8::gemm_phase((LAS unsigned char*)lds, g, S, E, c.tid);
}
__device__ __forceinline__ void p3_upkv(const Ctx& c, float* lds) {
    pg8::Gemm g{c.proj() + PC_CKV, c.wukv_t(), NPROJ, 256, 256, nullptr, 0, 0, 0};
    pg8::StaticOrder S; S.init(RT, KVW, (int)gridDim.x, (int)blockIdx.x);
    EpiUp<false> E{c.kvb(), c.pstat(), c.tabm()};
    pg8::gemm_phase((LAS unsigned char*)lds, g, S, E, c.tid);
}

namespace att {
using bf16x8 = __attribute__((ext_vector_type(8))) short;
using s16x4  = __attribute__((ext_vector_type(4))) short;
using f32x16 = __attribute__((ext_vector_type(16))) float;
constexpr int QBLK = 32, KVBLK = 64, NWV = 8;
constexpr float THR = 8.f;
constexpr int SHM_V = 16384, SHM_K = 16384, SHM_ATTN = 3 * SHM_V + 3 * SHM_K + NWV * 64 * 4;
#define KSWZ(row, colB) ((row) * 256 + ((colB) ^ (((row) & 7) << 4)))
#define SBAR() __builtin_amdgcn_sched_barrier(0)
__device__ __forceinline__ int crow(int r, int hi) { return (r & 3) + 8 * (r >> 2) + 4 * hi; }
__device__ __forceinline__ unsigned cvtpk(float lo, float hi) { unsigned r; asm volatile("v_cvt_pk_bf16_f32 %0, %1, %2" : "=v"(r) : "v"(lo), "v"(hi)); return r; }
__device__ __forceinline__ float max3f(float a, float b, float c) { float r; asm("v_max3_f32 %0, %1, %2, %3" : "=v"(r) : "v"(a), "v"(b), "v"(c)); return r; }
template <bool FIRST>
__device__ __forceinline__ void partialSM(f32x16& p0, f32x16& p1, float& m_reg, f32x16& negm, float& alpha) {
  float pa = max3f(p0[0], p0[1], p0[2]), pb = max3f(p1[0], p1[1], p1[2]);
#pragma unroll
  for (int r = 3; r < 15; r += 2) { pa = max3f(pa, p0[r], p0[r + 1]); pb = max3f(pb, p1[r], p1[r + 1]); }
  float pmax = max3f(pa, pb, fmaxf(p0[15], p1[15]));
  { auto rr = __builtin_amdgcn_permlane32_swap(__float_as_uint(pmax), __float_as_uint(pmax), false, false);
    pmax = fmaxf(__uint_as_float(rr[0]), __uint_as_float(rr[1])); }
  if (!FIRST && __builtin_expect(__all(pmax <= THR), 1)) { alpha = 1.f; }
  else { const float dl = FIRST ? pmax : fmaxf(pmax, 0.f); alpha = FIRST ? 1.f : __builtin_amdgcn_exp2f(-dl); m_reg += dl;
#pragma unroll
    for (int r = 0; r < 16; ++r) { p0[r] -= dl; p1[r] -= dl; }
#pragma unroll
    for (int r = 0; r < 16; ++r) negm[r] = -m_reg;
    asm volatile("" : "+v"(negm)); }
#pragma unroll
  for (int r = 0; r < 16; ++r) p0[r] = __builtin_amdgcn_exp2f(p0[r]);
}
__device__ __forceinline__ void finishSM(f32x16& p0, f32x16& p1, float alpha, float& l_reg, bf16x8& pa0, bf16x8& pa1, bf16x8& pa2, bf16x8& pa3) {
#pragma unroll
  for (int r = 0; r < 16; ++r) p1[r] = __builtin_amdgcn_exp2f(p1[r]);
  float ps = 0;
#pragma unroll
  for (int r = 0; r < 16; ++r) ps += p0[r];
#pragma unroll
  for (int r = 0; r < 16; ++r) ps += p1[r];
  { auto rr = __builtin_amdgcn_permlane32_swap(__float_as_uint(ps), __float_as_uint(ps), false, false);
    ps = __uint_as_float(rr[0]) + __uint_as_float(rr[1]); }
  l_reg = l_reg * alpha + ps;
#define PK4(P, BASE, OUT) do { unsigned a0 = cvtpk(P[BASE + 0], P[BASE + 1]), a1 = cvtpk(P[BASE + 2], P[BASE + 3]);   \
    unsigned b0 = cvtpk(P[BASE + 4], P[BASE + 5]), b1 = cvtpk(P[BASE + 6], P[BASE + 7]);                              \
    auto r0 = __builtin_amdgcn_permlane32_swap(a0, b0, false, false); auto r1 = __builtin_amdgcn_permlane32_swap(a1, b1, false, false); \
    u32x4 w = {r0[0], r1[0], r0[1], r1[1]}; OUT = *reinterpret_cast<bf16x8*>(&w); } while (0)
  PK4(p0, 0, pa0); PK4(p0, 8, pa1); PK4(p1, 0, pa2); PK4(p1, 8, pa3);
#undef PK4
}
__device__ __forceinline__ void qkt(f32x16& p0, f32x16& p1, const char* Ks, const bf16x8* qr, const f32x16& negm, int r32, int hi) {
#pragma unroll
  for (int d0 = 0; d0 < 6; ++d0) { const int cb = (d0 * 16 + hi * 8) * 2;
    const bf16x8 b0 = *reinterpret_cast<const bf16x8*>(Ks + KSWZ(r32, cb));
    const bf16x8 b1 = *reinterpret_cast<const bf16x8*>(Ks + KSWZ(32 + r32, cb));
    if (d0 == 0) { p0 = __builtin_amdgcn_mfma_f32_32x32x16_bf16(b0, qr[0], negm, 0, 0, 0); p1 = __builtin_amdgcn_mfma_f32_32x32x16_bf16(b1, qr[0], negm, 0, 0, 0); }
    else { p0 = __builtin_amdgcn_mfma_f32_32x32x16_bf16(b0, qr[d0], p0, 0, 0, 0); p1 = __builtin_amdgcn_mfma_f32_32x32x16_bf16(b1, qr[d0], p1, 0, 0, 0); } }
}
__device__ __forceinline__ int v_st(int k, int c) { const int kk = (k & ~0xC) | ((k & 4) << 1) | ((k & 8) >> 1); return ((kk >> 3) * 4 + (c >> 5)) * 512 + ((kk & 7) * 32 + (c & 31)) * 2; }
__device__ __forceinline__ int v_rd_base(int lane) { return ((lane & 3) << 3) | (((lane >> 2) & 3) << 6) | (((lane >> 4) & 1) << 5) | (((lane >> 5) & 1) << 8); }
constexpr int v_rd_off(int d0, int ks, int half) { return d0 * 512 + ks * 4096 + half * 2048; }
template <int OFF> __device__ __forceinline__ s16x4 tr_read(int vb) { s16x4 r; asm volatile("ds_read_b64_tr_b16 %0, %1 offset:%2" : "=&v"(r) : "v"(vb), "i"(OFF) : "memory"); return r; }
template <int D0> __device__ __forceinline__ void pv_one(f32x16& od, int vb, bf16x8 pa0, bf16x8 pa1, bf16x8 pa2, bf16x8 pa3) {
  const s16x4 l0 = tr_read<v_rd_off(D0, 0, 0)>(vb), h0 = tr_read<v_rd_off(D0, 0, 1)>(vb), l1 = tr_read<v_rd_off(D0, 1, 0)>(vb), h1 = tr_read<v_rd_off(D0, 1, 1)>(vb);
  const s16x4 l2 = tr_read<v_rd_off(D0, 2, 0)>(vb), h2 = tr_read<v_rd_off(D0, 2, 1)>(vb), l3 = tr_read<v_rd_off(D0, 3, 0)>(vb), h3 = tr_read<v_rd_off(D0, 3, 1)>(vb);
  asm volatile("s_waitcnt lgkmcnt(0)" ::: "memory"); SBAR();
#define PK(L, H) (bf16x8){L[0], L[1], L[2], L[3], H[0], H[1], H[2], H[3]}
  od = __builtin_amdgcn_mfma_f32_32x32x16_bf16(pa0, PK(l0, h0), od, 0, 0, 0);
  od = __builtin_amdgcn_mfma_f32_32x32x16_bf16(pa1, PK(l1, h1), od, 0, 0, 0);
  od = __builtin_amdgcn_mfma_f32_32x32x16_bf16(pa2, PK(l2, h2), od, 0, 0, 0);
  od = __builtin_amdgcn_mfma_f32_32x32x16_bf16(pa3, PK(l3, h3), od, 0, 0, 0);
#undef PK
}
__device__ __forceinline__ void pv_d0(f32x16* o, int vb, bf16x8 pa0, bf16x8 pa1, bf16x8 pa2, bf16x8 pa3) {
  const s16x4 l0 = tr_read<v_rd_off(0, 0, 0)>(vb), h0 = tr_read<v_rd_off(0, 0, 1)>(vb), l1 = tr_read<v_rd_off(0, 1, 0)>(vb), h1 = tr_read<v_rd_off(0, 1, 1)>(vb);
  const s16x4 l2 = tr_read<v_rd_off(0, 2, 0)>(vb), h2 = tr_read<v_rd_off(0, 2, 1)>(vb), l3 = tr_read<v_rd_off(0, 3, 0)>(vb), h3 = tr_read<v_rd_off(0, 3, 1)>(vb);
  const s16x4 m0 = tr_read<v_rd_off(1, 0, 0)>(vb), g0 = tr_read<v_rd_off(1, 0, 1)>(vb), m1 = tr_read<v_rd_off(1, 1, 0)>(vb), g1 = tr_read<v_rd_off(1, 1, 1)>(vb);
  const s16x4 m2 = tr_read<v_rd_off(1, 2, 0)>(vb), g2 = tr_read<v_rd_off(1, 2, 1)>(vb), m3 = tr_read<v_rd_off(1, 3, 0)>(vb), g3 = tr_read<v_rd_off(1, 3, 1)>(vb);
  asm volatile("s_waitcnt lgkmcnt(0)" ::: "memory"); SBAR();
#define PK(L, H) (bf16x8){L[0], L[1], L[2], L[3], H[0], H[1], H[2], H[3]}
  o[0] = __builtin_amdgcn_mfma_f32_32x32x16_bf16(pa0, PK(l0, h0), o[0], 0, 0, 0); o[1] = __builtin_amdgcn_mfma_f32_32x32x16_bf16(pa0, PK(m0, g0), o[1], 0, 0, 0);
  o[0] = __builtin_amdgcn_mfma_f32_32x32x16_bf16(pa1, PK(l1, h1), o[0], 0, 0, 0); o[1] = __builtin_amdgcn_mfma_f32_32x32x16_bf16(pa1, PK(m1, g1), o[1], 0, 0, 0);
  o[0] = __builtin_amdgcn_mfma_f32_32x32x16_bf16(pa2, PK(l2, h2), o[0], 0, 0, 0); o[1] = __builtin_amdgcn_mfma_f32_32x32x16_bf16(pa2, PK(m2, g2), o[1], 0, 0, 0);
  o[0] = __builtin_amdgcn_mfma_f32_32x32x16_bf16(pa3, PK(l3, h3), o[0], 0, 0, 0); o[1] = __builtin_amdgcn_mfma_f32_32x32x16_bf16(pa3, PK(m3, g3), o[1], 0, 0, 0);
#undef PK
}

__device__ __forceinline__ void attn_unit(const bf16_t* __restrict__ Qb, const bf16_t* __restrict__ KN, const bf16_t* __restrict__ KR, const bf16_t* __restrict__ VV, bf16_t* __restrict__ Ob, int b, char* lds, int tid) {
  const int wid = tid >> 6, lane = tid & 63, r32 = lane & 31, hi = lane >> 5;
  char* V_lds = lds; char* K_lds = lds + 3 * SHM_V;
  float* ws = (float*)(lds + 3 * SHM_V + 3 * SHM_K) + wid * 64; float* li_l = ws; float* al_l = ws + 32;
  float m_reg = 0.f, l_reg = 0; f32x16 o[2] = {}; bf16x8 qr[6]; f32x16 negm = {};
  const bf16_t* Qw = Qb + (long)(wid * QBLK + r32) * QW + hi * 8;
#pragma unroll
  for (int d0 = 0; d0 < 6; ++d0) qr[d0] = __builtin_nontemporal_load(reinterpret_cast<const bf16x8*>(Qw + d0 * 16));
  const int srow = tid >> 3, sch = tid & 7;
  const int rrow = (tid & 255) >> 2, rch = tid & 3;
  const int vst = v_st(srow, sch * 8), kst = KSWZ(srow, sch * 16), krst = KSWZ(rrow, 128 + rch * 16);
  const int vb0 = (int)(uintptr_t)V_lds + v_rd_base(lane);
  struct { bf16x8 vs, kn, kr; } sr_[2];
#define ROWBASE(j) ((j) < 64 ? (long)b * SEQ + (long)(j) * 64 : (long)RL + (long)b * LC + (long)((j) - 64) * 64)
#define SLOAD(i, j) do { const long rb_ = ROWBASE(j); sr_[i].vs = *reinterpret_cast<const bf16x8*>(VV + (rb_ + srow) * KVW + sch * 8); \
    sr_[i].kn = *reinterpret_cast<const bf16x8*>(KN + (rb_ + srow) * KVW + sch * 8); sr_[i].kr = *reinterpret_cast<const bf16x8*>(KR + (rb_ + rrow) * NPROJ + rch * 8); } while (0)
#define SWRITE(bb, i) do { *(bf16x8*)(V_lds + (bb) * SHM_V + vst) = sr_[i].vs; *(bf16x8*)(K_lds + (bb) * SHM_K + kst) = sr_[i].kn; \
    if (wid < 4) *(bf16x8*)(K_lds + (bb) * SHM_K + krst) = sr_[i].kr; } while (0)
#define SWAIT() asm volatile("s_waitcnt vmcnt(3)" ::: "memory")
#define RESC(a) do { if (__any((a) < 1.f)) { if (hi == 0) al_l[r32] = (a); asm volatile("s_waitcnt lgkmcnt(0)" ::: "memory"); \
    _Pragma("unroll") for (int d = 0; d < 2; ++d) _Pragma("unroll") for (int r = 0; r < 16; ++r) o[d][r] *= al_l[crow(r, hi)]; } } while (0)
  f32x16 pA0, pA1, pB0, pB1; float alA, alB; bf16x8 pa0, pa1, pa2, pa3; constexpr int NT = (SEQ + LC) / KVBLK;
  if (wid >= 4) __builtin_amdgcn_s_setprio(1);
  int cur = 1, prev = 0, nxt = 2;
  SLOAD(0, 0); SLOAD(1, 1); asm volatile("s_waitcnt vmcnt(0)" ::: "memory"); SWRITE(0, 0); SWRITE(1, 1); SLOAD(0, 2); SLOAD(1, 3); __syncthreads();
  qkt(pA0, pA1, K_lds, qr, negm, r32, hi); partialSM<true>(pA0, pA1, m_reg, negm, alA);
#define HALFSTEP(PX0, PX1, PP0, PP1, ALX, ALP, STG, T) do { \
    __syncthreads(); \
    SBAR(); qkt(PX0, PX1, K_lds + cur * SHM_K, qr, negm, r32, hi); \
    finishSM(PP0, PP1, ALP, l_reg, pa0, pa1, pa2, pa3); SBAR(); \
    if ((T) + 1 < NT) { SWAIT(); SWRITE(nxt, STG); if ((T) + 3 < NT) SLOAD(STG, (T) + 3); } SBAR(); \
    pv_d0(o, vb0 + prev * SHM_V, pa0, pa1, pa2, pa3); partialSM<false>(PX0, PX1, m_reg, negm, ALX); \
    RESC(ALX); { const int t_ = prev; prev = cur; cur = nxt; nxt = t_; } } while (0)
  for (int t = 1; t + 1 < NT; t += 2) {
    HALFSTEP(pB0, pB1, pA0, pA1, alB, alA, 0, t);
    HALFSTEP(pA0, pA1, pB0, pB1, alA, alB, 1, t + 1);
  }
  HALFSTEP(pB0, pB1, pA0, pA1, alB, alA, 0, NT - 1);
  finishSM(pB0, pB1, alB, l_reg, pa0, pa1, pa2, pa3); SBAR();
  pv_d0(o, vb0 + prev * SHM_V, pa0, pa1, pa2, pa3);
#undef HALFSTEP
  if (hi == 0) li_l[r32] = l_reg; asm volatile("s_waitcnt lgkmcnt(0)" ::: "memory");
  float rli[16];
#pragma unroll
  for (int r = 0; r < 16; ++r) rli[r] = __builtin_amdgcn_rcpf(li_l[crow(r, hi)]);
  bf16_t* Ow = Ob + (long)(wid * QBLK) * D;
#pragma unroll
  for (int r = 0; r < 16; ++r) { const int orow = crow(r, hi);
#pragma unroll
    for (int d0 = 0; d0 < 2; ++d0) Ow[(long)orow * D + d0 * 32 + r32] = f2bf(o[d0][r] * rli[r]); }
  __builtin_amdgcn_s_setprio(0);
  __syncthreads();
#undef ROWBASE
#undef SLOAD
#undef SWRITE
#undef SWAIT
#undef RESC
}
#undef KSWZ
#undef SBAR
}


__device__ __forceinline__ float lg2_of(float e) { return log1pf(-exp2f(-e)) * 1.4426950408889634f; }
namespace ret {
using att::bf16x8; using att::s16x4; using att::f32x16; using att::v_st; using att::v_rd_base; using att::v_rd_off; using att::tr_read; using att::crow; using att::cvtpk;
constexpr int TB = 16384;
__device__ __forceinline__ bf16x8 scale8(bf16x8 x, float z) {
    const u32x4 w = __builtin_bit_cast(u32x4, x); u32x4 o;
    o.x = cvtpk(__uint_as_float(w.x << 16) * z, __uint_as_float(w.x & 0xffff0000u) * z); o.y = cvtpk(__uint_as_float(w.y << 16) * z, __uint_as_float(w.y & 0xffff0000u) * z);
    o.z = cvtpk(__uint_as_float(w.z << 16) * z, __uint_as_float(w.z & 0xffff0000u) * z); o.w = cvtpk(__uint_as_float(w.w << 16) * z, __uint_as_float(w.w & 0xffff0000u) * z);
    return __builtin_bit_cast(bf16x8, o);
}
#define RET_PK(L, H) (bf16x8){L[0], L[1], L[2], L[3], H[0], H[1], H[2], H[3]}
__device__ __forceinline__ void tt_mma(f32x16& acc, int va, int vb) {
    const s16x4 al0 = tr_read<v_rd_off(0, 0, 0)>(va), ah0 = tr_read<v_rd_off(0, 0, 1)>(va), al1 = tr_read<v_rd_off(0, 1, 0)>(va), ah1 = tr_read<v_rd_off(0, 1, 1)>(va);
    const s16x4 al2 = tr_read<v_rd_off(0, 2, 0)>(va), ah2 = tr_read<v_rd_off(0, 2, 1)>(va), al3 = tr_read<v_rd_off(0, 3, 0)>(va), ah3 = tr_read<v_rd_off(0, 3, 1)>(va);
    const s16x4 bl0 = tr_read<v_rd_off(0, 0, 0)>(vb), bh0 = tr_read<v_rd_off(0, 0, 1)>(vb), bl1 = tr_read<v_rd_off(0, 1, 0)>(vb), bh1 = tr_read<v_rd_off(0, 1, 1)>(vb);
    const s16x4 bl2 = tr_read<v_rd_off(0, 2, 0)>(vb), bh2 = tr_read<v_rd_off(0, 2, 1)>(vb), bl3 = tr_read<v_rd_off(0, 3, 0)>(vb), bh3 = tr_read<v_rd_off(0, 3, 1)>(vb);
    asm volatile("s_waitcnt lgkmcnt(0)" ::: "memory"); __builtin_amdgcn_sched_barrier(0);
    acc = __builtin_amdgcn_mfma_f32_32x32x16_bf16(RET_PK(al0, ah0), RET_PK(bl0, bh0), acc, 0, 0, 0);
    acc = __builtin_amdgcn_mfma_f32_32x32x16_bf16(RET_PK(al1, ah1), RET_PK(bl1, bh1), acc, 0, 0, 0);
    acc = __builtin_amdgcn_mfma_f32_32x32x16_bf16(RET_PK(al2, ah2), RET_PK(bl2, bh2), acc, 0, 0, 0);
    acc = __builtin_amdgcn_mfma_f32_32x32x16_bf16(RET_PK(al3, ah3), RET_PK(bl3, bh3), acc, 0, 0, 0);
}
__device__ __forceinline__ void scan_seq(const bf16_t* __restrict__ proj, bf16_t* __restrict__ rstT, int b, int h, int dir, float lg2, char* lds, int tid) {
    const int wid = tid >> 6, lane = tid & 63, r32 = lane & 31, hi = lane >> 5;
    const float g128 = __builtin_amdgcn_exp2f(lg2 * 128.f);
    const int key0 = tid >> 3, key1 = 64 + (tid >> 3), ch = tid & 7;
    const float z0 = __builtin_amdgcn_exp2f(lg2 * (float)(dir ? key0 : 127 - key0)), z1 = __builtin_amdgcn_exp2f(lg2 * (float)(dir ? key1 : 127 - key1));
    const int st = v_st(tid >> 3, ch * 8);
    char* KI = lds; char* VI = lds + 4 * TB;
    const int mt = (wid >> 1) & 1, nt = wid & 1;
    const int vaK = (int)(uintptr_t)KI + v_rd_base(lane) + mt * 512, vbV = (int)(uintptr_t)VI + v_rd_base(lane) + nt * 512;
    f32x16 acc = {};
    bf16x8 k0a, k1a, v0a, v1a, k0b, k1b, v0b, v1b, k0c, k1c, v0c, v1c, k0d, k1d, v0d, v1d;
#define RROW(ck) ((ck) < 2 ? (long)RL + (long)b * LC + (long)(dir ? 1 - (ck) : (ck)) * 128 : (long)b * SEQ + (long)(dir ? NCH - 1 - ((ck) - 2) : (ck) - 2) * 128)
#define RLOAD(S, ck) do { const bf16_t* p_ = proj + RROW(ck) * NPROJ + h * 64 + ch * 8; k0##S = *(const bf16x8*)(p_ + (long)key0 * NPROJ + PC_RK); k1##S = *(const bf16x8*)(p_ + (long)key1 * NPROJ + PC_RK); \
        v0##S = *(const bf16x8*)(p_ + (long)key0 * NPROJ + PC_RV); v1##S = *(const bf16x8*)(p_ + (long)key1 * NPROJ + PC_RV); } while (0)
#define RWRITE(S, bb) do { *(bf16x8*)(KI + ((bb) * 2 + 0) * TB + st) = scale8(k0##S, z0); *(bf16x8*)(KI + ((bb) * 2 + 1) * TB + st) = scale8(k1##S, z1); \
        *(bf16x8*)(VI + ((bb) * 2 + 0) * TB + st) = v0##S; *(bf16x8*)(VI + ((bb) * 2 + 1) * TB + st) = v1##S; } while (0)
#define RCOMP(ck, bb) do { if (wid < 4) { \
            if ((ck) >= 2) { const int n = dir ? NCH - 1 - ((ck) - 2) : (ck) - 2; bf16_t* o = rstT + (size_t)n * 4096 + (size_t)(32 * nt + r32) * 64 + 32 * mt + 4 * hi; \
                _Pragma("unroll") for (int g = 0; g < 4; ++g) { u32x2 w; w.x = cvtpk(acc[4 * g], acc[4 * g + 1]); w.y = cvtpk(acc[4 * g + 2], acc[4 * g + 3]); *(u32x2*)(o + 8 * g) = w; } } \
            _Pragma("unroll") for (int r = 0; r < 16; ++r) acc[r] *= g128; \
            tt_mma(acc, vaK + ((bb) * 2 + 0) * TB, vbV + ((bb) * 2 + 0) * TB); \
            tt_mma(acc, vaK + ((bb) * 2 + 1) * TB, vbV + ((bb) * 2 + 1) * TB); } } while (0)
    constexpr int NCK = 2 + NCH;
#define RSTEP(ck, S) do { RCOMP(ck, (ck) & 1); if ((ck) + 1 < NCK) { RWRITE(S, ((ck) + 1) & 1); } if ((ck) + 5 < NCK) RLOAD(S, (ck) + 5); __syncthreads(); } while (0)
    __syncthreads();
    RLOAD(a, 0); RWRITE(a, 0); RLOAD(b, 1); RLOAD(c, 2); RLOAD(d, 3); RLOAD(a, 4); __syncthreads();
    for (int ck = 0; ck < 32; ck += 4) { RSTEP(ck, b); RSTEP(ck + 1, c); RSTEP(ck + 2, d); RSTEP(ck + 3, a); }
    RSTEP(32, b); RSTEP(33, c);
#undef RSTEP
#undef RCOMP
#undef RROW
#undef RLOAD
#undef RWRITE
}

__device__ __forceinline__ int vc_st(int k, int c) { const int kk = (k & ~0xC) | ((k & 4) << 1) | ((k & 8) >> 1); return ((kk >> 3) * 2 + (c >> 5)) * 512 + ((kk & 7) * 32 + (c & 31)) * 2; }
constexpr int vc_rd_off(int ks, int half) { return ks * 2048 + half * 1024; }
constexpr int RBUF = 32768;
struct RetUnit { int b, h, n; };
template <class UF>
__device__ __forceinline__ void ret_group(const bf16_t* __restrict__ proj, const bf16_t* __restrict__ rst, const float* __restrict__ g_ret, const float* __restrict__ exp_f, const float* __restrict__ exp_b,
                                          bf16_t* __restrict__ mix, int nunits, UF unit_of, char* gl, int t4, int w4, int lane) {
    const int r32 = lane & 31, hi = lane >> 5, i = 32 * w4 + r32;
    bf16x8 qn[4];
    int soff[8];
#pragma unroll
    for (int q_ = 0; q_ < 8; ++q_) { const int s_ = ((4 * q_ + w4) * 64 + lane) & 1023;
        if (q_ < 4) { const int img = s_ >> 9, sub = (s_ & 511) >> 5, rw = (s_ & 31) >> 2, cc = s_ & 3; const int kk = (sub >> 1) * 8 + rw, key = (kk & ~0xC) | ((kk & 4) << 1) | ((kk & 8) >> 1);
            soff[q_] = (img * 64 + key) * NPROJ + PC_RV + (sub & 1) * 32 + cc * 8; }
        else { const int row = s_ >> 3, cp = s_ & 7, chn = cp ^ ((row >> 1) & 7); soff[q_] = row * NPROJ + PC_RK + chn * 8; } }
#define RG_LOAD(u, bb) do { const bf16_t* base_ = proj + ((long)(u).b * SEQ + (long)(u).n * 128) * NPROJ + (u).h * 64; \
        _Pragma("unroll") for (int q_ = 0; q_ < 8; ++q_) __builtin_amdgcn_global_load_lds((const unsigned*)(base_ + soff[q_]), (LAS unsigned*)((LAS char*)gl + (bb) * RBUF + (4 * q_ + w4) * 1024), 16, 0, 0); \
        const bf16_t* qp_ = base_ + (long)i * NPROJ + PC_RQ + hi * 8; \
        _Pragma("unroll") for (int ks_ = 0; ks_ < 4; ++ks_) qn[ks_] = *(const bf16x8*)(qp_ + ks_ * 16); } while (0)
    RetUnit u = unit_of(0);
    RG_LOAD(u, 0);
    bf16x8 q[4];
#pragma unroll
    for (int ks = 0; ks < 4; ++ks) q[ks] = qn[ks];
    asm volatile("s_waitcnt vmcnt(0)" ::: "memory"); __syncthreads();
    for (int ui = 0; ui < nunits; ++ui) {
        const int bb = ui & 1; const RetUnit un = unit_of(ui + 1 < nunits ? ui + 1 : ui);
        if (ui + 1 < nunits) RG_LOAD(un, bb ^ 1);
        const float lf = lg2_of(exp_f[u.h]), lb = lg2_of(exp_b[u.h]);
        int io = i, hio = hi; asm volatile("" : "+v"(io), "+v"(hio));
        const long row0 = (long)u.b * SEQ + (long)u.n * 128;
        const bf16_t* rf = rst + (size_t)(((u.b * NH + u.h) * 2 + 0) * NCH + u.n) * 4096 + (size_t)r32 * 64 + hi * 8;
        const bf16_t* rb = rst + (size_t)(((u.b * NH + u.h) * 2 + 1) * NCH + u.n) * 4096 + (size_t)r32 * 64 + hi * 8;
        bf16x8 rff[2][4], rbf[2][4];
#pragma unroll
        for (int et = 0; et < 2; ++et)
#pragma unroll
            for (int ks = 0; ks < 4; ++ks) { rff[et][ks] = *(const bf16x8*)(rf + et * 2048 + ks * 16); rbf[et][ks] = *(const bf16x8*)(rb + et * 2048 + ks * 16); }
        f32x16 acc[2] = {f32x16{}, f32x16{}};
        const char* kt = gl + bb * RBUF + 16384; const int vimg0 = (int)(uintptr_t)(gl + bb * RBUF) + v_rd_base(lane);
#pragma unroll
        for (int t = 0; t < 4; ++t) {
            f32x16 p = {};
            const int krow = 32 * t + r32;
#pragma unroll
            for (int ks = 0; ks < 4; ++ks) { const bf16x8 kf = *(const bf16x8*)(kt + krow * 128 + (((2 * ks + hi) ^ ((krow >> 1) & 7)) << 4)); p = __builtin_amdgcn_mfma_f32_32x32x16_bf16(kf, q[ks], p, 0, 0, 0); }
#pragma unroll
            for (int r = 0; r < 16; ++r) { const int j = 32 * t + (r & 3) + 8 * (r >> 2) + 4 * hio; const int dd = io - j; p[r] *= __builtin_amdgcn_exp2f(dd >= 0 ? lf * (float)dd : lb * (float)(-dd)); }
            bf16x8 pa0, pa1;
#define PK4(P, BASE, OUT) do { unsigned a0 = cvtpk(P[BASE + 0], P[BASE + 1]), a1 = cvtpk(P[BASE + 2], P[BASE + 3]);   \
    unsigned b0 = cvtpk(P[BASE + 4], P[BASE + 5]), b1 = cvtpk(P[BASE + 6], P[BASE + 7]);                              \
    auto r0 = __builtin_amdgcn_permlane32_swap(a0, b0, false, false); auto r1 = __builtin_amdgcn_permlane32_swap(a1, b1, false, false); \
    u32x4 w = {r0[0], r1[0], r0[1], r1[1]}; OUT = *reinterpret_cast<bf16x8*>(&w); } while (0)
            PK4(p, 0, pa0); PK4(p, 8, pa1);
#undef PK4
            const int vimg = vimg0 + (t >> 1) * 8192;
#pragma unroll
            for (int et = 0; et < 2; ++et) {
                s16x4 l0, h0, l1, h1;
                if ((t & 1) == 0) { l0 = tr_read<vc_rd_off(0, 0)>(vimg + et * 512); h0 = tr_read<vc_rd_off(0, 1)>(vimg + et * 512); l1 = tr_read<vc_rd_off(1, 0)>(vimg + et * 512); h1 = tr_read<vc_rd_off(1, 1)>(vimg + et * 512); }
                else { l0 = tr_read<vc_rd_off(2, 0)>(vimg + et * 512); h0 = tr_read<vc_rd_off(2, 1)>(vimg + et * 512); l1 = tr_read<vc_rd_off(3, 0)>(vimg + et * 512); h1 = tr_read<vc_rd_off(3, 1)>(vimg + et * 512); }
                asm volatile("s_waitcnt lgkmcnt(0)" ::: "memory"); __builtin_amdgcn_sched_barrier(0);
                acc[et] = __builtin_amdgcn_mfma_f32_32x32x16_bf16(RET_PK(l0, h0), pa0, acc[et], 0, 0, 0);
                acc[et] = __builtin_amdgcn_mfma_f32_32x32x16_bf16(RET_PK(l1, h1), pa1, acc[et], 0, 0, 0);
            }
            asm volatile("" ::: "memory");
        }
        const float xf = __builtin_amdgcn_exp2f(lf * (float)(i + 1)), xb = __builtin_amdgcn_exp2f(lb * (float)(128 - i));
        const bf16_t* gp = proj + (row0 + i) * NPROJ + PC_RG + u.h * 64; bf16_t* op = mix + (row0 + i) * D + 512 + u.h * 64; const float* gr = g_ret + u.h * 64;
        u32x2 gwv[2][4];
#pragma unroll
        for (int et = 0; et < 2; ++et)
#pragma unroll
            for (int g = 0; g < 4; ++g) gwv[et][g] = *(const u32x2*)(gp + 32 * et + 8 * g + 4 * hi);
        bf16x8 qf[4], qbk[4];
#pragma unroll
        for (int ks = 0; ks < 4; ++ks) { qf[ks] = scale8(q[ks], xf); qbk[ks] = scale8(q[ks], xb); }
#pragma unroll
        for (int et = 0; et < 2; ++et) {
#pragma unroll
            for (int ks = 0; ks < 4; ++ks) acc[et] = __builtin_amdgcn_mfma_f32_32x32x16_bf16(rff[et][ks], qf[ks], acc[et], 0, 0, 0);
#pragma unroll
            for (int ks = 0; ks < 4; ++ks) acc[et] = __builtin_amdgcn_mfma_f32_32x32x16_bf16(rbf[et][ks], qbk[ks], acc[et], 0, 0, 0); }
        float s1 = 0.f;
#pragma unroll
        for (int et = 0; et < 2; ++et)
#pragma unroll
            for (int r = 0; r < 16; ++r) s1 += acc[et][r];
        { auto rr = __builtin_amdgcn_permlane32_swap(__float_as_uint(s1), __float_as_uint(s1), false, false); s1 = __uint_as_float(rr[0]) + __uint_as_float(rr[1]); }
        const float mu = s1 * (1.f / 64.f); float s2 = 0.f;
#pragma unroll
        for (int et = 0; et < 2; ++et)
#pragma unroll
            for (int r = 0; r < 16; ++r) { const float dlt = acc[et][r] - mu; s2 += dlt * dlt; }
        { auto rr = __builtin_amdgcn_permlane32_swap(__float_as_uint(s2), __float_as_uint(s2), false, false); s2 = __uint_as_float(rr[0]) + __uint_as_float(rr[1]); }
        const float rs = 1.f / sqrtf(s2 * (1.f / 64.f) + EPS);
#pragma unroll
        for (int et = 0; et < 2; ++et)
#pragma unroll
            for (int g = 0; g < 4; ++g) { const int e = 32 * et + 8 * g + 4 * hi; const u32x2 gw = gwv[et][g]; const f32x4 gg = *(const f32x4*)(gr + e);
                const float o0 = (acc[et][4 * g] - mu) * rs * gg.x * __uint_as_float(gw.x << 16), o1 = (acc[et][4 * g + 1] - mu) * rs * gg.y * __uint_as_float(gw.x & 0xffff0000u);
                const float o2 = (acc[et][4 * g + 2] - mu) * rs * gg.z * __uint_as_float(gw.y << 16), o3 = (acc[et][4 * g + 3] - mu) * rs * gg.w * __uint_as_float(gw.y & 0xffff0000u);
                u32x2 w; w.x = cvtpk(o0, o1); w.y = cvtpk(o2, o3); *(u32x2*)(op + e) = w; }
        if (ui + 1 < nunits) {
#pragma unroll
            for (int ks = 0; ks < 4; ++ks) q[ks] = qn[ks]; }
        u = un;
        asm volatile("s_waitcnt vmcnt(0)" ::: "memory"); __syncthreads();
    }
#undef RG_LOAD
}
#undef RET_PK
}

__device__ __forceinline__ void p4_attn(const Ctx& c, float* lds) {
    const int G = (int)gridDim.x, bx = (int)blockIdx.x; const int vcu = (G % 8 == 0) ? (bx % 8) * (G / 8) + bx / 8 : bx;
    for (int unit = vcu; unit < NB * NH * 16; unit += G) {
        const int qblk = unit & 15, h = (unit >> 4) & 7, b = unit >> 7;
        att::attn_unit(c.qb() + (size_t)(b * SEQ + qblk * 256) * QW + h * 96, c.kvb() + h * 128, c.proj() + PC_KR, c.kvb() + h * 128 + 64,
                       c.mix() + (size_t)(b * SEQ + qblk * 256) * D + h * 64, b, (char*)lds, c.tid);
    }
}
__device__ __forceinline__ void p3c_scan(const Ctx& c, float* lds) {
    const int bx = (int)blockIdx.x;
    for (int seq = bx >> 1; seq < NB * NH * 2 && (bx & 1) == 0; seq += (int)gridDim.x >> 1) {
        const int dir = seq & 1, h = (seq >> 1) & 7, b = seq >> 4;
        const float lg2 = lg2_of(dir ? c.exp_b()[h] : c.exp_f()[h]);
        ret::scan_seq(c.proj(), c.rst() + (size_t)((b * NH + h) * 2 + dir) * NCH * 4096, b, h, dir, lg2, (char*)lds, c.tid);
    }
    __syncthreads();
    { const int G = (int)gridDim.x; const int first = G == 256 ? QSTATIC : 0;
      for (int q = first + (G == 256 ? (bx >> 1) : bx); q < GU_STRIPS && (G != 256 || (bx & 1)); q += (G == 256 ? 128 : G)) gu_strip_i8(c, lds, q); }
    __syncthreads();
    p0_weights<1>(c, lds, 0, 1);
    __syncthreads();
}
__device__ __forceinline__ void p4_ret(const Ctx& c, float* lds) {
    const int tid = c.tid, wid = tid >> 6, lane = tid & 63, grp = wid >> 2, w4 = wid & 3;
    const int G = (int)gridDim.x, bx = (int)blockIdx.x; const int vcu = (G % 8 == 0) ? (bx % 8) * (G / 8) + bx / 8 : bx;
    const int gid = vcu * 2 + grp, ngrp = 2 * G; const int total = NB * NH * NCH;
    const int nun = (total - gid + ngrp - 1) / ngrp;
    __syncthreads();
    ret::ret_group(c.proj(), c.rst(), c.g_ret(), c.exp_f(), c.exp_b(), c.mix(), nun,
                   [gid, ngrp](int k) { const int unit = gid + ngrp * k; return ret::RetUnit{unit >> 8, (unit >> 5) & 7, unit & 31}; }, (char*)lds + grp * 2 * ret::RBUF, tid & 255, w4, lane);
}

struct EpiRes {
    static constexpr bool PERM = true;
    const float* x; bf16_t* out; const float* modv; float* part;
    __device__ __forceinline__ void operator()(const f32x4 (&acc)[2][2][4][2], const pg8::Unit& u, int wr, int wc, int fr, int fq) const {
        const int row0 = u.pm * 256 + wr * 64 + fr, col0 = u.pn * 256 + wc * 32 + 8 * fq; const int b = (u.pm * 256) / SEQ;
        f32x4 ga[2][2];
#pragma unroll
        for (int bj = 0; bj < 2; ++bj) { ga[bj][0] = *(const f32x4*)(modv + b * 6144 + 2048 + col0 + bj * 128); ga[bj][1] = *(const f32x4*)(modv + b * 6144 + 2048 + col0 + bj * 128 + 4); }
#pragma unroll
        for (int ai = 0; ai < 2; ++ai) {
            f32x4 xv[4][2][2];
#pragma unroll
            for (int m = 0; m < 4; ++m)
#pragma unroll
                for (int bj = 0; bj < 2; ++bj) { const float* xr = x + (size_t)(row0 + ai * 128 + m * 16) * D + col0 + bj * 128; xv[m][bj][0] = __builtin_nontemporal_load((const f32x4*)xr); xv[m][bj][1] = __builtin_nontemporal_load((const f32x4*)(xr + 4)); }
#pragma unroll
            for (int m = 0; m < 4; ++m) { float ssq = 0.f, mx = 0.f;
#pragma unroll
                for (int bj = 0; bj < 2; ++bj) { const f32x4 y0 = xv[m][bj][0] + ga[bj][0] * acc[ai][bj][m][0], y1 = xv[m][bj][1] + ga[bj][1] * acc[ai][bj][m][1];
                    const float o[8] = {y0.x, y0.y, y0.z, y0.w, y1.x, y1.y, y1.z, y1.w}; store8_bf16(out + (size_t)(row0 + ai * 128 + m * 16) * D + col0 + bj * 128, o);
                    const f32x4 tm = __builtin_elementwise_max(__builtin_elementwise_abs(y0), __builtin_elementwise_abs(y1)), sq = y0 * y0 + y1 * y1;
                    ssq += (sq.x + sq.y) + (sq.z + sq.w); mx = fmaxf(mx, fmaxf(fmaxf(tm.x, tm.y), fmaxf(tm.z, tm.w))); }
                ssq += __shfl_xor(ssq, 16); ssq += __shfl_xor(ssq, 32); mx = fmaxf(mx, __shfl_xor(mx, 16)); mx = fmaxf(mx, __shfl_xor(mx, 32));
                if (fq == 0) { float* pp = part + (size_t)(row0 + ai * 128 + m * 16) * 32 + u.pn * 4 + wc; pp[0] = ssq; pp[16] = mx; } }
            asm volatile("" ::: "memory");
        }
    }
};
__device__ __forceinline__ void p6_wo(const Ctx& c, float* lds) {
    pg8::Gemm g{c.mix(), c.wo_t(), D, D, D, nullptr, 0, 0, 0};
    pg8::StaticOrder S; S.init(RL, D, (int)gridDim.x, (int)blockIdx.x);
    EpiRes E{c.x(), c.x1b(), c.modv(), c.rpart()};
    pg8::gemm_phase((LAS unsigned char*)lds, g, S, E, c.tid);
}
__device__ __forceinline__ void p7_norm_router(const Ctx& c, float* lds) {
    typedef short bf16x8_t __attribute__((ext_vector_type(8)));
    constexpr int WP = 1032;
    bf16_t* whi = (bf16_t*)lds; bf16_t* wlo = whi + 16 * WP; float* gsl = (float*)(wlo + 16 * WP); float* shl = gsl + 1024; float* gpl = shl + 1024;
    const int G = (int)gridDim.x, bx = (int)blockIdx.x;
    __syncthreads();
    for (int i = c.tid; i < 1024 * 16; i += 512) { const int k = i >> 4, e = i & 15; const float w = c.w_router()[i]; const bf16_t h = f2bf(w); whi[e * WP + k] = h; wlo[e * WP + k] = f2bf(w - bf2f(h)); }
    for (int blk = bx; blk < RL / 128; blk += G) {
        const int b = (blk * 128) / SEQ; const float* md = c.modv() + b * 6144;
        __syncthreads();
        for (int k = c.tid; k < 1024; k += 512) { gsl[k] = c.g_ffn()[k] * (1.f + md[4096 + k]); shl[k] = md[3072 + k]; }
        __syncthreads();
        if (c.tid < 16) { float gm = 0.f; const int c0_ = (c.tid >> 2) * 256 + (c.tid & 3) * 32;
            for (int k = 0; k < 32; ++k) gm = fmaxf(gm, fmaxf(fabsf(gsl[c0_ + k]), fabsf(gsl[c0_ + 128 + k])));
            gpl[c.tid] = gm; }
        __syncthreads();
        const int fr = c.lane & 15, fq = c.lane >> 4; const int row = blk * 128 + c.wave * 16 + fr;
        const bf16_t* xr = c.x1b() + (size_t)row * D + 8 * fq;
        const LAS float* gs_l = (const LAS float*)gsl; const LAS float* sh_l = (const LAS float*)shl;
        float shm = 0.f;
#pragma unroll
        for (int i = 0; i < 4; ++i) { const f32x4 s4 = *(const LAS f32x4*)(sh_l + 4 * c.lane + 256 * i); shm = fmaxf(fmaxf(shm, fmaxf(fabsf(s4.x), fabsf(s4.y))), fmaxf(fabsf(s4.z), fabsf(s4.w))); }
#pragma unroll
        for (int o = 1; o < 64; o <<= 1) shm = fmaxf(shm, __shfl_xor(shm, o));
        const f32x4 ps = *(const f32x4*)(c.rpart() + (size_t)row * 32 + 4 * fq), pm4 = *(const f32x4*)(c.rpart() + (size_t)row * 32 + 16 + 4 * fq);
        float ss = (ps.x + ps.y) + (ps.z + ps.w), mx; { const f32x4 gq = *(const LAS f32x4*)((const LAS float*)gpl + 4 * fq); mx = fmaxf(fmaxf(pm4.x * gq.x, pm4.y * gq.y), fmaxf(pm4.z * gq.z, pm4.w * gq.w)) * 1.00390625f; }
        ss += __shfl_xor(ss, 16); ss += __shfl_xor(ss, 32); mx = fmaxf(mx, __shfl_xor(mx, 16)); mx = fmaxf(mx, __shfl_xor(mx, 32));
        const float rinv = 1.f / sqrtf(ss * (1.f / D) + EPS);
        const float bnd = fmaxf(rinv * mx + shm, 1e-30f), qs = 127.f / bnd;
        if (fq == 0) c.sa()[row] = bnd * (1.f / 127.f);
        f32x4 acc = {0.f, 0.f, 0.f, 0.f};
        const LAS bf16_t* wh_l = (const LAS bf16_t*)whi + fr * WP + 16 * fq; const LAS bf16_t* wl_l = (const LAS bf16_t*)wlo + fr * WP + 16 * fq;
        const bf16_t* xr2 = c.x1b() + (size_t)row * D + 16 * fq; signed char* hq = c.h2q() + (size_t)row * D + 16 * fq;
#pragma unroll 2
        for (int ks2 = 0; ks2 < 16; ++ks2) { u32x4 qo;
#pragma unroll
            for (int hf = 0; hf < 2; ++hf) { const int ko = 64 * ks2 + 8 * hf; const u32x4 w = *(const u32x4*)(xr2 + ko);
                const f32x4 g0 = *(const LAS f32x4*)(gs_l + 16 * fq + ko), g1 = *(const LAS f32x4*)(gs_l + 16 * fq + ko + 4), s0 = *(const LAS f32x4*)(sh_l + 16 * fq + ko), s1 = *(const LAS f32x4*)(sh_l + 16 * fq + ko + 4);
                float h[8];
                h[0] = __uint_as_float(w.x << 16) * rinv * g0.x + s0.x; h[1] = __uint_as_float(w.x & 0xffff0000u) * rinv * g0.y + s0.y; h[2] = __uint_as_float(w.y << 16) * rinv * g0.z + s0.z; h[3] = __uint_as_float(w.y & 0xffff0000u) * rinv * g0.w + s0.w;
                h[4] = __uint_as_float(w.z << 16) * rinv * g1.x + s1.x; h[5] = __uint_as_float(w.z & 0xffff0000u) * rinv * g1.y + s1.y; h[6] = __uint_as_float(w.w << 16) * rinv * g1.z + s1.z; h[7] = __uint_as_float(w.w & 0xffff0000u) * rinv * g1.w + s1.w;
                const unsigned qa = q8pack(h[0], h[1], h[2], h[3], qs), qb = q8pack(h[4], h[5], h[6], h[7], qs);
                if (hf == 0) { qo.x = qa; qo.y = qb; } else { qo.z = qa; qo.w = qb; }
                u32x4 hi; hi.x = pk2(h[0], h[1]); hi.y = pk2(h[2], h[3]); hi.z = pk2(h[4], h[5]); hi.w = pk2(h[6], h[7]);
                u32x4 lo; lo.x = pk2(h[0] - __uint_as_float(hi.x << 16), h[1] - __uint_as_float(hi.x & 0xffff0000u)); lo.y = pk2(h[2] - __uint_as_float(hi.y << 16), h[3] - __uint_as_float(hi.y & 0xffff0000u));
                lo.z = pk2(h[4] - __uint_as_float(hi.z << 16), h[5] - __uint_as_float(hi.z & 0xffff0000u)); lo.w = pk2(h[6] - __uint_as_float(hi.w << 16), h[7] - __uint_as_float(hi.w & 0xffff0000u));
                const bf16x8_t bh = *(const LAS bf16x8_t*)(wh_l + ko), bl = *(const LAS bf16x8_t*)(wl_l + ko);
                const bf16x8_t ah = __builtin_bit_cast(bf16x8_t, hi), al = __builtin_bit_cast(bf16x8_t, lo);
                acc = __builtin_amdgcn_mfma_f32_16x16x32_bf16(ah, bh, acc, 0, 0, 0);
                acc = __builtin_amdgcn_mfma_f32_16x16x32_bf16(al, bh, acc, 0, 0, 0);
                acc = __builtin_amdgcn_mfma_f32_16x16x32_bf16(ah, bl, acc, 0, 0, 0); }
            *(u32x4*)(hq + 64 * ks2) = qo; }
        float ov[4];
#pragma unroll
        for (int i = 0; i < 4; ++i) { float mx = acc[i];
            mx = fmaxf(mx, __shfl_xor(mx, 1)); mx = fmaxf(mx, __shfl_xor(mx, 2)); mx = fmaxf(mx, __shfl_xor(mx, 4)); mx = fmaxf(mx, __shfl_xor(mx, 8));
            const float ex = __expf(acc[i] - mx); float den = ex;
            den += __shfl_xor(den, 1); den += __shfl_xor(den, 2); den += __shfl_xor(den, 4); den += __shfl_xor(den, 8);
            ov[i] = ex / den; }
        const int t0 = (blk * 128 + c.wave * 16 + 4 * fq) & (SEQ - 1);
        *(f32x4*)(c.aff() + (size_t)(b * NE + fr) * SEQ + t0) = (f32x4){ov[0], ov[1], ov[2], ov[3]};
    }
}
__device__ __forceinline__ int block_excl_scan(int v, int& tot, int* lw, int tid) {
    const int lane = tid & 63, wv = tid >> 6; int inc = v;
#pragma unroll
    for (int o = 1; o < 64; o <<= 1) { const int u = __shfl_up(inc, o); if (lane >= o) inc += u; }
    __syncthreads();
    if (lane == 63) lw[wv] = inc;
    __syncthreads();
    int base = 0; tot = 0;
#pragma unroll
    for (int w = 0; w < 8; ++w) { const int x = lw[w]; if (w < wv) base += x; tot += x; }
    return base + inc - v;
}
__device__ __forceinline__ void p8_topk(const Ctx& c, float* lds) {
    int* cnt = (int*)lds;
    int* lw = (int*)lds + 64;
    for (int unit = blockIdx.x; unit < NB * NE; unit += gridDim.x) {
        const int b = unit >> 4, e = unit & 15; const float* a = c.aff() + (size_t)unit * SEQ;
        const f32x4 v0 = *(const f32x4*)(a + 8 * c.tid), v1 = *(const f32x4*)(a + 8 * c.tid + 4);
        unsigned u[8] = {__float_as_uint(v0.x), __float_as_uint(v0.y), __float_as_uint(v0.z), __float_as_uint(v0.w), __float_as_uint(v1.x), __float_as_uint(v1.y), __float_as_uint(v1.z), __float_as_uint(v1.w)};
        __syncthreads();
        if (c.tid < 32) cnt[c.tid] = 0;
        __syncthreads();
        unsigned T = 0u;
        for (int bit = 30; bit >= 0; --bit) {
            const unsigned cand = T | (1u << bit); int cw = 0;
#pragma unroll
            for (int j = 0; j < 8; ++j) cw += __popcll(__ballot(u[j] >= cand));
            if (c.lane == 0) atomicAdd(&cnt[bit], cw);
            __syncthreads();
            if (cnt[bit] >= CAP) T = cand;
        }
        int ngt = 0, neq = 0;
#pragma unroll
        for (int j = 0; j < 8; ++j) { ngt += u[j] > T ? 1 : 0; neq += u[j] == T ? 1 : 0; }
        int tot_gt, tot_eq; const int eq_base = block_excl_scan(neq, tot_eq, lw, c.tid); (void)block_excl_scan(ngt, tot_gt, lw + 16, c.tid);
        const int need = CAP - tot_gt;
        bool sel[8]; int nsel = 0, eqc = eq_base;
#pragma unroll
        for (int j = 0; j < 8; ++j) { const bool isq = u[j] == T; sel[j] = u[j] > T || (isq && eqc < need); eqc += isq ? 1 : 0; nsel += sel[j] ? 1 : 0; }
        int tot_sel; int slot = block_excl_scan(nsel, tot_sel, lw + 32, c.tid);
        int iv[8];
#pragma unroll
        for (int j = 0; j < 8; ++j) { iv[j] = sel[j] ? slot : -1;
            if (sel[j]) { c.seli()[unit * CAP + slot] = b * SEQ + 8 * c.tid + j; c.selg()[unit * CAP + slot] = __uint_as_float(u[j]); c.sels()[unit * CAP + slot] = c.sa()[b * SEQ + 8 * c.tid + j]; ++slot; } }
#pragma unroll
        for (int j = 0; j < 8; ++j) c.inv()[(size_t)(b * SEQ + 8 * c.tid + j) * NE + e] = iv[j];
    }
    __syncthreads();
}
struct EpiGateUpQ {
    static constexpr bool PERM = true;
    bf16_t* act; const float* sels; const float* sw;
    __device__ __forceinline__ void operator()(const f32x4 (&acc)[2][2][4][2], const pg8::Unit& u, int wr, int wc, int fr, int fq) const {
        const int row0 = u.pm * 256 + wr * 64 + fr, col0 = u.pn * 256 + wc * 32 + 8 * fq; const float* swe = sw + ((u.pm >> 1) & 15) * 1536 + col0;
        float rs[8];
#pragma unroll
        for (int i = 0; i < 8; ++i) rs[i] = sels[row0 + (i >> 2) * 128 + (i & 3) * 16];
        const f32x4 sg0 = *(const f32x4*)swe, su0 = *(const f32x4*)(swe + 4), sg1 = *(const f32x4*)(swe + 128), su1 = *(const f32x4*)(swe + 132);
#pragma unroll
        for (int ai = 0; ai < 2; ++ai)
#pragma unroll
            for (int m = 0; m < 4; ++m) { const float r_ = rs[ai * 4 + m];
#pragma unroll
                for (int bj = 0; bj < 2; ++bj) { const f32x4 gt = acc[ai][bj][m][0] * (bj ? sg1 : sg0) * r_, up = acc[ai][bj][m][1] * (bj ? su1 : su0) * r_;
                    u32x2 w; w.x = pk2(silu_f(gt[0]) * up[0], silu_f(gt[1]) * up[1]); w.y = pk2(silu_f(gt[2]) * up[2], silu_f(gt[3]) * up[3]);
                    *(u32x2*)(act + (size_t)(row0 + ai * 128 + m * 16) * DE + ((col0 + bj * 128) >> 1)) = w; } }
    }
};
__device__ __forceinline__ void p9_gateup(const Ctx& c, float* lds) {
    pg8::Gemm g{(const bf16_t*)c.h2q(), (const bf16_t*)c.wgu_q(), D / 2, D / 2, D / 2, c.seli(), 1, 15, (size_t)1536 * 512};
    pg8::ExpertOrder S; S.init(NSLOT, 1536, (int)gridDim.x, (int)blockIdx.x);
    EpiGateUpQ E{c.act(), c.sels(), c.swgu()};
    pg8::gemm_phase<true>((LAS unsigned char*)lds, g, S, E, c.tid);
}
struct EpiDown {
    static constexpr bool PERM = true;
    bf16_t* yb; const float* selg;
    __device__ __forceinline__ void operator()(const f32x4 (&acc)[2][2][4][2], const pg8::Unit& u, int wr, int wc, int fr, int fq) const {
        const int row0 = u.pm * 256 + wr * 64 + fr, col0 = u.pn * 256 + wc * 32 + 8 * fq;
        float gg[8];
#pragma unroll
        for (int i = 0; i < 8; ++i) gg[i] = selg[row0 + (i >> 2) * 128 + (i & 3) * 16];
#pragma unroll
        for (int ai = 0; ai < 2; ++ai)
#pragma unroll
            for (int m = 0; m < 4; ++m) { const float g_ = gg[ai * 4 + m];
#pragma unroll
                for (int bj = 0; bj < 2; ++bj) { const f32x4 a = acc[ai][bj][m][0] * g_, b = acc[ai][bj][m][1] * g_; const float o[8] = {a[0], a[1], a[2], a[3], b[0], b[1], b[2], b[3]};
                    store8_bf16(yb + (size_t)(row0 + ai * 128 + m * 16) * D + col0 + bj * 128, o); } }
    }
};
__device__ __forceinline__ void p10_down(const Ctx& c, float* lds) {
    pg8::Gemm g{c.act(), c.wdn_t(), DE, DE, DE, nullptr, 1, 15, (size_t)1024 * 768};
    pg8::ExpertOrder S; S.init(NSLOT, D, (int)gridDim.x, (int)blockIdx.x);
    EpiDown E{c.yb(), c.selg()};
    pg8::gemm_phase((LAS unsigned char*)lds, g, S, E, c.tid);
}
__device__ __forceinline__ void p11_final(const Ctx& c) {
    for (int r0 = c.gw * 2; r0 < RL; r0 += c.ngw * 2) {
        const int b = r0 / SEQ;
        int sl[2]; f32x4 x1[2][4]; f32x4 acc[2][4];
#pragma unroll
        for (int q = 0; q < 2; ++q) { sl[q] = c.lane < NE ? c.inv()[(size_t)(r0 + q) * NE + c.lane] : -1;
#pragma unroll
            for (int j = 0; j < 4; ++j) { const u32x2 w = __builtin_nontemporal_load((const u32x2*)(c.x1b() + (size_t)(r0 + q) * D + 4 * c.lane + 256 * j));
                x1[q][j] = (f32x4){__uint_as_float(w.x << 16), __uint_as_float(w.x & 0xffff0000u), __uint_as_float(w.y << 16), __uint_as_float(w.y & 0xffff0000u)}; acc[q][j] = (f32x4){0.f, 0.f, 0.f, 0.f}; } }
#pragma unroll
        for (int q = 0; q < 2; ++q) {
            unsigned long long m = __ballot(sl[q] >= 0);
            while (m) { const int e = __builtin_ctzll(m); m &= m - 1; const int slot = __builtin_amdgcn_readlane(sl[q], e);
                const bf16_t* yr = c.yb() + (size_t)((b * NE + e) * CAP + slot) * D;
#pragma unroll
                for (int j = 0; j < 4; ++j) { const u32x2 w = __builtin_nontemporal_load((const u32x2*)(yr + 4 * c.lane + 256 * j));
                    acc[q][j].x += __uint_as_float(w.x << 16); acc[q][j].y += __uint_as_float(w.x & 0xffff0000u); acc[q][j].z += __uint_as_float(w.y << 16); acc[q][j].w += __uint_as_float(w.y & 0xffff0000u); } } }
        const float* md = c.modv() + b * 6144 + 5120; float ss[2] = {0.f, 0.f};
#pragma unroll
        for (int j = 0; j < 4; ++j) { const int k = 4 * c.lane + 256 * j; const f32x4 ga = *(const f32x4*)(md + k);
#pragma unroll
            for (int q = 0; q < 2; ++q) { x1[q][j] = x1[q][j] + ga * acc[q][j]; ss[q] += x1[q][j].x * x1[q][j].x + x1[q][j].y * x1[q][j].y + x1[q][j].z * x1[q][j].z + x1[q][j].w * x1[q][j].w; } }
        const float ri0 = 1.f / sqrtf(wave_sum(ss[0]) * (1.f / D) + EPS), ri1 = 1.f / sqrtf(wave_sum(ss[1]) * (1.f / D) + EPS);
#pragma unroll
        for (int j = 0; j < 4; ++j) { const int k = 4 * c.lane + 256 * j; const f32x4 g = *(const f32x4*)(c.g_final() + k);
            __builtin_nontemporal_store(x1[0][j] * ri0 * g, (f32x4*)(c.out() + (size_t)r0 * D + k)); __builtin_nontemporal_store(x1[1][j] * ri1 * g, (f32x4*)(c.out() + (size_t)(r0 + 1) * D + k)); }
    }
}

#define XB_TMO      128
#define XB_XCNT(j)  (256  + 64 * (j))
#define XB_XSUB(j)  (1280 + 64 * (j))
#define XB_XGEN(j)  (2304 + 64 * (j))
#define XB_TOP      3328
#define XB_TOPGEN   3392
#define XCD_BAR_WORDS 3456
#define XB_SPIN_CAP (1u << 18)

__device__ __forceinline__ unsigned xb_ld(unsigned* p)              { return __hip_atomic_load(p, __ATOMIC_RELAXED, __HIP_MEMORY_SCOPE_AGENT); }
__device__ __forceinline__ unsigned xb_add(unsigned* p, unsigned v) { return __hip_atomic_fetch_add(p, v, __ATOMIC_RELAXED, __HIP_MEMORY_SCOPE_AGENT); }
__device__ __forceinline__ unsigned xb_xcc_id() { return (unsigned)__builtin_amdgcn_s_getreg((3 << 11) | 20) & 0xFu; }
#define XB_SPIN(cond, bar) do { unsigned _sp = 0; while (cond) { __builtin_amdgcn_s_sleep(1); \
    if ((++_sp & 255u) == 0u) { if (xb_ld(&(bar)[XB_TMO])) break; if (_sp > XB_SPIN_CAP) { atomicAdd(&(bar)[XB_TMO], 1u); break; } } } } while (0)

struct XcdBarrier {
    unsigned* bar; unsigned x;
    volatile LAS unsigned* st;
};
__device__ __forceinline__ XcdBarrier xcd_barrier_post(unsigned* bar, volatile LAS unsigned* st, bool t0) {
    XcdBarrier b; b.bar = bar; b.x = xb_xcc_id(); b.st = st;
    if (t0) (void)xb_add(&bar[XB_XCNT(b.x)], 1u);
    return b;
}
__device__ __forceinline__ void xcd_barrier_complete(unsigned* bar, unsigned x, unsigned& nloc, unsigned& nx) {
    const unsigned G = gridDim.x * gridDim.y * gridDim.z;
    unsigned sum, cnt, mine, sp = 0u;
    for (;;) {
        sum = 0u; cnt = 0u; mine = 0u;
#pragma unroll
        for (unsigned j = 0; j < 16; ++j) { const unsigned c = xb_ld(&bar[XB_XCNT(j)]); sum += c; cnt += (c > 0u) ? 1u : 0u; mine = (j == x) ? c : mine; }
        if (sum == G) break;
        __builtin_amdgcn_s_sleep(1);
        if ((++sp & 255u) == 0u) { if (xb_ld(&bar[XB_TMO])) break; if (sp > XB_SPIN_CAP) { atomicAdd(&bar[XB_TMO], 1u); break; } }
    }
    nloc = mine > 0u ? mine : 1u; nx = cnt > 0u ? cnt : 1u;
}
__device__ __forceinline__ void xcd_barrier(const XcdBarrier& b, bool t0) {
    asm volatile("s_waitcnt vmcnt(0)" ::: "memory");
    __syncthreads();
    if (t0) {
        unsigned* bar = b.bar;
        __builtin_amdgcn_s_waitcnt(0);
        unsigned nloc = b.st[0], nx = b.st[1];
        if (nloc == 0u) { xcd_barrier_complete(bar, b.x, nloc, nx); b.st[0] = nloc; b.st[1] = nx; }
        const unsigned old = xb_add(&bar[XB_XSUB(b.x)], 1u);
        const unsigned gen = old / nloc;
        if (old + 1u == (gen + 1u) * nloc) {
            __builtin_amdgcn_fence(__ATOMIC_RELEASE, "agent");
            asm volatile("s_waitcnt vmcnt(0)" ::: "memory");
            const unsigned og = xb_add(&bar[XB_TOP], 1u);
            const unsigned tg = og / nx;
            if (og + 1u == (tg + 1u) * nx) xb_add(&bar[XB_TOPGEN], 1u);
            else XB_SPIN(xb_ld(&bar[XB_TOPGEN]) == tg, bar);
            __builtin_amdgcn_fence(__ATOMIC_ACQUIRE, "agent");
            xb_add(&bar[XB_XGEN(b.x)], 1u);
            asm volatile("s_waitcnt vmcnt(0)" ::: "memory");
        } else {
            XB_SPIN(xb_ld(&bar[XB_XGEN(b.x)]) == gen, bar);
            __builtin_amdgcn_fence(__ATOMIC_ACQUIRE, "agent");
            asm volatile("s_waitcnt vmcnt(0)" ::: "memory");
        }
    }
    __syncthreads();
}

template <int PH0, int PH1> __global__ void __launch_bounds__(512, 2) fwd_kernel(Args args) {
    extern __shared__ __attribute__((aligned(16))) unsigned char lds_raw[];
    float* lds = (float*)lds_raw;
    volatile LAS unsigned* xbst = (volatile LAS unsigned*)((LAS unsigned char*)lds_raw + (LDS_BYTES - 16));
    const int wave_s = __builtin_amdgcn_readfirstlane((int)threadIdx.x >> 6);
#define TID_NOW() ([&]() { unsigned z_ = 0u; asm volatile("" : "+v"(z_)); return wave_s * 64 + (int)__builtin_amdgcn_mbcnt_hi(~0u, __builtin_amdgcn_mbcnt_lo(~0u, z_)); }())
    if (TID_NOW() == 0) { xbst[0] = 0u; xbst[1] = 0u; }
    __syncthreads();
    XcdBarrier bar; bar.bar = nullptr; bar.x = 0; bar.st = nullptr;
    if constexpr (PH1 - PH0 > 1) bar = xcd_barrier_post((unsigned*)(args.ws + WS_CTL) + 4096, xbst, TID_NOW() == 0);
#define GRID_BAR(k) do { if constexpr (PH1 - PH0 > 1) { if (lo <= (k) && (k) + 1 < hi) { xcd_barrier(bar, TID_NOW() == 0); if (BARREP) xcd_barrier(bar, TID_NOW() == 0); } } } while (0)
    const int lo = args.ph_lo, hi = args.ph_hi;
#ifndef PHMASK
#define PHMASK 0xffffffffu
#endif
#ifndef BARREP
#define BARREP 0
#endif
#ifndef REPMASK
#define REPMASK 0u
#endif
#define REP(k) ((REPMASK >> (k)) & 1u)
#define IN(k) (((PHMASK >> (k)) & 1u) && PH0 <= (k) && (k) < PH1 && lo <= (k) && (k) < hi)
#define CTX() Ctx c; { kptr_t kp_ = (kptr_t)__builtin_amdgcn_kernarg_segment_ptr(); asm volatile("" : "+s"(kp_)); c.kp = kp_; int t_ = TID_NOW(); asm volatile("" : "+v"(t_)); int b_ = blockIdx.x; asm volatile("" : "+s"(b_)); c.tid = t_; c.lane = t_ & 63; c.wave = t_ >> 6; c.gw = b_ * 8 + c.wave; c.ngw = gridDim.x * 8; }
    if (IN(0)) { CTX(); p0_mod(c, lds); __syncthreads(); p0_weights<0>(c, lds, c.gw, c.ngw); p0_tables(c); }
    if (REP(0) && IN(0)) { __syncthreads(); CTX(); p0_mod(c, lds); __syncthreads(); p0_weights<0>(c, lds, c.gw, c.ngw); p0_tables(c); }
    GRID_BAR(0);
    if (IN(1)) { CTX(); p1_norm(c); }
    if (REP(1) && IN(1)) { __syncthreads(); CTX(); p1_norm(c); }
    GRID_BAR(1);
    if (IN(2)) { CTX(); p2_proj(c, lds); }
    if (REP(2) && IN(2)) { __syncthreads(); CTX(); p2_proj(c, lds); }
    GRID_BAR(2);
    if (IN(3)) { CTX(); p3_upq(c, lds); }
    if (REP(3) && IN(3)) { __syncthreads(); CTX(); p3_upq(c, lds); }
    if (IN(4)) { CTX(); p3_upkv(c, lds); }
    if (REP(4) && IN(4)) { __syncthreads(); CTX(); p3_upkv(c, lds); }
    if (IN(5)) { CTX(); p3c_scan(c, lds); }
    if (REP(5) && IN(5)) { __syncthreads(); CTX(); p3c_scan(c, lds); }
    GRID_BAR(5);
    if (IN(6)) { CTX(); p4_attn(c, lds); }
    if (REP(6) && IN(6)) { __syncthreads(); CTX(); p4_attn(c, lds); }
    if (IN(7)) { CTX(); p4_ret(c, lds); }
    if (REP(7) && IN(7)) { __syncthreads(); CTX(); p4_ret(c, lds); }
    GRID_BAR(7);
    if (IN(8)) { CTX(); p6_wo(c, lds); }
    if (REP(8) && IN(8)) { __syncthreads(); CTX(); p6_wo(c, lds); }
    GRID_BAR(8);
    if (IN(9)) { CTX(); p7_norm_router(c, lds); }
    if (REP(9) && IN(9)) { __syncthreads(); CTX(); p7_norm_router(c, lds); }
    GRID_BAR(9);
    if (IN(10)) { CTX(); p8_topk(c, lds); }
    if (REP(10) && IN(10)) { __syncthreads(); CTX(); p8_topk(c, lds); }
    GRID_BAR(10);
    if (IN(11)) { CTX(); p9_gateup(c, lds); }
    if (REP(11) && IN(11)) { __syncthreads(); CTX(); p9_gateup(c, lds); }
    GRID_BAR(11);
    if (IN(12)) { CTX(); p10_down(c, lds); }
    if (REP(12) && IN(12)) { __syncthreads(); CTX(); p10_down(c, lds); }
    GRID_BAR(12);
    if (IN(13)) { CTX(); p11_final(c); }
    if (REP(13) && IN(13)) { __syncthreads(); CTX(); p11_final(c); }
#undef IN
}


static hipError_t set_lds_all() { return hipFuncSetAttribute((const void*)fwd_kernel<0, NPH>, hipFuncAttributeMaxDynamicSharedMemorySize, LDS_BYTES); }
static void launch_all(int grid, hipStream_t stream, const Args& a) { hipLaunchKernelGGL((fwd_kernel<0, NPH>), dim3(grid), dim3(512), LDS_BYTES, stream, a); }

extern "C" void kernel_launch(void* const* d_in, const int* in_sizes, int n_in, void* d_out, int out_size, void* d_ws, size_t ws_size, hipStream_t stream) {
    static int grid = 0;
    if (grid == 0) {
        if (n_in != 22 || in_sizes[0] != RL * D || out_size != RL * D || ws_size < WS_END) {
            fprintf(stderr, "kernel_launch: unexpected shapes: n_in %d in0 %d out %d ws %zu (need %zu)\n", n_in, n_in > 0 ? in_sizes[0] : -1, out_size, ws_size, (size_t)WS_END); grid = -1; return; }
        int dev = 0, cus = 0;
        if (hipGetDevice(&dev) != hipSuccess || hipDeviceGetAttribute(&cus, hipDeviceAttributeMultiprocessorCount, dev) != hipSuccess) { grid = -1; return; }
        if (set_lds_all() != hipSuccess) { fprintf(stderr, "kernel_launch: hipFuncSetAttribute failed\n"); grid = -1; return; }
        int per_cu = 0;
        if (MK_SINGLE) { if (hipOccupancyMaxActiveBlocksPerMultiprocessor(&per_cu, (const void*)fwd_kernel<0, NPH>, 512, LDS_BYTES) != hipSuccess || per_cu < 1) { fprintf(stderr, "kernel_launch: occupancy query says %d blocks per CU\n", per_cu); grid = -1; return; } }
        (void)hipGetLastError();
        grid = cus;
    }
    if (grid < 0) return;
    Args a{};
    for (int i = 0; i < 22; ++i) a.in[i] = (const float*)d_in[i];
    a.out = (float*)d_out; a.ws = (unsigned char*)d_ws;
    a.ph_lo = 0; a.ph_hi = NPH;
    if (MK_SINGLE) { if (hipMemsetAsync((char*)d_ws + WS_CTL, 0, CTL_BYTES, stream) != hipSuccess) { fprintf(stderr, "kernel_launch: memset failed\n"); return; } }
    launch_all(grid, stream, a);
}
```

```cpp
#include <hip/hip_runtime.h>
#include <cstdio>
#include <cstdint>

#ifndef MK_SINGLE
#define MK_SINGLE 1
#endif

typedef unsigned short bf16_t;
typedef float f32x4 __attribute__((ext_vector_type(4)));
typedef unsigned u32x4 __attribute__((ext_vector_type(4)));
typedef unsigned u32x2 __attribute__((ext_vector_type(2)));
#define LAS __attribute__((address_space(3)))

constexpr int D = 1024, NB = 8, SEQ = 4096, LC = 256;
constexpr int RL = NB * SEQ, RC = NB * LC, RT = RL + RC;
constexpr int NPROJ = 2560;
constexpr int PC_CQ = 0, PC_CKV = 256, PC_KR = 384, PC_RQ = 512, PC_RK = 1024, PC_RV = 1536, PC_RG = 2048;
constexpr int NH = 8, QW = 768, KVW = 1024;
constexpr int NE = 16, CAP = 512, DE = 768, NSLOT = NB * NE * CAP;
constexpr int NCH = 32;
constexpr float EPS = 1e-6f;
constexpr float QSCALE = 0.10206207261596577f * 1.4426950408889634f;

constexpr size_t MiB = 1u << 20;
constexpr size_t WS_CTL = 0, CTL_BYTES = 64 * 1024;
constexpr size_t WS_MOD = 1 * MiB;
constexpr size_t WS_TABR = 2 * MiB;
constexpr size_t WS_TABM = 3 * MiB;
constexpr size_t WS_PSTAT = 4 * MiB;
constexpr size_t WS_AFF = 6 * MiB;
constexpr size_t WS_SELI = 8 * MiB;
constexpr size_t WS_SELG = 8 * MiB + 512 * 1024;
constexpr size_t WS_INV = 9 * MiB;
constexpr size_t WS_SELS = 11 * MiB;
constexpr size_t WS_WIN = 12 * MiB;
constexpr size_t WS_WUQ = 17 * MiB;
constexpr size_t WS_WUKV = 17 * MiB + 512 * 1024;
constexpr size_t WS_WO = 18 * MiB;
constexpr size_t WS_WGU = 20 * MiB;
constexpr size_t WS_WDN = 68 * MiB;
constexpr size_t WS_H = 92 * MiB;
constexpr size_t WS_RST = 92 * MiB;
constexpr size_t WS_PROJ = 160 * MiB;
constexpr size_t WS_ACT = 160 * MiB;
constexpr size_t WS_YB = 256 * MiB;
constexpr size_t WS_Q = 330 * MiB;
constexpr size_t WS_KV = 378 * MiB;
constexpr size_t WS_MIX = 446 * MiB;
constexpr size_t WS_END = 510 * MiB;
static_assert(WS_PROJ + (size_t)RT * NPROJ * 2 <= WS_Q && WS_Q + (size_t)RL * QW * 2 <= WS_KV && WS_KV + (size_t)RT * KVW * 2 <= WS_MIX, "ws map");
static_assert(WS_H + (size_t)RT * D * 2 <= WS_PROJ && WS_WDN + (size_t)NE * D * DE * 2 <= WS_H && WS_PSTAT + (size_t)RT * 32 <= WS_AFF, "ws map 2");

constexpr int LDS_BYTES = 147456;
constexpr int NPH = 14;

__device__ __forceinline__ float bf2f(bf16_t v) { return __uint_as_float((unsigned)v << 16); }
__device__ __forceinline__ bf16_t f2bf(float f) { unsigned u = __float_as_uint(f); return (bf16_t)((u + 0x7fffu + ((u >> 16) & 1u)) >> 16); }
__device__ __forceinline__ unsigned pk2(float lo, float hi) { unsigned r; asm("v_cvt_pk_bf16_f32 %0, %1, %2" : "=v"(r) : "v"(lo), "v"(hi)); return r; }
__device__ __forceinline__ float wave_sum(float v) {
#pragma unroll
    for (int o = 1; o < 64; o <<= 1) v += __shfl_xor(v, o);
    return v;
}
__device__ __forceinline__ float silu_f(float v) { return v / (1.f + __expf(-v)); }

struct Args {
    const float* in[22]; float* out; unsigned char* ws; int ph_lo, ph_hi;
};

typedef __attribute__((address_space(4))) const char* kptr_t;
typedef const float* cfp_t; typedef float* fp_t; typedef unsigned char* ucp_t;
typedef __attribute__((address_space(4))) const cfp_t* kcfpp; typedef __attribute__((address_space(4))) const fp_t* kfpp; typedef __attribute__((address_space(4))) const ucp_t* kucpp;
static_assert(sizeof(Args) == 200, "Args layout: in[22] @0, out @176, ws @184, ph_lo @192, ph_hi @196");
struct Ctx {
    kptr_t kp; int tid, lane, wave, gw, ngw;
    __device__ __forceinline__ const float* in(int i) const { return *(kcfpp)(kp + 8 * i); }
    __device__ __forceinline__ unsigned char* wsb() const { return *(kucpp)(kp + 184); }
    __device__ __forceinline__ const float* x() const { return in(0); }
    __device__ __forceinline__ const float* cvec() const { return in(1); }
    __device__ __forceinline__ const float* ctx() const { return in(2); }
    __device__ __forceinline__ const float* c_ctx() const { return in(3); }
    __device__ __forceinline__ const float* w_ada() const { return in(4); }
    __device__ __forceinline__ const float* b_ada() const { return in(5); }
    __device__ __forceinline__ const float* g_mix() const { return in(6); }
    __device__ __forceinline__ const float* g_ffn() const { return in(7); }
    __device__ __forceinline__ const float* w_in() const { return in(8); }
    __device__ __forceinline__ const float* g_q() const { return in(9); }
    __device__ __forceinline__ const float* g_kv() const { return in(10); }
    __device__ __forceinline__ const float* w_uq() const { return in(11); }
    __device__ __forceinline__ const float* w_ukv() const { return in(12); }
    __device__ __forceinline__ const float* exp_f() const { return in(13); }
    __device__ __forceinline__ const float* exp_b() const { return in(14); }
    __device__ __forceinline__ const float* g_ret() const { return in(15); }
    __device__ __forceinline__ const float* w_o() const { return in(16); }
    __device__ __forceinline__ const float* w_router() const { return in(17); }
    __device__ __forceinline__ const float* w_gate() const { return in(18); }
    __device__ __forceinline__ const float* w_up() const { return in(19); }
    __device__ __forceinline__ const float* w_down() const { return in(20); }
    __device__ __forceinline__ const float* g_final() const { return in(21); }
    __device__ __forceinline__ float* out() const { return *(kfpp)(kp + 176); }
    __device__ __forceinline__ float* modv() const { return (float*)(wsb() + WS_MOD); }
    __device__ __forceinline__ float* tabr() const { return (float*)(wsb() + WS_TABR); }
    __device__ __forceinline__ float* tabm() const { return (float*)(wsb() + WS_TABM); }
    __device__ __forceinline__ float* pstat() const { return (float*)(wsb() + WS_PSTAT); }
    __device__ __forceinline__ float* aff() const { return (float*)(wsb() + WS_AFF); }
    __device__ __forceinline__ float* selg() const { return (float*)(wsb() + WS_SELG); }
    __device__ __forceinline__ int* seli() const { return (int*)(wsb() + WS_SELI); }
    __device__ __forceinline__ int* inv() const { return (int*)(wsb() + WS_INV); }
    __device__ __forceinline__ float* sels() const { return (float*)(wsb() + WS_SELS); }
    __device__ __forceinline__ float* rpart() const { return (float*)(wsb() + WS_Q); }
    __device__ __forceinline__ bf16_t* win_t() const { return (bf16_t*)(wsb() + WS_WIN); }
    __device__ __forceinline__ bf16_t* wuq_t() const { return (bf16_t*)(wsb() + WS_WUQ); }
    __device__ __forceinline__ bf16_t* wukv_t() const { return (bf16_t*)(wsb() + WS_WUKV); }
    __device__ __forceinline__ bf16_t* wo_t() const { return (bf16_t*)(wsb() + WS_WO); }
    __device__ __forceinline__ bf16_t* wgu_t() const { return (bf16_t*)(wsb() + WS_WGU); }
    __device__ __forceinline__ bf16_t* wdn_t() const { return (bf16_t*)(wsb() + WS_WDN); }
    __device__ __forceinline__ bf16_t* hb() const { return (bf16_t*)(wsb() + WS_H); }
    __device__ __forceinline__ bf16_t* rst() const { return (bf16_t*)(wsb() + WS_RST); }
    __device__ __forceinline__ bf16_t* proj() const { return (bf16_t*)(wsb() + WS_PROJ); }
    __device__ __forceinline__ bf16_t* act() const { return (bf16_t*)(wsb() + WS_ACT); }
    __device__ __forceinline__ bf16_t* yb() const { return (bf16_t*)(wsb() + WS_YB); }
    __device__ __forceinline__ bf16_t* qb() const { return (bf16_t*)(wsb() + WS_Q); }
    __device__ __forceinline__ bf16_t* kvb() const { return (bf16_t*)(wsb() + WS_KV); }
    __device__ __forceinline__ bf16_t* mix() const { return (bf16_t*)(wsb() + WS_MIX); }
    __device__ __forceinline__ bf16_t* x1b() const { return (bf16_t*)(wsb() + WS_H); }
    __device__ __forceinline__ bf16_t* h2() const { return (bf16_t*)(wsb() + WS_MIX); }
    __device__ __forceinline__ signed char* h2q() const { return (signed char*)(wsb() + WS_MIX); }
    __device__ __forceinline__ float* sa() const { return (float*)(wsb() + WS_MIX + 32 * MiB); }
    __device__ __forceinline__ signed char* wgu_q() const { return (signed char*)(wsb() + WS_WGU); }
    __device__ __forceinline__ float* swgu() const { return (float*)(wsb() + WS_WGU + 24 * MiB); }
};

__device__ __forceinline__ void p0_mod(const Ctx& c, float* lds) {
    float* sc = lds;
    float* red = lds + 9 * 1024;
    for (int i = c.tid; i < 9 * 1024; i += 512) { const int r = i >> 10, k = i & 1023; const float v = r < 8 ? c.cvec()[r * 1024 + k] : c.c_ctx()[k]; sc[i] = silu_f(v); }
    __syncthreads();
    for (int unit = blockIdx.x; unit < 192; unit += gridDim.x) {
        const int nn = c.tid & 31, n = unit * 32 + nn, kg = c.tid >> 5;
        float acc[9];
#pragma unroll
        for (int r = 0; r < 9; ++r) acc[r] = 0.f;
        for (int k0 = kg; k0 < 1024; k0 += 16 * 8) { float w[8];
#pragma unroll
            for (int i = 0; i < 8; ++i) w[i] = __builtin_nontemporal_load(c.w_ada() + (size_t)(k0 + 16 * i) * 6144 + n);
#pragma unroll
            for (int i = 0; i < 8; ++i)
#pragma unroll
                for (int r = 0; r < 9; ++r) acc[r] += sc[r * 1024 + k0 + 16 * i] * w[i]; }
#pragma unroll
        for (int r = 0; r < 9; ++r) red[(kg * 9 + r) * 32 + nn] = acc[r];
        __syncthreads();
        for (int i = c.tid; i < 9 * 32; i += 512) { const int r = i >> 5, n2 = i & 31; float s = 0.f;
#pragma unroll
            for (int g = 0; g < 16; ++g) s += red[(g * 9 + r) * 32 + n2];
            c.modv()[r * 6144 + unit * 32 + n2] = s + c.b_ada()[unit * 32 + n2]; }
        __syncthreads();
    }
}
template <class CM, class GN>
__device__ __forceinline__ void transpose_item(const float* W, int Ksrc, int Nsrc, bf16_t* WT, int Kdst, CM cm, GN gain, float* scr, int kb, int nb, int lane) {
    const int k0 = 64 * kb, n0 = 32 * nb;
    const int srcc = cm(n0 + (lane & 31));
#pragma unroll 8
    for (int i = 0; i < 32; ++i) { const int kk = 2 * i + (lane >> 5), k = k0 + kk;
        float v = 0.f; if (srcc >= 0 && k < Ksrc) v = W[(size_t)k * Nsrc + srcc] * gain(k);
        scr[kk * 33 + (lane & 31)] = v; }
    asm volatile("s_waitcnt lgkmcnt(0)" ::: "memory");
    const int ch = lane & 7;
#pragma unroll
    for (int j = 0; j < 4; ++j) { const int n = (lane >> 3) + 8 * j; const float* s = scr + (8 * ch) * 33 + n;
        u32x4 o; o.x = pk2(s[0 * 33], s[1 * 33]); o.y = pk2(s[2 * 33], s[3 * 33]); o.z = pk2(s[4 * 33], s[5 * 33]); o.w = pk2(s[6 * 33], s[7 * 33]);
        *(u32x4*)(WT + (size_t)(n0 + n) * Kdst + k0 + 8 * ch) = o; }
    asm volatile("s_waitcnt lgkmcnt(0)" ::: "memory");
}
__device__ __forceinline__ int ilv(int p, int half) { const int g = p >> 3, w = p & 7; return w < 4 ? 4 * g + w : half + 4 * g + (w - 4); }
__device__ __forceinline__ int cm_win(int n) {
    if (n < 384) return n;
    if (n < 416) return 384 + ilv(n - 384, 16);
    if (n < 512) return -1;
    if (n < 1024) { const int j = n - 512; return 416 + (j >> 6) * 64 + ilv(j & 63, 32); }
    if (n < 1536) { const int j = n - 1024; return 928 + (j >> 6) * 64 + ilv(j & 63, 32); }
    if (n < 2048) return 1440 + (n - 1536);
    return 1952 + (n - 2048);
}
__device__ __forceinline__ int cm_wuq(int n) { const int h = n / 96, p = n % 96; return p < 64 ? n : h * 96 + 64 + ilv(p - 64, 16); }
__device__ __forceinline__ int cm_wgu(int n) { const int q = n >> 3, w = n & 7; return w < 4 ? 4 * q + w : 768 + 4 * q + (w - 4); }
template <bool NTST = false, class TC>
__device__ __forceinline__ void transpose64(const float* srcA, const float* srcB, int ld, bf16_t* dst, int ldd, TC tcol, float* scr, int lane) {
    const int r = lane >> 3, c4 = (lane & 7) * 4;
    f32x4 va[8], vb[8];
#pragma unroll
    for (int i = 0; i < 8; ++i) { va[i] = srcA ? __builtin_nontemporal_load((const f32x4*)(srcA + (size_t)(8 * i + r) * ld + c4)) : (f32x4){0.f, 0.f, 0.f, 0.f}; vb[i] = srcB ? __builtin_nontemporal_load((const f32x4*)(srcB + (size_t)(8 * i + r) * ld + c4)) : (f32x4){0.f, 0.f, 0.f, 0.f}; }
#pragma unroll
    for (int i = 0; i < 8; ++i) { float* p = scr + (8 * i + r) * 65 + c4; p[0] = va[i].x; p[1] = va[i].y; p[2] = va[i].z; p[3] = va[i].w; p[32] = vb[i].x; p[33] = vb[i].y; p[34] = vb[i].z; p[35] = vb[i].w; }
    asm volatile("s_waitcnt lgkmcnt(0)" ::: "memory");
    const int kc = lane & 7;
#pragma unroll
    for (int j = 0; j < 8; ++j) { const int nl = (lane >> 3) + 8 * j, col = tcol(nl); u32x4 o = {0u, 0u, 0u, 0u};
        if (col >= 0) { const float* sp = scr + (8 * kc) * 65 + col; o.x = pk2(sp[0 * 65], sp[1 * 65]); o.y = pk2(sp[2 * 65], sp[3 * 65]); o.z = pk2(sp[4 * 65], sp[5 * 65]); o.w = pk2(sp[6 * 65], sp[7 * 65]); }
        if (NTST) __builtin_nontemporal_store(o, (u32x4*)(dst + (size_t)nl * ldd + 8 * kc)); else *(u32x4*)(dst + (size_t)nl * ldd + 8 * kc) = o; }
    asm volatile("s_waitcnt lgkmcnt(0)" ::: "memory");
}
typedef int i32x4 __attribute__((ext_vector_type(4)));
constexpr int GU_STRIPS = NE * 24;
__device__ __forceinline__ unsigned q8pack(float a, float b, float c_, float d, float inv) {
    const unsigned q0 = __float_as_uint(__builtin_fmaf(a, inv, 12582912.f)), q1 = __float_as_uint(__builtin_fmaf(b, inv, 12582912.f)), q2 = __float_as_uint(__builtin_fmaf(c_, inv, 12582912.f)), q3 = __float_as_uint(__builtin_fmaf(d, inv, 12582912.f));
    return (q0 & 255u) | ((q1 & 255u) << 8) | ((q2 & 255u) << 16) | (q3 << 24);
}
__device__ __forceinline__ void gu_strip_i8(const Ctx& c, float* lds, int s) {
    const int e = s / 24, nb = s % 24;
    float* scr = lds + c.wave * (64 * 65); float* cm = lds + 8 * 64 * 65; float* fin = cm + 512;
    const int r = c.lane >> 3, c4 = (c.lane & 7) * 4;
    const size_t so = (size_t)e * 1024 * 768 + 32 * nb + c4;
    const float* gA = c.w_gate() + so; const float* gB = c.w_up() + so;
    f32x4 va[2][8], vb[2][8];
#pragma unroll
    for (int t = 0; t < 2; ++t)
#pragma unroll
        for (int i = 0; i < 8; ++i) { const size_t ro = (size_t)(64 * (2 * c.wave + t) + 8 * i + r) * 768; va[t][i] = __builtin_nontemporal_load((const f32x4*)(gA + ro)); vb[t][i] = __builtin_nontemporal_load((const f32x4*)(gB + ro)); }
    f32x4 mA = {0.f, 0.f, 0.f, 0.f}, mB = {0.f, 0.f, 0.f, 0.f};
#pragma unroll
    for (int t = 0; t < 2; ++t)
#pragma unroll
        for (int i = 0; i < 8; ++i) { mA = __builtin_elementwise_max(mA, __builtin_elementwise_abs(va[t][i])); mB = __builtin_elementwise_max(mB, __builtin_elementwise_abs(vb[t][i])); }
#pragma unroll
    for (int o = 8; o < 64; o <<= 1)
#pragma unroll
        for (int j = 0; j < 4; ++j) { mA[j] = fmaxf(mA[j], __shfl_xor(mA[j], o)); mB[j] = fmaxf(mB[j], __shfl_xor(mB[j], o)); }
    __syncthreads();
    if (r == 0) { *(f32x4*)(cm + c.wave * 64 + c4) = mA; *(f32x4*)(cm + c.wave * 64 + 32 + c4) = mB; }
    __syncthreads();
    if (c.tid < 64) { float m = cm[c.tid];
#pragma unroll
        for (int w = 1; w < 8; ++w) m = fmaxf(m, cm[w * 64 + c.tid]);
        fin[c.tid] = fmaxf(m, 1e-30f); }
    __syncthreads();
    const int w8 = c.lane >> 3, kc = c.lane & 7;
    if (c.tid < 64) { const int qq = c.tid >> 3, w = c.tid & 7; c.swgu()[e * 1536 + 64 * nb + c.tid] = fin[w < 4 ? 4 * qq + w : 32 + 4 * qq + (w - 4)] * (1.f / 127.f); }
    signed char* dq = c.wgu_q() + (size_t)e * 1536 * 1024 + (size_t)(64 * nb + w8) * 1024 + 128 * c.wave + 8 * kc;
#pragma unroll
    for (int t = 0; t < 2; ++t) {
#pragma unroll
        for (int i = 0; i < 8; ++i) { float* p = scr + (8 * i + r) * 65 + c4; p[0] = va[t][i].x; p[1] = va[t][i].y; p[2] = va[t][i].z; p[3] = va[t][i].w; p[32] = vb[t][i].x; p[33] = vb[t][i].y; p[34] = vb[t][i].z; p[35] = vb[t][i].w; }
        asm volatile("s_waitcnt lgkmcnt(0)" ::: "memory");
#pragma unroll
        for (int j = 0; j < 8; ++j) { const int col = w8 < 4 ? 4 * j + w8 : 32 + 4 * j + (w8 - 4);
            const float inv = 127.f / fin[col]; const float* sp = scr + (8 * kc) * 65 + col;
            u32x2 o; o.x = q8pack(sp[0 * 65], sp[1 * 65], sp[2 * 65], sp[3 * 65], inv); o.y = q8pack(sp[4 * 65], sp[5 * 65], sp[6 * 65], sp[7 * 65], inv);
            *(u32x2*)(dq + (size_t)(8 * j) * 1024 + 64 * t) = o; }
        asm volatile("s_waitcnt lgkmcnt(0)" ::: "memory");
    }
}
constexpr int QSHORT0 = 80, QSTRIPS = 2, QSTATIC = (256 - QSHORT0) * QSTRIPS;
template <int PART>
__device__ __forceinline__ void p0_weights(const Ctx& c, float* lds, int gw, int ngw) {
    float* scr = lds + c.wave * (64 * 65);
    constexpr int I_WIN = 16 * 40, I_WO = 16 * 16, I_GU = 16 * 24, I_DN = 12 * 16, I_WUQ = 4 * 24, I_WUKV = 4 * 32;
    constexpr int NEXP = NE * I_GU + NE * I_DN, NIT = NEXP + I_WIN + I_WO + I_WUQ + I_WUKV;
    unsigned* qctr = (unsigned*)(c.wsb() + WS_CTL) + 2048; int qbase = 0, qk = 8;
    for (int it = (PART == 1 ? NE * I_GU : NEXP + gw); it < (PART == 1 ? NEXP : NIT); it += (PART == 0 ? ngw : 1)) {
        if (PART == 1) { if (qk == 8) { int p_ = 0; if (c.lane == 0) p_ = (int)__hip_atomic_fetch_add(qctr, 1u, __ATOMIC_RELAXED, __HIP_MEMORY_SCOPE_AGENT); qbase = NE * I_GU + __builtin_amdgcn_readfirstlane(p_) * 8; qk = 0; }
            it = qbase + qk; ++qk; if (it >= NEXP) break; }
        int r = it;
        r -= NE * I_GU;
        if (r < NE * I_DN) { const int e = r / I_DN, q = r % I_DN, kb = q / 16, nb = q % 16;
            const float* src = c.w_down() + (size_t)e * 768 * 1024 + (size_t)(64 * kb) * 1024 + 64 * nb;
            transpose64<true>(src, src + 32, 1024, c.wdn_t() + (size_t)e * 1024 * 768 + (size_t)(64 * nb) * 768 + 64 * kb, 768, [](int nl) { return nl; }, scr, c.lane); continue; } r -= NE * I_DN;
        if (r < I_WIN) { const int kb = r / 40, nb = r % 40; const float* base = c.w_in() + (size_t)(64 * kb) * 2464; bf16_t* dst = c.win_t() + (size_t)(64 * nb) * 1024 + 64 * kb;
            if (nb < 6) { transpose64(base + 64 * nb, base + 64 * nb + 32, 2464, dst, 1024, [](int nl) { return nl; }, scr, c.lane); }
            else if (nb == 6) { transpose64(base + 384, (const float*)nullptr, 2464, dst, 1024, [](int nl) { return nl < 32 ? ilv(nl, 16) : -1; }, scr, c.lane); }
            else if (nb == 7) { transpose64((const float*)nullptr, (const float*)nullptr, 2464, dst, 1024, [](int) { return -1; }, scr, c.lane); }
            else if (nb < 24) { const int s0 = (nb < 16 ? 416 : 928) + 64 * ((nb - 8) & 7); transpose64(base + s0, base + s0 + 32, 2464, dst, 1024, [](int nl) { return ilv(nl, 32); }, scr, c.lane); }
            else { const int s0 = (nb < 32 ? 1440 : 1952) + 64 * (nb & 7); transpose64(base + s0, base + s0 + 32, 2464, dst, 1024, [](int nl) { return nl; }, scr, c.lane); }
            continue; } r -= I_WIN;
        if (r < I_WO) { const int kb = r / 16, nb = r % 16; const float* src = c.w_o() + (size_t)(64 * kb) * 1024 + 64 * nb;
            transpose64(src, src + 32, 1024, c.wo_t() + (size_t)(64 * nb) * 1024 + 64 * kb, 1024, [](int nl) { return nl; }, scr, c.lane); continue; } r -= I_WO;
        if (r < I_WUQ) { const float* g = c.g_q(); transpose_item(c.w_uq(), 256, 768, c.wuq_t(), 256, [](int n) { return cm_wuq(n); }, [g](int k) { return g[k]; }, scr, r / 24, r % 24, c.lane); continue; } r -= I_WUQ;
        { const float* g = c.g_kv(); transpose_item(c.w_ukv(), 128, 1024, c.wukv_t(), 256, [](int n) { return n; }, [g](int k) { return g[k]; }, scr, r / 32, r % 32, c.lane); }
    }
}
__device__ __forceinline__ void sincos_d(double x, double& s, double& co) {
    const double PIO2_HI = 1.5707963267948966, PIO2_LO = 6.123233995736766e-17;
    const double kd = __builtin_rint(x * 0.6366197723675814); const int k = (int)kd;
    const double r = (x - kd * PIO2_HI) - kd * PIO2_LO, r2 = r * r;
    double sr = r - r * r2 * (1.0 / 6.0 - r2 * (1.0 / 120.0 - r2 * (1.0 / 5040.0 - r2 * (1.0 / 362880.0 - r2 * (1.0 / 39916800.0 - r2 * (1.0 / 6227020800.0 - r2 * (1.0 / 1307674368000.0 - r2 * (1.0 / 355687428096000.0))))))));
    double cr = 1.0 - r2 * (0.5 - r2 * (1.0 / 24.0 - r2 * (1.0 / 720.0 - r2 * (1.0 / 40320.0 - r2 * (1.0 / 3628800.0 - r2 * (1.0 / 479001600.0 - r2 * (1.0 / 87178291200.0 - r2 * (1.0 / 20922789888000.0))))))));
    switch (k & 3) { case 0: s = sr; co = cr; break; case 1: s = cr; co = -sr; break; case 2: s = -sr; co = -cr; break; default: s = -cr; co = sr; break; }
}
__device__ __forceinline__ void p0_tables(const Ctx& c) {
    const int gt = blockIdx.x * 512 + c.tid, ngt = gridDim.x * 512;
    const double r16 = 1.0 / __builtin_sqrt(__builtin_sqrt(10.0));
    const double r8 = 1.0 / __builtin_sqrt(10.0);
    for (int i = gt; i < 4096 * 48; i += ngt) {
        const int t = i / 48, j = i % 48; const int prow = t >> 6, pcol = t & 63;
        double ang;
        if (j < 32) { const int jj = j & 15; double inv = 1.0; for (int q = 0; q < jj; ++q) inv *= r16; ang = (double)(j < 16 ? prow : pcol) * inv; }
        else { const int j2 = j - 32, jj = j2 & 7; double inv = 1.0; for (int q = 0; q < jj; ++q) inv *= r8; ang = (double)(j2 < 8 ? prow : pcol) * inv; }
        double s, co; sincos_d(ang, s, co);
        if (j < 32) { c.tabr()[(t * 32 + j) * 2] = (float)co; c.tabr()[(t * 32 + j) * 2 + 1] = (float)s; }
        else { c.tabm()[(t * 16 + j - 32) * 2] = (float)co; c.tabm()[(t * 16 + j - 32) * 2 + 1] = (float)s; }
    }
}

__device__ __forceinline__ void p1_norm(const Ctx& c) {
    for (int r = c.gw * 2; r < RT; r += c.ngw * 2) {
        const float* src = r < RL ? c.x() + (size_t)r * D : c.ctx() + (size_t)(r - RL) * D; const int b = r < RL ? r / SEQ : 8;
        f32x4 v[2][4]; float s0 = 0.f, s1 = 0.f;
#pragma unroll
        for (int j = 0; j < 4; ++j) { v[0][j] = __builtin_nontemporal_load((const f32x4*)src + c.lane + 64 * j); v[1][j] = __builtin_nontemporal_load((const f32x4*)(src + D) + c.lane + 64 * j); }
#pragma unroll
        for (int j = 0; j < 4; ++j) { s0 += v[0][j].x * v[0][j].x + v[0][j].y * v[0][j].y + v[0][j].z * v[0][j].z + v[0][j].w * v[0][j].w; s1 += v[1][j].x * v[1][j].x + v[1][j].y * v[1][j].y + v[1][j].z * v[1][j].z + v[1][j].w * v[1][j].w; }
        const float ri0 = 1.f / sqrtf(wave_sum(s0) * (1.f / D) + EPS), ri1 = 1.f / sqrtf(wave_sum(s1) * (1.f / D) + EPS);
        const float* md = c.modv() + b * 6144;
#pragma unroll
        for (int j = 0; j < 4; ++j) { const int k = 4 * c.lane + 256 * j;
            const f32x4 g = *(const f32x4*)(c.g_mix() + k), sh = *(const f32x4*)(md + k), scv = *(const f32x4*)(md + 1024 + k);
            const f32x4 gs = g * (scv + 1.f); const f32x4 o0 = v[0][j] * ri0 * gs + sh, o1 = v[1][j] * ri1 * gs + sh;
            u32x2 w0, w1; w0.x = pk2(o0.x, o0.y); w0.y = pk2(o0.z, o0.w); w1.x = pk2(o1.x, o1.y); w1.y = pk2(o1.z, o1.w);
            *(u32x2*)(c.hb() + (size_t)r * D + k) = w0; *(u32x2*)(c.hb() + (size_t)(r + 1) * D + k) = w1; }
    }
}

__device__ __forceinline__ void store8_bf16(bf16_t* p, const float (&v)[8]) { u32x4 w; w.x = pk2(v[0], v[1]); w.y = pk2(v[2], v[3]); w.z = pk2(v[4], v[5]); w.w = pk2(v[6], v[7]); *(u32x4*)p = w; }


namespace pg8 {
typedef short bf16x8 __attribute__((ext_vector_type(8)));
constexpr int BM = 256, BK = 64, HALF = 128, HTB = HALF * BK * 2, STAGE_BYTES = 8 * HTB, NXCD = 8, WGM = 8;
__host__ __device__ __forceinline__ int lds_byte(int r, int c) { const int st = (r >> 4) * 2 + (c >> 5), rr = r & 15, cc = c & 31, ob = rr * 64 + cc * 2; return st * 1024 + (ob ^ (((ob >> 9) & 1) << 5)); }
__host__ __device__ __forceinline__ void stage_rc(int b, int& R, int& C) { const int st = b / 1024, sb = b % 1024, swz = sb ^ (((sb >> 9) & 1) << 5); R = (st >> 1) * 16 + swz / 64; C = (st & 1) * 32 + (swz % 64) / 2; }
__host__ __device__ __forceinline__ int perm32(int rho) { const int n = rho >> 4, i = rho & 15; return 8 * (i >> 2) + 4 * n + (i & 3); }
struct Unit { int pm, pn; };
struct Gemm { const bf16_t* A; const bf16_t* Bt; int lda, ldb, K; const int* rowlist; int gshift, gmask; size_t gstride; };
struct StaticOrder {
    int nM, nN, nwg, G, c;
    __host__ __device__ void init(int M, int N, int G_, int c_) { nM = M / BM; nN = N / BM; nwg = nM * nN; G = G_; c = c_; }
    __host__ __device__ bool next(int i, Unit& u) const {
        const long L = (long)i * G + c; if (L >= nwg) return false;
        int wgid = (int)L; { const int q = nwg / NXCD, r = nwg % NXCD, xcd = wgid % NXCD, off = wgid / NXCD; wgid = (xcd < r ? xcd * (q + 1) : r * (q + 1) + (xcd - r) * q) + off; }
        const int nig = WGM * nN, gid = wgid / nig, fm = gid * WGM, gsz = (nM - fm) < WGM ? (nM - fm) : WGM;
        u.pm = fm + ((wgid % nig) % gsz); u.pn = (wgid % nig) / gsz; return true;
    }
};
struct ExpertOrder : StaticOrder {
    __host__ __device__ bool next(int i, Unit& u) const {
        if (!StaticOrder::next(i, u)) return false;
        const int p = u.pm, x = p >> 5, el = (p >> 4) & 1, b = (p >> 1) & 7, j = p & 1; u.pm = 32 * b + 2 * (2 * x + el) + j; return true;
    }
};
template <class F, bool FENCE = false> struct EpiRow8 {
    static constexpr bool PERM = true;
    F f;
    __device__ __forceinline__ void operator()(const f32x4 (&acc)[2][2][4][2], const Unit& u, int wr, int wc, int fr, int fq) const {
        const int row0 = u.pm * BM + wr * 64 + fr, col0 = u.pn * BM + wc * 32 + 8 * fq;
#pragma unroll
        for (int ai = 0; ai < 2; ++ai)
#pragma unroll
            for (int m = 0; m < 4; ++m)
#pragma unroll
                for (int bj = 0; bj < 2; ++bj) { const f32x4 a = acc[ai][bj][m][0], b = acc[ai][bj][m][1]; const float v[8] = {a[0], a[1], a[2], a[3], b[0], b[1], b[2], b[3]};
                    f(row0 + ai * HALF + m * 16, col0 + bj * HALF, v); if (FENCE && bj == 1) asm volatile("" ::: "memory"); }
    }
};
template <bool I8> __device__ __forceinline__ f32x4 mma_step(bf16x8 a, bf16x8 b, f32x4 c) {
    if constexpr (I8) return __builtin_bit_cast(f32x4, __builtin_amdgcn_mfma_i32_16x16x64_i8(__builtin_bit_cast(i32x4, a), __builtin_bit_cast(i32x4, b), __builtin_bit_cast(i32x4, c), 0, 0, 0));
    else return __builtin_amdgcn_mfma_f32_16x16x32_bf16(a, b, c, 0, 0, 0);
}
template <bool I8 = false, class Epi, class Sched>
__device__ __forceinline__ void gemm_phase(LAS unsigned char* lds, const Gemm g, const Sched& S, const Epi& E, int tid) {
    const int wid = __builtin_amdgcn_readfirstlane(tid >> 6), lane = tid & 63, wr = wid >> 2, wc = wid & 3, fr = lane & 15, fq = lane >> 4;
    int Kv_ = g.K; asm volatile("" : "+s"(Kv_)); const int nt = Kv_ / BK;
    unsigned voffB[2];
#pragma unroll
    for (int i = 0; i < 2; ++i) { int R, C; stage_rc(tid * 16 + i * 8192, R, C); const int Rb = Epi::PERM ? ((R & ~31) + perm32(R & 31)) : R;
        voffB[i] = (unsigned)(Rb * g.ldb + C) * 2u; }
    const size_t kstep = (size_t)(BK * 2);
    const size_t hstepB = (size_t)HALF * g.ldb * 2, tstepB = 2 * hstepB;
    const unsigned ldsw = (unsigned)wid * 1024u;
    const int aoff = lds_byte(wr * 64 + fr, fq * 8), boff = lds_byte(wc * 32 + fr, fq * 8);
    const unsigned lda2 = (unsigned)g.lda * 2u;
#define PG8_SA(b, h) (((b) * 2 + (h)) * HTB)
#define PG8_SB(b, h) ((4 + (b) * 2 + (h)) * HTB)
#define PG8_STAGE(bufoff, gbase, voff) do { _Pragma("unroll") for (int _i = 0; _i < 2; ++_i) \
        __builtin_amdgcn_global_load_lds((const unsigned*)((const char*)(gbase) + (voff)[_i]), (LAS unsigned*)(lds + (bufoff) + ldsw + _i * 8192), 16, 0, 0); } while (0)
#define PG8_LDA(dst, b, h) do { _Pragma("unroll") for (int m = 0; m < 4; ++m) _Pragma("unroll") for (int k = 0; k < 2; ++k) dst[m][k] = *(const LAS bf16x8*)(lds + PG8_SA(b, h) + aoff + m * 2048 + k * 1024); } while (0)
#define PG8_LDB(dst, b, h) do { _Pragma("unroll") for (int n = 0; n < 2; ++n) _Pragma("unroll") for (int k = 0; k < 2; ++k) dst[n][k] = *(const LAS bf16x8*)(lds + PG8_SB(b, h) + boff + n * 2048 + k * 1024); } while (0)
#define PG8_MMA(ai, bj, At, Bt) do { __builtin_amdgcn_s_setprio(1); _Pragma("unroll") for (int m = 0; m < 4; ++m) _Pragma("unroll") for (int n = 0; n < 2; ++n) _Pragma("unroll") for (int k = 0; k < 2; ++k) \
        acc[ai][bj][m][n] = mma_step<I8>(Bt[n][k], At[m][k], acc[ai][bj][m][n]); __builtin_amdgcn_s_setprio(0); } while (0)
#define PG8_WAIT_V(n) asm volatile("s_waitcnt vmcnt(" #n ")" ::: "memory")
#define PG8_WAIT_L(n) asm volatile("s_waitcnt lgkmcnt(" #n ")" ::: "memory")
#define PG8_BAR __builtin_amdgcn_s_barrier()
#define PG8_SCHED __builtin_amdgcn_sched_barrier(0)
#define PG8_AOFFS(vo, u) do { _Pragma("unroll") for (int _i = 0; _i < 2; ++_i) { int _R, _C; stage_rc(tid * 16 + _i * 8192, _R, _C); _Pragma("unroll") for (int _h = 0; _h < 2; ++_h) { const int _r = (u).pm * BM + _h * HALF + _R; \
        const int _row = g.rowlist ? g.rowlist[_r] : _r; vo[_h][_i] = (unsigned)_row * lda2 + (unsigned)(_C * 2); } } } while (0)
#define PG8_BBASE(u) ((const char*)g.Bt + ((size_t)(((u).pm >> g.gshift) & g.gmask) * g.gstride) * 2 + (size_t)(u).pn * tstepB)
    Unit cur, nxt; int ui = 0;
    if (!S.next(0, cur)) return;
    f32x4 acc[2][2][4][2];
#pragma unroll
    for (int a = 0; a < 2; ++a)
#pragma unroll
        for (int b = 0; b < 2; ++b)
#pragma unroll
            for (int m = 0; m < 4; ++m)
#pragma unroll
                for (int n = 0; n < 2; ++n) acc[a][b][m][n] = (f32x4){0.f, 0.f, 0.f, 0.f};
    bf16x8 At[4][2], B0[2][2], B1[2][2];
    unsigned voc[2][2], von[2][2];
    PG8_AOFFS(voc, cur);
    const char* const A0 = (const char*)g.A; const char* cB = PG8_BBASE(cur);
    PG8_STAGE(PG8_SB(0, 0), cB, voffB); PG8_STAGE(PG8_SB(0, 1), cB + hstepB, voffB); PG8_STAGE(PG8_SA(0, 0), A0, voc[0]); PG8_STAGE(PG8_SA(0, 1), A0, voc[1]);
    if (wr == 1) PG8_BAR;
    PG8_WAIT_V(2); PG8_BAR;
    PG8_STAGE(PG8_SB(1, 0), cB + kstep, voffB); PG8_STAGE(PG8_SA(1, 0), A0 + kstep, voc[0]); PG8_STAGE(PG8_SB(1, 1), cB + hstepB + kstep, voffB);
    PG8_WAIT_V(6); PG8_BAR;
    for (;;) {
        const bool has_next = S.next(ui + 1, nxt);
        const char* nB = has_next ? PG8_BBASE(nxt) : cB;
        for (int t = 0; t < nt; t += 2) {
            const bool last = (t == nt - 2);
            const char* a1 = A0 + (size_t)(t + 1) * kstep;
            const char* a2 = last ? A0 : A0 + (size_t)(t + 2) * kstep; const char* b2 = last ? nB : cB + (size_t)(t + 2) * kstep;
            const char* a3 = a2 + kstep; const char* b3 = b2 + kstep;
            if (last) { if (has_next) { PG8_AOFFS(von, nxt); } else { _Pragma("unroll") for (int h = 0; h < 2; ++h) _Pragma("unroll") for (int i = 0; i < 2; ++i) von[h][i] = voc[h][i]; } }
            unsigned vo2[2][2];
#pragma unroll
            for (int h = 0; h < 2; ++h)
#pragma unroll
                for (int i = 0; i < 2; ++i) vo2[h][i] = last ? von[h][i] : voc[h][i];
            PG8_LDB(B0, 0, 0); PG8_LDB(B1, 0, 1); PG8_SCHED; PG8_LDA(At, 0, 0); PG8_STAGE(PG8_SA(1, 1), a1, voc[1]);
            PG8_WAIT_V(8); PG8_WAIT_L(0); PG8_BAR; PG8_MMA(0, 0, At, B0); PG8_MMA(0, 1, At, B1); PG8_BAR; PG8_SCHED;
            PG8_LDA(At, 0, 1); PG8_STAGE(PG8_SB(0, 0), b2, voffB); PG8_STAGE(PG8_SB(0, 1), b2 + hstepB, voffB); PG8_STAGE(PG8_SA(0, 0), a2, vo2[0]);
            PG8_WAIT_V(8); PG8_WAIT_L(0); PG8_BAR; PG8_MMA(1, 0, At, B0); PG8_MMA(1, 1, At, B1); PG8_BAR; PG8_SCHED;
            PG8_LDB(B0, 1, 0); PG8_LDB(B1, 1, 1); PG8_SCHED; PG8_LDA(At, 1, 0); PG8_STAGE(PG8_SA(0, 1), a2, vo2[1]);
            PG8_WAIT_V(8); PG8_WAIT_L(0); PG8_BAR; PG8_MMA(0, 0, At, B0); PG8_MMA(0, 1, At, B1); PG8_BAR; PG8_SCHED;
            PG8_LDA(At, 1, 1); PG8_STAGE(PG8_SB(1, 0), b3, voffB); PG8_STAGE(PG8_SB(1, 1), b3 + hstepB, voffB); PG8_STAGE(PG8_SA(1, 0), a3, vo2[0]);
            PG8_WAIT_V(8); PG8_WAIT_L(0); PG8_BAR; PG8_MMA(1, 0, At, B0); PG8_MMA(1, 1, At, B1); PG8_BAR; PG8_SCHED;
        }
        if (wr == 0) PG8_BAR;
        if constexpr (I8) {
#pragma unroll
            for (int a = 0; a < 2; ++a)
#pragma unroll
                for (int b = 0; b < 2; ++b)
#pragma unroll
                    for (int m = 0; m < 4; ++m)
#pragma unroll
                        for (int n = 0; n < 2; ++n) acc[a][b][m][n] = __builtin_convertvector(__builtin_bit_cast(i32x4, acc[a][b][m][n]), f32x4); }
        E(acc, cur, wr, wc, fr, fq);
        if (!has_next) break;
#pragma unroll
        for (int a = 0; a < 2; ++a)
#pragma unroll
            for (int b = 0; b < 2; ++b)
#pragma unroll
                for (int m = 0; m < 4; ++m)
#pragma unroll
                    for (int n = 0; n < 2; ++n) acc[a][b][m][n] = (f32x4){0.f, 0.f, 0.f, 0.f};
        cur = nxt; cB = nB; ++ui;
#pragma unroll
        for (int h = 0; h < 2; ++h)
#pragma unroll
            for (int i = 0; i < 2; ++i) voc[h][i] = von[h][i];
        if (wr == 1) PG8_BAR;
    }
    PG8_WAIT_V(0);
    PG8_BAR;
#undef PG8_SA
#undef PG8_SB
#undef PG8_STAGE
#undef PG8_LDA
#undef PG8_LDB
#undef PG8_MMA
#undef PG8_WAIT_V
#undef PG8_WAIT_L
#undef PG8_BAR
#undef PG8_SCHED
#undef PG8_AOFFS
#undef PG8_BBASE
}
}
template <class F> __device__ __forceinline__ pg8::EpiRow8<F> make_epi(F f) { return pg8::EpiRow8<F>{f}; }
template <class F> __device__ __forceinline__ pg8::EpiRow8<F, true> make_epi_fenced(F f) { return pg8::EpiRow8<F, true>{f}; }

struct EpiProj {
    static constexpr bool PERM = true;
    bf16_t* proj; float* pstat; const float* tabr; const float* tabm;
    __device__ __forceinline__ void operator()(const f32x4 (&acc)[2][2][4][2], const pg8::Unit& u, int wr, int wc, int fr, int fq) const {
        const int row0 = u.pm * 256 + wr * 64 + fr, pn = u.pn; const bool lat = u.pm < RL / 256;
        const bool rope_r = pn >= 2 && pn < 6 && lat, rope_m = pn == 1 && wc == 0 && lat;
        f32x4 tb[8][2];
        if (rope_r || rope_m) { const int g = rope_r ? ((wc * 32 + 8 * fq) & 63) >> 3 : fq; const float* tab = rope_r ? tabr : tabm; const int nf = rope_r ? 32 : 16;
#pragma unroll
            for (int i = 0; i < 8; ++i) { const int t = (row0 + (i >> 2) * 128 + (i & 3) * 16) & (SEQ - 1); tb[i][0] = *(const f32x4*)(tab + (t * nf + 4 * g) * 2); tb[i][1] = *(const f32x4*)(tab + (t * nf + 4 * g) * 2 + 4); } }
        else {
#pragma unroll
            for (int i = 0; i < 8; ++i) { tb[i][0] = (f32x4){1.f, 0.f, 1.f, 0.f}; tb[i][1] = (f32x4){1.f, 0.f, 1.f, 0.f}; } }
#pragma unroll
        for (int ai = 0; ai < 2; ++ai)
#pragma unroll
            for (int m = 0; m < 4; ++m) {
                const int row = row0 + ai * 128 + m * 16;
                bf16_t* pr = proj + (size_t)row * NPROJ + pn * 256 + wc * 32 + 8 * fq;
                const f32x4 c0 = tb[ai * 4 + m][0], c1 = tb[ai * 4 + m][1]; const float co[4] = {c0.x, c0.z, c1.x, c1.z}, si[4] = {c0.y, c0.w, c1.y, c1.w};
                float v[2][8];
#pragma unroll
                for (int bj = 0; bj < 2; ++bj) { const f32x4 a = acc[ai][bj][m][0], b = acc[ai][bj][m][1]; v[bj][0] = a[0]; v[bj][1] = a[1]; v[bj][2] = a[2]; v[bj][3] = a[3]; v[bj][4] = b[0]; v[bj][5] = b[1]; v[bj][6] = b[2]; v[bj][7] = b[3]; }
                if (pn == 0) {
                    float sq = 0.f;
#pragma unroll
                    for (int bj = 0; bj < 2; ++bj)
#pragma unroll
                        for (int j = 0; j < 8; ++j) sq += v[bj][j] * v[bj][j];
                    sq += __shfl_xor(sq, 16); sq += __shfl_xor(sq, 32);
                    if (fq == 0) pstat[(size_t)row * 8 + wc] = sq;
                } else if (pn == 1) {
                    float sq = 0.f;
#pragma unroll
                    for (int j = 0; j < 8; ++j) sq += v[0][j] * v[0][j];
                    sq += __shfl_xor(sq, 16); sq += __shfl_xor(sq, 32);
                    if (fq == 0) pstat[(size_t)row * 8 + 4 + wc] = sq;
                    if (wc == 0) {
#pragma unroll
                        for (int w = 0; w < 4; ++w) { const float x1 = v[1][w], x2 = v[1][4 + w]; v[1][w] = x1 * co[w] - x2 * si[w]; v[1][4 + w] = x1 * si[w] + x2 * co[w]; } }
                } else if (pn < 6) {
                    const float ksc = pn >= 4 ? 0.125f : 1.f;
#pragma unroll
                    for (int bj = 0; bj < 2; ++bj)
#pragma unroll
                        for (int w = 0; w < 4; ++w) { const float x1 = v[bj][w], x2 = v[bj][4 + w]; v[bj][w] = (x1 * co[w] - x2 * si[w]) * ksc; v[bj][4 + w] = (x1 * si[w] + x2 * co[w]) * ksc; }
                } else if (pn >= 8) {
#pragma unroll
                    for (int bj = 0; bj < 2; ++bj)
#pragma unroll
                        for (int j = 0; j < 8; ++j) v[bj][j] = silu_f(v[bj][j]);
                }
                store8_bf16(pr, v[0]); store8_bf16(pr + 128, v[1]);
            }
    }
};
__device__ __forceinline__ void p2_proj(const Ctx& c, float* lds) {
    pg8::Gemm g{c.hb(), c.win_t(), D, D, D, nullptr, 0, 0, 0};
    pg8::StaticOrder S; S.init(RT, NPROJ, (int)gridDim.x, (int)blockIdx.x);
    EpiProj E{c.proj(), c.pstat(), c.tabr(), c.tabm()};
    pg8::gemm_phase((LAS unsigned char*)lds, g, S, E, c.tid);
    if ((int)gridDim.x == 256 && (int)blockIdx.x >= QSHORT0) { __syncthreads();
        for (int q = 0; q < QSTRIPS; ++q) gu_strip_i8(c, lds, ((int)blockIdx.x - QSHORT0) * QSTRIPS + q);
        __syncthreads(); }
}
template <bool ISQ> struct EpiUp {
    static constexpr bool PERM = true;
    bf16_t* out; const float* pstat; const float* tabm;
    __device__ __forceinline__ void operator()(const f32x4 (&acc)[2][2][4][2], const pg8::Unit& u, int wr, int wc, int fr, int fq) const {
        const int row0 = u.pm * 256 + wr * 64 + fr, col00 = u.pn * 256 + wc * 32 + 8 * fq;
        float sc[8];
#pragma unroll
        for (int i = 0; i < 8; ++i) { const f32x4 ps = *(const f32x4*)(pstat + (size_t)(row0 + (i >> 2) * 128 + (i & 3) * 16) * 8 + (ISQ ? 0 : 4));
            sc[i] = (ISQ ? QSCALE : 1.f) / sqrtf((ps.x + ps.y + ps.z + ps.w) * (ISQ ? 1.f / 256.f : 1.f / 128.f) + EPS); }
#pragma unroll
        for (int ai = 0; ai < 2; ++ai)
#pragma unroll
            for (int m = 0; m < 4; ++m) { const int row = row0 + ai * 128 + m * 16; const float s_ = sc[ai * 4 + m];
#pragma unroll
                for (int bj = 0; bj < 2; ++bj) { const int c0 = col00 + bj * 128; const f32x4 a = acc[ai][bj][m][0], b = acc[ai][bj][m][1];
                    float o[8] = {a[0] * s_, a[1] * s_, a[2] * s_, a[3] * s_, b[0] * s_, b[1] * s_, b[2] * s_, b[3] * s_};
                    if (ISQ) { const int p = c0 - 96 * ((c0 * 683) >> 16);
                        if (p >= 64) { const int t = row & (SEQ - 1), g = (p - 64) >> 3;
                            const f32x4 c0v = *(const f32x4*)(tabm + (t * 16 + 4 * g) * 2), c1v = *(const f32x4*)(tabm + (t * 16 + 4 * g) * 2 + 4);
                            const float co[4] = {c0v.x, c0v.z, c1v.x, c1v.z}, si[4] = {c0v.y, c0v.w, c1v.y, c1v.w};
#pragma unroll
                            for (int w = 0; w < 4; ++w) { const float x1 = o[w], x2 = o[4 + w]; o[w] = x1 * co[w] - x2 * si[w]; o[4 + w] = x1 * si[w] + x2 * co[w]; } } }
                    store8_bf16(out + (size_t)row * (ISQ ? QW : KVW) + c0, o); } }
    }
};
__device__ __forceinline__ void p3_upq(const Ctx& c, float* lds) {
    pg8::Gemm g{c.proj() + PC_CQ, c.wuq_t(), NPROJ, 256, 256, nullptr, 0, 0, 0};
    pg8::StaticOrder S; S.init(RL, QW, (int)gridDim.x, (int)blockIdx.x);
    EpiUp<true> E{c.qb(), c.pstat(), c.tabm()};
    pg8::gemm_phase((LAS unsigned char*)lds, g, S, E, c.tid);
}
__device__ __forceinline__ void p3_upkv(const Ctx& c, float* lds) {
    pg8::Gemm g{c.proj() + PC_CKV, c.wukv_t(), NPROJ, 256, 256, nullptr, 0, 0, 0};
    pg8::StaticOrder S; S.init(RT, KVW, (int)gridDim.x, (int)blockIdx.x);
    EpiUp<false> E{c.kvb(), c.pstat(), c.tabm()};
    pg8::gemm_phase((LAS unsigned char*)lds, g, S, E, c.tid);
}

namespace att {
using bf16x8 = __attribute__((ext_vector_type(8))) short;
using s16x4  = __attribute__((ext_vector_type(4))) short;
using f32x16 = __attribute__((ext_vector_type(16))) float;
constexpr int QBLK = 32, KVBLK = 64, NWV = 8;
constexpr float THR = 8.f;
constexpr int SHM_V = 16384, SHM_K = 16384, SHM_ATTN = 3 * SHM_V + 3 * SHM_K + NWV * 64 * 4;
#define KSWZ(row, colB) ((row) * 256 + ((colB) ^ (((row) & 7) << 4)))
#define SBAR() __builtin_amdgcn_sched_barrier(0)
__device__ __forceinline__ int crow(int r, int hi) { return (r & 3) + 8 * (r >> 2) + 4 * hi; }
__device__ __forceinline__ unsigned cvtpk(float lo, float hi) { unsigned r; asm volatile("v_cvt_pk_bf16_f32 %0, %1, %2" : "=v"(r) : "v"(lo), "v"(hi)); return r; }
__device__ __forceinline__ float max3f(float a, float b, float c) { float r; asm("v_max3_f32 %0, %1, %2, %3" : "=v"(r) : "v"(a), "v"(b), "v"(c)); return r; }
template <bool FIRST>
__device__ __forceinline__ void partialSM(f32x16& p0, f32x16& p1, float& m_reg, f32x16& negm, float& alpha) {
  float pa = max3f(p0[0], p0[1], p0[2]), pb = max3f(p1[0], p1[1], p1[2]);
#pragma unroll
  for (int r = 3; r < 15; r += 2) { pa = max3f(pa, p0[r], p0[r + 1]); pb = max3f(pb, p1[r], p1[r + 1]); }
  float pmax = max3f(pa, pb, fmaxf(p0[15], p1[15]));
  { auto rr = __builtin_amdgcn_permlane32_swap(__float_as_uint(pmax), __float_as_uint(pmax), false, false);
    pmax = fmaxf(__uint_as_float(rr[0]), __uint_as_float(rr[1])); }
  if (!FIRST && __builtin_expect(__all(pmax <= THR), 1)) { alpha = 1.f; }
  else { const float dl = FIRST ? pmax : fmaxf(pmax, 0.f); alpha = FIRST ? 1.f : __builtin_amdgcn_exp2f(-dl); m_reg += dl;
#pragma unroll
    for (int r = 0; r < 16; ++r) { p0[r] -= dl; p1[r] -= dl; }
#pragma unroll
    for (int r = 0; r < 16; ++r) negm[r] = -m_reg;
    asm volatile("" : "+v"(negm)); }
#pragma unroll
  for (int r = 0; r < 16; ++r) p0[r] = __builtin_amdgcn_exp2f(p0[r]);
}
__device__ __forceinline__ void finishSM(f32x16& p0, f32x16& p1, float alpha, float& l_reg, bf16x8& pa0, bf16x8& pa1, bf16x8& pa2, bf16x8& pa3) {
#pragma unroll
  for (int r = 0; r < 16; ++r) p1[r] = __builtin_amdgcn_exp2f(p1[r]);
  float ps = 0;
#pragma unroll
  for (int r = 0; r < 16; ++r) ps += p0[r];
#pragma unroll
  for (int r = 0; r < 16; ++r) ps += p1[r];
  { auto rr = __builtin_amdgcn_permlane32_swap(__float_as_uint(ps), __float_as_uint(ps), false, false);
    ps = __uint_as_float(rr[0]) + __uint_as_float(rr[1]); }
  l_reg = l_reg * alpha + ps;
#define PK4(P, BASE, OUT) do { unsigned a0 = cvtpk(P[BASE + 0], P[BASE + 1]), a1 = cvtpk(P[BASE + 2], P[BASE + 3]);   \
    unsigned b0 = cvtpk(P[BASE + 4], P[BASE + 5]), b1 = cvtpk(P[BASE + 6], P[BASE + 7]);                              \
    auto r0 = __builtin_amdgcn_permlane32_swap(a0, b0, false, false); auto r1 = __builtin_amdgcn_permlane32_swap(a1, b1, false, false); \
    u32x4 w = {r0[0], r1[0], r0[1], r1[1]}; OUT = *reinterpret_cast<bf16x8*>(&w); } while (0)
  PK4(p0, 0, pa0); PK4(p0, 8, pa1); PK4(p1, 0, pa2); PK4(p1, 8, pa3);
#undef PK4
}
__device__ __forceinline__ void qkt(f32x16& p0, f32x16& p1, const char* Ks, const bf16x8* qr, const f32x16& negm, int r32, int hi) {
#pragma unroll
  for (int d0 = 0; d0 < 6; ++d0) { const int cb = (d0 * 16 + hi * 8) * 2;
    const bf16x8 b0 = *reinterpret_cast<const bf16x8*>(Ks + KSWZ(r32, cb));
    const bf16x8 b1 = *reinterpret_cast<const bf16x8*>(Ks + KSWZ(32 + r32, cb));
    if (d0 == 0) { p0 = __builtin_amdgcn_mfma_f32_32x32x16_bf16(b0, qr[0], negm, 0, 0, 0); p1 = __builtin_amdgcn_mfma_f32_32x32x16_bf16(b1, qr[0], negm, 0, 0, 0); }
    else { p0 = __builtin_amdgcn_mfma_f32_32x32x16_bf16(b0, qr[d0], p0, 0, 0, 0); p1 = __builtin_amdgcn_mfma_f32_32x32x16_bf16(b1, qr[d0], p1, 0, 0, 0); } }
}
__device__ __forceinline__ int v_st(int k, int c) { const int kk = (k & ~0xC) | ((k & 4) << 1) | ((k & 8) >> 1); return ((kk >> 3) * 4 + (c >> 5)) * 512 + ((kk & 7) * 32 + (c & 31)) * 2; }
__device__ __forceinline__ int v_rd_base(int lane) { return ((lane & 3) << 3) | (((lane >> 2) & 3) << 6) | (((lane >> 4) & 1) << 5) | (((lane >> 5) & 1) << 8); }
constexpr int v_rd_off(int d0, int ks, int half) { return d0 * 512 + ks * 4096 + half * 2048; }
template <int OFF> __device__ __forceinline__ s16x4 tr_read(int vb) { s16x4 r; asm volatile("ds_read_b64_tr_b16 %0, %1 offset:%2" : "=&v"(r) : "v"(vb), "i"(OFF) : "memory"); return r; }
template <int D0> __device__ __forceinline__ void pv_one(f32x16& od, int vb, bf16x8 pa0, bf16x8 pa1, bf16x8 pa2, bf16x8 pa3) {
  const s16x4 l0 = tr_read<v_rd_off(D0, 0, 0)>(vb), h0 = tr_read<v_rd_off(D0, 0, 1)>(vb), l1 = tr_read<v_rd_off(D0, 1, 0)>(vb), h1 = tr_read<v_rd_off(D0, 1, 1)>(vb);
  const s16x4 l2 = tr_read<v_rd_off(D0, 2, 0)>(vb), h2 = tr_read<v_rd_off(D0, 2, 1)>(vb), l3 = tr_read<v_rd_off(D0, 3, 0)>(vb), h3 = tr_read<v_rd_off(D0, 3, 1)>(vb);
  asm volatile("s_waitcnt lgkmcnt(0)" ::: "memory"); SBAR();
#define PK(L, H) (bf16x8){L[0], L[1], L[2], L[3], H[0], H[1], H[2], H[3]}
  od = __builtin_amdgcn_mfma_f32_32x32x16_bf16(pa0, PK(l0, h0), od, 0, 0, 0);
  od = __builtin_amdgcn_mfma_f32_32x32x16_bf16(pa1, PK(l1, h1), od, 0, 0, 0);
  od = __builtin_amdgcn_mfma_f32_32x32x16_bf16(pa2, PK(l2, h2), od, 0, 0, 0);
  od = __builtin_amdgcn_mfma_f32_32x32x16_bf16(pa3, PK(l3, h3), od, 0, 0, 0);
#undef PK
}
__device__ __forceinline__ void pv_d0(f32x16* o, int vb, bf16x8 pa0, bf16x8 pa1, bf16x8 pa2, bf16x8 pa3) {
  const s16x4 l0 = tr_read<v_rd_off(0, 0, 0)>(vb), h0 = tr_read<v_rd_off(0, 0, 1)>(vb), l1 = tr_read<v_rd_off(0, 1, 0)>(vb), h1 = tr_read<v_rd_off(0, 1, 1)>(vb);
  const s16x4 l2 = tr_read<v_rd_off(0, 2, 0)>(vb), h2 = tr_read<v_rd_off(0, 2, 1)>(vb), l3 = tr_read<v_rd_off(0, 3, 0)>(vb), h3 = tr_read<v_rd_off(0, 3, 1)>(vb);
  const s16x4 m0 = tr_read<v_rd_off(1, 0, 0)>(vb), g0 = tr_read<v_rd_off(1, 0, 1)>(vb), m1 = tr_read<v_rd_off(1, 1, 0)>(vb), g1 = tr_read<v_rd_off(1, 1, 1)>(vb);
  const s16x4 m2 = tr_read<v_rd_off(1, 2, 0)>(vb), g2 = tr_read<v_rd_off(1, 2, 1)>(vb), m3 = tr_read<v_rd_off(1, 3, 0)>(vb), g3 = tr_read<v_rd_off(1, 3, 1)>(vb);
  asm volatile("s_waitcnt lgkmcnt(0)" ::: "memory"); SBAR();
#define PK(L, H) (bf16x8){L[0], L[1], L[2], L[3], H[0], H[1], H[2], H[3]}
  o[0] = __builtin_amdgcn_mfma_f32_32x32x16_bf16(pa0, PK(l0, h0), o[0], 0, 0, 0); o[1] = __builtin_amdgcn_mfma_f32_32x32x16_bf16(pa0, PK(m0, g0), o[1], 0, 0, 0);
  o[0] = __builtin_amdgcn_mfma_f32_32x32x16_bf16(pa1, PK(l1, h1), o[0], 0, 0, 0); o[1] = __builtin_amdgcn_mfma_f32_32x32x16_bf16(pa1, PK(m1, g1), o[1], 0, 0, 0);
  o[0] = __builtin_amdgcn_mfma_f32_32x32x16_bf16(pa2, PK(l2, h2), o[0], 0, 0, 0); o[1] = __builtin_amdgcn_mfma_f32_32x32x16_bf16(pa2, PK(m2, g2), o[1], 0, 0, 0);
  o[0] = __builtin_amdgcn_mfma_f32_32x32x16_bf16(pa3, PK(l3, h3), o[0], 0, 0, 0); o[1] = __builtin_amdgcn_mfma_f32_32x32x16_bf16(pa3, PK(m3, g3), o[1], 0, 0, 0);
#undef PK
}

__device__ __forceinline__ void attn_unit(const bf16_t* __restrict__ Qb, const bf16_t* __restrict__ KN, const bf16_t* __restrict__ KR, const bf16_t* __restrict__ VV, bf16_t* __restrict__ Ob, int b, char* lds, int tid) {
  const int wid = tid >> 6, lane = tid & 63, r32 = lane & 31, hi = lane >> 5;
  char* V_lds = lds; char* K_lds = lds + 3 * SHM_V;
  float* ws = (float*)(lds + 3 * SHM_V + 3 * SHM_K) + wid * 64; float* li_l = ws; float* al_l = ws + 32;
  float m_reg = 0.f, l_reg = 0; f32x16 o[2] = {}; bf16x8 qr[6]; f32x16 negm = {};
  const bf16_t* Qw = Qb + (long)(wid * QBLK + r32) * QW + hi * 8;
#pragma unroll
  for (int d0 = 0; d0 < 6; ++d0) qr[d0] = __builtin_nontemporal_load(reinterpret_cast<const bf16x8*>(Qw + d0 * 16));
  const int srow = tid >> 3, sch = tid & 7;
  const int rrow = (tid & 255) >> 2, rch = tid & 3;
  const int vst = v_st(srow, sch * 8), kst = KSWZ(srow, sch * 16), krst = KSWZ(rrow, 128 + rch * 16);
  const int vb0 = (int)(uintptr_t)V_lds + v_rd_base(lane);
  struct { bf16x8 vs, kn, kr; } sr_[2];
#define ROWBASE(j) ((j) < 64 ? (long)b * SEQ + (long)(j) * 64 : (long)RL + (long)b * LC + (long)((j) - 64) * 64)
#define SLOAD(i, j) do { const long rb_ = ROWBASE(j); sr_[i].vs = *reinterpret_cast<const bf16x8*>(VV + (rb_ + srow) * KVW + sch * 8); \
    sr_[i].kn = *reinterpret_cast<const bf16x8*>(KN + (rb_ + srow) * KVW + sch * 8); sr_[i].kr = *reinterpret_cast<const bf16x8*>(KR + (rb_ + rrow) * NPROJ + rch * 8); } while (0)
#define SWRITE(bb, i) do { *(bf16x8*)(V_lds + (bb) * SHM_V + vst) = sr_[i].vs; *(bf16x8*)(K_lds + (bb) * SHM_K + kst) = sr_[i].kn; \
    if (wid < 4) *(bf16x8*)(K_lds + (bb) * SHM_K + krst) = sr_[i].kr; } while (0)
#define SWAIT() asm volatile("s_waitcnt vmcnt(3)" ::: "memory")
#define RESC(a) do { if (__any((a) < 1.f)) { if (hi == 0) al_l[r32] = (a); asm volatile("s_waitcnt lgkmcnt(0)" ::: "memory"); \
    _Pragma("unroll") for (int d = 0; d < 2; ++d) _Pragma("unroll") for (int r = 0; r < 16; ++r) o[d][r] *= al_l[crow(r, hi)]; } } while (0)
  f32x16 pA0, pA1, pB0, pB1; float alA, alB; bf16x8 pa0, pa1, pa2, pa3; constexpr int NT = (SEQ + LC) / KVBLK;
  if (wid >= 4) __builtin_amdgcn_s_setprio(1);
  int cur = 1, prev = 0, nxt = 2;
  SLOAD(0, 0); SLOAD(1, 1); asm volatile("s_waitcnt vmcnt(0)" ::: "memory"); SWRITE(0, 0); SWRITE(1, 1); SLOAD(0, 2); SLOAD(1, 3); __syncthreads();
  qkt(pA0, pA1, K_lds, qr, negm, r32, hi); partialSM<true>(pA0, pA1, m_reg, negm, alA);
#define HALFSTEP(PX0, PX1, PP0, PP1, ALX, ALP, STG, T) do { \
    __syncthreads(); \
    SBAR(); qkt(PX0, PX1, K_lds + cur * SHM_K, qr, negm, r32, hi); \
    finishSM(PP0, PP1, ALP, l_reg, pa0, pa1, pa2, pa3); SBAR(); \
    if ((T) + 1 < NT) { SWAIT(); SWRITE(nxt, STG); if ((T) + 3 < NT) SLOAD(STG, (T) + 3); } SBAR(); \
    pv_d0(o, vb0 + prev * SHM_V, pa0, pa1, pa2, pa3); partialSM<false>(PX0, PX1, m_reg, negm, ALX); \
    RESC(ALX); { const int t_ = prev; prev = cur; cur = nxt; nxt = t_; } } while (0)
  for (int t = 1; t + 1 < NT; t += 2) {
    HALFSTEP(pB0, pB1, pA0, pA1, alB, alA, 0, t);
    HALFSTEP(pA0, pA1, pB0, pB1, alA, alB, 1, t + 1);
  }
  HALFSTEP(pB0, pB1, pA0, pA1, alB, alA, 0, NT - 1);
  finishSM(pB0, pB1, alB, l_reg, pa0, pa1, pa2, pa3); SBAR();
  pv_d0(o, vb0 + prev * SHM_V, pa0, pa1, pa2, pa3);
#undef HALFSTEP
  if (hi == 0) li_l[r32] = l_reg; asm volatile("s_waitcnt lgkmcnt(0)" ::: "memory");
  float rli[16];
#pragma unroll
  for (int r = 0; r < 16; ++r) rli[r] = __builtin_amdgcn_rcpf(li_l[crow(r, hi)]);
  bf16_t* Ow = Ob + (long)(wid * QBLK) * D;
#pragma unroll
  for (int r = 0; r < 16; ++r) { const int orow = crow(r, hi);
#pragma unroll
    for (int d0 = 0; d0 < 2; ++d0) Ow[(long)orow * D + d0 * 32 + r32] = f2bf(o[d0][r] * rli[r]); }
  __builtin_amdgcn_s_setprio(0);
  __syncthreads();
#undef ROWBASE
#undef SLOAD
#undef SWRITE
#undef SWAIT
#undef RESC
}
#undef KSWZ
#undef SBAR
}


__device__ __forceinline__ float lg2_of(float e) { return log1pf(-exp2f(-e)) * 1.4426950408889634f; }
namespace ret {
using att::bf16x8; using att::s16x4; using att::f32x16; using att::v_st; using att::v_rd_base; using att::v_rd_off; using att::tr_read; using att::crow; using att::cvtpk;
constexpr int TB = 16384;
__device__ __forceinline__ bf16x8 scale8(bf16x8 x, float z) {
    const u32x4 w = __builtin_bit_cast(u32x4, x); u32x4 o;
    o.x = cvtpk(__uint_as_float(w.x << 16) * z, __uint_as_float(w.x & 0xffff0000u) * z); o.y = cvtpk(__uint_as_float(w.y << 16) * z, __uint_as_float(w.y & 0xffff0000u) * z);
    o.z = cvtpk(__uint_as_float(w.z << 16) * z, __uint_as_float(w.z & 0xffff0000u) * z); o.w = cvtpk(__uint_as_float(w.w << 16) * z, __uint_as_float(w.w & 0xffff0000u) * z);
    return __builtin_bit_cast(bf16x8, o);
}
#define RET_PK(L, H) (bf16x8){L[0], L[1], L[2], L[3], H[0], H[1], H[2], H[3]}
__device__ __forceinline__ void tt_mma(f32x16& acc, int va, int vb) {
    const s16x4 al0 = tr_read<v_rd_off(0, 0, 0)>(va), ah0 = tr_read<v_rd_off(0, 0, 1)>(va), al1 = tr_read<v_rd_off(0, 1, 0)>(va), ah1 = tr_read<v_rd_off(0, 1, 1)>(va);
    const s16x4 al2 = tr_read<v_rd_off(0, 2, 0)>(va), ah2 = tr_read<v_rd_off(0, 2, 1)>(va), al3 = tr_read<v_rd_off(0, 3, 0)>(va), ah3 = tr_read<v_rd_off(0, 3, 1)>(va);
    const s16x4 bl0 = tr_read<v_rd_off(0, 0, 0)>(vb), bh0 = tr_read<v_rd_off(0, 0, 1)>(vb), bl1 = tr_read<v_rd_off(0, 1, 0)>(vb), bh1 = tr_read<v_rd_off(0, 1, 1)>(vb);
    const s16x4 bl2 = tr_read<v_rd_off(0, 2, 0)>(vb), bh2 = tr_read<v_rd_off(0, 2, 1)>(vb), bl3 = tr_read<v_rd_off(0, 3, 0)>(vb), bh3 = tr_read<v_rd_off(0, 3, 1)>(vb);
    asm volatile("s_waitcnt lgkmcnt(0)" ::: "memory"); __builtin_amdgcn_sched_barrier(0);
    acc = __builtin_amdgcn_mfma_f32_32x32x16_bf16(RET_PK(al0, ah0), RET_PK(bl0, bh0), acc, 0, 0, 0);
    acc = __builtin_amdgcn_mfma_f32_32x32x16_bf16(RET_PK(al1, ah1), RET_PK(bl1, bh1), acc, 0, 0, 0);
    acc = __builtin_amdgcn_mfma_f32_32x32x16_bf16(RET_PK(al2, ah2), RET_PK(bl2, bh2), acc, 0, 0, 0);
    acc = __builtin_amdgcn_mfma_f32_32x32x16_bf16(RET_PK(al3, ah3), RET_PK(bl3, bh3), acc, 0, 0, 0);
}
__device__ __forceinline__ void scan_seq(const bf16_t* __restrict__ proj, bf16_t* __restrict__ rstT, int b, int h, int dir, float lg2, char* lds, int tid) {
    const int wid = tid >> 6, lane = tid & 63, r32 = lane & 31, hi = lane >> 5;
    const float g128 = __builtin_amdgcn_exp2f(lg2 * 128.f);
    const int key0 = tid >> 3, key1 = 64 + (tid >> 3), ch = tid & 7;
    const float z0 = __builtin_amdgcn_exp2f(lg2 * (float)(dir ? key0 : 127 - key0)), z1 = __builtin_amdgcn_exp2f(lg2 * (float)(dir ? key1 : 127 - key1));
    const int st = v_st(tid >> 3, ch * 8);
    char* KI = lds; char* VI = lds + 4 * TB;
    const int mt = (wid >> 1) & 1, nt = wid & 1;
    const int vaK = (int)(uintptr_t)KI + v_rd_base(lane) + mt * 512, vbV = (int)(uintptr_t)VI + v_rd_base(lane) + nt * 512;
    f32x16 acc = {};
    bf16x8 k0a, k1a, v0a, v1a, k0b, k1b, v0b, v1b, k0c, k1c, v0c, v1c, k0d, k1d, v0d, v1d;
#define RROW(ck) ((ck) < 2 ? (long)RL + (long)b * LC + (long)(dir ? 1 - (ck) : (ck)) * 128 : (long)b * SEQ + (long)(dir ? NCH - 1 - ((ck) - 2) : (ck) - 2) * 128)
#define RLOAD(S, ck) do { const bf16_t* p_ = proj + RROW(ck) * NPROJ + h * 64 + ch * 8; k0##S = *(const bf16x8*)(p_ + (long)key0 * NPROJ + PC_RK); k1##S = *(const bf16x8*)(p_ + (long)key1 * NPROJ + PC_RK); \
        v0##S = *(const bf16x8*)(p_ + (long)key0 * NPROJ + PC_RV); v1##S = *(const bf16x8*)(p_ + (long)key1 * NPROJ + PC_RV); } while (0)
#define RWRITE(S, bb) do { *(bf16x8*)(KI + ((bb) * 2 + 0) * TB + st) = scale8(k0##S, z0); *(bf16x8*)(KI + ((bb) * 2 + 1) * TB + st) = scale8(k1##S, z1); \
        *(bf16x8*)(VI + ((bb) * 2 + 0) * TB + st) = v0##S; *(bf16x8*)(VI + ((bb) * 2 + 1) * TB + st) = v1##S; } while (0)
#define RCOMP(ck, bb) do { if (wid < 4) { \
            if ((ck) >= 2) { const int n = dir ? NCH - 1 - ((ck) - 2) : (ck) - 2; bf16_t* o = rstT + (size_t)n * 4096 + (size_t)(32 * nt + r32) * 64 + 32 * mt + 4 * hi; \
                _Pragma("unroll") for (int g = 0; g < 4; ++g) { u32x2 w; w.x = cvtpk(acc[4 * g], acc[4 * g + 1]); w.y = cvtpk(acc[4 * g + 2], acc[4 * g + 3]); *(u32x2*)(o + 8 * g) = w; } } \
            _Pragma("unroll") for (int r = 0; r < 16; ++r) acc[r] *= g128; \
            tt_mma(acc, vaK + ((bb) * 2 + 0) * TB, vbV + ((bb) * 2 + 0) * TB); \
            tt_mma(acc, vaK + ((bb) * 2 + 1) * TB, vbV + ((bb) * 2 + 1) * TB); } } while (0)
    constexpr int NCK = 2 + NCH;
#define RSTEP(ck, S) do { RCOMP(ck, (ck) & 1); if ((ck) + 1 < NCK) { RWRITE(S, ((ck) + 1) & 1); } if ((ck) + 5 < NCK) RLOAD(S, (ck) + 5); __syncthreads(); } while (0)
    __syncthreads();
    RLOAD(a, 0); RWRITE(a, 0); RLOAD(b, 1); RLOAD(c, 2); RLOAD(d, 3); RLOAD(a, 4); __syncthreads();
    for (int ck = 0; ck < 32; ck += 4) { RSTEP(ck, b); RSTEP(ck + 1, c); RSTEP(ck + 2, d); RSTEP(ck + 3, a); }
    RSTEP(32, b); RSTEP(33, c);
#undef RSTEP
#undef RCOMP
#undef RROW
#undef RLOAD
#undef RWRITE
}

__device__ __forceinline__ int vc_st(int k, int c) { const int kk = (k & ~0xC) | ((k & 4) << 1) | ((k & 8) >> 1); return ((kk >> 3) * 2 + (c >> 5)) * 512 + ((kk & 7) * 32 + (c & 31)) * 2; }
constexpr int vc_rd_off(int ks, int half) { return ks * 2048 + half * 1024; }
constexpr int RBUF = 32768;
struct RetUnit { int b, h, n; };
template <class UF>
__device__ __forceinline__ void ret_group(const bf16_t* __restrict__ proj, const bf16_t* __restrict__ rst, const float* __restrict__ g_ret, const float* __restrict__ exp_f, const float* __restrict__ exp_b,
                                          bf16_t* __restrict__ mix, int nunits, UF unit_of, char* gl, int t4, int w4, int lane) {
    const int r32 = lane & 31, hi = lane >> 5, i = 32 * w4 + r32;
    bf16x8 qn[4];
    int soff[8];
#pragma unroll
    for (int q_ = 0; q_ < 8; ++q_) { const int s_ = ((4 * q_ + w4) * 64 + lane) & 1023;
        if (q_ < 4) { const int img = s_ >> 9, sub = (s_ & 511) >> 5, rw = (s_ & 31) >> 2, cc = s_ & 3; const int kk = (sub >> 1) * 8 + rw, key = (kk & ~0xC) | ((kk & 4) << 1) | ((kk & 8) >> 1);
            soff[q_] = (img * 64 + key) * NPROJ + PC_RV + (sub & 1) * 32 + cc * 8; }
        else { const int row = s_ >> 3, cp = s_ & 7, chn = cp ^ ((row >> 1) & 7); soff[q_] = row * NPROJ + PC_RK + chn * 8; } }
#define RG_LOAD(u, bb) do { const bf16_t* base_ = proj + ((long)(u).b * SEQ + (long)(u).n * 128) * NPROJ + (u).h * 64; \
        _Pragma("unroll") for (int q_ = 0; q_ < 8; ++q_) __builtin_amdgcn_global_load_lds((const unsigned*)(base_ + soff[q_]), (LAS unsigned*)((LAS char*)gl + (bb) * RBUF + (4 * q_ + w4) * 1024), 16, 0, 0); \
        const bf16_t* qp_ = base_ + (long)i * NPROJ + PC_RQ + hi * 8; \
        _Pragma("unroll") for (int ks_ = 0; ks_ < 4; ++ks_) qn[ks_] = *(const bf16x8*)(qp_ + ks_ * 16); } while (0)
    RetUnit u = unit_of(0);
    RG_LOAD(u, 0);
    bf16x8 q[4];
#pragma unroll
    for (int ks = 0; ks < 4; ++ks) q[ks] = qn[ks];
    asm volatile("s_waitcnt vmcnt(0)" ::: "memory"); __syncthreads();
    for (int ui = 0; ui < nunits; ++ui) {
        const int bb = ui & 1; const RetUnit un = unit_of(ui + 1 < nunits ? ui + 1 : ui);
        if (ui + 1 < nunits) RG_LOAD(un, bb ^ 1);
        const float lf = lg2_of(exp_f[u.h]), lb = lg2_of(exp_b[u.h]);
        int io = i, hio = hi; asm volatile("" : "+v"(io), "+v"(hio));
        const long row0 = (long)u.b * SEQ + (long)u.n * 128;
        const bf16_t* rf = rst + (size_t)(((u.b * NH + u.h) * 2 + 0) * NCH + u.n) * 4096 + (size_t)r32 * 64 + hi * 8;
        const bf16_t* rb = rst + (size_t)(((u.b * NH + u.h) * 2 + 1) * NCH + u.n) * 4096 + (size_t)r32 * 64 + hi * 8;
        bf16x8 rff[2][4], rbf[2][4];
#pragma unroll
        for (int et = 0; et < 2; ++et)
#pragma unroll
            for (int ks = 0; ks < 4; ++ks) { rff[et][ks] = *(const bf16x8*)(rf + et * 2048 + ks * 16); rbf[et][ks] = *(const bf16x8*)(rb + et * 2048 + ks * 16); }
        f32x16 acc[2] = {f32x16{}, f32x16{}};
        const char* kt = gl + bb * RBUF + 16384; const int vimg0 = (int)(uintptr_t)(gl + bb * RBUF) + v_rd_base(lane);
#pragma unroll
        for (int t = 0; t < 4; ++t) {
            f32x16 p = {};
            const int krow = 32 * t + r32;
#pragma unroll
            for (int ks = 0; ks < 4; ++ks) { const bf16x8 kf = *(const bf16x8*)(kt + krow * 128 + (((2 * ks + hi) ^ ((krow >> 1) & 7)) << 4)); p = __builtin_amdgcn_mfma_f32_32x32x16_bf16(kf, q[ks], p, 0, 0, 0); }
#pragma unroll
            for (int r = 0; r < 16; ++r) { const int j = 32 * t + (r & 3) + 8 * (r >> 2) + 4 * hio; const int dd = io - j; p[r] *= __builtin_amdgcn_exp2f(dd >= 0 ? lf * (float)dd : lb * (float)(-dd)); }
            bf16x8 pa0, pa1;
#define PK4(P, BASE, OUT) do { unsigned a0 = cvtpk(P[BASE + 0], P[BASE + 1]), a1 = cvtpk(P[BASE + 2], P[BASE + 3]);   \
    unsigned b0 = cvtpk(P[BASE + 4], P[BASE + 5]), b1 = cvtpk(P[BASE + 6], P[BASE + 7]);                              \
    auto r0 = __builtin_amdgcn_permlane32_swap(a0, b0, false, false); auto r1 = __builtin_amdgcn_permlane32_swap(a1, b1, false, false); \
    u32x4 w = {r0[0], r1[0], r0[1], r1[1]}; OUT = *reinterpret_cast<bf16x8*>(&w); } while (0)
            PK4(p, 0, pa0); PK4(p, 8, pa1);
#undef PK4
            const int vimg = vimg0 + (t >> 1) * 8192;
#pragma unroll
            for (int et = 0; et < 2; ++et) {
                s16x4 l0, h0, l1, h1;
                if ((t & 1) == 0) { l0 = tr_read<vc_rd_off(0, 0)>(vimg + et * 512); h0 = tr_read<vc_rd_off(0, 1)>(vimg + et * 512); l1 = tr_read<vc_rd_off(1, 0)>(vimg + et * 512); h1 = tr_read<vc_rd_off(1, 1)>(vimg + et * 512); }
                else { l0 = tr_read<vc_rd_off(2, 0)>(vimg + et * 512); h0 = tr_read<vc_rd_off(2, 1)>(vimg + et * 512); l1 = tr_read<vc_rd_off(3, 0)>(vimg + et * 512); h1 = tr_read<vc_rd_off(3, 1)>(vimg + et * 512); }
                asm volatile("s_waitcnt lgkmcnt(0)" ::: "memory"); __builtin_amdgcn_sched_barrier(0);
                acc[et] = __builtin_amdgcn_mfma_f32_32x32x16_bf16(RET_PK(l0, h0), pa0, acc[et], 0, 0, 0);
                acc[et] = __builtin_amdgcn_mfma_f32_32x32x16_bf16(RET_PK(l1, h1), pa1, acc[et], 0, 0, 0);
            }
            asm volatile("" ::: "memory");
        }
        const float xf = __builtin_amdgcn_exp2f(lf * (float)(i + 1)), xb = __builtin_amdgcn_exp2f(lb * (float)(128 - i));
        const bf16_t* gp = proj + (row0 + i) * NPROJ + PC_RG + u.h * 64; bf16_t* op = mix + (row0 + i) * D + 512 + u.h * 64; const float* gr = g_ret + u.h * 64;
        u32x2 gwv[2][4];
#pragma unroll
        for (int et = 0; et < 2; ++et)
#pragma unroll
            for (int g = 0; g < 4; ++g) gwv[et][g] = *(const u32x2*)(gp + 32 * et + 8 * g + 4 * hi);
        bf16x8 qf[4], qbk[4];
#pragma unroll
        for (int ks = 0; ks < 4; ++ks) { qf[ks] = scale8(q[ks], xf); qbk[ks] = scale8(q[ks], xb); }
#pragma unroll
        for (int et = 0; et < 2; ++et) {
#pragma unroll
            for (int ks = 0; ks < 4; ++ks) acc[et] = __builtin_amdgcn_mfma_f32_32x32x16_bf16(rff[et][ks], qf[ks], acc[et], 0, 0, 0);
#pragma unroll
            for (int ks = 0; ks < 4; ++ks) acc[et] = __builtin_amdgcn_mfma_f32_32x32x16_bf16(rbf[et][ks], qbk[ks], acc[et], 0, 0, 0); }
        float s1 = 0.f;
#pragma unroll
        for (int et = 0; et < 2; ++et)
#pragma unroll
            for (int r = 0; r < 16; ++r) s1 += acc[et][r];
        { auto rr = __builtin_amdgcn_permlane32_swap(__float_as_uint(s1), __float_as_uint(s1), false, false); s1 = __uint_as_float(rr[0]) + __uint_as_float(rr[1]); }
        const float mu = s1 * (1.f / 64.f); float s2 = 0.f;
#pragma unroll
        for (int et = 0; et < 2; ++et)
#pragma unroll
            for (int r = 0; r < 16; ++r) { const float dlt = acc[et][r] - mu; s2 += dlt * dlt; }
        { auto rr = __builtin_amdgcn_permlane32_swap(__float_as_uint(s2), __float_as_uint(s2), false, false); s2 = __uint_as_float(rr[0]) + __uint_as_float(rr[1]); }
        const float rs = 1.f / sqrtf(s2 * (1.f / 64.f) + EPS);
#pragma unroll
        for (int et = 0; et < 2; ++et)
#pragma unroll
            for (int g = 0; g < 4; ++g) { const int e = 32 * et + 8 * g + 4 * hi; const u32x2 gw = gwv[et][g]; const f32x4 gg = *(const f32x4*)(gr + e);
                const float o0 = (acc[et][4 * g] - mu) * rs * gg.x * __uint_as_float(gw.x << 16), o1 = (acc[et][4 * g + 1] - mu) * rs * gg.y * __uint_as_float(gw.x & 0xffff0000u);
                const float o2 = (acc[et][4 * g + 2] - mu) * rs * gg.z * __uint_as_float(gw.y << 16), o3 = (acc[et][4 * g + 3] - mu) * rs * gg.w * __uint_as_float(gw.y & 0xffff0000u);
                u32x2 w; w.x = cvtpk(o0, o1); w.y = cvtpk(o2, o3); *(u32x2*)(op + e) = w; }
        if (ui + 1 < nunits) {
#pragma unroll
            for (int ks = 0; ks < 4; ++ks) q[ks] = qn[ks]; }
        u = un;
        asm volatile("s_waitcnt vmcnt(0)" ::: "memory"); __syncthreads();
    }
#undef RG_LOAD
}
#undef RET_PK
}

__device__ __forceinline__ void p4_attn(const Ctx& c, float* lds) {
    const int G = (int)gridDim.x, bx = (int)blockIdx.x; const int vcu = (G % 8 == 0) ? (bx % 8) * (G / 8) + bx / 8 : bx;
    for (int unit = vcu; unit < NB * NH * 16; unit += G) {
        const int qblk = unit & 15, h = (unit >> 4) & 7, b = unit >> 7;
        att::attn_unit(c.qb() + (size_t)(b * SEQ + qblk * 256) * QW + h * 96, c.kvb() + h * 128, c.proj() + PC_KR, c.kvb() + h * 128 + 64,
                       c.mix() + (size_t)(b * SEQ + qblk * 256) * D + h * 64, b, (char*)lds, c.tid);
    }
}
__device__ __forceinline__ void p3c_scan(const Ctx& c, float* lds) {
    const int bx = (int)blockIdx.x;
    for (int seq = bx >> 1; seq < NB * NH * 2 && (bx & 1) == 0; seq += (int)gridDim.x >> 1) {
        const int dir = seq & 1, h = (seq >> 1) & 7, b = seq >> 4;
        const float lg2 = lg2_of(dir ? c.exp_b()[h] : c.exp_f()[h]);
        ret::scan_seq(c.proj(), c.rst() + (size_t)((b * NH + h) * 2 + dir) * NCH * 4096, b, h, dir, lg2, (char*)lds, c.tid);
    }
    __syncthreads();
    { const int G = (int)gridDim.x; const int first = G == 256 ? QSTATIC : 0;
      for (int q = first + (G == 256 ? (bx >> 1) : bx); q < GU_STRIPS && (G != 256 || (bx & 1)); q += (G == 256 ? 128 : G)) gu_strip_i8(c, lds, q); }
    __syncthreads();
    p0_weights<1>(c, lds, 0, 1);
    __syncthreads();
}
__device__ __forceinline__ void p4_ret(const Ctx& c, float* lds) {
    const int tid = c.tid, wid = tid >> 6, lane = tid & 63, grp = wid >> 2, w4 = wid & 3;
    const int G = (int)gridDim.x, bx = (int)blockIdx.x; const int vcu = (G % 8 == 0) ? (bx % 8) * (G / 8) + bx / 8 : bx;
    const int gid = vcu * 2 + grp, ngrp = 2 * G; const int total = NB * NH * NCH;
    const int nun = (total - gid + ngrp - 1) / ngrp;
    __syncthreads();
    ret::ret_group(c.proj(), c.rst(), c.g_ret(), c.exp_f(), c.exp_b(), c.mix(), nun,
                   [gid, ngrp](int k) { const int unit = gid + ngrp * k; return ret::RetUnit{unit >> 8, (unit >> 5) & 7, unit & 31}; }, (char*)lds + grp * 2 * ret::RBUF, tid & 255, w4, lane);
}

struct EpiRes {
    static constexpr bool PERM = true;
    const float* x; bf16_t* out; const float* modv; float* part;
    __device__ __forceinline__ void operator()(const f32x4 (&acc)[2][2][4][2], const pg8::Unit& u, int wr, int wc, int fr, int fq) const {
        const int row0 = u.pm * 256 + wr * 64 + fr, col0 = u.pn * 256 + wc * 32 + 8 * fq; const int b = (u.pm * 256) / SEQ;
        f32x4 ga[2][2];
#pragma unroll
        for (int bj = 0; bj < 2; ++bj) { ga[bj][0] = *(const f32x4*)(modv + b * 6144 + 2048 + col0 + bj * 128); ga[bj][1] = *(const f32x4*)(modv + b * 6144 + 2048 + col0 + bj * 128 + 4); }
#pragma unroll
        for (int ai = 0; ai < 2; ++ai) {
            f32x4 xv[4][2][2];
#pragma unroll
            for (int m = 0; m < 4; ++m)
#pragma unroll
                for (int bj = 0; bj < 2; ++bj) { const float* xr = x + (size_t)(row0 + ai * 128 + m * 16) * D + col0 + bj * 128; xv[m][bj][0] = __builtin_nontemporal_load((const f32x4*)xr); xv[m][bj][1] = __builtin_nontemporal_load((const f32x4*)(xr + 4)); }
#pragma unroll
            for (int m = 0; m < 4; ++m) { float ssq = 0.f, mx = 0.f;
#pragma unroll
                for (int bj = 0; bj < 2; ++bj) { const f32x4 y0 = xv[m][bj][0] + ga[bj][0] * acc[ai][bj][m][0], y1 = xv[m][bj][1] + ga[bj][1] * acc[ai][bj][m][1];
                    const float o[8] = {y0.x, y0.y, y0.z, y0.w, y1.x, y1.y, y1.z, y1.w}; store8_bf16(out + (size_t)(row0 + ai * 128 + m * 16) * D + col0 + bj * 128, o);
                    const f32x4 tm = __builtin_elementwise_max(__builtin_elementwise_abs(y0), __builtin_elementwise_abs(y1)), sq = y0 * y0 + y1 * y1;
                    ssq += (sq.x + sq.y) + (sq.z + sq.w); mx = fmaxf(mx, fmaxf(fmaxf(tm.x, tm.y), fmaxf(tm.z, tm.w))); }
                ssq += __shfl_xor(ssq, 16); ssq += __shfl_xor(ssq, 32); mx = fmaxf(mx, __shfl_xor(mx, 16)); mx = fmaxf(mx, __shfl_xor(mx, 32));
                if (fq == 0) { float* pp = part + (size_t)(row0 + ai * 128 + m * 16) * 32 + u.pn * 4 + wc; pp[0] = ssq; pp[16] = mx; } }
            asm volatile("" ::: "memory");
        }
    }
};
__device__ __forceinline__ void p6_wo(const Ctx& c, float* lds) {
    pg8::Gemm g{c.mix(), c.wo_t(), D, D, D, nullptr, 0, 0, 0};
    pg8::StaticOrder S; S.init(RL, D, (int)gridDim.x, (int)blockIdx.x);
    EpiRes E{c.x(), c.x1b(), c.modv(), c.rpart()};
    pg8::gemm_phase((LAS unsigned char*)lds, g, S, E, c.tid);
}
__device__ __forceinline__ void p7_norm_router(const Ctx& c, float* lds) {
    typedef short bf16x8_t __attribute__((ext_vector_type(8)));
    constexpr int WP = 1032;
    bf16_t* whi = (bf16_t*)lds; bf16_t* wlo = whi + 16 * WP; float* gsl = (float*)(wlo + 16 * WP); float* shl = gsl + 1024; float* gpl = shl + 1024;
    const int G = (int)gridDim.x, bx = (int)blockIdx.x;
    bool first = true;
    for (int blk = bx; blk < RL / 128; blk += G) {
        const int b = (blk * 128) / SEQ; const float* md = c.modv() + b * 6144;
        const int fr = c.lane & 15, fq = c.lane >> 4; const int row = blk * 128 + c.wave * 16 + fr;
        const bf16_t* xr2 = c.x1b() + (size_t)row * D + 16 * fq;
        float wv[32];
        if (first) {
#pragma unroll
            for (int it = 0; it < 32; ++it) wv[it] = c.w_router()[c.tid + 512 * it]; }
        u32x4 xw[32];
#pragma unroll
        for (int i = 0; i < 16; ++i) xw[i] = *(const u32x4*)(xr2 + 64 * (i >> 1) + 8 * (i & 1));
        asm volatile("s_waitcnt lgkmcnt(0)\n\ts_barrier" ::: "memory");
        for (int k = c.tid; k < 1024; k += 512) { gsl[k] = c.g_ffn()[k] * (1.f + md[4096 + k]); shl[k] = md[3072 + k]; }
        if (first) { int tl = c.tid; asm volatile("" : "+v"(tl));
#pragma unroll
            for (int it = 0; it < 32; ++it) { const int i = tl + 512 * it, k = i >> 4, e = i & 15; const float w = wv[it]; const bf16_t h = f2bf(w); whi[e * WP + k] = h; wlo[e * WP + k] = f2bf(w - bf2f(h)); }
            first = false; }
#pragma unroll
        for (int i = 16; i < 32; ++i) xw[i] = *(const u32x4*)(xr2 + 64 * (i >> 1) + 8 * (i & 1));
        asm volatile("s_waitcnt lgkmcnt(0)\n\ts_barrier" ::: "memory");
        if (c.tid < 16) { float gm = 0.f; const int c0_ = (c.tid >> 2) * 256 + (c.tid & 3) * 32;
            for (int k = 0; k < 32; ++k) gm = fmaxf(gm, fmaxf(fabsf(gsl[c0_ + k]), fabsf(gsl[c0_ + 128 + k])));
            gpl[c.tid] = gm; }
        asm volatile("s_waitcnt lgkmcnt(0)\n\ts_barrier" ::: "memory");
        const LAS float* gs_l = (const LAS float*)gsl; const LAS float* sh_l = (const LAS float*)shl;
        float shm = 0.f;
#pragma unroll
        for (int i = 0; i < 4; ++i) { const f32x4 s4 = *(const LAS f32x4*)(sh_l + 4 * c.lane + 256 * i); shm = fmaxf(fmaxf(shm, fmaxf(fabsf(s4.x), fabsf(s4.y))), fmaxf(fabsf(s4.z), fabsf(s4.w))); }
#pragma unroll
        for (int o = 1; o < 64; o <<= 1) shm = fmaxf(shm, __shfl_xor(shm, o));
        const f32x4 ps = *(const f32x4*)(c.rpart() + (size_t)row * 32 + 4 * fq), pm4 = *(const f32x4*)(c.rpart() + (size_t)row * 32 + 16 + 4 * fq);
        float ss = (ps.x + ps.y) + (ps.z + ps.w), mx; { const f32x4 gq = *(const LAS f32x4*)((const LAS float*)gpl + 4 * fq); mx = fmaxf(fmaxf(pm4.x * gq.x, pm4.y * gq.y), fmaxf(pm4.z * gq.z, pm4.w * gq.w)) * 1.00390625f; }
        ss += __shfl_xor(ss, 16); ss += __shfl_xor(ss, 32); mx = fmaxf(mx, __shfl_xor(mx, 16)); mx = fmaxf(mx, __shfl_xor(mx, 32));
        const float rinv = 1.f / sqrtf(ss * (1.f / D) + EPS);
        const float bnd = fmaxf(rinv * mx + shm, 1e-30f), qs = 127.f / bnd;
        if (fq == 0) c.sa()[row] = bnd * (1.f / 127.f);
        f32x4 acc = {0.f, 0.f, 0.f, 0.f};
        const LAS bf16_t* wh_l = (const LAS bf16_t*)whi + fr * WP + 16 * fq; const LAS bf16_t* wl_l = (const LAS bf16_t*)wlo + fr * WP + 16 * fq;
        signed char* hq = c.h2q() + (size_t)row * D + 16 * fq;
#pragma unroll
        for (int ks2 = 0; ks2 < 16; ++ks2) { u32x4 qo;
#pragma unroll
            for (int hf = 0; hf < 2; ++hf) { const int ko = 64 * ks2 + 8 * hf; const u32x4 w = xw[2 * ks2 + hf];
                const f32x4 g0 = *(const LAS f32x4*)(gs_l + 16 * fq + ko), g1 = *(const LAS f32x4*)(gs_l + 16 * fq + ko + 4), s0 = *(const LAS f32x4*)(sh_l + 16 * fq + ko), s1 = *(const LAS f32x4*)(sh_l + 16 * fq + ko + 4);
                float h[8];
                h[0] = __uint_as_float(w.x << 16) * rinv * g0.x + s0.x; h[1] = __uint_as_float(w.x & 0xffff0000u) * rinv * g0.y + s0.y; h[2] = __uint_as_float(w.y << 16) * rinv * g0.z + s0.z; h[3] = __uint_as_float(w.y & 0xffff0000u) * rinv * g0.w + s0.w;
                h[4] = __uint_as_float(w.z << 16) * rinv * g1.x + s1.x; h[5] = __uint_as_float(w.z & 0xffff0000u) * rinv * g1.y + s1.y; h[6] = __uint_as_float(w.w << 16) * rinv * g1.z + s1.z; h[7] = __uint_as_float(w.w & 0xffff0000u) * rinv * g1.w + s1.w;
                const unsigned qa = q8pack(h[0], h[1], h[2], h[3], qs), qb = q8pack(h[4], h[5], h[6], h[7], qs);
                if (hf == 0) { qo.x = qa; qo.y = qb; } else { qo.z = qa; qo.w = qb; }
                u32x4 hi; hi.x = pk2(h[0], h[1]); hi.y = pk2(h[2], h[3]); hi.z = pk2(h[4], h[5]); hi.w = pk2(h[6], h[7]);
                u32x4 lo; lo.x = pk2(h[0] - __uint_as_float(hi.x << 16), h[1] - __uint_as_float(hi.x & 0xffff0000u)); lo.y = pk2(h[2] - __uint_as_float(hi.y << 16), h[3] - __uint_as_float(hi.y & 0xffff0000u));
                lo.z = pk2(h[4] - __uint_as_float(hi.z << 16), h[5] - __uint_as_float(hi.z & 0xffff0000u)); lo.w = pk2(h[6] - __uint_as_float(hi.w << 16), h[7] - __uint_as_float(hi.w & 0xffff0000u));
                const bf16x8_t bh = *(const LAS bf16x8_t*)(wh_l + ko), bl = *(const LAS bf16x8_t*)(wl_l + ko);
                const bf16x8_t ah = __builtin_bit_cast(bf16x8_t, hi), al = __builtin_bit_cast(bf16x8_t, lo);
                acc = __builtin_amdgcn_mfma_f32_16x16x32_bf16(ah, bh, acc, 0, 0, 0);
                acc = __builtin_amdgcn_mfma_f32_16x16x32_bf16(al, bh, acc, 0, 0, 0);
                acc = __builtin_amdgcn_mfma_f32_16x16x32_bf16(ah, bl, acc, 0, 0, 0); }
            *(u32x4*)(hq + 64 * ks2) = qo;
            asm volatile("" ::: "memory"); }
        float ov[4];
#pragma unroll
        for (int i = 0; i < 4; ++i) { float mx = acc[i];
            mx = fmaxf(mx, __shfl_xor(mx, 1)); mx = fmaxf(mx, __shfl_xor(mx, 2)); mx = fmaxf(mx, __shfl_xor(mx, 4)); mx = fmaxf(mx, __shfl_xor(mx, 8));
            const float ex = __expf(acc[i] - mx); float den = ex;
            den += __shfl_xor(den, 1); den += __shfl_xor(den, 2); den += __shfl_xor(den, 4); den += __shfl_xor(den, 8);
            ov[i] = ex / den; }
        const int t0 = (blk * 128 + c.wave * 16 + 4 * fq) & (SEQ - 1);
        *(f32x4*)(c.aff() + (size_t)(b * NE + fr) * SEQ + t0) = (f32x4){ov[0], ov[1], ov[2], ov[3]};
    }
}
__device__ __forceinline__ int block_excl_scan(int v, int& tot, int* lw, int tid) {
    const int lane = tid & 63, wv = tid >> 6; int inc = v;
#pragma unroll
    for (int o = 1; o < 64; o <<= 1) { const int u = __shfl_up(inc, o); if (lane >= o) inc += u; }
    __syncthreads();
    if (lane == 63) lw[wv] = inc;
    __syncthreads();
    int base = 0; tot = 0;
#pragma unroll
    for (int w = 0; w < 8; ++w) { const int x = lw[w]; if (w < wv) base += x; tot += x; }
    return base + inc - v;
}
__device__ __forceinline__ void p8_topk(const Ctx& c, float* lds) {
    int* cnt = (int*)lds;
    int* lw = (int*)lds + 64;
    for (int unit = blockIdx.x; unit < NB * NE; unit += gridDim.x) {
        const int b = unit >> 4, e = unit & 15; const float* a = c.aff() + (size_t)unit * SEQ;
        const f32x4 v0 = *(const f32x4*)(a + 8 * c.tid), v1 = *(const f32x4*)(a + 8 * c.tid + 4);
        unsigned u[8] = {__float_as_uint(v0.x), __float_as_uint(v0.y), __float_as_uint(v0.z), __float_as_uint(v0.w), __float_as_uint(v1.x), __float_as_uint(v1.y), __float_as_uint(v1.z), __float_as_uint(v1.w)};
        __syncthreads();
        if (c.tid < 32) cnt[c.tid] = 0;
        __syncthreads();
        unsigned T = 0u;
        for (int bit = 30; bit >= 0; --bit) {
            const unsigned cand = T | (1u << bit); int cw = 0;
#pragma unroll
            for (int j = 0; j < 8; ++j) cw += __popcll(__ballot(u[j] >= cand));
            if (c.lane == 0) atomicAdd(&cnt[bit], cw);
            __syncthreads();
            if (cnt[bit] >= CAP) T = cand;
        }
        int ngt = 0, neq = 0;
#pragma unroll
        for (int j = 0; j < 8; ++j) { ngt += u[j] > T ? 1 : 0; neq += u[j] == T ? 1 : 0; }
        int tot_gt, tot_eq; const int eq_base = block_excl_scan(neq, tot_eq, lw, c.tid); (void)block_excl_scan(ngt, tot_gt, lw + 16, c.tid);
        const int need = CAP - tot_gt;
        bool sel[8]; int nsel = 0, eqc = eq_base;
#pragma unroll
        for (int j = 0; j < 8; ++j) { const bool isq = u[j] == T; sel[j] = u[j] > T || (isq && eqc < need); eqc += isq ? 1 : 0; nsel += sel[j] ? 1 : 0; }
        int tot_sel; int slot = block_excl_scan(nsel, tot_sel, lw + 32, c.tid);
        int iv[8];
#pragma unroll
        for (int j = 0; j < 8; ++j) { iv[j] = sel[j] ? slot : -1;
            if (sel[j]) { c.seli()[unit * CAP + slot] = b * SEQ + 8 * c.tid + j; c.selg()[unit * CAP + slot] = __uint_as_float(u[j]); c.sels()[unit * CAP + slot] = c.sa()[b * SEQ + 8 * c.tid + j]; ++slot; } }
#pragma unroll
        for (int j = 0; j < 8; ++j) c.inv()[(size_t)(b * SEQ + 8 * c.tid + j) * NE + e] = iv[j];
    }
    __syncthreads();
}
struct EpiGateUpQ {
    static constexpr bool PERM = true;
    bf16_t* act; const float* sels; const float* sw;
    __device__ __forceinline__ void operator()(const f32x4 (&acc)[2][2][4][2], const pg8::Unit& u, int wr, int wc, int fr, int fq) const {
        const int row0 = u.pm * 256 + wr * 64 + fr, col0 = u.pn * 256 + wc * 32 + 8 * fq; const float* swe = sw + ((u.pm >> 1) & 15) * 1536 + col0;
        float rs[8];
#pragma unroll
        for (int i = 0; i < 8; ++i) rs[i] = sels[row0 + (i >> 2) * 128 + (i & 3) * 16];
        const f32x4 sg0 = *(const f32x4*)swe, su0 = *(const f32x4*)(swe + 4), sg1 = *(const f32x4*)(swe + 128), su1 = *(const f32x4*)(swe + 132);
#pragma unroll
        for (int ai = 0; ai < 2; ++ai)
#pragma unroll
            for (int m = 0; m < 4; ++m) { const float r_ = rs[ai * 4 + m];
#pragma unroll
                for (int bj = 0; bj < 2; ++bj) { const f32x4 gt = acc[ai][bj][m][0] * (bj ? sg1 : sg0) * r_, up = acc[ai][bj][m][1] * (bj ? su1 : su0) * r_;
                    u32x2 w; w.x = pk2(silu_f(gt[0]) * up[0], silu_f(gt[1]) * up[1]); w.y = pk2(silu_f(gt[2]) * up[2], silu_f(gt[3]) * up[3]);
                    *(u32x2*)(act + (size_t)(row0 + ai * 128 + m * 16) * DE + ((col0 + bj * 128) >> 1)) = w; } }
    }
};
__device__ __forceinline__ void p9_gateup(const Ctx& c, float* lds) {
    pg8::Gemm g{(const bf16_t*)c.h2q(), (const bf16_t*)c.wgu_q(), D / 2, D / 2, D / 2, c.seli(), 1, 15, (size_t)1536 * 512};
    pg8::ExpertOrder S; S.init(NSLOT, 1536, (int)gridDim.x, (int)blockIdx.x);
    EpiGateUpQ E{c.act(), c.sels(), c.swgu()};
    pg8::gemm_phase<true>((LAS unsigned char*)lds, g, S, E, c.tid);
}
struct EpiDown {
    static constexpr bool PERM = true;
    bf16_t* yb; const float* selg;
    __device__ __forceinline__ void operator()(const f32x4 (&acc)[2][2][4][2], const pg8::Unit& u, int wr, int wc, int fr, int fq) const {
        const int row0 = u.pm * 256 + wr * 64 + fr, col0 = u.pn * 256 + wc * 32 + 8 * fq;
        float gg[8];
#pragma unroll
        for (int i = 0; i < 8; ++i) gg[i] = selg[row0 + (i >> 2) * 128 + (i & 3) * 16];
#pragma unroll
        for (int ai = 0; ai < 2; ++ai)
#pragma unroll
            for (int m = 0; m < 4; ++m) { const float g_ = gg[ai * 4 + m];
#pragma unroll
                for (int bj = 0; bj < 2; ++bj) { const f32x4 a = acc[ai][bj][m][0] * g_, b = acc[ai][bj][m][1] * g_; const float o[8] = {a[0], a[1], a[2], a[3], b[0], b[1], b[2], b[3]};
                    store8_bf16(yb + (size_t)(row0 + ai * 128 + m * 16) * D + col0 + bj * 128, o); } }
    }
};
__device__ __forceinline__ void p10_down(const Ctx& c, float* lds) {
    pg8::Gemm g{c.act(), c.wdn_t(), DE, DE, DE, nullptr, 1, 15, (size_t)1024 * 768};
    pg8::ExpertOrder S; S.init(NSLOT, D, (int)gridDim.x, (int)blockIdx.x);
    EpiDown E{c.yb(), c.selg()};
    pg8::gemm_phase((LAS unsigned char*)lds, g, S, E, c.tid);
}
__device__ __forceinline__ void p11_final(const Ctx& c) {
    for (int r0 = c.gw * 2; r0 < RL; r0 += c.ngw * 2) {
        const int b = r0 / SEQ;
        int sl[2]; f32x4 x1[2][4]; f32x4 acc[2][4];
#pragma unroll
        for (int q = 0; q < 2; ++q) { sl[q] = c.lane < NE ? c.inv()[(size_t)(r0 + q) * NE + c.lane] : -1;
#pragma unroll
            for (int j = 0; j < 4; ++j) { const u32x2 w = __builtin_nontemporal_load((const u32x2*)(c.x1b() + (size_t)(r0 + q) * D + 4 * c.lane + 256 * j));
                x1[q][j] = (f32x4){__uint_as_float(w.x << 16), __uint_as_float(w.x & 0xffff0000u), __uint_as_float(w.y << 16), __uint_as_float(w.y & 0xffff0000u)}; acc[q][j] = (f32x4){0.f, 0.f, 0.f, 0.f}; } }
#pragma unroll
        for (int q = 0; q < 2; ++q) {
            unsigned long long m = __ballot(sl[q] >= 0);
            while (m) { const int e = __builtin_ctzll(m); m &= m - 1; const int slot = __builtin_amdgcn_readlane(sl[q], e);
                const bf16_t* yr = c.yb() + (size_t)((b * NE + e) * CAP + slot) * D;
#pragma unroll
                for (int j = 0; j < 4; ++j) { const u32x2 w = __builtin_nontemporal_load((const u32x2*)(yr + 4 * c.lane + 256 * j));
                    acc[q][j].x += __uint_as_float(w.x << 16); acc[q][j].y += __uint_as_float(w.x & 0xffff0000u); acc[q][j].z += __uint_as_float(w.y << 16); acc[q][j].w += __uint_as_float(w.y & 0xffff0000u); } } }
        const float* md = c.modv() + b * 6144 + 5120; float ss[2] = {0.f, 0.f};
#pragma unroll
        for (int j = 0; j < 4; ++j) { const int k = 4 * c.lane + 256 * j; const f32x4 ga = *(const f32x4*)(md + k);
#pragma unroll
            for (int q = 0; q < 2; ++q) { x1[q][j] = x1[q][j] + ga * acc[q][j]; ss[q] += x1[q][j].x * x1[q][j].x + x1[q][j].y * x1[q][j].y + x1[q][j].z * x1[q][j].z + x1[q][j].w * x1[q][j].w; } }
        const float ri0 = 1.f / sqrtf(wave_sum(ss[0]) * (1.f / D) + EPS), ri1 = 1.f / sqrtf(wave_sum(ss[1]) * (1.f / D) + EPS);
#pragma unroll
        for (int j = 0; j < 4; ++j) { const int k = 4 * c.lane + 256 * j; const f32x4 g = *(const f32x4*)(c.g_final() + k);
            __builtin_nontemporal_store(x1[0][j] * ri0 * g, (f32x4*)(c.out() + (size_t)r0 * D + k)); __builtin_nontemporal_store(x1[1][j] * ri1 * g, (f32x4*)(c.out() + (size_t)(r0 + 1) * D + k)); }
    }
}

#define XB_TMO      128
#define XB_XCNT(j)  (256  + 64 * (j))
#define XB_XSUB(j)  (1280 + 64 * (j))
#define XB_XGEN(j)  (2304 + 64 * (j))
#define XB_TOP      3328
#define XB_TOPGEN   3392
#define XCD_BAR_WORDS 3456
#define XB_SPIN_CAP (1u << 18)

__device__ __forceinline__ unsigned xb_ld(unsigned* p)              { return __hip_atomic_load(p, __ATOMIC_RELAXED, __HIP_MEMORY_SCOPE_AGENT); }
__device__ __forceinline__ unsigned xb_add(unsigned* p, unsigned v) { return __hip_atomic_fetch_add(p, v, __ATOMIC_RELAXED, __HIP_MEMORY_SCOPE_AGENT); }
__device__ __forceinline__ unsigned xb_xcc_id() { return (unsigned)__builtin_amdgcn_s_getreg((3 << 11) | 20) & 0xFu; }
#define XB_SPIN(cond, bar) do { unsigned _sp = 0; while (cond) { __builtin_amdgcn_s_sleep(1); \
    if ((++_sp & 255u) == 0u) { if (xb_ld(&(bar)[XB_TMO])) break; if (_sp > XB_SPIN_CAP) { atomicAdd(&(bar)[XB_TMO], 1u); break; } } } } while (0)

struct XcdBarrier {
    unsigned* bar; unsigned x;
    volatile LAS unsigned* st;
};
__device__ __forceinline__ XcdBarrier xcd_barrier_post(unsigned* bar, volatile LAS unsigned* st, bool t0) {
    XcdBarrier b; b.bar = bar; b.x = xb_xcc_id(); b.st = st;
    if (t0) (void)xb_add(&bar[XB_XCNT(b.x)], 1u);
    return b;
}
__device__ __forceinline__ void xcd_barrier_complete(unsigned* bar, unsigned x, unsigned& nloc, unsigned& nx) {
    const unsigned G = gridDim.x * gridDim.y * gridDim.z;
    unsigned sum, cnt, mine, sp = 0u;
    for (;;) {
        sum = 0u; cnt = 0u; mine = 0u;
#pragma unroll
        for (unsigned j = 0; j < 16; ++j) { const unsigned c = xb_ld(&bar[XB_XCNT(j)]); sum += c; cnt += (c > 0u) ? 1u : 0u; mine = (j == x) ? c : mine; }
        if (sum == G) break;
        __builtin_amdgcn_s_sleep(1);
        if ((++sp & 255u) == 0u) { if (xb_ld(&bar[XB_TMO])) break; if (sp > XB_SPIN_CAP) { atomicAdd(&bar[XB_TMO], 1u); break; } }
    }
    nloc = mine > 0u ? mine : 1u; nx = cnt > 0u ? cnt : 1u;
}
__device__ __forceinline__ void xcd_barrier(const XcdBarrier& b, bool t0) {
    asm volatile("s_waitcnt vmcnt(0)" ::: "memory");
    __syncthreads();
    if (t0) {
        unsigned* bar = b.bar;
        __builtin_amdgcn_s_waitcnt(0);
        unsigned nloc = b.st[0], nx = b.st[1];
        if (nloc == 0u) { xcd_barrier_complete(bar, b.x, nloc, nx); b.st[0] = nloc; b.st[1] = nx; }
        const unsigned old = xb_add(&bar[XB_XSUB(b.x)], 1u);
        const unsigned gen = old / nloc;
        if (old + 1u == (gen + 1u) * nloc) {
            __builtin_amdgcn_fence(__ATOMIC_RELEASE, "agent");
            asm volatile("s_waitcnt vmcnt(0)" ::: "memory");
            const unsigned og = xb_add(&bar[XB_TOP], 1u);
            const unsigned tg = og / nx;
            if (og + 1u == (tg + 1u) * nx) xb_add(&bar[XB_TOPGEN], 1u);
            else XB_SPIN(xb_ld(&bar[XB_TOPGEN]) == tg, bar);
            __builtin_amdgcn_fence(__ATOMIC_ACQUIRE, "agent");
            xb_add(&bar[XB_XGEN(b.x)], 1u);
            asm volatile("s_waitcnt vmcnt(0)" ::: "memory");
        } else {
            XB_SPIN(xb_ld(&bar[XB_XGEN(b.x)]) == gen, bar);
            __builtin_amdgcn_fence(__ATOMIC_ACQUIRE, "agent");
            asm volatile("s_waitcnt vmcnt(0)" ::: "memory");
        }
    }
    __syncthreads();
}

template <int PH0, int PH1> __global__ void __launch_bounds__(512, 2) fwd_kernel(Args args) {
    extern __shared__ __attribute__((aligned(16))) unsigned char lds_raw[];
    float* lds = (float*)lds_raw;
    volatile LAS unsigned* xbst = (volatile LAS unsigned*)((LAS unsigned char*)lds_raw + (LDS_BYTES - 16));
    const int wave_s = __builtin_amdgcn_readfirstlane((int)threadIdx.x >> 6);
#define TID_NOW() ([&]() { unsigned z_ = 0u; asm volatile("" : "+v"(z_)); return wave_s * 64 + (int)__builtin_amdgcn_mbcnt_hi(~0u, __builtin_amdgcn_mbcnt_lo(~0u, z_)); }())
    if (TID_NOW() == 0) { xbst[0] = 0u; xbst[1] = 0u; }
    __syncthreads();
    XcdBarrier bar; bar.bar = nullptr; bar.x = 0; bar.st = nullptr;
    if constexpr (PH1 - PH0 > 1) bar = xcd_barrier_post((unsigned*)(args.ws + WS_CTL) + 4096, xbst, TID_NOW() == 0);
#define GRID_BAR(k) do { if constexpr (PH1 - PH0 > 1) { if (lo <= (k) && (k) + 1 < hi) { xcd_barrier(bar, TID_NOW() == 0); if (BARREP) xcd_barrier(bar, TID_NOW() == 0); } } } while (0)
    const int lo = args.ph_lo, hi = args.ph_hi;
#ifndef PHMASK
#define PHMASK 0xffffffffu
#endif
#ifndef BARREP
#define BARREP 0
#endif
#ifndef REPMASK
#define REPMASK 0u
#endif
#define REP(k) ((REPMASK >> (k)) & 1u)
#define IN(k) (((PHMASK >> (k)) & 1u) && PH0 <= (k) && (k) < PH1 && lo <= (k) && (k) < hi)
#define CTX() Ctx c; { kptr_t kp_ = (kptr_t)__builtin_amdgcn_kernarg_segment_ptr(); asm volatile("" : "+s"(kp_)); c.kp = kp_; int t_ = TID_NOW(); asm volatile("" : "+v"(t_)); int b_ = blockIdx.x; asm volatile("" : "+s"(b_)); c.tid = t_; c.lane = t_ & 63; c.wave = t_ >> 6; c.gw = b_ * 8 + c.wave; c.ngw = gridDim.x * 8; }
    if (IN(0)) { CTX(); p0_mod(c, lds); __syncthreads(); p0_weights<0>(c, lds, c.gw, c.ngw); p0_tables(c); }
    if (REP(0) && IN(0)) { __syncthreads(); CTX(); p0_mod(c, lds); __syncthreads(); p0_weights<0>(c, lds, c.gw, c.ngw); p0_tables(c); }
    GRID_BAR(0);
    if (IN(1)) { CTX(); p1_norm(c); }
    if (REP(1) && IN(1)) { __syncthreads(); CTX(); p1_norm(c); }
    GRID_BAR(1);
    if (IN(2)) { CTX(); p2_proj(c, lds); }
    if (REP(2) && IN(2)) { __syncthreads(); CTX(); p2_proj(c, lds); }
    GRID_BAR(2);
    if (IN(3)) { CTX(); p3_upq(c, lds); }
    if (REP(3) && IN(3)) { __syncthreads(); CTX(); p3_upq(c, lds); }
    if (IN(4)) { CTX(); p3_upkv(c, lds); }
    if (REP(4) && IN(4)) { __syncthreads(); CTX(); p3_upkv(c, lds); }
    if (IN(5)) { CTX(); p3c_scan(c, lds); }
    if (REP(5) && IN(5)) { __syncthreads(); CTX(); p3c_scan(c, lds); }
    GRID_BAR(5);
    if (IN(6)) { CTX(); p4_attn(c, lds); }
    if (REP(6) && IN(6)) { __syncthreads(); CTX(); p4_attn(c, lds); }
    if (IN(7)) { CTX(); p4_ret(c, lds); }
    if (REP(7) && IN(7)) { __syncthreads(); CTX(); p4_ret(c, lds); }
    GRID_BAR(7);
    if (IN(8)) { CTX(); p6_wo(c, lds); }
    if (REP(8) && IN(8)) { __syncthreads(); CTX(); p6_wo(c, lds); }
    GRID_BAR(8);
    if (IN(9)) { CTX(); p7_norm_router(c, lds); }
    if (REP(9) && IN(9)) { __syncthreads(); CTX(); p7_norm_router(c, lds); }
    GRID_BAR(9);
    if (IN(10)) { CTX(); p8_topk(c, lds); }
    if (REP(10) && IN(10)) { __syncthreads(); CTX(); p8_topk(c, lds); }
    GRID_BAR(10);
    if (IN(11)) { CTX(); p9_gateup(c, lds); }
    if (REP(11) && IN(11)) { __syncthreads(); CTX(); p9_gateup(c, lds); }
    GRID_BAR(11);
    if (IN(12)) { CTX(); p10_down(c, lds); }
    if (REP(12) && IN(12)) { __syncthreads(); CTX(); p10_down(c, lds); }
    GRID_BAR(12);
    if (IN(13)) { CTX(); p11_final(c); }
    if (REP(13) && IN(13)) { __syncthreads(); CTX(); p11_final(c); }
#undef IN
}


static hipError_t set_lds_all() { return hipFuncSetAttribute((const void*)fwd_kernel<0, NPH>, hipFuncAttributeMaxDynamicSharedMemorySize, LDS_BYTES); }
static void launch_all(int grid, hipStream_t stream, const Args& a) { hipLaunchKernelGGL((fwd_kernel<0, NPH>), dim3(grid), dim3(512), LDS_BYTES, stream, a); }

extern "C" void kernel_launch(void* const* d_in, const int* in_sizes, int n_in, void* d_out, int out_size, void* d_ws, size_t ws_size, hipStream_t stream) {
    static int grid = 0;
    if (grid == 0) {
        if (n_in != 22 || in_sizes[0] != RL * D || out_size != RL * D || ws_size < WS_END) {
            fprintf(stderr, "kernel_launch: unexpected shapes: n_in %d in0 %d out %d ws %zu (need %zu)\n", n_in, n_in > 0 ? in_sizes[0] : -1, out_size, ws_size, (size_t)WS_END); grid = -1; return; }
        int dev = 0, cus = 0;
        if (hipGetDevice(&dev) != hipSuccess || hipDeviceGetAttribute(&cus, hipDeviceAttributeMultiprocessorCount, dev) != hipSuccess) { grid = -1; return; }
        if (set_lds_all() != hipSuccess) { fprintf(stderr, "kernel_launch: hipFuncSetAttribute failed\n"); grid = -1; return; }
        int per_cu = 0;
        if (MK_SINGLE) { if (hipOccupancyMaxActiveBlocksPerMultiprocessor(&per_cu, (const void*)fwd_kernel<0, NPH>, 512, LDS_BYTES) != hipSuccess || per_cu < 1) { fprintf(stderr, "kernel_launch: occupancy query says %d blocks per CU\n", per_cu); grid = -1; return; } }
        (void)hipGetLastError();
        grid = cus;
    }
    if (grid < 0) return;
    Args a{};
    for (int i = 0; i < 22; ++i) a.in[i] = (const float*)d_in[i];
    a.out = (float*)d_out; a.ws = (unsigned char*)d_ws;
    a.ph_lo = 0; a.ph_hi = NPH;
    if (MK_SINGLE) { if (hipMemsetAsync((char*)d_ws + WS_CTL, 0, CTL_BYTES, stream) != hipSuccess) { fprintf(stderr, "kernel_launch: memset failed\n"); return; } }
    launch_all(grid, stream, a);
}
```

```cpp
#include <hip/hip_runtime.h>
#include <cstdio>
#include <cstdint>

#ifndef MK_SINGLE
#define MK_SINGLE 1
#endif

typedef unsigned short bf16_t;
typedef float f32x4 __attribute__((ext_vector_type(4)));
typedef unsigned u32x4 __attribute__((ext_vector_type(4)));
typedef unsigned u32x2 __attribute__((ext_vector_type(2)));
#define LAS __attribute__((address_space(3)))

constexpr int D = 1024, NB = 8, SEQ = 4096, LC = 256;
constexpr int RL = NB * SEQ, RC = NB * LC, RT = RL + RC;
constexpr int NPROJ = 2560;
constexpr int PC_CQ = 0, PC_CKV = 256, PC_KR = 384, PC_RQ = 512, PC_RK = 1024, PC_RV = 1536, PC_RG = 2048;
constexpr int NH = 8, QW = 768, KVW = 1024;
constexpr int NE = 16, CAP = 512, DE = 768, NSLOT = NB * NE * CAP;
constexpr int NCH = 32;
constexpr float EPS = 1e-6f;
constexpr float QSCALE = 0.10206207261596577f * 1.4426950408889634f;

constexpr size_t MiB = 1u << 20;
constexpr size_t WS_CTL = 0, CTL_BYTES = 64 * 1024;
constexpr size_t WS_MOD = 1 * MiB;
constexpr size_t WS_TABR = 2 * MiB;
constexpr size_t WS_TABM = 3 * MiB;
constexpr size_t WS_PSTAT = 4 * MiB;
constexpr size_t WS_AFF = 6 * MiB;
constexpr size_t WS_SELI = 8 * MiB;
constexpr size_t WS_SELG = 8 * MiB + 512 * 1024;
constexpr size_t WS_INV = 9 * MiB;
constexpr size_t WS_SELS = 11 * MiB;
constexpr size_t WS_WIN = 12 * MiB;
constexpr size_t WS_WUQ = 17 * MiB;
constexpr size_t WS_WUKV = 17 * MiB + 512 * 1024;
constexpr size_t WS_WO = 18 * MiB;
constexpr size_t WS_WGU = 20 * MiB;
constexpr size_t WS_WDN = 68 * MiB;
constexpr size_t WS_H = 92 * MiB;
constexpr size_t WS_RST = 92 * MiB;
constexpr size_t WS_PROJ = 160 * MiB;
constexpr size_t WS_ACT = 160 * MiB;
constexpr size_t WS_YB = 256 * MiB;
constexpr size_t WS_Q = 330 * MiB;
constexpr size_t WS_KV = 378 * MiB;
constexpr size_t WS_MIX = 446 * MiB;
constexpr size_t WS_END = 510 * MiB;
static_assert(WS_PROJ + (size_t)RT * NPROJ * 2 <= WS_Q && WS_Q + (size_t)RL * QW * 2 <= WS_KV && WS_KV + (size_t)RT * KVW * 2 <= WS_MIX, "ws map");
static_assert(WS_H + (size_t)RT * D * 2 <= WS_PROJ && WS_WDN + (size_t)NE * D * DE * 2 <= WS_H && WS_PSTAT + (size_t)RT * 32 <= WS_AFF, "ws map 2");

constexpr int LDS_BYTES = 147456;
constexpr int NPH = 14;

__device__ __forceinline__ float bf2f(bf16_t v) { return __uint_as_float((unsigned)v << 16); }
__device__ __forceinline__ bf16_t f2bf(float f) { unsigned u = __float_as_uint(f); return (bf16_t)((u + 0x7fffu + ((u >> 16) & 1u)) >> 16); }
__device__ __forceinline__ unsigned pk2(float lo, float hi) { unsigned r; asm("v_cvt_pk_bf16_f32 %0, %1, %2" : "=v"(r) : "v"(lo), "v"(hi)); return r; }
__device__ __forceinline__ float wave_sum(float v) {
#pragma unroll
    for (int o = 1; o < 64; o <<= 1) v += __shfl_xor(v, o);
    return v;
}
__device__ __forceinline__ float silu_f(float v) { return v / (1.f + __expf(-v)); }

struct Args {
    const float* in[22]; float* out; unsigned char* ws; int ph_lo, ph_hi;
};

typedef __attribute__((address_space(4))) const char* kptr_t;
typedef const float* cfp_t; typedef float* fp_t; typedef unsigned char* ucp_t;
typedef __attribute__((address_space(4))) const cfp_t* kcfpp; typedef __attribute__((address_space(4))) const fp_t* kfpp; typedef __attribute__((address_space(4))) const ucp_t* kucpp;
static_assert(sizeof(Args) == 200, "Args layout: in[22] @0, out @176, ws @184, ph_lo @192, ph_hi @196");
struct Ctx {
    kptr_t kp; int tid, lane, wave, gw, ngw;
    __device__ __forceinline__ const float* in(int i) const { return *(kcfpp)(kp + 8 * i); }
    __device__ __forceinline__ unsigned char* wsb() const { return *(kucpp)(kp + 184); }
    __device__ __forceinline__ const float* x() const { return in(0); }
    __device__ __forceinline__ const float* cvec() const { return in(1); }
    __device__ __forceinline__ const float* ctx() const { return in(2); }
    __device__ __forceinline__ const float* c_ctx() const { return in(3); }
    __device__ __forceinline__ const float* w_ada() const { return in(4); }
    __device__ __forceinline__ const float* b_ada() const { return in(5); }
    __device__ __forceinline__ const float* g_mix() const { return in(6); }
    __device__ __forceinline__ const float* g_ffn() const { return in(7); }
    __device__ __forceinline__ const float* w_in() const { return in(8); }
    __device__ __forceinline__ const float* g_q() const { return in(9); }
    __device__ __forceinline__ const float* g_kv() const { return in(10); }
    __device__ __forceinline__ const float* w_uq() const { return in(11); }
    __device__ __forceinline__ const float* w_ukv() const { return in(12); }
    __device__ __forceinline__ const float* exp_f() const { return in(13); }
    __device__ __forceinline__ const float* exp_b() const { return in(14); }
    __device__ __forceinline__ const float* g_ret() const { return in(15); }
    __device__ __forceinline__ const float* w_o() const { return in(16); }
    __device__ __forceinline__ const float* w_router() const { return in(17); }
    __device__ __forceinline__ const float* w_gate() const { return in(18); }
    __device__ __forceinline__ const float* w_up() const { return in(19); }
    __device__ __forceinline__ const float* w_down() const { return in(20); }
    __device__ __forceinline__ const float* g_final() const { return in(21); }
    __device__ __forceinline__ float* out() const { return *(kfpp)(kp + 176); }
    __device__ __forceinline__ float* modv() const { return (float*)(wsb() + WS_MOD); }
    __device__ __forceinline__ float* tabr() const { return (float*)(wsb() + WS_TABR); }
    __device__ __forceinline__ float* tabm() const { return (float*)(wsb() + WS_TABM); }
    __device__ __forceinline__ float* pstat() const { return (float*)(wsb() + WS_PSTAT); }
    __device__ __forceinline__ float* aff() const { return (float*)(wsb() + WS_AFF); }
    __device__ __forceinline__ float* selg() const { return (float*)(wsb() + WS_SELG); }
    __device__ __forceinline__ int* seli() const { return (int*)(wsb() + WS_SELI); }
    __device__ __forceinline__ int* inv() const { return (int*)(wsb() + WS_INV); }
    __device__ __forceinline__ float* sels() const { return (float*)(wsb() + WS_SELS); }
    __device__ __forceinline__ float* rpart() const { return (float*)(wsb() + WS_Q); }
    __device__ __forceinline__ bf16_t* win_t() const { return (bf16_t*)(wsb() + WS_WIN); }
    __device__ __forceinline__ bf16_t* wuq_t() const { return (bf16_t*)(wsb() + WS_WUQ); }
    __device__ __forceinline__ bf16_t* wukv_t() const { return (bf16_t*)(wsb() + WS_WUKV); }
    __device__ __forceinline__ bf16_t* wo_t() const { return (bf16_t*)(wsb() + WS_WO); }
    __device__ __forceinline__ bf16_t* wgu_t() const { return (bf16_t*)(wsb() + WS_WGU); }
    __device__ __forceinline__ bf16_t* wdn_t() const { return (bf16_t*)(wsb() + WS_WDN); }
    __device__ __forceinline__ bf16_t* hb() const { return (bf16_t*)(wsb() + WS_H); }
    __device__ __forceinline__ bf16_t* rst() const { return (bf16_t*)(wsb() + WS_RST); }
    __device__ __forceinline__ bf16_t* proj() const { return (bf16_t*)(wsb() + WS_PROJ); }
    __device__ __forceinline__ bf16_t* act() const { return (bf16_t*)(wsb() + WS_ACT); }
    __device__ __forceinline__ bf16_t* yb() const { return (bf16_t*)(wsb() + WS_YB); }
    __device__ __forceinline__ bf16_t* qb() const { return (bf16_t*)(wsb() + WS_Q); }
    __device__ __forceinline__ bf16_t* kvb() const { return (bf16_t*)(wsb() + WS_KV); }
    __device__ __forceinline__ bf16_t* mix() const { return (bf16_t*)(wsb() + WS_MIX); }
    __device__ __forceinline__ bf16_t* x1b() const { return (bf16_t*)(wsb() + WS_H); }
    __device__ __forceinline__ bf16_t* h2() const { return (bf16_t*)(wsb() + WS_MIX); }
    __device__ __forceinline__ signed char* h2q() const { return (signed char*)(wsb() + WS_MIX); }
    __device__ __forceinline__ float* sa() const { return (float*)(wsb() + WS_MIX + 32 * MiB); }
    __device__ __forceinline__ signed char* wgu_q() const { return (signed char*)(wsb() + WS_WGU); }
    __device__ __forceinline__ float* swgu() const { return (float*)(wsb() + WS_WGU + 24 * MiB); }
};

__device__ __forceinline__ void p0_mod(const Ctx& c, float* lds) {
    float* sc = lds;
    float* red = lds + 9 * 1024;
    for (int i = c.tid; i < 9 * 1024; i += 512) { const int r = i >> 10, k = i & 1023; const float v = r < 8 ? c.cvec()[r * 1024 + k] : c.c_ctx()[k]; sc[i] = silu_f(v); }
    __syncthreads();
    for (int unit = blockIdx.x; unit < 192; unit += gridDim.x) {
        const int nn = c.tid & 31, n = unit * 32 + nn, kg = c.tid >> 5;
        float acc[9];
#pragma unroll
        for (int r = 0; r < 9; ++r) acc[r] = 0.f;
        for (int k0 = kg; k0 < 1024; k0 += 16 * 8) { float w[8];
#pragma unroll
            for (int i = 0; i < 8; ++i) w[i] = __builtin_nontemporal_load(c.w_ada() + (size_t)(k0 + 16 * i) * 6144 + n);
#pragma unroll
            for (int i = 0; i < 8; ++i)
#pragma unroll
                for (int r = 0; r < 9; ++r) acc[r] += sc[r * 1024 + k0 + 16 * i] * w[i]; }
#pragma unroll
        for (int r = 0; r < 9; ++r) red[(kg * 9 + r) * 32 + nn] = acc[r];
        __syncthreads();
        for (int i = c.tid; i < 9 * 32; i += 512) { const int r = i >> 5, n2 = i & 31; float s = 0.f;
#pragma unroll
            for (int g = 0; g < 16; ++g) s += red[(g * 9 + r) * 32 + n2];
            c.modv()[r * 6144 + unit * 32 + n2] = s + c.b_ada()[unit * 32 + n2]; }
        __syncthreads();
    }
}
template <class CM, class GN>
__device__ __forceinline__ void transpose_item(const float* W, int Ksrc, int Nsrc, bf16_t* WT, int Kdst, CM cm, GN gain, float* scr, int kb, int nb, int lane) {
    const int k0 = 64 * kb, n0 = 32 * nb;
    const int srcc = cm(n0 + (lane & 31));
#pragma unroll 8
    for (int i = 0; i < 32; ++i) { const int kk = 2 * i + (lane >> 5), k = k0 + kk;
        float v = 0.f; if (srcc >= 0 && k < Ksrc) v = W[(size_t)k * Nsrc + srcc] * gain(k);
        scr[kk * 33 + (lane & 31)] = v; }
    asm volatile("s_waitcnt lgkmcnt(0)" ::: "memory");
    const int ch = lane & 7;
#pragma unroll
    for (int j = 0; j < 4; ++j) { const int n = (lane >> 3) + 8 * j; const float* s = scr + (8 * ch) * 33 + n;
        u32x4 o; o.x = pk2(s[0 * 33], s[1 * 33]); o.y = pk2(s[2 * 33], s[3 * 33]); o.z = pk2(s[4 * 33], s[5 * 33]); o.w = pk2(s[6 * 33], s[7 * 33]);
        *(u32x4*)(WT + (size_t)(n0 + n) * Kdst + k0 + 8 * ch) = o; }
    asm volatile("s_waitcnt lgkmcnt(0)" ::: "memory");
}
__device__ __forceinline__ int ilv(int p, int half) { const int g = p >> 3, w = p & 7; return w < 4 ? 4 * g + w : half + 4 * g + (w - 4); }
__device__ __forceinline__ int cm_win(int n) {
    if (n < 384) return n;
    if (n < 416) return 384 + ilv(n - 384, 16);
    if (n < 512) return -1;
    if (n < 1024) { const int j = n - 512; return 416 + (j >> 6) * 64 + ilv(j & 63, 32); }
    if (n < 1536) { const int j = n - 1024; return 928 + (j >> 6) * 64 + ilv(j & 63, 32); }
    if (n < 2048) return 1440 + (n - 1536);
    return 1952 + (n - 2048);
}
__device__ __forceinline__ int cm_wuq(int n) { const int h = n / 96, p = n % 96; return p < 64 ? n : h * 96 + 64 + ilv(p - 64, 16); }
__device__ __forceinline__ int cm_wgu(int n) { const int q = n >> 3, w = n & 7; return w < 4 ? 4 * q + w : 768 + 4 * q + (w - 4); }
template <bool NTST = false, class TC>
__device__ __forceinline__ void transpose64(const float* srcA, const float* srcB, int ld, bf16_t* dst, int ldd, TC tcol, float* scr, int lane) {
    const int r = lane >> 3, c4 = (lane & 7) * 4;
    f32x4 va[8], vb[8];
#pragma unroll
    for (int i = 0; i < 8; ++i) { va[i] = srcA ? __builtin_nontemporal_load((const f32x4*)(srcA + (size_t)(8 * i + r) * ld + c4)) : (f32x4){0.f, 0.f, 0.f, 0.f}; vb[i] = srcB ? __builtin_nontemporal_load((const f32x4*)(srcB + (size_t)(8 * i + r) * ld + c4)) : (f32x4){0.f, 0.f, 0.f, 0.f}; }
#pragma unroll
    for (int i = 0; i < 8; ++i) { float* p = scr + (8 * i + r) * 65 + c4; p[0] = va[i].x; p[1] = va[i].y; p[2] = va[i].z; p[3] = va[i].w; p[32] = vb[i].x; p[33] = vb[i].y; p[34] = vb[i].z; p[35] = vb[i].w; }
    asm volatile("s_waitcnt lgkmcnt(0)" ::: "memory");
    const int kc = lane & 7;
#pragma unroll
    for (int j = 0; j < 8; ++j) { const int nl = (lane >> 3) + 8 * j, col = tcol(nl); u32x4 o = {0u, 0u, 0u, 0u};
        if (col >= 0) { const float* sp = scr + (8 * kc) * 65 + col; o.x = pk2(sp[0 * 65], sp[1 * 65]); o.y = pk2(sp[2 * 65], sp[3 * 65]); o.z = pk2(sp[4 * 65], sp[5 * 65]); o.w = pk2(sp[6 * 65], sp[7 * 65]); }
        if (NTST) __builtin_nontemporal_store(o, (u32x4*)(dst + (size_t)nl * ldd + 8 * kc)); else *(u32x4*)(dst + (size_t)nl * ldd + 8 * kc) = o; }
    asm volatile("s_waitcnt lgkmcnt(0)" ::: "memory");
}
typedef int i32x4 __attribute__((ext_vector_type(4)));
constexpr int GU_STRIPS = NE * 24;
__device__ __forceinline__ unsigned q8pack(float a, float b, float c_, float d, float inv) {
    const unsigned q0 = __float_as_uint(__builtin_fmaf(a, inv, 12582912.f)), q1 = __float_as_uint(__builtin_fmaf(b, inv, 12582912.f)), q2 = __float_as_uint(__builtin_fmaf(c_, inv, 12582912.f)), q3 = __float_as_uint(__builtin_fmaf(d, inv, 12582912.f));
    return (q0 & 255u) | ((q1 & 255u) << 8) | ((q2 & 255u) << 16) | (q3 << 24);
}
__device__ __forceinline__ void gu_strip_i8(const Ctx& c, float* lds, int s) {
    const int e = s / 24, nb = s % 24;
    float* scr = lds + c.wave * (64 * 65); float* cm = lds + 8 * 64 * 65; float* fin = cm + 512;
    const int r = c.lane >> 3, c4 = (c.lane & 7) * 4;
    const size_t so = (size_t)e * 1024 * 768 + 32 * nb + c4;
    const float* gA = c.w_gate() + so; const float* gB = c.w_up() + so;
    f32x4 va[2][8], vb[2][8];
#pragma unroll
    for (int t = 0; t < 2; ++t)
#pragma unroll
        for (int i = 0; i < 8; ++i) { const size_t ro = (size_t)(64 * (2 * c.wave + t) + 8 * i + r) * 768; va[t][i] = __builtin_nontemporal_load((const f32x4*)(gA + ro)); vb[t][i] = __builtin_nontemporal_load((const f32x4*)(gB + ro)); }
    f32x4 mA = {0.f, 0.f, 0.f, 0.f}, mB = {0.f, 0.f, 0.f, 0.f};
#pragma unroll
    for (int t = 0; t < 2; ++t)
#pragma unroll
        for (int i = 0; i < 8; ++i) { mA = __builtin_elementwise_max(mA, __builtin_elementwise_abs(va[t][i])); mB = __builtin_elementwise_max(mB, __builtin_elementwise_abs(vb[t][i])); }
#pragma unroll
    for (int o = 8; o < 64; o <<= 1)
#pragma unroll
        for (int j = 0; j < 4; ++j) { mA[j] = fmaxf(mA[j], __shfl_xor(mA[j], o)); mB[j] = fmaxf(mB[j], __shfl_xor(mB[j], o)); }
    __syncthreads();
    if (r == 0) { *(f32x4*)(cm + c.wave * 64 + c4) = mA; *(f32x4*)(cm + c.wave * 64 + 32 + c4) = mB; }
    __syncthreads();
    if (c.tid < 64) { float m = cm[c.tid];
#pragma unroll
        for (int w = 1; w < 8; ++w) m = fmaxf(m, cm[w * 64 + c.tid]);
        fin[c.tid] = fmaxf(m, 1e-30f); }
    __syncthreads();
    const int w8 = c.lane >> 3, kc = c.lane & 7;
    if (c.tid < 64) { const int qq = c.tid >> 3, w = c.tid & 7; c.swgu()[e * 1536 + 64 * nb + c.tid] = fin[w < 4 ? 4 * qq + w : 32 + 4 * qq + (w - 4)] * (1.f / 127.f); }
    signed char* dq = c.wgu_q() + (size_t)e * 1536 * 1024 + (size_t)(64 * nb + w8) * 1024 + 128 * c.wave + 8 * kc;
#pragma unroll
    for (int t = 0; t < 2; ++t) {
#pragma unroll
        for (int i = 0; i < 8; ++i) { float* p = scr + (8 * i + r) * 65 + c4; p[0] = va[t][i].x; p[1] = va[t][i].y; p[2] = va[t][i].z; p[3] = va[t][i].w; p[32] = vb[t][i].x; p[33] = vb[t][i].y; p[34] = vb[t][i].z; p[35] = vb[t][i].w; }
        asm volatile("s_waitcnt lgkmcnt(0)" ::: "memory");
#pragma unroll
        for (int j = 0; j < 8; ++j) { const int col = w8 < 4 ? 4 * j + w8 : 32 + 4 * j + (w8 - 4);
            const float inv = 127.f / fin[col]; const float* sp = scr + (8 * kc) * 65 + col;
            u32x2 o; o.x = q8pack(sp[0 * 65], sp[1 * 65], sp[2 * 65], sp[3 * 65], inv); o.y = q8pack(sp[4 * 65], sp[5 * 65], sp[6 * 65], sp[7 * 65], inv);
            *(u32x2*)(dq + (size_t)(8 * j) * 1024 + 64 * t) = o; }
        asm volatile("s_waitcnt lgkmcnt(0)" ::: "memory");
    }
}
constexpr int QSHORT0 = 80, QSTRIPS = 2, QSTATIC = (256 - QSHORT0) * QSTRIPS;
template <int PART>
__device__ __forceinline__ void p0_weights(const Ctx& c, float* lds, int gw, int ngw) {
    float* scr = lds + c.wave * (64 * 65);
    constexpr int I_WIN = 16 * 40, I_WO = 16 * 16, I_GU = 16 * 24, I_DN = 12 * 16, I_WUQ = 4 * 24, I_WUKV = 4 * 32;
    constexpr int NEXP = NE * I_GU + NE * I_DN, NIT = NEXP + I_WIN + I_WO + I_WUQ + I_WUKV;
    unsigned* qctr = (unsigned*)(c.wsb() + WS_CTL) + 2048; int qbase = 0, qk = 8;
    for (int it = (PART == 1 ? NE * I_GU : NEXP + gw); it < (PART == 1 ? NEXP : NIT); it += (PART == 0 ? ngw : 1)) {
        if (PART == 1) { if (qk == 8) { int p_ = 0; if (c.lane == 0) p_ = (int)__hip_atomic_fetch_add(qctr, 1u, __ATOMIC_RELAXED, __HIP_MEMORY_SCOPE_AGENT); qbase = NE * I_GU + __builtin_amdgcn_readfirstlane(p_) * 8; qk = 0; }
            it = qbase + qk; ++qk; if (it >= NEXP) break; }
        int r = it;
        r -= NE * I_GU;
        if (r < NE * I_DN) { const int e = r / I_DN, q = r % I_DN, kb = q / 16, nb = q % 16;
            const float* src = c.w_down() + (size_t)e * 768 * 1024 + (size_t)(64 * kb) * 1024 + 64 * nb;
            transpose64<true>(src, src + 32, 1024, c.wdn_t() + (size_t)e * 1024 * 768 + (size_t)(64 * nb) * 768 + 64 * kb, 768, [](int nl) { return nl; }, scr, c.lane); continue; } r -= NE * I_DN;
        if (r < I_WIN) { const int kb = r / 40, nb = r % 40; const float* base = c.w_in() + (size_t)(64 * kb) * 2464; bf16_t* dst = c.win_t() + (size_t)(64 * nb) * 1024 + 64 * kb;
            if (nb < 6) { transpose64(base + 64 * nb, base + 64 * nb + 32, 2464, dst, 1024, [](int nl) { return nl; }, scr, c.lane); }
            else if (nb == 6) { transpose64(base + 384, (const float*)nullptr, 2464, dst, 1024, [](int nl) { return nl < 32 ? ilv(nl, 16) : -1; }, scr, c.lane); }
            else if (nb == 7) { transpose64((const float*)nullptr, (const float*)nullptr, 2464, dst, 1024, [](int) { return -1; }, scr, c.lane); }
            else if (nb < 24) { const int s0 = (nb < 16 ? 416 : 928) + 64 * ((nb - 8) & 7); transpose64(base + s0, base + s0 + 32, 2464, dst, 1024, [](int nl) { return ilv(nl, 32); }, scr, c.lane); }
            else { const int s0 = (nb < 32 ? 1440 : 1952) + 64 * (nb & 7); transpose64(base + s0, base + s0 + 32, 2464, dst, 1024, [](int nl) { return nl; }, scr, c.lane); }
            continue; } r -= I_WIN;
        if (r < I_WO) { const int kb = r / 16, nb = r % 16; const float* src = c.w_o() + (size_t)(64 * kb) * 1024 + 64 * nb;
            transpose64(src, src + 32, 1024, c.wo_t() + (size_t)(64 * nb) * 1024 + 64 * kb, 1024, [](int nl) { return nl; }, scr, c.lane); continue; } r -= I_WO;
        if (r < I_WUQ) { const float* g = c.g_q(); transpose_item(c.w_uq(), 256, 768, c.wuq_t(), 256, [](int n) { return cm_wuq(n); }, [g](int k) { return g[k]; }, scr, r / 24, r % 24, c.lane); continue; } r -= I_WUQ;
        { const float* g = c.g_kv(); transpose_item(c.w_ukv(), 128, 1024, c.wukv_t(), 256, [](int n) { return n; }, [g](int k) { return g[k]; }, scr, r / 32, r % 32, c.lane); }
    }
}
__device__ __forceinline__ void sincos_d(double x, double& s, double& co) {
    const double PIO2_HI = 1.5707963267948966, PIO2_LO = 6.123233995736766e-17;
    const double kd = __builtin_rint(x * 0.6366197723675814); const int k = (int)kd;
    const double r = (x - kd * PIO2_HI) - kd * PIO2_LO, r2 = r * r;
    double sr = r - r * r2 * (1.0 / 6.0 - r2 * (1.0 / 120.0 - r2 * (1.0 / 5040.0 - r2 * (1.0 / 362880.0 - r2 * (1.0 / 39916800.0 - r2 * (1.0 / 6227020800.0 - r2 * (1.0 / 1307674368000.0 - r2 * (1.0 / 355687428096000.0))))))));
    double cr = 1.0 - r2 * (0.5 - r2 * (1.0 / 24.0 - r2 * (1.0 / 720.0 - r2 * (1.0 / 40320.0 - r2 * (1.0 / 3628800.0 - r2 * (1.0 / 479001600.0 - r2 * (1.0 / 87178291200.0 - r2 * (1.0 / 20922789888000.0))))))));
    switch (k & 3) { case 0: s = sr; co = cr; break; case 1: s = cr; co = -sr; break; case 2: s = -sr; co = -cr; break; default: s = -cr; co = sr; break; }
}
__device__ __forceinline__ void p0_tables(const Ctx& c) {
    const int gt = blockIdx.x * 512 + c.tid, ngt = gridDim.x * 512;
    const double r16 = 1.0 / __builtin_sqrt(__builtin_sqrt(10.0));
    const double r8 = 1.0 / __builtin_sqrt(10.0);
    for (int i = gt; i < 4096 * 48; i += ngt) {
        const int t = i / 48, j = i % 48; const int prow = t >> 6, pcol = t & 63;
        double ang;
        if (j < 32) { const int jj = j & 15; double inv = 1.0; for (int q = 0; q < jj; ++q) inv *= r16; ang = (double)(j < 16 ? prow : pcol) * inv; }
        else { const int j2 = j - 32, jj = j2 & 7; double inv = 1.0; for (int q = 0; q < jj; ++q) inv *= r8; ang = (double)(j2 < 8 ? prow : pcol) * inv; }
        double s, co; sincos_d(ang, s, co);
        if (j < 32) { c.tabr()[(t * 32 + j) * 2] = (float)co; c.tabr()[(t * 32 + j) * 2 + 1] = (float)s; }
        else { c.tabm()[(t * 16 + j - 32) * 2] = (float)co; c.tabm()[(t * 16 + j - 32) * 2 + 1] = (float)s; }
    }
}

__device__ __forceinline__ void p1_norm(const Ctx& c) {
    for (int r = c.gw * 2; r < RT; r += c.ngw * 2) {
        const float* src = r < RL ? c.x() + (size_t)r * D : c.ctx() + (size_t)(r - RL) * D; const int b = r < RL ? r / SEQ : 8;
        f32x4 v[2][4]; float s0 = 0.f, s1 = 0.f;
#pragma unroll
        for (int j = 0; j < 4; ++j) { v[0][j] = __builtin_nontemporal_load((const f32x4*)src + c.lane + 64 * j); v[1][j] = __builtin_nontemporal_load((const f32x4*)(src + D) + c.lane + 64 * j); }
#pragma unroll
        for (int j = 0; j < 4; ++j) { s0 += v[0][j].x * v[0][j].x + v[0][j].y * v[0][j].y + v[0][j].z * v[0][j].z + v[0][j].w * v[0][j].w; s1 += v[1][j].x * v[1][j].x + v[1][j].y * v[1][j].y + v[1][j].z * v[1][j].z + v[1][j].w * v[1][j].w; }
        const float ri0 = 1.f / sqrtf(wave_sum(s0) * (1.f / D) + EPS), ri1 = 1.f / sqrtf(wave_sum(s1) * (1.f / D) + EPS);
        const float* md = c.modv() + b * 6144;
#pragma unroll
        for (int j = 0; j < 4; ++j) { const int k = 4 * c.lane + 256 * j;
            const f32x4 g = *(const f32x4*)(c.g_mix() + k), sh = *(const f32x4*)(md + k), scv = *(const f32x4*)(md + 1024 + k);
            const f32x4 gs = g * (scv + 1.f); const f32x4 o0 = v[0][j] * ri0 * gs + sh, o1 = v[1][j] * ri1 * gs + sh;
            u32x2 w0, w1; w0.x = pk2(o0.x, o0.y); w0.y = pk2(o0.z, o0.w); w1.x = pk2(o1.x, o1.y); w1.y = pk2(o1.z, o1.w);
            *(u32x2*)(c.hb() + (size_t)r * D + k) = w0; *(u32x2*)(c.hb() + (size_t)(r + 1) * D + k) = w1; }
    }
}

__device__ __forceinline__ void store8_bf16(bf16_t* p, const float (&v)[8]) { u32x4 w; w.x = pk2(v[0], v[1]); w.y = pk2(v[2], v[3]); w.z = pk2(v[4], v[5]); w.w = pk2(v[6], v[7]); *(u32x4*)p = w; }


namespace pg8 {
typedef short bf16x8 __attribute__((ext_vector_type(8)));
constexpr int BM = 256, BK = 64, HALF = 128, HTB = HALF * BK * 2, STAGE_BYTES = 8 * HTB, NXCD = 8, WGM = 8;
__host__ __device__ __forceinline__ int lds_byte(int r, int c) { const int st = (r >> 4) * 2 + (c >> 5), rr = r & 15, cc = c & 31, ob = rr * 64 + cc * 2; return st * 1024 + (ob ^ (((ob >> 9) & 1) << 5)); }
__host__ __device__ __forceinline__ void stage_rc(int b, int& R, int& C) { const int st = b / 1024, sb = b % 1024, swz = sb ^ (((sb >> 9) & 1) << 5); R = (st >> 1) * 16 + swz / 64; C = (st & 1) * 32 + (swz % 64) / 2; }
__host__ __device__ __forceinline__ int perm32(int rho) { const int n = rho >> 4, i = rho & 15; return 8 * (i >> 2) + 4 * n + (i & 3); }
struct Unit { int pm, pn; };
struct Gemm { const bf16_t* A; const bf16_t* Bt; int lda, ldb, K; const int* rowlist; int gshift, gmask; size_t gstride; };
struct StaticOrder {
    int nM, nN, nwg, G, c;
    __host__ __device__ void init(int M, int N, int G_, int c_) { nM = M / BM; nN = N / BM; nwg = nM * nN; G = G_; c = c_; }
    __host__ __device__ bool next(int i, Unit& u) const {
        const long L = (long)i * G + c; if (L >= nwg) return false;
        int wgid = (int)L; { const int q = nwg / NXCD, r = nwg % NXCD, xcd = wgid % NXCD, off = wgid / NXCD; wgid = (xcd < r ? xcd * (q + 1) : r * (q + 1) + (xcd - r) * q) + off; }
        const int nig = WGM * nN, gid = wgid / nig, fm = gid * WGM, gsz = (nM - fm) < WGM ? (nM - fm) : WGM;
        u.pm = fm + ((wgid % nig) % gsz); u.pn = (wgid % nig) / gsz; return true;
    }
};
struct ExpertOrder : StaticOrder {
    __host__ __device__ bool next(int i, Unit& u) const {
        if (!StaticOrder::next(i, u)) return false;
        const int p = u.pm, x = p >> 5, el = (p >> 4) & 1, b = (p >> 1) & 7, j = p & 1; u.pm = 32 * b + 2 * (2 * x + el) + j; return true;
    }
};
template <class F, bool FENCE = false> struct EpiRow8 {
    static constexpr bool PERM = true;
    F f;
    __device__ __forceinline__ void operator()(const f32x4 (&acc)[2][2][4][2], const Unit& u, int wr, int wc, int fr, int fq) const {
        const int row0 = u.pm * BM + wr * 64 + fr, col0 = u.pn * BM + wc * 32 + 8 * fq;
#pragma unroll
        for (int ai = 0; ai < 2; ++ai)
#pragma unroll
            for (int m = 0; m < 4; ++m)
#pragma unroll
                for (int bj = 0; bj < 2; ++bj) { const f32x4 a = acc[ai][bj][m][0], b = acc[ai][bj][m][1]; const float v[8] = {a[0], a[1], a[2], a[3], b[0], b[1], b[2], b[3]};
                    f(row0 + ai * HALF + m * 16, col0 + bj * HALF, v); if (FENCE && bj == 1) asm volatile("" ::: "memory"); }
    }
};
template <bool I8> __device__ __forceinline__ f32x4 mma_step(bf16x8 a, bf16x8 b, f32x4 c) {
    if constexpr (I8) return __builtin_bit_cast(f32x4, __builtin_amdgcn_mfma_i32_16x16x64_i8(__builtin_bit_cast(i32x4, a), __builtin_bit_cast(i32x4, b), __builtin_bit_cast(i32x4, c), 0, 0, 0));
    else return __builtin_amdgcn_mfma_f32_16x16x32_bf16(a, b, c, 0, 0, 0);
}
template <bool I8 = false, class Epi, class Sched>
__device__ __forceinline__ void gemm_phase(LAS unsigned char* lds, const Gemm g, const Sched& S, const Epi& E, int tid) {
    const int wid = __builtin_amdgcn_readfirstlane(tid >> 6), lane = tid & 63, wr = wid >> 2, wc = wid & 3, fr = lane & 15, fq = lane >> 4;
    int Kv_ = g.K; asm volatile("" : "+s"(Kv_)); const int nt = Kv_ / BK;
    unsigned voffB[2];
#pragma unroll
    for (int i = 0; i < 2; ++i) { int R, C; stage_rc(tid * 16 + i * 8192, R, C); const int Rb = Epi::PERM ? ((R & ~31) + perm32(R & 31)) : R;
        voffB[i] = (unsigned)(Rb * g.ldb + C) * 2u; }
    const size_t kstep = (size_t)(BK * 2);
    const size_t hstepB = (size_t)HALF * g.ldb * 2, tstepB = 2 * hstepB;
    const unsigned ldsw = (unsigned)wid * 1024u;
    const int aoff = lds_byte(wr * 64 + fr, fq * 8), boff = lds_byte(wc * 32 + fr, fq * 8);
    const unsigned lda2 = (unsigned)g.lda * 2u;
#define PG8_SA(b, h) (((b) * 2 + (h)) * HTB)
#define PG8_SB(b, h) ((4 + (b) * 2 + (h)) * HTB)
#define PG8_STAGE(bufoff, gbase, voff) do { _Pragma("unroll") for (int _i = 0; _i < 2; ++_i) \
        __builtin_amdgcn_global_load_lds((const unsigned*)((const char*)(gbase) + (voff)[_i]), (LAS unsigned*)(lds + (bufoff) + ldsw + _i * 8192), 16, 0, 0); } while (0)
#define PG8_LDA(dst, b, h) do { _Pragma("unroll") for (int m = 0; m < 4; ++m) _Pragma("unroll") for (int k = 0; k < 2; ++k) dst[m][k] = *(const LAS bf16x8*)(lds + PG8_SA(b, h) + aoff + m * 2048 + k * 1024); } while (0)
#define PG8_LDB(dst, b, h) do { _Pragma("unroll") for (int n = 0; n < 2; ++n) _Pragma("unroll") for (int k = 0; k < 2; ++k) dst[n][k] = *(const LAS bf16x8*)(lds + PG8_SB(b, h) + boff + n * 2048 + k * 1024); } while (0)
#define PG8_MMA(ai, bj, At, Bt) do { __builtin_amdgcn_s_setprio(1); _Pragma("unroll") for (int m = 0; m < 4; ++m) _Pragma("unroll") for (int n = 0; n < 2; ++n) _Pragma("unroll") for (int k = 0; k < 2; ++k) \
        acc[ai][bj][m][n] = mma_step<I8>(Bt[n][k], At[m][k], acc[ai][bj][m][n]); __builtin_amdgcn_s_setprio(0); } while (0)
#define PG8_WAIT_V(n) asm volatile("s_waitcnt vmcnt(" #n ")" ::: "memory")
#define PG8_WAIT_L(n) asm volatile("s_waitcnt lgkmcnt(" #n ")" ::: "memory")
#define PG8_BAR __builtin_amdgcn_s_barrier()
#define PG8_SCHED __builtin_amdgcn_sched_barrier(0)
#define PG8_AOFFS(vo, u) do { _Pragma("unroll") for (int _i = 0; _i < 2; ++_i) { int _R, _C; stage_rc(tid * 16 + _i * 8192, _R, _C); _Pragma("unroll") for (int _h = 0; _h < 2; ++_h) { const int _r = (u).pm * BM + _h * HALF + _R; \
        const int _row = g.rowlist ? g.rowlist[_r] : _r; vo[_h][_i] = (unsigned)_row * lda2 + (unsigned)(_C * 2); } } } while (0)
#define PG8_BBASE(u) ((const char*)g.Bt + ((size_t)(((u).pm >> g.gshift) & g.gmask) * g.gstride) * 2 + (size_t)(u).pn * tstepB)
    Unit cur, nxt; int ui = 0;
    if (!S.next(0, cur)) return;
    f32x4 acc[2][2][4][2];
#pragma unroll
    for (int a = 0; a < 2; ++a)
#pragma unroll
        for (int b = 0; b < 2; ++b)
#pragma unroll
            for (int m = 0; m < 4; ++m)
#pragma unroll
                for (int n = 0; n < 2; ++n) acc[a][b][m][n] = (f32x4){0.f, 0.f, 0.f, 0.f};
    bf16x8 At[4][2], B0[2][2], B1[2][2];
    unsigned voc[2][2], von[2][2];
    PG8_AOFFS(voc, cur);
    const char* const A0 = (const char*)g.A; const char* cB = PG8_BBASE(cur);
    PG8_STAGE(PG8_SB(0, 0), cB, voffB); PG8_STAGE(PG8_SB(0, 1), cB + hstepB, voffB); PG8_STAGE(PG8_SA(0, 0), A0, voc[0]); PG8_STAGE(PG8_SA(0, 1), A0, voc[1]);
    if (wr == 1) PG8_BAR;
    PG8_WAIT_V(2); PG8_BAR;
    PG8_STAGE(PG8_SB(1, 0), cB + kstep, voffB); PG8_STAGE(PG8_SA(1, 0), A0 + kstep, voc[0]); PG8_STAGE(PG8_SB(1, 1), cB + hstepB + kstep, voffB);
    PG8_WAIT_V(6); PG8_BAR;
    for (;;) {
        const bool has_next = S.next(ui + 1, nxt);
        const char* nB = has_next ? PG8_BBASE(nxt) : cB;
        for (int t = 0; t < nt; t += 2) {
            const bool last = (t == nt - 2);
            const char* a1 = A0 + (size_t)(t + 1) * kstep;
            const char* a2 = last ? A0 : A0 + (size_t)(t + 2) * kstep; const char* b2 = last ? nB : cB + (size_t)(t + 2) * kstep;
            const char* a3 = a2 + kstep; const char* b3 = b2 + kstep;
            if (last) { if (has_next) { PG8_AOFFS(von, nxt); } else { _Pragma("unroll") for (int h = 0; h < 2; ++h) _Pragma("unroll") for (int i = 0; i < 2; ++i) von[h][i] = voc[h][i]; } }
            unsigned vo2[2][2];
#pragma unroll
            for (int h = 0; h < 2; ++h)
#pragma unroll
                for (int i = 0; i < 2; ++i) vo2[h][i] = last ? von[h][i] : voc[h][i];
            PG8_LDB(B0, 0, 0); PG8_LDB(B1, 0, 1); PG8_SCHED; PG8_LDA(At, 0, 0); PG8_STAGE(PG8_SA(1, 1), a1, voc[1]);
            PG8_WAIT_V(8); PG8_WAIT_L(0); PG8_BAR; PG8_MMA(0, 0, At, B0); PG8_MMA(0, 1, At, B1); PG8_BAR; PG8_SCHED;
            PG8_LDA(At, 0, 1); PG8_STAGE(PG8_SB(0, 0), b2, voffB); PG8_STAGE(PG8_SB(0, 1), b2 + hstepB, voffB); PG8_STAGE(PG8_SA(0, 0), a2, vo2[0]);
            PG8_WAIT_V(8); PG8_WAIT_L(0); PG8_BAR; PG8_MMA(1, 0, At, B0); PG8_MMA(1, 1, At, B1); PG8_BAR; PG8_SCHED;
            PG8_LDB(B0, 1, 0); PG8_LDB(B1, 1, 1); PG8_SCHED; PG8_LDA(At, 1, 0); PG8_STAGE(PG8_SA(0, 1), a2, vo2[1]);
            PG8_WAIT_V(8); PG8_WAIT_L(0); PG8_BAR; PG8_MMA(0, 0, At, B0); PG8_MMA(0, 1, At, B1); PG8_BAR; PG8_SCHED;
            PG8_LDA(At, 1, 1); PG8_STAGE(PG8_SB(1, 0), b3, voffB); PG8_STAGE(PG8_SB(1, 1), b3 + hstepB, voffB); PG8_STAGE(PG8_SA(1, 0), a3, vo2[0]);
            PG8_WAIT_V(8); PG8_WAIT_L(0); PG8_BAR; PG8_MMA(1, 0, At, B0); PG8_MMA(1, 1, At, B1); PG8_BAR; PG8_SCHED;
        }
        if (wr == 0) PG8_BAR;
        if constexpr (I8) {
#pragma unroll
            for (int a = 0; a < 2; ++a)
#pragma unroll
                for (int b = 0; b < 2; ++b)
#pragma unroll
                    for (int m = 0; m < 4; ++m)
#pragma unroll
                        for (int n = 0; n < 2; ++n) acc[a][b][m][n] = __builtin_convertvector(__builtin_bit_cast(i32x4, acc[a][b][m][n]), f32x4); }
        E(acc, cur, wr, wc, fr, fq);
        if (!has_next) break;
#pragma unroll
        for (int a = 0; a < 2; ++a)
#pragma unroll
            for (int b = 0; b < 2; ++b)
#pragma unroll
                for (int m = 0; m < 4; ++m)
#pragma unroll
                    for (int n = 0; n < 2; ++n) acc[a][b][m][n] = (f32x4){0.f, 0.f, 0.f, 0.f};
        cur = nxt; cB = nB; ++ui;
#pragma unroll
        for (int h = 0; h < 2; ++h)
#pragma unroll
            for (int i = 0; i < 2; ++i) voc[h][i] = von[h][i];
        if (wr == 1) PG8_BAR;
    }
    PG8_WAIT_V(0);
    PG8_BAR;
#undef PG8_SA
#undef PG8_SB
#undef PG8_STAGE
#undef PG8_LDA
#undef PG8_LDB
#undef PG8_MMA
#undef PG8_WAIT_V
#undef PG8_WAIT_L
#undef PG8_BAR
#undef PG8_SCHED
#undef PG8_AOFFS
#undef PG8_BBASE
}
}
template <class F> __device__ __forceinline__ pg8::EpiRow8<F> make_epi(F f) { return pg8::EpiRow8<F>{f}; }
template <class F> __device__ __forceinline__ pg8::EpiRow8<F, true> make_epi_fenced(F f) { return pg8::EpiRow8<F, true>{f}; }

struct EpiProj {
    static constexpr bool PERM = true;
    bf16_t* proj; float* pstat; const float* tabr; const float* tabm;
    __device__ __forceinline__ void operator()(const f32x4 (&acc)[2][2][4][2], const pg8::Unit& u, int wr, int wc, int fr, int fq) const {
        const int row0 = u.pm * 256 + wr * 64 + fr, pn = u.pn; const bool lat = u.pm < RL / 256;
        const bool rope_r = pn >= 2 && pn < 6 && lat, rope_m = pn == 1 && wc == 0 && lat;
        f32x4 tb[8][2];
        if (rope_r || rope_m) { const int g = rope_r ? ((wc * 32 + 8 * fq) & 63) >> 3 : fq; const float* tab = rope_r ? tabr : tabm; const int nf = rope_r ? 32 : 16;
#pragma unroll
            for (int i = 0; i < 8; ++i) { const int t = (row0 + (i >> 2) * 128 + (i & 3) * 16) & (SEQ - 1); tb[i][0] = *(const f32x4*)(tab + (t * nf + 4 * g) * 2); tb[i][1] = *(const f32x4*)(tab + (t * nf + 4 * g) * 2 + 4); } }
        else {
#pragma unroll
            for (int i = 0; i < 8; ++i) { tb[i][0] = (f32x4){1.f, 0.f, 1.f, 0.f}; tb[i][1] = (f32x4){1.f, 0.f, 1.f, 0.f}; } }
#pragma unroll
        for (int ai = 0; ai < 2; ++ai)
#pragma unroll
            for (int m = 0; m < 4; ++m) {
                const int row = row0 + ai * 128 + m * 16;
                bf16_t* pr = proj + (size_t)row * NPROJ + pn * 256 + wc * 32 + 8 * fq;
                const f32x4 c0 = tb[ai * 4 + m][0], c1 = tb[ai * 4 + m][1]; const float co[4] = {c0.x, c0.z, c1.x, c1.z}, si[4] = {c0.y, c0.w, c1.y, c1.w};
                float v[2][8];
#pragma unroll
                for (int bj = 0; bj < 2; ++bj) { const f32x4 a = acc[ai][bj][m][0], b = acc[ai][bj][m][1]; v[bj][0] = a[0]; v[bj][1] = a[1]; v[bj][2] = a[2]; v[bj][3] = a[3]; v[bj][4] = b[0]; v[bj][5] = b[1]; v[bj][6] = b[2]; v[bj][7] = b[3]; }
                if (pn == 0) {
                    float sq = 0.f;
#pragma unroll
                    for (int bj = 0; bj < 2; ++bj)
#pragma unroll
                        for (int j = 0; j < 8; ++j) sq += v[bj][j] * v[bj][j];
                    sq += __shfl_xor(sq, 16); sq += __shfl_xor(sq, 32);
                    if (fq == 0) pstat[(size_t)row * 8 + wc] = sq;
                } else if (pn == 1) {
                    float sq = 0.f;
#pragma unroll
                    for (int j = 0; j < 8; ++j) sq += v[0][j] * v[0][j];
                    sq += __shfl_xor(sq, 16); sq += __shfl_xor(sq, 32);
                    if (fq == 0) pstat[(size_t)row * 8 + 4 + wc] = sq;
                    if (wc == 0) {
#pragma unroll
                        for (int w = 0; w < 4; ++w) { const float x1 = v[1][w], x2 = v[1][4 + w]; v[1][w] = x1 * co[w] - x2 * si[w]; v[1][4 + w] = x1 * si[w] + x2 * co[w]; } }
                } else if (pn < 6) {
                    const float ksc = pn >= 4 ? 0.125f : 1.f;
#pragma unroll
                    for (int bj = 0; bj < 2; ++bj)
#pragma unroll
                        for (int w = 0; w < 4; ++w) { const float x1 = v[bj][w], x2 = v[bj][4 + w]; v[bj][w] = (x1 * co[w] - x2 * si[w]) * ksc; v[bj][4 + w] = (x1 * si[w] + x2 * co[w]) * ksc; }
                } else if (pn >= 8) {
#pragma unroll
                    for (int bj = 0; bj < 2; ++bj)
#pragma unroll
                        for (int j = 0; j < 8; ++j) v[bj][j] = silu_f(v[bj][j]);
                }
                store8_bf16(pr, v[0]); store8_bf16(pr + 128, v[1]);
            }
    }
};
__device__ __forceinline__ void p2_proj(const Ctx& c, float* lds) {
    pg8::Gemm g{c.hb(), c.win_t(), D, D, D, nullptr, 0, 0, 0};
    pg8::StaticOrder S; S.init(RT, NPROJ, (int)gridDim.x, (int)blockIdx.x);
    EpiProj E{c.proj(), c.pstat(), c.tabr(), c.tabm()};
    pg8::gemm_phase((LAS unsigned char*)lds, g, S, E, c.tid);
    if ((int)gridDim.x == 256 && (int)blockIdx.x >= QSHORT0) { __syncthreads();
        for (int q = 0; q < QSTRIPS; ++q) gu_strip_i8(c, lds, ((int)blockIdx.x - QSHORT0) * QSTRIPS + q);
        __syncthreads(); }
}
template <bool ISQ> struct EpiUp {
    static constexpr bool PERM = true;
    bf16_t* out; const float* pstat; const float* tabm;
    __device__ __forceinline__ void operator()(const f32x4 (&acc)[2][2][4][2], const pg8::Unit& u, int wr, int wc, int fr, int fq) const {
        const int row0 = u.pm * 256 + wr * 64 + fr, col00 = u.pn * 256 + wc * 32 + 8 * fq;
        float sc[8];
#pragma unroll
        for (int i = 0; i < 8; ++i) { const f32x4 ps = *(const f32x4*)(pstat + (size_t)(row0 + (i >> 2) * 128 + (i & 3) * 16) * 8 + (ISQ ? 0 : 4));
            sc[i] = (ISQ ? QSCALE : 1.f) / sqrtf((ps.x + ps.y + ps.z + ps.w) * (ISQ ? 1.f / 256.f : 1.f / 128.f) + EPS); }
#pragma unroll
        for (int ai = 0; ai < 2; ++ai)
#pragma unroll
            for (int m = 0; m < 4; ++m) { const int row = row0 + ai * 128 + m * 16; const float s_ = sc[ai * 4 + m];
#pragma unroll
                for (int bj = 0; bj < 2; ++bj) { const int c0 = col00 + bj * 128; const f32x4 a = acc[ai][bj][m][0], b = acc[ai][bj][m][1];
                    float o[8] = {a[0] * s_, a[1] * s_, a[2] * s_, a[3] * s_, b[0] * s_, b[1] * s_, b[2] * s_, b[3] * s_};
                    if (ISQ) { const int p = c0 - 96 * ((c0 * 683) >> 16);
                        if (p >= 64) { const int t = row & (SEQ - 1), g = (p - 64) >> 3;
                            const f32x4 c0v = *(const f32x4*)(tabm + (t * 16 + 4 * g) * 2), c1v = *(const f32x4*)(tabm + (t * 16 + 4 * g) * 2 + 4);
                            const float co[4] = {c0v.x, c0v.z, c1v.x, c1v.z}, si[4] = {c0v.y, c0v.w, c1v.y, c1v.w};
#pragma unroll
                            for (int w = 0; w < 4; ++w) { const float x1 = o[w], x2 = o[4 + w]; o[w] = x1 * co[w] - x2 * si[w]; o[4 + w] = x1 * si[w] + x2 * co[w]; } } }
                    store8_bf16(out + (size_t)row * (ISQ ? QW : KVW) + c0, o); } }
    }
};
__device__ __forceinline__ void p3_upq(const Ctx& c, float* lds) {
    pg8::Gemm g{c.proj() + PC_CQ, c.wuq_t(), NPROJ, 256, 256, nullptr, 0, 0, 0};
    pg8::StaticOrder S; S.init(RL, QW, (int)gridDim.x, (int)blockIdx.x);
    EpiUp<true> E{c.qb(), c.pstat(), c.tabm()};
    pg8::gemm_phase((LAS unsigned char*)lds, g, S, E, c.tid);
}
__device__ __forceinline__ void p3_upkv(const Ctx& c, float* lds) {
    pg8::Gemm g{c.proj() + PC_CKV, c.wukv_t(), NPROJ, 256, 128, nullptr, 0, 0, 0};
    pg8::StaticOrder S; S.init(RT, KVW, (int)gridDim.x, (int)blockIdx.x);
    EpiUp<false> E{c.kvb(), c.pstat(), c.tabm()};
    pg8::gemm_phase((LAS unsigned char*)lds, g, S, E, c.tid);
}

namespace att {
using bf16x8 = __attribute__((ext_vector_type(8))) short;
using s16x4  = __attribute__((ext_vector_type(4))) short;
using f32x16 = __attribute__((ext_vector_type(16))) float;
constexpr int QBLK = 32, KVBLK = 64, NWV = 8;
constexpr float THR = 8.f;
constexpr int SHM_V = 16384, SHM_K = 16384, SHM_ATTN = 3 * SHM_V + 3 * SHM_K + NWV * 64 * 4;
#define KSWZ(row, colB) ((row) * 256 + ((colB) ^ (((row) & 7) << 4)))
#define SBAR() __builtin_amdgcn_sched_barrier(0)
__device__ __forceinline__ int crow(int r, int hi) { return (r & 3) + 8 * (r >> 2) + 4 * hi; }
__device__ __forceinline__ unsigned cvtpk(float lo, float hi) { unsigned r; asm volatile("v_cvt_pk_bf16_f32 %0, %1, %2" : "=v"(r) : "v"(lo), "v"(hi)); return r; }
__device__ __forceinline__ float max3f(float a, float b, float c) { float r; asm("v_max3_f32 %0, %1, %2, %3" : "=v"(r) : "v"(a), "v"(b), "v"(c)); return r; }
template <bool FIRST>
__device__ __forceinline__ void partialSM(f32x16& p0, f32x16& p1, float& m_reg, f32x16& negm, float& alpha) {
  float pa = max3f(p0[0], p0[1], p0[2]), pb = max3f(p1[0], p1[1], p1[2]);
#pragma unroll
  for (int r = 3; r < 15; r += 2) { pa = max3f(pa, p0[r], p0[r + 1]); pb = max3f(pb, p1[r], p1[r + 1]); }
  float pmax = max3f(pa, pb, fmaxf(p0[15], p1[15]));
  { auto rr = __builtin_amdgcn_permlane32_swap(__float_as_uint(pmax), __float_as_uint(pmax), false, false);
    pmax = fmaxf(__uint_as_float(rr[0]), __uint_as_float(rr[1])); }
  if (!FIRST && __builtin_expect(__all(pmax <= THR), 1)) { alpha = 1.f; }
  else { const float dl = FIRST ? pmax : fmaxf(pmax, 0.f); alpha = FIRST ? 1.f : __builtin_amdgcn_exp2f(-dl); m_reg += dl;
#pragma unroll
    for (int r = 0; r < 16; ++r) { p0[r] -= dl; p1[r] -= dl; }
#pragma unroll
    for (int r = 0; r < 16; ++r) negm[r] = -m_reg;
    asm volatile("" : "+v"(negm)); }
#pragma unroll
  for (int r = 0; r < 16; ++r) p0[r] = __builtin_amdgcn_exp2f(p0[r]);
}
__device__ __forceinline__ void finishSM(f32x16& p0, f32x16& p1, float alpha, float& l_reg, bf16x8& pa0, bf16x8& pa1, bf16x8& pa2, bf16x8& pa3) {
#pragma unroll
  for (int r = 0; r < 16; ++r) p1[r] = __builtin_amdgcn_exp2f(p1[r]);
  float ps = 0;
#pragma unroll
  for (int r = 0; r < 16; ++r) ps += p0[r];
#pragma unroll
  for (int r = 0; r < 16; ++r) ps += p1[r];
  { auto rr = __builtin_amdgcn_permlane32_swap(__float_as_uint(ps), __float_as_uint(ps), false, false);
    ps = __uint_as_float(rr[0]) + __uint_as_float(rr[1]); }
  l_reg = l_reg * alpha + ps;
#define PK4(P, BASE, OUT) do { unsigned a0 = cvtpk(P[BASE + 0], P[BASE + 1]), a1 = cvtpk(P[BASE + 2], P[BASE + 3]);   \
    unsigned b0 = cvtpk(P[BASE + 4], P[BASE + 5]), b1 = cvtpk(P[BASE + 6], P[BASE + 7]);                              \
    auto r0 = __builtin_amdgcn_permlane32_swap(a0, b0, false, false); auto r1 = __builtin_amdgcn_permlane32_swap(a1, b1, false, false); \
    u32x4 w = {r0[0], r1[0], r0[1], r1[1]}; OUT = *reinterpret_cast<bf16x8*>(&w); } while (0)
  PK4(p0, 0, pa0); PK4(p0, 8, pa1); PK4(p1, 0, pa2); PK4(p1, 8, pa3);
#undef PK4
}
__device__ __forceinline__ void qkt(f32x16& p0, f32x16& p1, const char* Ks, const bf16x8* qr, const f32x16& negm, int r32, int hi) {
#pragma unroll
  for (int d0 = 0; d0 < 6; ++d0) { const int cb = (d0 * 16 + hi * 8) * 2;
    const bf16x8 b0 = *reinterpret_cast<const bf16x8*>(Ks + KSWZ(r32, cb));
    const bf16x8 b1 = *reinterpret_cast<const bf16x8*>(Ks + KSWZ(32 + r32, cb));
    if (d0 == 0) { p0 = __builtin_amdgcn_mfma_f32_32x32x16_bf16(b0, qr[0], negm, 0, 0, 0); p1 = __builtin_amdgcn_mfma_f32_32x32x16_bf16(b1, qr[0], negm, 0, 0, 0); }
    else { p0 = __builtin_amdgcn_mfma_f32_32x32x16_bf16(b0, qr[d0], p0, 0, 0, 0); p1 = __builtin_amdgcn_mfma_f32_32x32x16_bf16(b1, qr[d0], p1, 0, 0, 0); } }
}
__device__ __forceinline__ int v_st(int k, int c) { const int kk = (k & ~0xC) | ((k & 4) << 1) | ((k & 8) >> 1); return ((kk >> 3) * 4 + (c >> 5)) * 512 + ((kk & 7) * 32 + (c & 31)) * 2; }
__device__ __forceinline__ int v_rd_base(int lane) { return ((lane & 3) << 3) | (((lane >> 2) & 3) << 6) | (((lane >> 4) & 1) << 5) | (((lane >> 5) & 1) << 8); }
constexpr int v_rd_off(int d0, int ks, int half) { return d0 * 512 + ks * 4096 + half * 2048; }
template <int OFF> __device__ __forceinline__ s16x4 tr_read(int vb) { s16x4 r; asm volatile("ds_read_b64_tr_b16 %0, %1 offset:%2" : "=&v"(r) : "v"(vb), "i"(OFF) : "memory"); return r; }
template <int D0> __device__ __forceinline__ void pv_one(f32x16& od, int vb, bf16x8 pa0, bf16x8 pa1, bf16x8 pa2, bf16x8 pa3) {
  const s16x4 l0 = tr_read<v_rd_off(D0, 0, 0)>(vb), h0 = tr_read<v_rd_off(D0, 0, 1)>(vb), l1 = tr_read<v_rd_off(D0, 1, 0)>(vb), h1 = tr_read<v_rd_off(D0, 1, 1)>(vb);
  const s16x4 l2 = tr_read<v_rd_off(D0, 2, 0)>(vb), h2 = tr_read<v_rd_off(D0, 2, 1)>(vb), l3 = tr_read<v_rd_off(D0, 3, 0)>(vb), h3 = tr_read<v_rd_off(D0, 3, 1)>(vb);
  asm volatile("s_waitcnt lgkmcnt(0)" ::: "memory"); SBAR();
#define PK(L, H) (bf16x8){L[0], L[1], L[2], L[3], H[0], H[1], H[2], H[3]}
  od = __builtin_amdgcn_mfma_f32_32x32x16_bf16(pa0, PK(l0, h0), od, 0, 0, 0);
  od = __builtin_amdgcn_mfma_f32_32x32x16_bf16(pa1, PK(l1, h1), od, 0, 0, 0);
  od = __builtin_amdgcn_mfma_f32_32x32x16_bf16(pa2, PK(l2, h2), od, 0, 0, 0);
  od = __builtin_amdgcn_mfma_f32_32x32x16_bf16(pa3, PK(l3, h3), od, 0, 0, 0);
#undef PK
}
__device__ __forceinline__ void pv_d0(f32x16* o, int vb, bf16x8 pa0, bf16x8 pa1, bf16x8 pa2, bf16x8 pa3) {
  const s16x4 l0 = tr_read<v_rd_off(0, 0, 0)>(vb), h0 = tr_read<v_rd_off(0, 0, 1)>(vb), l1 = tr_read<v_rd_off(0, 1, 0)>(vb), h1 = tr_read<v_rd_off(0, 1, 1)>(vb);
  const s16x4 l2 = tr_read<v_rd_off(0, 2, 0)>(vb), h2 = tr_read<v_rd_off(0, 2, 1)>(vb), l3 = tr_read<v_rd_off(0, 3, 0)>(vb), h3 = tr_read<v_rd_off(0, 3, 1)>(vb);
  const s16x4 m0 = tr_read<v_rd_off(1, 0, 0)>(vb), g0 = tr_read<v_rd_off(1, 0, 1)>(vb), m1 = tr_read<v_rd_off(1, 1, 0)>(vb), g1 = tr_read<v_rd_off(1, 1, 1)>(vb);
  const s16x4 m2 = tr_read<v_rd_off(1, 2, 0)>(vb), g2 = tr_read<v_rd_off(1, 2, 1)>(vb), m3 = tr_read<v_rd_off(1, 3, 0)>(vb), g3 = tr_read<v_rd_off(1, 3, 1)>(vb);
  asm volatile("s_waitcnt lgkmcnt(0)" ::: "memory"); SBAR();
#define PK(L, H) (bf16x8){L[0], L[1], L[2], L[3], H[0], H[1], H[2], H[3]}
  o[0] = __builtin_amdgcn_mfma_f32_32x32x16_bf16(pa0, PK(l0, h0), o[0], 0, 0, 0); o[1] = __builtin_amdgcn_mfma_f32_32x32x16_bf16(pa0, PK(m0, g0), o[1], 0, 0, 0);
  o[0] = __builtin_amdgcn_mfma_f32_32x32x16_bf16(pa1, PK(l1, h1), o[0], 0, 0, 0); o[1] = __builtin_amdgcn_mfma_f32_32x32x16_bf16(pa1, PK(m1, g1), o[1], 0, 0, 0);
  o[0] = __builtin_amdgcn_mfma_f32_32x32x16_bf16(pa2, PK(l2, h2), o[0], 0, 0, 0); o[1] = __builtin_amdgcn_mfma_f32_32x32x16_bf16(pa2, PK(m2, g2), o[1], 0, 0, 0);
  o[0] = __builtin_amdgcn_mfma_f32_32x32x16_bf16(pa3, PK(l3, h3), o[0], 0, 0, 0); o[1] = __builtin_amdgcn_mfma_f32_32x32x16_bf16(pa3, PK(m3, g3), o[1], 0, 0, 0);
#undef PK
}

__device__ __forceinline__ void attn_unit(const bf16_t* __restrict__ Qb, const bf16_t* __restrict__ KN, const bf16_t* __restrict__ KR, const bf16_t* __restrict__ VV, bf16_t* __restrict__ Ob, int b, char* lds, int tid) {
  const int wid = tid >> 6, lane = tid & 63, r32 = lane & 31, hi = lane >> 5;
  char* V_lds = lds; char* K_lds = lds + 3 * SHM_V;
  float* ws = (float*)(lds + 3 * SHM_V + 3 * SHM_K) + wid * 64; float* li_l = ws; float* al_l = ws + 32;
  float m_reg = 0.f, l_reg = 0; f32x16 o[2] = {}; bf16x8 qr[6]; f32x16 negm = {};
  const bf16_t* Qw = Qb + (long)(wid * QBLK + r32) * QW + hi * 8;
#pragma unroll
  for (int d0 = 0; d0 < 6; ++d0) qr[d0] = __builtin_nontemporal_load(reinterpret_cast<const bf16x8*>(Qw + d0 * 16));
  const int srow = tid >> 3, sch = tid & 7;
  const int rrow = (tid & 255) >> 2, rch = tid & 3;
  const int vst = v_st(srow, sch * 8), kst = KSWZ(srow, sch * 16), krst = KSWZ(rrow, 128 + rch * 16);
  const int vb0 = (int)(uintptr_t)V_lds + v_rd_base(lane);
  struct { bf16x8 vs, kn, kr; } sr_[2];
#define ROWBASE(j) ((j) < 64 ? (long)b * SEQ + (long)(j) * 64 : (long)RL + (long)b * LC + (long)((j) - 64) * 64)
#define SLOAD(i, j) do { const long rb_ = ROWBASE(j); sr_[i].vs = *reinterpret_cast<const bf16x8*>(VV + (rb_ + srow) * KVW + sch * 8); \
    sr_[i].kn = *reinterpret_cast<const bf16x8*>(KN + (rb_ + srow) * KVW + sch * 8); sr_[i].kr = *reinterpret_cast<const bf16x8*>(KR + (rb_ + rrow) * NPROJ + rch * 8); } while (0)
#define SWRITE(bb, i) do { *(bf16x8*)(V_lds + (bb) * SHM_V + vst) = sr_[i].vs; *(bf16x8*)(K_lds + (bb) * SHM_K + kst) = sr_[i].kn; \
    if (wid < 4) *(bf16x8*)(K_lds + (bb) * SHM_K + krst) = sr_[i].kr; } while (0)
#define SWAIT() asm volatile("s_waitcnt vmcnt(3)" ::: "memory")
#define RESC(a) do { if (__any((a) < 1.f)) { if (hi == 0) al_l[r32] = (a); asm volatile("s_waitcnt lgkmcnt(0)" ::: "memory"); \
    _Pragma("unroll") for (int d = 0; d < 2; ++d) _Pragma("unroll") for (int r = 0; r < 16; ++r) o[d][r] *= al_l[crow(r, hi)]; } } while (0)
  f32x16 pA0, pA1, pB0, pB1; float alA, alB; bf16x8 pa0, pa1, pa2, pa3; constexpr int NT = (SEQ + LC) / KVBLK;
  if (wid >= 4) __builtin_amdgcn_s_setprio(1);
  int cur = 1, prev = 0, nxt = 2;
  SLOAD(0, 0); SLOAD(1, 1); asm volatile("s_waitcnt vmcnt(0)" ::: "memory"); SWRITE(0, 0); SWRITE(1, 1); SLOAD(0, 2); SLOAD(1, 3); __syncthreads();
  qkt(pA0, pA1, K_lds, qr, negm, r32, hi); partialSM<true>(pA0, pA1, m_reg, negm, alA);
#define HALFSTEP(PX0, PX1, PP0, PP1, ALX, ALP, STG, T) do { \
    __syncthreads(); \
    SBAR(); qkt(PX0, PX1, K_lds + cur * SHM_K, qr, negm, r32, hi); \
    finishSM(PP0, PP1, ALP, l_reg, pa0, pa1, pa2, pa3); SBAR(); \
    if ((T) + 1 < NT) { SWAIT(); SWRITE(nxt, STG); if ((T) + 3 < NT) SLOAD(STG, (T) + 3); } SBAR(); \
    pv_d0(o, vb0 + prev * SHM_V, pa0, pa1, pa2, pa3); partialSM<false>(PX0, PX1, m_reg, negm, ALX); \
    RESC(ALX); { const int t_ = prev; prev = cur; cur = nxt; nxt = t_; } } while (0)
  for (int t = 1; t + 1 < NT; t += 2) {
    HALFSTEP(pB0, pB1, pA0, pA1, alB, alA, 0, t);
    HALFSTEP(pA0, pA1, pB0, pB1, alA, alB, 1, t + 1);
  }
  HALFSTEP(pB0, pB1, pA0, pA1, alB, alA, 0, NT - 1);
  finishSM(pB0, pB1, alB, l_reg, pa0, pa1, pa2, pa3); SBAR();
  pv_d0(o, vb0 + prev * SHM_V, pa0, pa1, pa2, pa3);
#undef HALFSTEP
  if (hi == 0) li_l[r32] = l_reg; asm volatile("s_waitcnt lgkmcnt(0)" ::: "memory");
  float rli[16];
#pragma unroll
  for (int r = 0; r < 16; ++r) rli[r] = __builtin_amdgcn_rcpf(li_l[crow(r, hi)]);
  bf16_t* Ow = Ob + (long)(wid * QBLK) * D;
#pragma unroll
  for (int r = 0; r < 16; ++r) { const int orow = crow(r, hi);
#pragma unroll
    for (int d0 = 0; d0 < 2; ++d0) Ow[(long)orow * D + d0 * 32 + r32] = f2bf(o[d0][r] * rli[r]); }
  __builtin_amdgcn_s_setprio(0);
  __syncthreads();
#undef ROWBASE
#undef SLOAD
#undef SWRITE
#undef SWAIT
#undef RESC
}
#undef KSWZ
#undef SBAR
}


__device__ __forceinline__ float lg2_of(float e) { return log1pf(-exp2f(-e)) * 1.4426950408889634f; }
namespace ret {
using att::bf16x8; using att::s16x4; using att::f32x16; using att::v_st; using att::v_rd_base; using att::v_rd_off; using att::tr_read; using att::crow; using att::cvtpk;
constexpr int TB = 16384;
__device__ __forceinline__ bf16x8 scale8(bf16x8 x, float z) {
    const u32x4 w = __builtin_bit_cast(u32x4, x); u32x4 o;
    o.x = cvtpk(__uint_as_float(w.x << 16) * z, __uint_as_float(w.x & 0xffff0000u) * z); o.y = cvtpk(__uint_as_float(w.y << 16) * z, __uint_as_float(w.y & 0xffff0000u) * z);
    o.z = cvtpk(__uint_as_float(w.z << 16) * z, __uint_as_float(w.z & 0xffff0000u) * z); o.w = cvtpk(__uint_as_float(w.w << 16) * z, __uint_as_float(w.w & 0xffff0000u) * z);
    return __builtin_bit_cast(bf16x8, o);
}
#define RET_PK(L, H) (bf16x8){L[0], L[1], L[2], L[3], H[0], H[1], H[2], H[3]}
__device__ __forceinline__ void tt_mma(f32x16& acc, int va, int vb) {
    const s16x4 al0 = tr_read<v_rd_off(0, 0, 0)>(va), ah0 = tr_read<v_rd_off(0, 0, 1)>(va), al1 = tr_read<v_rd_off(0, 1, 0)>(va), ah1 = tr_read<v_rd_off(0, 1, 1)>(va);
    const s16x4 al2 = tr_read<v_rd_off(0, 2, 0)>(va), ah2 = tr_read<v_rd_off(0, 2, 1)>(va), al3 = tr_read<v_rd_off(0, 3, 0)>(va), ah3 = tr_read<v_rd_off(0, 3, 1)>(va);
    const s16x4 bl0 = tr_read<v_rd_off(0, 0, 0)>(vb), bh0 = tr_read<v_rd_off(0, 0, 1)>(vb), bl1 = tr_read<v_rd_off(0, 1, 0)>(vb), bh1 = tr_read<v_rd_off(0, 1, 1)>(vb);
    const s16x4 bl2 = tr_read<v_rd_off(0, 2, 0)>(vb), bh2 = tr_read<v_rd_off(0, 2, 1)>(vb), bl3 = tr_read<v_rd_off(0, 3, 0)>(vb), bh3 = tr_read<v_rd_off(0, 3, 1)>(vb);
    asm volatile("s_waitcnt lgkmcnt(0)" ::: "memory"); __builtin_amdgcn_sched_barrier(0);
    acc = __builtin_amdgcn_mfma_f32_32x32x16_bf16(RET_PK(al0, ah0), RET_PK(bl0, bh0), acc, 0, 0, 0);
    acc = __builtin_amdgcn_mfma_f32_32x32x16_bf16(RET_PK(al1, ah1), RET_PK(bl1, bh1), acc, 0, 0, 0);
    acc = __builtin_amdgcn_mfma_f32_32x32x16_bf16(RET_PK(al2, ah2), RET_PK(bl2, bh2), acc, 0, 0, 0);
    acc = __builtin_amdgcn_mfma_f32_32x32x16_bf16(RET_PK(al3, ah3), RET_PK(bl3, bh3), acc, 0, 0, 0);
}
__device__ __forceinline__ void scan_seq(const bf16_t* __restrict__ proj, bf16_t* __restrict__ rstT, int b, int h, int dir, float lg2, char* lds, int tid) {
    const int wid = tid >> 6, lane = tid & 63, r32 = lane & 31, hi = lane >> 5;
    const float g128 = __builtin_amdgcn_exp2f(lg2 * 128.f);
    const int key0 = tid >> 3, key1 = 64 + (tid >> 3), ch = tid & 7;
    const float z0 = __builtin_amdgcn_exp2f(lg2 * (float)(dir ? key0 : 127 - key0)), z1 = __builtin_amdgcn_exp2f(lg2 * (float)(dir ? key1 : 127 - key1));
    const int st = v_st(tid >> 3, ch * 8);
    char* KI = lds; char* VI = lds + 4 * TB;
    const int mt = (wid >> 1) & 1, nt = wid & 1;
    const int vaK = (int)(uintptr_t)KI + v_rd_base(lane) + mt * 512, vbV = (int)(uintptr_t)VI + v_rd_base(lane) + nt * 512;
    f32x16 acc = {};
    bf16x8 k0a, k1a, v0a, v1a, k0b, k1b, v0b, v1b, k0c, k1c, v0c, v1c, k0d, k1d, v0d, v1d;
#define RROW(ck) ((ck) < 2 ? (long)RL + (long)b * LC + (long)(dir ? 1 - (ck) : (ck)) * 128 : (long)b * SEQ + (long)(dir ? NCH - 1 - ((ck) - 2) : (ck) - 2) * 128)
#define RLOAD(S, ck) do { const bf16_t* p_ = proj + RROW(ck) * NPROJ + h * 64 + ch * 8; k0##S = *(const bf16x8*)(p_ + (long)key0 * NPROJ + PC_RK); k1##S = *(const bf16x8*)(p_ + (long)key1 * NPROJ + PC_RK); \
        v0##S = *(const bf16x8*)(p_ + (long)key0 * NPROJ + PC_RV); v1##S = *(const bf16x8*)(p_ + (long)key1 * NPROJ + PC_RV); } while (0)
#define RWRITE(S, bb) do { *(bf16x8*)(KI + ((bb) * 2 + 0) * TB + st) = scale8(k0##S, z0); *(bf16x8*)(KI + ((bb) * 2 + 1) * TB + st) = scale8(k1##S, z1); \
        *(bf16x8*)(VI + ((bb) * 2 + 0) * TB + st) = v0##S; *(bf16x8*)(VI + ((bb) * 2 + 1) * TB + st) = v1##S; } while (0)
#define RCOMP(ck, bb) do { if (wid < 4) { \
            if ((ck) >= 2) { const int n = dir ? NCH - 1 - ((ck) - 2) : (ck) - 2; bf16_t* o = rstT + (size_t)n * 4096 + (size_t)(32 * nt + r32) * 64 + 32 * mt + 4 * hi; \
                _Pragma("unroll") for (int g = 0; g < 4; ++g) { u32x2 w; w.x = cvtpk(acc[4 * g], acc[4 * g + 1]); w.y = cvtpk(acc[4 * g + 2], acc[4 * g + 3]); *(u32x2*)(o + 8 * g) = w; } } \
            _Pragma("unroll") for (int r = 0; r < 16; ++r) acc[r] *= g128; \
            tt_mma(acc, vaK + ((bb) * 2 + 0) * TB, vbV + ((bb) * 2 + 0) * TB); \
            tt_mma(acc, vaK + ((bb) * 2 + 1) * TB, vbV + ((bb) * 2 + 1) * TB); } } while (0)
    constexpr int NCK = 2 + NCH;
#define RSTEP(ck, S) do { RCOMP(ck, (ck) & 1); if ((ck) + 1 < NCK) { RWRITE(S, ((ck) + 1) & 1); } if ((ck) + 5 < NCK) RLOAD(S, (ck) + 5); __syncthreads(); } while (0)
    __syncthreads();
    RLOAD(a, 0); RWRITE(a, 0); RLOAD(b, 1); RLOAD(c, 2); RLOAD(d, 3); RLOAD(a, 4); __syncthreads();
    for (int ck = 0; ck < 32; ck += 4) { RSTEP(ck, b); RSTEP(ck + 1, c); RSTEP(ck + 2, d); RSTEP(ck + 3, a); }
    RSTEP(32, b); RSTEP(33, c);
#undef RSTEP
#undef RCOMP
#undef RROW
#undef RLOAD
#undef RWRITE
}

__device__ __forceinline__ int vc_st(int k, int c) { const int kk = (k & ~0xC) | ((k & 4) << 1) | ((k & 8) >> 1); return ((kk >> 3) * 2 + (c >> 5)) * 512 + ((kk & 7) * 32 + (c & 31)) * 2; }
constexpr int vc_rd_off(int ks, int half) { return ks * 2048 + half * 1024; }
constexpr int RBUF = 32768;
struct RetUnit { int b, h, n; };
template <class UF>
__device__ __forceinline__ void ret_group(const bf16_t* __restrict__ proj, const bf16_t* __restrict__ rst, const float* __restrict__ g_ret, const float* __restrict__ exp_f, const float* __restrict__ exp_b,
                                          bf16_t* __restrict__ mix, int nunits, UF unit_of, char* gl, int t4, int w4, int lane) {
    const int r32 = lane & 31, hi = lane >> 5, i = 32 * w4 + r32;
    bf16x8 qn[4];
    int soff[8];
#pragma unroll
    for (int q_ = 0; q_ < 8; ++q_) { const int s_ = ((4 * q_ + w4) * 64 + lane) & 1023;
        if (q_ < 4) { const int img = s_ >> 9, sub = (s_ & 511) >> 5, rw = (s_ & 31) >> 2, cc = s_ & 3; const int kk = (sub >> 1) * 8 + rw, key = (kk & ~0xC) | ((kk & 4) << 1) | ((kk & 8) >> 1);
            soff[q_] = (img * 64 + key) * NPROJ + PC_RV + (sub & 1) * 32 + cc * 8; }
        else { const int row = s_ >> 3, cp = s_ & 7, chn = cp ^ ((row >> 1) & 7); soff[q_] = row * NPROJ + PC_RK + chn * 8; } }
#define RG_LOAD(u, bb) do { const bf16_t* base_ = proj + ((long)(u).b * SEQ + (long)(u).n * 128) * NPROJ + (u).h * 64; \
        _Pragma("unroll") for (int q_ = 0; q_ < 8; ++q_) __builtin_amdgcn_global_load_lds((const unsigned*)(base_ + soff[q_]), (LAS unsigned*)((LAS char*)gl + (bb) * RBUF + (4 * q_ + w4) * 1024), 16, 0, 0); \
        const bf16_t* qp_ = base_ + (long)i * NPROJ + PC_RQ + hi * 8; \
        _Pragma("unroll") for (int ks_ = 0; ks_ < 4; ++ks_) qn[ks_] = *(const bf16x8*)(qp_ + ks_ * 16); } while (0)
    RetUnit u = unit_of(0);
    RG_LOAD(u, 0);
    bf16x8 q[4];
#pragma unroll
    for (int ks = 0; ks < 4; ++ks) q[ks] = qn[ks];
    asm volatile("s_waitcnt vmcnt(0)" ::: "memory"); __syncthreads();
    for (int ui = 0; ui < nunits; ++ui) {
        const int bb = ui & 1; const RetUnit un = unit_of(ui + 1 < nunits ? ui + 1 : ui);
        if (ui + 1 < nunits) RG_LOAD(un, bb ^ 1);
        const float lf = lg2_of(exp_f[u.h]), lb = lg2_of(exp_b[u.h]);
        int io = i, hio = hi; asm volatile("" : "+v"(io), "+v"(hio));
        const long row0 = (long)u.b * SEQ + (long)u.n * 128;
        const bf16_t* rf = rst + (size_t)(((u.b * NH + u.h) * 2 + 0) * NCH + u.n) * 4096 + (size_t)r32 * 64 + hi * 8;
        const bf16_t* rb = rst + (size_t)(((u.b * NH + u.h) * 2 + 1) * NCH + u.n) * 4096 + (size_t)r32 * 64 + hi * 8;
        bf16x8 rff[2][4], rbf[2][4];
#pragma unroll
        for (int et = 0; et < 2; ++et)
#pragma unroll
            for (int ks = 0; ks < 4; ++ks) { rff[et][ks] = *(const bf16x8*)(rf + et * 2048 + ks * 16); rbf[et][ks] = *(const bf16x8*)(rb + et * 2048 + ks * 16); }
        f32x16 acc[2] = {f32x16{}, f32x16{}};
        const char* kt = gl + bb * RBUF + 16384; const int vimg0 = (int)(uintptr_t)(gl + bb * RBUF) + v_rd_base(lane);
#pragma unroll
        for (int t = 0; t < 4; ++t) {
            f32x16 p = {};
            const int krow = 32 * t + r32;
#pragma unroll
            for (int ks = 0; ks < 4; ++ks) { const bf16x8 kf = *(const bf16x8*)(kt + krow * 128 + (((2 * ks + hi) ^ ((krow >> 1) & 7)) << 4)); p = __builtin_amdgcn_mfma_f32_32x32x16_bf16(kf, q[ks], p, 0, 0, 0); }
#pragma unroll
            for (int r = 0; r < 16; ++r) { const int j = 32 * t + (r & 3) + 8 * (r >> 2) + 4 * hio; const int dd = io - j; p[r] *= __builtin_amdgcn_exp2f(dd >= 0 ? lf * (float)dd : lb * (float)(-dd)); }
            bf16x8 pa0, pa1;
#define PK4(P, BASE, OUT) do { unsigned a0 = cvtpk(P[BASE + 0], P[BASE + 1]), a1 = cvtpk(P[BASE + 2], P[BASE + 3]);   \
    unsigned b0 = cvtpk(P[BASE + 4], P[BASE + 5]), b1 = cvtpk(P[BASE + 6], P[BASE + 7]);                              \
    auto r0 = __builtin_amdgcn_permlane32_swap(a0, b0, false, false); auto r1 = __builtin_amdgcn_permlane32_swap(a1, b1, false, false); \
    u32x4 w = {r0[0], r1[0], r0[1], r1[1]}; OUT = *reinterpret_cast<bf16x8*>(&w); } while (0)
            PK4(p, 0, pa0); PK4(p, 8, pa1);
#undef PK4
            const int vimg = vimg0 + (t >> 1) * 8192;
#pragma unroll
            for (int et = 0; et < 2; ++et) {
                s16x4 l0, h0, l1, h1;
                if ((t & 1) == 0) { l0 = tr_read<vc_rd_off(0, 0)>(vimg + et * 512); h0 = tr_read<vc_rd_off(0, 1)>(vimg + et * 512); l1 = tr_read<vc_rd_off(1, 0)>(vimg + et * 512); h1 = tr_read<vc_rd_off(1, 1)>(vimg + et * 512); }
                else { l0 = tr_read<vc_rd_off(2, 0)>(vimg + et * 512); h0 = tr_read<vc_rd_off(2, 1)>(vimg + et * 512); l1 = tr_read<vc_rd_off(3, 0)>(vimg + et * 512); h1 = tr_read<vc_rd_off(3, 1)>(vimg + et * 512); }
                asm volatile("s_waitcnt lgkmcnt(0)" ::: "memory"); __builtin_amdgcn_sched_barrier(0);
                acc[et] = __builtin_amdgcn_mfma_f32_32x32x16_bf16(RET_PK(l0, h0), pa0, acc[et], 0, 0, 0);
                acc[et] = __builtin_amdgcn_mfma_f32_32x32x16_bf16(RET_PK(l1, h1), pa1, acc[et], 0, 0, 0);
            }
            asm volatile("" ::: "memory");
        }
        const float xf = __builtin_amdgcn_exp2f(lf * (float)(i + 1)), xb = __builtin_amdgcn_exp2f(lb * (float)(128 - i));
        const bf16_t* gp = proj + (row0 + i) * NPROJ + PC_RG + u.h * 64; bf16_t* op = mix + (row0 + i) * D + 512 + u.h * 64; const float* gr = g_ret + u.h * 64;
        u32x2 gwv[2][4];
#pragma unroll
        for (int et = 0; et < 2; ++et)
#pragma unroll
            for (int g = 0; g < 4; ++g) gwv[et][g] = *(const u32x2*)(gp + 32 * et + 8 * g + 4 * hi);
        bf16x8 qf[4], qbk[4];
#pragma unroll
        for (int ks = 0; ks < 4; ++ks) { qf[ks] = scale8(q[ks], xf); qbk[ks] = scale8(q[ks], xb); }
#pragma unroll
        for (int et = 0; et < 2; ++et) {
#pragma unroll
            for (int ks = 0; ks < 4; ++ks) acc[et] = __builtin_amdgcn_mfma_f32_32x32x16_bf16(rff[et][ks], qf[ks], acc[et], 0, 0, 0);
#pragma unroll
            for (int ks = 0; ks < 4; ++ks) acc[et] = __builtin_amdgcn_mfma_f32_32x32x16_bf16(rbf[et][ks], qbk[ks], acc[et], 0, 0, 0); }
        float s1 = 0.f;
#pragma unroll
        for (int et = 0; et < 2; ++et)
#pragma unroll
            for (int r = 0; r < 16; ++r) s1 += acc[et][r];
        { auto rr = __builtin_amdgcn_permlane32_swap(__float_as_uint(s1), __float_as_uint(s1), false, false); s1 = __uint_as_float(rr[0]) + __uint_as_float(rr[1]); }
        const float mu = s1 * (1.f / 64.f); float s2 = 0.f;
#pragma unroll
        for (int et = 0; et < 2; ++et)
#pragma unroll
            for (int r = 0; r < 16; ++r) { const float dlt = acc[et][r] - mu; s2 += dlt * dlt; }
        { auto rr = __builtin_amdgcn_permlane32_swap(__float_as_uint(s2), __float_as_uint(s2), false, false); s2 = __uint_as_float(rr[0]) + __uint_as_float(rr[1]); }
        const float rs = 1.f / sqrtf(s2 * (1.f / 64.f) + EPS);
#pragma unroll
        for (int et = 0; et < 2; ++et)
#pragma unroll
            for (int g = 0; g < 4; ++g) { const int e = 32 * et + 8 * g + 4 * hi; const u32x2 gw = gwv[et][g]; const f32x4 gg = *(const f32x4*)(gr + e);
                const float o0 = (acc[et][4 * g] - mu) * rs * gg.x * __uint_as_float(gw.x << 16), o1 = (acc[et][4 * g + 1] - mu) * rs * gg.y * __uint_as_float(gw.x & 0xffff0000u);
                const float o2 = (acc[et][4 * g + 2] - mu) * rs * gg.z * __uint_as_float(gw.y << 16), o3 = (acc[et][4 * g + 3] - mu) * rs * gg.w * __uint_as_float(gw.y & 0xffff0000u);
                u32x2 w; w.x = cvtpk(o0, o1); w.y = cvtpk(o2, o3); *(u32x2*)(op + e) = w; }
        if (ui + 1 < nunits) {
#pragma unroll
            for (int ks = 0; ks < 4; ++ks) q[ks] = qn[ks]; }
        u = un;
        asm volatile("s_waitcnt vmcnt(0)" ::: "memory"); __syncthreads();
    }
#undef RG_LOAD
}
#undef RET_PK
}

__device__ __forceinline__ void p4_attn(const Ctx& c, float* lds) {
    const int G = (int)gridDim.x, bx = (int)blockIdx.x; const int vcu = (G % 8 == 0) ? (bx % 8) * (G / 8) + bx / 8 : bx;
    for (int unit = vcu; unit < NB * NH * 16; unit += G) {
        const int qblk = unit & 15, h = (unit >> 4) & 7, b = unit >> 7;
        att::attn_unit(c.qb() + (size_t)(b * SEQ + qblk * 256) * QW + h * 96, c.kvb() + h * 128, c.proj() + PC_KR, c.kvb() + h * 128 + 64,
                       c.mix() + (size_t)(b * SEQ + qblk * 256) * D + h * 64, b, (char*)lds, c.tid);
    }
}
__device__ __forceinline__ void p3c_scan(const Ctx& c, float* lds) {
    const int bx = (int)blockIdx.x;
    for (int seq = bx >> 1; seq < NB * NH * 2 && (bx & 1) == 0; seq += (int)gridDim.x >> 1) {
        const int dir = seq & 1, h = (seq >> 1) & 7, b = seq >> 4;
        const float lg2 = lg2_of(dir ? c.exp_b()[h] : c.exp_f()[h]);
        ret::scan_seq(c.proj(), c.rst() + (size_t)((b * NH + h) * 2 + dir) * NCH * 4096, b, h, dir, lg2, (char*)lds, c.tid);
    }
    __syncthreads();
    { const int G = (int)gridDim.x; const int first = G == 256 ? QSTATIC : 0;
      for (int q = first + (G == 256 ? (bx >> 1) : bx); q < GU_STRIPS && (G != 256 || (bx & 1)); q += (G == 256 ? 128 : G)) gu_strip_i8(c, lds, q); }
    __syncthreads();
    p0_weights<1>(c, lds, 0, 1);
    __syncthreads();
}
__device__ __forceinline__ void p4_ret(const Ctx& c, float* lds) {
    const int tid = c.tid, wid = tid >> 6, lane = tid & 63, grp = wid >> 2, w4 = wid & 3;
    const int G = (int)gridDim.x, bx = (int)blockIdx.x; const int vcu = (G % 8 == 0) ? (bx % 8) * (G / 8) + bx / 8 : bx;
    const int gid = vcu * 2 + grp, ngrp = 2 * G; const int total = NB * NH * NCH;
    const int nun = (total - gid + ngrp - 1) / ngrp;
    __syncthreads();
    ret::ret_group(c.proj(), c.rst(), c.g_ret(), c.exp_f(), c.exp_b(), c.mix(), nun,
                   [gid, ngrp](int k) { const int unit = gid + ngrp * k; return ret::RetUnit{unit >> 8, (unit >> 5) & 7, unit & 31}; }, (char*)lds + grp * 2 * ret::RBUF, tid & 255, w4, lane);
}

struct EpiRes {
    static constexpr bool PERM = true;
    const float* x; bf16_t* out; const float* modv; float* part;
    __device__ __forceinline__ void operator()(const f32x4 (&acc)[2][2][4][2], const pg8::Unit& u, int wr, int wc, int fr, int fq) const {
        const int row0 = u.pm * 256 + wr * 64 + fr, col0 = u.pn * 256 + wc * 32 + 8 * fq; const int b = (u.pm * 256) / SEQ;
        f32x4 ga[2][2];
#pragma unroll
        for (int bj = 0; bj < 2; ++bj) { ga[bj][0] = *(const f32x4*)(modv + b * 6144 + 2048 + col0 + bj * 128); ga[bj][1] = *(const f32x4*)(modv + b * 6144 + 2048 + col0 + bj * 128 + 4); }
#pragma unroll
        for (int ai = 0; ai < 2; ++ai) {
            f32x4 xv[4][2][2];
#pragma unroll
            for (int m = 0; m < 4; ++m)
#pragma unroll
                for (int bj = 0; bj < 2; ++bj) { const float* xr = x + (size_t)(row0 + ai * 128 + m * 16) * D + col0 + bj * 128; xv[m][bj][0] = __builtin_nontemporal_load((const f32x4*)xr); xv[m][bj][1] = __builtin_nontemporal_load((const f32x4*)(xr + 4)); }
#pragma unroll
            for (int m = 0; m < 4; ++m) { float ssq = 0.f, mx = 0.f;
#pragma unroll
                for (int bj = 0; bj < 2; ++bj) { const f32x4 y0 = xv[m][bj][0] + ga[bj][0] * acc[ai][bj][m][0], y1 = xv[m][bj][1] + ga[bj][1] * acc[ai][bj][m][1];
                    const float o[8] = {y0.x, y0.y, y0.z, y0.w, y1.x, y1.y, y1.z, y1.w}; store8_bf16(out + (size_t)(row0 + ai * 128 + m * 16) * D + col0 + bj * 128, o);
                    const f32x4 tm = __builtin_elementwise_max(__builtin_elementwise_abs(y0), __builtin_elementwise_abs(y1)), sq = y0 * y0 + y1 * y1;
                    ssq += (sq.x + sq.y) + (sq.z + sq.w); mx = fmaxf(mx, fmaxf(fmaxf(tm.x, tm.y), fmaxf(tm.z, tm.w))); }
                ssq += __shfl_xor(ssq, 16); ssq += __shfl_xor(ssq, 32); mx = fmaxf(mx, __shfl_xor(mx, 16)); mx = fmaxf(mx, __shfl_xor(mx, 32));
                if (fq == 0) { float* pp = part + (size_t)(row0 + ai * 128 + m * 16) * 32 + u.pn * 4 + wc; pp[0] = ssq; pp[16] = mx; } }
            asm volatile("" ::: "memory");
        }
    }
};
__device__ __forceinline__ void p6_wo(const Ctx& c, float* lds) {
    pg8::Gemm g{c.mix(), c.wo_t(), D, D, D, nullptr, 0, 0, 0};
    pg8::StaticOrder S; S.init(RL, D, (int)gridDim.x, (int)blockIdx.x);
    EpiRes E{c.x(), c.x1b(), c.modv(), c.rpart()};
    pg8::gemm_phase((LAS unsigned char*)lds, g, S, E, c.tid);
}
__device__ __forceinline__ void p7_norm_router(const Ctx& c, float* lds) {
    typedef short bf16x8_t __attribute__((ext_vector_type(8)));
    constexpr int WP = 1032;
    bf16_t* whi = (bf16_t*)lds; bf16_t* wlo = whi + 16 * WP; float* gsl = (float*)(wlo + 16 * WP); float* shl = gsl + 1024; float* gpl = shl + 1024;
    const int G = (int)gridDim.x, bx = (int)blockIdx.x;
    bool first = true;
    for (int blk = bx; blk < RL / 128; blk += G) {
        const int b = (blk * 128) / SEQ; const float* md = c.modv() + b * 6144;
        const int fr = c.lane & 15, fq = c.lane >> 4; const int row = blk * 128 + c.wave * 16 + fr;
        const bf16_t* xr2 = c.x1b() + (size_t)row * D + 16 * fq;
        float wv[32];
        if (first) {
#pragma unroll
            for (int it = 0; it < 32; ++it) wv[it] = c.w_router()[c.tid + 512 * it]; }
        u32x4 xw[32];
#pragma unroll
        for (int i = 0; i < 16; ++i) xw[i] = *(const u32x4*)(xr2 + 64 * (i >> 1) + 8 * (i & 1));
        asm volatile("s_waitcnt lgkmcnt(0)\n\ts_barrier" ::: "memory");
        for (int k = c.tid; k < 1024; k += 512) { gsl[k] = c.g_ffn()[k] * (1.f + md[4096 + k]); shl[k] = md[3072 + k]; }
        if (first) { int tl = c.tid; asm volatile("" : "+v"(tl));
#pragma unroll
            for (int it = 0; it < 32; ++it) { const int i = tl + 512 * it, k = i >> 4, e = i & 15; const float w = wv[it]; const bf16_t h = f2bf(w); whi[e * WP + k] = h; wlo[e * WP + k] = f2bf(w - bf2f(h)); }
            first = false; }
#pragma unroll
        for (int i = 16; i < 32; ++i) xw[i] = *(const u32x4*)(xr2 + 64 * (i >> 1) + 8 * (i & 1));
        asm volatile("s_waitcnt lgkmcnt(0)\n\ts_barrier" ::: "memory");
        if (c.tid < 16) { float gm = 0.f; const int c0_ = (c.tid >> 2) * 256 + (c.tid & 3) * 32;
            for (int k = 0; k < 32; ++k) gm = fmaxf(gm, fmaxf(fabsf(gsl[c0_ + k]), fabsf(gsl[c0_ + 128 + k])));
            gpl[c.tid] = gm; }
        asm volatile("s_waitcnt lgkmcnt(0)\n\ts_barrier" ::: "memory");
        const LAS float* gs_l = (const LAS float*)gsl; const LAS float* sh_l = (const LAS float*)shl;
        float shm = 0.f;
#pragma unroll
        for (int i = 0; i < 4; ++i) { const f32x4 s4 = *(const LAS f32x4*)(sh_l + 4 * c.lane + 256 * i); shm = fmaxf(fmaxf(shm, fmaxf(fabsf(s4.x), fabsf(s4.y))), fmaxf(fabsf(s4.z), fabsf(s4.w))); }
#pragma unroll
        for (int o = 1; o < 64; o <<= 1) shm = fmaxf(shm, __shfl_xor(shm, o));
        const f32x4 ps = *(const f32x4*)(c.rpart() + (size_t)row * 32 + 4 * fq), pm4 = *(const f32x4*)(c.rpart() + (size_t)row * 32 + 16 + 4 * fq);
        float ss = (ps.x + ps.y) + (ps.z + ps.w), mx; { const f32x4 gq = *(const LAS f32x4*)((const LAS float*)gpl + 4 * fq); mx = fmaxf(fmaxf(pm4.x * gq.x, pm4.y * gq.y), fmaxf(pm4.z * gq.z, pm4.w * gq.w)) * 1.00390625f; }
        ss += __shfl_xor(ss, 16); ss += __shfl_xor(ss, 32); mx = fmaxf(mx, __shfl_xor(mx, 16)); mx = fmaxf(mx, __shfl_xor(mx, 32));
        const float rinv = 1.f / sqrtf(ss * (1.f / D) + EPS);
        const float bnd = fmaxf(rinv * mx + shm, 1e-30f), qs = 127.f / bnd;
        if (fq == 0) c.sa()[row] = bnd * (1.f / 127.f);
        f32x4 acc = {0.f, 0.f, 0.f, 0.f};
        const LAS bf16_t* wh_l = (const LAS bf16_t*)whi + fr * WP + 16 * fq; const LAS bf16_t* wl_l = (const LAS bf16_t*)wlo + fr * WP + 16 * fq;
        signed char* hq = c.h2q() + (size_t)row * D + 16 * fq;
#pragma unroll
        for (int ks2 = 0; ks2 < 16; ++ks2) { u32x4 qo;
#pragma unroll
            for (int hf = 0; hf < 2; ++hf) { const int ko = 64 * ks2 + 8 * hf; const u32x4 w = xw[2 * ks2 + hf];
                const f32x4 g0 = *(const LAS f32x4*)(gs_l + 16 * fq + ko), g1 = *(const LAS f32x4*)(gs_l + 16 * fq + ko + 4), s0 = *(const LAS f32x4*)(sh_l + 16 * fq + ko), s1 = *(const LAS f32x4*)(sh_l + 16 * fq + ko + 4);
                float h[8];
                h[0] = __uint_as_float(w.x << 16) * rinv * g0.x + s0.x; h[1] = __uint_as_float(w.x & 0xffff0000u) * rinv * g0.y + s0.y; h[2] = __uint_as_float(w.y << 16) * rinv * g0.z + s0.z; h[3] = __uint_as_float(w.y & 0xffff0000u) * rinv * g0.w + s0.w;
                h[4] = __uint_as_float(w.z << 16) * rinv * g1.x + s1.x; h[5] = __uint_as_float(w.z & 0xffff0000u) * rinv * g1.y + s1.y; h[6] = __uint_as_float(w.w << 16) * rinv * g1.z + s1.z; h[7] = __uint_as_float(w.w & 0xffff0000u) * rinv * g1.w + s1.w;
                const unsigned qa = q8pack(h[0], h[1], h[2], h[3], qs), qb = q8pack(h[4], h[5], h[6], h[7], qs);
                if (hf == 0) { qo.x = qa; qo.y = qb; } else { qo.z = qa; qo.w = qb; }
                u32x4 hi; hi.x = pk2(h[0], h[1]); hi.y = pk2(h[2], h[3]); hi.z = pk2(h[4], h[5]); hi.w = pk2(h[6], h[7]);
                u32x4 lo; lo.x = pk2(h[0] - __uint_as_float(hi.x << 16), h[1] - __uint_as_float(hi.x & 0xffff0000u)); lo.y = pk2(h[2] - __uint_as_float(hi.y << 16), h[3] - __uint_as_float(hi.y & 0xffff0000u));
                lo.z = pk2(h[4] - __uint_as_float(hi.z << 16), h[5] - __uint_as_float(hi.z & 0xffff0000u)); lo.w = pk2(h[6] - __uint_as_float(hi.w << 16), h[7] - __uint_as_float(hi.w & 0xffff0000u));
                const bf16x8_t bh = *(const LAS bf16x8_t*)(wh_l + ko), bl = *(const LAS bf16x8_t*)(wl_l + ko);
                const bf16x8_t ah = __builtin_bit_cast(bf16x8_t, hi), al = __builtin_bit_cast(bf16x8_t, lo);
                acc = __builtin_amdgcn_mfma_f32_16x16x32_bf16(ah, bh, acc, 0, 0, 0);
                acc = __builtin_amdgcn_mfma_f32_16x16x32_bf16(al, bh, acc, 0, 0, 0);
                acc = __builtin_amdgcn_mfma_f32_16x16x32_bf16(ah, bl, acc, 0, 0, 0); }
            *(u32x4*)(hq + 64 * ks2) = qo;
            asm volatile("" ::: "memory"); }
        float ov[4];
#pragma unroll
        for (int i = 0; i < 4; ++i) { float mx = acc[i];
            mx = fmaxf(mx, __shfl_xor(mx, 1)); mx = fmaxf(mx, __shfl_xor(mx, 2)); mx = fmaxf(mx, __shfl_xor(mx, 4)); mx = fmaxf(mx, __shfl_xor(mx, 8));
            const float ex = __expf(acc[i] - mx); float den = ex;
            den += __shfl_xor(den, 1); den += __shfl_xor(den, 2); den += __shfl_xor(den, 4); den += __shfl_xor(den, 8);
            ov[i] = ex / den; }
        const int t0 = (blk * 128 + c.wave * 16 + 4 * fq) & (SEQ - 1);
        *(f32x4*)(c.aff() + (size_t)(b * NE + fr) * SEQ + t0) = (f32x4){ov[0], ov[1], ov[2], ov[3]};
    }
}
__device__ __forceinline__ int block_excl_scan(int v, int& tot, int* lw, int tid) {
    const int lane = tid & 63, wv = tid >> 6; int inc = v;
#pragma unroll
    for (int o = 1; o < 64; o <<= 1) { const int u = __shfl_up(inc, o); if (lane >= o) inc += u; }
    __syncthreads();
    if (lane == 63) lw[wv] = inc;
    __syncthreads();
    int base = 0; tot = 0;
#pragma unroll
    for (int w = 0; w < 8; ++w) { const int x = lw[w]; if (w < wv) base += x; tot += x; }
    return base + inc - v;
}
__device__ __forceinline__ void p8_topk(const Ctx& c, float* lds) {
    int* cnt = (int*)lds;
    int* lw = (int*)lds + 64;
    for (int unit = blockIdx.x; unit < NB * NE; unit += gridDim.x) {
        const int b = unit >> 4, e = unit & 15; const float* a = c.aff() + (size_t)unit * SEQ;
        const f32x4 v0 = *(const f32x4*)(a + 8 * c.tid), v1 = *(const f32x4*)(a + 8 * c.tid + 4);
        unsigned u[8] = {__float_as_uint(v0.x), __float_as_uint(v0.y), __float_as_uint(v0.z), __float_as_uint(v0.w), __float_as_uint(v1.x), __float_as_uint(v1.y), __float_as_uint(v1.z), __float_as_uint(v1.w)};
        __syncthreads();
        if (c.tid < 32) cnt[c.tid] = 0;
        __syncthreads();
        unsigned T = 0u;
        for (int bit = 30; bit >= 0; --bit) {
            const unsigned cand = T | (1u << bit); int cw = 0;
#pragma unroll
            for (int j = 0; j < 8; ++j) cw += __popcll(__ballot(u[j] >= cand));
            if (c.lane == 0) atomicAdd(&cnt[bit], cw);
            __syncthreads();
            if (cnt[bit] >= CAP) T = cand;
        }
        int ngt = 0, neq = 0;
#pragma unroll
        for (int j = 0; j < 8; ++j) { ngt += u[j] > T ? 1 : 0; neq += u[j] == T ? 1 : 0; }
        int tot_gt, tot_eq; const int eq_base = block_excl_scan(neq, tot_eq, lw, c.tid); (void)block_excl_scan(ngt, tot_gt, lw + 16, c.tid);
        const int need = CAP - tot_gt;
        bool sel[8]; int nsel = 0, eqc = eq_base;
#pragma unroll
        for (int j = 0; j < 8; ++j) { const bool isq = u[j] == T; sel[j] = u[j] > T || (isq && eqc < need); eqc += isq ? 1 : 0; nsel += sel[j] ? 1 : 0; }
        int tot_sel; int slot = block_excl_scan(nsel, tot_sel, lw + 32, c.tid);
        int iv[8];
#pragma unroll
        for (int j = 0; j < 8; ++j) { iv[j] = sel[j] ? slot : -1;
            if (sel[j]) { c.seli()[unit * CAP + slot] = b * SEQ + 8 * c.tid + j; c.selg()[unit * CAP + slot] = __uint_as_float(u[j]); c.sels()[unit * CAP + slot] = c.sa()[b * SEQ + 8 * c.tid + j]; ++slot; } }
#pragma unroll
        for (int j = 0; j < 8; ++j) c.inv()[(size_t)(b * SEQ + 8 * c.tid + j) * NE + e] = iv[j];
    }
    __syncthreads();
}
struct EpiGateUpQ {
    static constexpr bool PERM = true;
    bf16_t* act; const float* sels; const float* sw;
    __device__ __forceinline__ void operator()(const f32x4 (&acc)[2][2][4][2], const pg8::Unit& u, int wr, int wc, int fr, int fq) const {
        const int row0 = u.pm * 256 + wr * 64 + fr, col0 = u.pn * 256 + wc * 32 + 8 * fq; const float* swe = sw + ((u.pm >> 1) & 15) * 1536 + col0;
        float rs[8];
#pragma unroll
        for (int i = 0; i < 8; ++i) rs[i] = sels[row0 + (i >> 2) * 128 + (i & 3) * 16];
        const f32x4 sg0 = *(const f32x4*)swe, su0 = *(const f32x4*)(swe + 4), sg1 = *(const f32x4*)(swe + 128), su1 = *(const f32x4*)(swe + 132);
#pragma unroll
        for (int ai = 0; ai < 2; ++ai)
#pragma unroll
            for (int m = 0; m < 4; ++m) { const float r_ = rs[ai * 4 + m];
#pragma unroll
                for (int bj = 0; bj < 2; ++bj) { const f32x4 gt = acc[ai][bj][m][0] * (bj ? sg1 : sg0) * r_, up = acc[ai][bj][m][1] * (bj ? su1 : su0) * r_;
                    u32x2 w; w.x = pk2(silu_f(gt[0]) * up[0], silu_f(gt[1]) * up[1]); w.y = pk2(silu_f(gt[2]) * up[2], silu_f(gt[3]) * up[3]);
                    *(u32x2*)(act + (size_t)(row0 + ai * 128 + m * 16) * DE + ((col0 + bj * 128) >> 1)) = w; } }
    }
};
__device__ __forceinline__ void p9_gateup(const Ctx& c, float* lds) {
    pg8::Gemm g{(const bf16_t*)c.h2q(), (const bf16_t*)c.wgu_q(), D / 2, D / 2, D / 2, c.seli(), 1, 15, (size_t)1536 * 512};
    pg8::ExpertOrder S; S.init(NSLOT, 1536, (int)gridDim.x, (int)blockIdx.x);
    EpiGateUpQ E{c.act(), c.sels(), c.swgu()};
    pg8::gemm_phase<true>((LAS unsigned char*)lds, g, S, E, c.tid);
}
struct EpiDown {
    static constexpr bool PERM = true;
    bf16_t* yb; const float* selg;
    __device__ __forceinline__ void operator()(const f32x4 (&acc)[2][2][4][2], const pg8::Unit& u, int wr, int wc, int fr, int fq) const {
        const int row0 = u.pm * 256 + wr * 64 + fr, col0 = u.pn * 256 + wc * 32 + 8 * fq;
        float gg[8];
#pragma unroll
        for (int i = 0; i < 8; ++i) gg[i] = selg[row0 + (i >> 2) * 128 + (i & 3) * 16];
#pragma unroll
        for (int ai = 0; ai < 2; ++ai)
#pragma unroll
            for (int m = 0; m < 4; ++m) { const float g_ = gg[ai * 4 + m];
#pragma unroll
                for (int bj = 0; bj < 2; ++bj) { const f32x4 a = acc[ai][bj][m][0] * g_, b = acc[ai][bj][m][1] * g_; const float o[8] = {a[0], a[1], a[2], a[3], b[0], b[1], b[2], b[3]};
                    store8_bf16(yb + (size_t)(row0 + ai * 128 + m * 16) * D + col0 + bj * 128, o); } }
    }
};
__device__ __forceinline__ void p10_down(const Ctx& c, float* lds) {
    pg8::Gemm g{c.act(), c.wdn_t(), DE, DE, DE, nullptr, 1, 15, (size_t)1024 * 768};
    pg8::ExpertOrder S; S.init(NSLOT, D, (int)gridDim.x, (int)blockIdx.x);
    EpiDown E{c.yb(), c.selg()};
    pg8::gemm_phase((LAS unsigned char*)lds, g, S, E, c.tid);
}
__device__ __forceinline__ void p11_final(const Ctx& c) {
    for (int r0 = c.gw * 2; r0 < RL; r0 += c.ngw * 2) {
        const int b = r0 / SEQ;
        int sl[2]; f32x4 x1[2][4]; f32x4 acc[2][4];
#pragma unroll
        for (int q = 0; q < 2; ++q) { sl[q] = c.lane < NE ? c.inv()[(size_t)(r0 + q) * NE + c.lane] : -1;
#pragma unroll
            for (int j = 0; j < 4; ++j) { const u32x2 w = __builtin_nontemporal_load((const u32x2*)(c.x1b() + (size_t)(r0 + q) * D + 4 * c.lane + 256 * j));
                x1[q][j] = (f32x4){__uint_as_float(w.x << 16), __uint_as_float(w.x & 0xffff0000u), __uint_as_float(w.y << 16), __uint_as_float(w.y & 0xffff0000u)}; acc[q][j] = (f32x4){0.f, 0.f, 0.f, 0.f}; } }
#pragma unroll
        for (int q = 0; q < 2; ++q) {
            unsigned long long m = __ballot(sl[q] >= 0);
            while (m) { const int e = __builtin_ctzll(m); m &= m - 1; const int slot = __builtin_amdgcn_readlane(sl[q], e);
                const bf16_t* yr = c.yb() + (size_t)((b * NE + e) * CAP + slot) * D;
#pragma unroll
                for (int j = 0; j < 4; ++j) { const u32x2 w = __builtin_nontemporal_load((const u32x2*)(yr + 4 * c.lane + 256 * j));
                    acc[q][j].x += __uint_as_float(w.x << 16); acc[q][j].y += __uint_as_float(w.x & 0xffff0000u); acc[q][j].z += __uint_as_float(w.y << 16); acc[q][j].w += __uint_as_float(w.y & 0xffff0000u); } } }
        const float* md = c.modv() + b * 6144 + 5120; float ss[2] = {0.f, 0.f};
#pragma unroll
        for (int j = 0; j < 4; ++j) { const int k = 4 * c.lane + 256 * j; const f32x4 ga = *(const f32x4*)(md + k);
#pragma unroll
            for (int q = 0; q < 2; ++q) { x1[q][j] = x1[q][j] + ga * acc[q][j]; ss[q] += x1[q][j].x * x1[q][j].x + x1[q][j].y * x1[q][j].y + x1[q][j].z * x1[q][j].z + x1[q][j].w * x1[q][j].w; } }
        const float ri0 = 1.f / sqrtf(wave_sum(ss[0]) * (1.f / D) + EPS), ri1 = 1.f / sqrtf(wave_sum(ss[1]) * (1.f / D) + EPS);
#pragma unroll
        for (int j = 0; j < 4; ++j) { const int k = 4 * c.lane + 256 * j; const f32x4 g = *(const f32x4*)(c.g_final() + k);
            __builtin_nontemporal_store(x1[0][j] * ri0 * g, (f32x4*)(c.out() + (size_t)r0 * D + k)); __builtin_nontemporal_store(x1[1][j] * ri1 * g, (f32x4*)(c.out() + (size_t)(r0 + 1) * D + k)); }
    }
}

#define XB_TMO      128
#define XB_XCNT(j)  (256  + 64 * (j))
#define XB_XSUB(j)  (1280 + 64 * (j))
#define XB_XGEN(j)  (2304 + 64 * (j))
#define XB_TOP      3328
#define XB_TOPGEN   3392
#define XCD_BAR_WORDS 3456
#define XB_SPIN_CAP (1u << 18)

__device__ __forceinline__ unsigned xb_ld(unsigned* p)              { return __hip_atomic_load(p, __ATOMIC_RELAXED, __HIP_MEMORY_SCOPE_AGENT); }
__device__ __forceinline__ unsigned xb_add(unsigned* p, unsigned v) { return __hip_atomic_fetch_add(p, v, __ATOMIC_RELAXED, __HIP_MEMORY_SCOPE_AGENT); }
__device__ __forceinline__ unsigned xb_xcc_id() { return (unsigned)__builtin_amdgcn_s_getreg((3 << 11) | 20) & 0xFu; }
#define XB_SPIN(cond, bar) do { unsigned _sp = 0; while (cond) { __builtin_amdgcn_s_sleep(1); \
    if ((++_sp & 255u) == 0u) { if (xb_ld(&(bar)[XB_TMO])) break; if (_sp > XB_SPIN_CAP) { atomicAdd(&(bar)[XB_TMO], 1u); break; } } } } while (0)

struct XcdBarrier {
    unsigned* bar; unsigned x;
    volatile LAS unsigned* st;
};
__device__ __forceinline__ XcdBarrier xcd_barrier_post(unsigned* bar, volatile LAS unsigned* st, bool t0) {
    XcdBarrier b; b.bar = bar; b.x = xb_xcc_id(); b.st = st;
    if (t0) (void)xb_add(&bar[XB_XCNT(b.x)], 1u);
    return b;
}
__device__ __forceinline__ void xcd_barrier_complete(unsigned* bar, unsigned x, unsigned& nloc, unsigned& nx) {
    const unsigned G = gridDim.x * gridDim.y * gridDim.z;
    unsigned sum, cnt, mine, sp = 0u;
    for (;;) {
        sum = 0u; cnt = 0u; mine = 0u;
#pragma unroll
        for (unsigned j = 0; j < 16; ++j) { const unsigned c = xb_ld(&bar[XB_XCNT(j)]); sum += c; cnt += (c > 0u) ? 1u : 0u; mine = (j == x) ? c : mine; }
        if (sum == G) break;
        __builtin_amdgcn_s_sleep(1);
        if ((++sp & 255u) == 0u) { if (xb_ld(&bar[XB_TMO])) break; if (sp > XB_SPIN_CAP) { atomicAdd(&bar[XB_TMO], 1u); break; } }
    }
    nloc = mine > 0u ? mine : 1u; nx = cnt > 0u ? cnt : 1u;
}
__device__ __forceinline__ void xcd_barrier(const XcdBarrier& b, bool t0) {
    asm volatile("s_waitcnt vmcnt(0)" ::: "memory");
    __syncthreads();
    if (t0) {
        unsigned* bar = b.bar;
        __builtin_amdgcn_s_waitcnt(0);
        unsigned nloc = b.st[0], nx = b.st[1];
        if (nloc == 0u) { xcd_barrier_complete(bar, b.x, nloc, nx); b.st[0] = nloc; b.st[1] = nx; }
        const unsigned old = xb_add(&bar[XB_XSUB(b.x)], 1u);
        const unsigned gen = old / nloc;
        if (old + 1u == (gen + 1u) * nloc) {
            __builtin_amdgcn_fence(__ATOMIC_RELEASE, "agent");
            asm volatile("s_waitcnt vmcnt(0)" ::: "memory");
            const unsigned og = xb_add(&bar[XB_TOP], 1u);
            const unsigned tg = og / nx;
            if (og + 1u == (tg + 1u) * nx) xb_add(&bar[XB_TOPGEN], 1u);
            else XB_SPIN(xb_ld(&bar[XB_TOPGEN]) == tg, bar);
            __builtin_amdgcn_fence(__ATOMIC_ACQUIRE, "agent");
            xb_add(&bar[XB_XGEN(b.x)], 1u);
            asm volatile("s_waitcnt vmcnt(0)" ::: "memory");
        } else {
            XB_SPIN(xb_ld(&bar[XB_XGEN(b.x)]) == gen, bar);
            __builtin_amdgcn_fence(__ATOMIC_ACQUIRE, "agent");
            asm volatile("s_waitcnt vmcnt(0)" ::: "memory");
        }
    }
    __syncthreads();
}

template <int PH0, int PH1> __global__ void __launch_bounds__(512, 2) fwd_kernel(Args args) {
    extern __shared__ __attribute__((aligned(16))) unsigned char lds_raw[];
    float* lds = (float*)lds_raw;
    volatile LAS unsigned* xbst = (volatile LAS unsigned*)((LAS unsigned char*)lds_raw + (LDS_BYTES - 16));
    const int wave_s = __builtin_amdgcn_readfirstlane((int)threadIdx.x >> 6);
#define TID_NOW() ([&]() { unsigned z_ = 0u; asm volatile("" : "+v"(z_)); return wave_s * 64 + (int)__builtin_amdgcn_mbcnt_hi(~0u, __builtin_amdgcn_mbcnt_lo(~0u, z_)); }())
    if (TID_NOW() == 0) { xbst[0] = 0u; xbst[1] = 0u; }
    __syncthreads();
    XcdBarrier bar; bar.bar = nullptr; bar.x = 0; bar.st = nullptr;
    if constexpr (PH1 - PH0 > 1) bar = xcd_barrier_post((unsigned*)(args.ws + WS_CTL) + 4096, xbst, TID_NOW() == 0);
#define GRID_BAR(k) do { if constexpr (PH1 - PH0 > 1) { if (lo <= (k) && (k) + 1 < hi) { xcd_barrier(bar, TID_NOW() == 0); if (BARREP) xcd_barrier(bar, TID_NOW() == 0); } } } while (0)
    const int lo = args.ph_lo, hi = args.ph_hi;
#ifndef PHMASK
#define PHMASK 0xffffffffu
#endif
#ifndef BARREP
#define BARREP 0
#endif
#ifndef REPMASK
#define REPMASK 0u
#endif
#define REP(k) ((REPMASK >> (k)) & 1u)
#define IN(k) (((PHMASK >> (k)) & 1u) && PH0 <= (k) && (k) < PH1 && lo <= (k) && (k) < hi)
#define CTX() Ctx c; { kptr_t kp_ = (kptr_t)__builtin_amdgcn_kernarg_segment_ptr(); asm volatile("" : "+s"(kp_)); c.kp = kp_; int t_ = TID_NOW(); asm volatile("" : "+v"(t_)); int b_ = blockIdx.x; asm volatile("" : "+s"(b_)); c.tid = t_; c.lane = t_ & 63; c.wave = t_ >> 6; c.gw = b_ * 8 + c.wave; c.ngw = gridDim.x * 8; }
    if (IN(0)) { CTX(); p0_mod(c, lds); __syncthreads(); p0_weights<0>(c, lds, c.gw, c.ngw); p0_tables(c); }
    if (REP(0) && IN(0)) { __syncthreads(); CTX(); p0_mod(c, lds); __syncthreads(); p0_weights<0>(c, lds, c.gw, c.ngw); p0_tables(c); }
    GRID_BAR(0);
    if (IN(1)) { CTX(); p1_norm(c); }
    if (REP(1) && IN(1)) { __syncthreads(); CTX(); p1_norm(c); }
    GRID_BAR(1);
    if (IN(2)) { CTX(); p2_proj(c, lds); }
    if (REP(2) && IN(2)) { __syncthreads(); CTX(); p2_proj(c, lds); }
    GRID_BAR(2);
    if (IN(3)) { CTX(); p3_upq(c, lds); }
    if (REP(3) && IN(3)) { __syncthreads(); CTX(); p3_upq(c, lds); }
    if (IN(4)) { CTX(); p3_upkv(c, lds); }
    if (REP(4) && IN(4)) { __syncthreads(); CTX(); p3_upkv(c, lds); }
    if (IN(5)) { CTX(); p3c_scan(c, lds); }
    if (REP(5) && IN(5)) { __syncthreads(); CTX(); p3c_scan(c, lds); }
    GRID_BAR(5);
    if (IN(6)) { CTX(); p4_attn(c, lds); }
    if (REP(6) && IN(6)) { __syncthreads(); CTX(); p4_attn(c, lds); }
    if (IN(7)) { CTX(); p4_ret(c, lds); }
    if (REP(7) && IN(7)) { __syncthreads(); CTX(); p4_ret(c, lds); }
    GRID_BAR(7);
    if (IN(8)) { CTX(); p6_wo(c, lds); }
    if (REP(8) && IN(8)) { __syncthreads(); CTX(); p6_wo(c, lds); }
    GRID_BAR(8);
    if (IN(9)) { CTX(); p7_norm_router(c, lds); }
    if (REP(9) && IN(9)) { __syncthreads(); CTX(); p7_norm_router(c, lds); }
    GRID_BAR(9);
    if (IN(10)) { CTX(); p8_topk(c, lds); }
    if (REP(10) && IN(10)) { __syncthreads(); CTX(); p8_topk(c, lds); }
    GRID_BAR(10);
    if (IN(11)) { CTX(); p9_gateup(c, lds); }
    if (REP(11) && IN(11)) { __syncthreads(); CTX(); p9_gateup(c, lds); }
    GRID_BAR(11);
    if (IN(12)) { CTX(); p10_down(c, lds); }
    if (REP(12) && IN(12)) { __syncthreads(); CTX(); p10_down(c, lds); }
    GRID_BAR(12);
    if (IN(13)) { CTX(); p11_final(c); }
    if (REP(13) && IN(13)) { __syncthreads(); CTX(); p11_final(c); }
#undef IN
}


static hipError_t set_lds_all() { return hipFuncSetAttribute((const void*)fwd_kernel<0, NPH>, hipFuncAttributeMaxDynamicSharedMemorySize, LDS_BYTES); }
static void launch_all(int grid, hipStream_t stream, const Args& a) { hipLaunchKernelGGL((fwd_kernel<0, NPH>), dim3(grid), dim3(512), LDS_BYTES, stream, a); }

extern "C" void kernel_launch(void* const* d_in, const int* in_sizes, int n_in, void* d_out, int out_size, void* d_ws, size_t ws_size, hipStream_t stream) {
    static int grid = 0;
    if (grid == 0) {
        if (n_in != 22 || in_sizes[0] != RL * D || out_size != RL * D || ws_size < WS_END) {
            fprintf(stderr, "kernel_launch: unexpected shapes: n_in %d in0 %d out %d ws %zu (need %zu)\n", n_in, n_in > 0 ? in_sizes[0] : -1, out_size, ws_size, (size_t)WS_END); grid = -1; return; }
        int dev = 0, cus = 0;
        if (hipGetDevice(&dev) != hipSuccess || hipDeviceGetAttribute(&cus, hipDeviceAttributeMultiprocessorCount, dev) != hipSuccess) { grid = -1; return; }
        if (set_lds_all() != hipSuccess) { fprintf(stderr, "kernel_launch: hipFuncSetAttribute failed\n"); grid = -1; return; }
        int per_cu = 0;
        if (MK_SINGLE) { if (hipOccupancyMaxActiveBlocksPerMultiprocessor(&per_cu, (const void*)fwd_kernel<0, NPH>, 512, LDS_BYTES) != hipSuccess || per_cu < 1) { fprintf(stderr, "kernel_launch: occupancy query says %d blocks per CU\n", per_cu); grid = -1; return; } }
        (void)hipGetLastError();
        grid = cus;
    }
    if (grid < 0) return;
    Args a{};
    for (int i = 0; i < 22; ++i) a.in[i] = (const float*)d_in[i];
    a.out = (float*)d_out; a.ws = (unsigned char*)d_ws;
    a.ph_lo = 0; a.ph_hi = NPH;
    if (MK_SINGLE) { if (hipMemsetAsync((char*)d_ws + WS_CTL, 0, CTL_BYTES, stream) != hipSuccess) { fprintf(stderr, "kernel_launch: memset failed\n"); return; } }
    launch_all(grid, stream, a);
}
```

```cpp
#include <hip/hip_runtime.h>
#include <cstdio>
#include <cstdint>

#ifndef MK_SINGLE
#define MK_SINGLE 1
#endif

typedef unsigned short bf16_t;
typedef float f32x4 __attribute__((ext_vector_type(4)));
typedef unsigned u32x4 __attribute__((ext_vector_type(4)));
typedef unsigned u32x2 __attribute__((ext_vector_type(2)));
#define LAS __attribute__((address_space(3)))

constexpr int D = 1024, NB = 8, SEQ = 4096, LC = 256;
constexpr int RL = NB * SEQ, RC = NB * LC, RT = RL + RC;
constexpr int NPROJ = 2560;
constexpr int PC_CQ = 0, PC_CKV = 256, PC_KR = 384, PC_RQ = 512, PC_RK = 1024, PC_RV = 1536, PC_RG = 2048;
constexpr int NH = 8, QW = 768, KVW = 1024;
constexpr int NE = 16, CAP = 512, DE = 768, NSLOT = NB * NE * CAP;
constexpr int NCH = 32;
constexpr float EPS = 1e-6f;
constexpr float QSCALE = 0.10206207261596577f * 1.4426950408889634f;

constexpr size_t MiB = 1u << 20;
constexpr size_t WS_CTL = 0, CTL_BYTES = 64 * 1024;
constexpr size_t WS_MOD = 1 * MiB;
constexpr size_t WS_TABR = 2 * MiB;
constexpr size_t WS_TABM = 3 * MiB;
constexpr size_t WS_PSTAT = 4 * MiB;
constexpr size_t WS_AFF = 6 * MiB;
constexpr size_t WS_SELI = 8 * MiB;
constexpr size_t WS_SELG = 8 * MiB + 512 * 1024;
constexpr size_t WS_INV = 9 * MiB;
constexpr size_t WS_SELS = 11 * MiB;
constexpr size_t WS_WIN = 12 * MiB;
constexpr size_t WS_WUQ = 17 * MiB;
constexpr size_t WS_WUKV = 17 * MiB + 512 * 1024;
constexpr size_t WS_WO = 18 * MiB;
constexpr size_t WS_WGU = 20 * MiB;
constexpr size_t WS_WDN = 68 * MiB;
constexpr size_t WS_H = 92 * MiB;
constexpr size_t WS_RST = 92 * MiB;
constexpr size_t WS_PROJ = 160 * MiB;
constexpr size_t WS_ACT = 160 * MiB;
constexpr size_t WS_YB = 256 * MiB;
constexpr size_t WS_Q = 330 * MiB;
constexpr size_t WS_KV = 378 * MiB;
constexpr size_t WS_MIX = 446 * MiB;
constexpr size_t WS_END = 510 * MiB;
static_assert(WS_PROJ + (size_t)RT * NPROJ * 2 <= WS_Q && WS_Q + (size_t)RL * QW * 2 <= WS_KV && WS_KV + (size_t)RT * KVW * 2 <= WS_MIX, "ws map");
static_assert(WS_H + (size_t)RT * D * 2 <= WS_PROJ && WS_WDN + (size_t)NE * D * DE * 2 <= WS_H && WS_PSTAT + (size_t)RT * 32 <= WS_AFF, "ws map 2");

constexpr int LDS_BYTES = 147456;
constexpr int NPH = 14;

__device__ __forceinline__ float bf2f(bf16_t v) { return __uint_as_float((unsigned)v << 16); }
__device__ __forceinline__ bf16_t f2bf(float f) { unsigned u = __float_as_uint(f); return (bf16_t)((u + 0x7fffu + ((u >> 16) & 1u)) >> 16); }
__device__ __forceinline__ unsigned pk2(float lo, float hi) { unsigned r; asm("v_cvt_pk_bf16_f32 %0, %1, %2" : "=v"(r) : "v"(lo), "v"(hi)); return r; }
__device__ __forceinline__ float wave_sum(float v) {
#pragma unroll
    for (int o = 1; o < 64; o <<= 1) v += __shfl_xor(v, o);
    return v;
}
__device__ __forceinline__ float silu_f(float v) { return v / (1.f + __expf(-v)); }

struct Args {
    const float* in[22]; float* out; unsigned char* ws; int ph_lo, ph_hi;
};

typedef __attribute__((address_space(4))) const char* kptr_t;
typedef const float* cfp_t; typedef float* fp_t; typedef unsigned char* ucp_t;
typedef __attribute__((address_space(4))) const cfp_t* kcfpp; typedef __attribute__((address_space(4))) const fp_t* kfpp; typedef __attribute__((address_space(4))) const ucp_t* kucpp;
static_assert(sizeof(Args) == 200, "Args layout: in[22] @0, out @176, ws @184, ph_lo @192, ph_hi @196");
struct Ctx {
    kptr_t kp; int tid, lane, wave, gw, ngw;
    __device__ __forceinline__ const float* in(int i) const { return *(kcfpp)(kp + 8 * i); }
    __device__ __forceinline__ unsigned char* wsb() const { return *(kucpp)(kp + 184); }
    __device__ __forceinline__ const float* x() const { return in(0); }
    __device__ __forceinline__ const float* cvec() const { return in(1); }
    __device__ __forceinline__ const float* ctx() const { return in(2); }
    __device__ __forceinline__ const float* c_ctx() const { return in(3); }
    __device__ __forceinline__ const float* w_ada() const { return in(4); }
    __device__ __forceinline__ const float* b_ada() const { return in(5); }
    __device__ __forceinline__ const float* g_mix() const { return in(6); }
    __device__ __forceinline__ const float* g_ffn() const { return in(7); }
    __device__ __forceinline__ const float* w_in() const { return in(8); }
    __device__ __forceinline__ const float* g_q() const { return in(9); }
    __device__ __forceinline__ const float* g_kv() const { return in(10); }
    __device__ __forceinline__ const float* w_uq() const { return in(11); }
    __device__ __forceinline__ const float* w_ukv() const { return in(12); }
    __device__ __forceinline__ const float* exp_f() const { return in(13); }
    __device__ __forceinline__ const float* exp_b() const { return in(14); }
    __device__ __forceinline__ const float* g_ret() const { return in(15); }
    __device__ __forceinline__ const float* w_o() const { return in(16); }
    __device__ __forceinline__ const float* w_router() const { return in(17); }
    __device__ __forceinline__ const float* w_gate() const { return in(18); }
    __device__ __forceinline__ const float* w_up() const { return in(19); }
    __device__ __forceinline__ const float* w_down() const { return in(20); }
    __device__ __forceinline__ const float* g_final() const { return in(21); }
    __device__ __forceinline__ float* out() const { return *(kfpp)(kp + 176); }
    __device__ __forceinline__ float* modv() const { return (float*)(wsb() + WS_MOD); }
    __device__ __forceinline__ float* tabr() const { return (float*)(wsb() + WS_TABR); }
    __device__ __forceinline__ float* tabm() const { return (float*)(wsb() + WS_TABM); }
    __device__ __forceinline__ float* pstat() const { return (float*)(wsb() + WS_PSTAT); }
    __device__ __forceinline__ float* aff() const { return (float*)(wsb() + WS_AFF); }
    __device__ __forceinline__ float* selg() const { return (float*)(wsb() + WS_SELG); }
    __device__ __forceinline__ int* seli() const { return (int*)(wsb() + WS_SELI); }
    __device__ __forceinline__ int* inv() const { return (int*)(wsb() + WS_INV); }
    __device__ __forceinline__ float* sels() const { return (float*)(wsb() + WS_SELS); }
    __device__ __forceinline__ float* rpart() const { return (float*)(wsb() + WS_Q); }
    __device__ __forceinline__ bf16_t* win_t() const { return (bf16_t*)(wsb() + WS_WIN); }
    __device__ __forceinline__ bf16_t* wuq_t() const { return (bf16_t*)(wsb() + WS_WUQ); }
    __device__ __forceinline__ bf16_t* wukv_t() const { return (bf16_t*)(wsb() + WS_WUKV); }
    __device__ __forceinline__ bf16_t* wo_t() const { return (bf16_t*)(wsb() + WS_WO); }
    __device__ __forceinline__ bf16_t* wgu_t() const { return (bf16_t*)(wsb() + WS_WGU); }
    __device__ __forceinline__ bf16_t* wdn_t() const { return (bf16_t*)(wsb() + WS_WDN); }
    __device__ __forceinline__ bf16_t* hb() const { return (bf16_t*)(wsb() + WS_H); }
    __device__ __forceinline__ bf16_t* rst() const { return (bf16_t*)(wsb() + WS_RST); }
    __device__ __forceinline__ bf16_t* proj() const { return (bf16_t*)(wsb() + WS_PROJ); }
    __device__ __forceinline__ bf16_t* act() const { return (bf16_t*)(wsb() + WS_ACT); }
    __device__ __forceinline__ bf16_t* yb() const { return (bf16_t*)(wsb() + WS_YB); }
    __device__ __forceinline__ bf16_t* qb() const { return (bf16_t*)(wsb() + WS_Q); }
    __device__ __forceinline__ bf16_t* kvb() const { return (bf16_t*)(wsb() + WS_KV); }
    __device__ __forceinline__ bf16_t* mix() const { return (bf16_t*)(wsb() + WS_MIX); }
    __device__ __forceinline__ bf16_t* x1b() const { return (bf16_t*)(wsb() + WS_H); }
    __device__ __forceinline__ bf16_t* h2() const { return (bf16_t*)(wsb() + WS_MIX); }
    __device__ __forceinline__ signed char* h2q() const { return (signed char*)(wsb() + WS_MIX); }
    __device__ __forceinline__ float* sa() const { return (float*)(wsb() + WS_MIX + 32 * MiB); }
    __device__ __forceinline__ signed char* wgu_q() const { return (signed char*)(wsb() + WS_WGU); }
    __device__ __forceinline__ float* swgu() const { return (float*)(wsb() + WS_WGU + 24 * MiB); }
    __device__ __forceinline__ signed char* wdn_q() const { return (signed char*)(wsb() + WS_WDN); }
    __device__ __forceinline__ float* swdn() const { return (float*)(wsb() + WS_WDN + 12 * MiB); }
    __device__ __forceinline__ signed char* actq() const { return (signed char*)(wsb() + 384 * MiB); }
    __device__ __forceinline__ float* sactg() const { return (float*)(wsb() + 432 * MiB); }
};

__device__ __forceinline__ void p0_mod(const Ctx& c, float* lds) {
    float* sc = lds;
    float* red = lds + 9 * 1024;
    for (int i = c.tid; i < 9 * 1024; i += 512) { const int r = i >> 10, k = i & 1023; const float v = r < 8 ? c.cvec()[r * 1024 + k] : c.c_ctx()[k]; sc[i] = silu_f(v); }
    __syncthreads();
    for (int unit = blockIdx.x; unit < 192; unit += gridDim.x) {
        const int nn = c.tid & 31, n = unit * 32 + nn, kg = c.tid >> 5;
        float acc[9];
#pragma unroll
        for (int r = 0; r < 9; ++r) acc[r] = 0.f;
        for (int k0 = kg; k0 < 1024; k0 += 16 * 8) { float w[8];
#pragma unroll
            for (int i = 0; i < 8; ++i) w[i] = __builtin_nontemporal_load(c.w_ada() + (size_t)(k0 + 16 * i) * 6144 + n);
#pragma unroll
            for (int i = 0; i < 8; ++i)
#pragma unroll
                for (int r = 0; r < 9; ++r) acc[r] += sc[r * 1024 + k0 + 16 * i] * w[i]; }
#pragma unroll
        for (int r = 0; r < 9; ++r) red[(kg * 9 + r) * 32 + nn] = acc[r];
        __syncthreads();
        for (int i = c.tid; i < 9 * 32; i += 512) { const int r = i >> 5, n2 = i & 31; float s = 0.f;
#pragma unroll
            for (int g = 0; g < 16; ++g) s += red[(g * 9 + r) * 32 + n2];
            c.modv()[r * 6144 + unit * 32 + n2] = s + c.b_ada()[unit * 32 + n2]; }
        __syncthreads();
    }
}
template <class CM, class GN>
__device__ __forceinline__ void transpose_item(const float* W, int Ksrc, int Nsrc, bf16_t* WT, int Kdst, CM cm, GN gain, float* scr, int kb, int nb, int lane) {
    const int k0 = 64 * kb, n0 = 32 * nb;
    const int srcc = cm(n0 + (lane & 31));
#pragma unroll 8
    for (int i = 0; i < 32; ++i) { const int kk = 2 * i + (lane >> 5), k = k0 + kk;
        float v = 0.f; if (srcc >= 0 && k < Ksrc) v = W[(size_t)k * Nsrc + srcc] * gain(k);
        scr[kk * 33 + (lane & 31)] = v; }
    asm volatile("s_waitcnt lgkmcnt(0)" ::: "memory");
    const int ch = lane & 7;
#pragma unroll
    for (int j = 0; j < 4; ++j) { const int n = (lane >> 3) + 8 * j; const float* s = scr + (8 * ch) * 33 + n;
        u32x4 o; o.x = pk2(s[0 * 33], s[1 * 33]); o.y = pk2(s[2 * 33], s[3 * 33]); o.z = pk2(s[4 * 33], s[5 * 33]); o.w = pk2(s[6 * 33], s[7 * 33]);
        *(u32x4*)(WT + (size_t)(n0 + n) * Kdst + k0 + 8 * ch) = o; }
    asm volatile("s_waitcnt lgkmcnt(0)" ::: "memory");
}
__device__ __forceinline__ int ilv(int p, int half) { const int g = p >> 3, w = p & 7; return w < 4 ? 4 * g + w : half + 4 * g + (w - 4); }
__device__ __forceinline__ int cm_win(int n) {
    if (n < 384) return n;
    if (n < 416) return 384 + ilv(n - 384, 16);
    if (n < 512) return -1;
    if (n < 1024) { const int j = n - 512; return 416 + (j >> 6) * 64 + ilv(j & 63, 32); }
    if (n < 1536) { const int j = n - 1024; return 928 + (j >> 6) * 64 + ilv(j & 63, 32); }
    if (n < 2048) return 1440 + (n - 1536);
    return 1952 + (n - 2048);
}
__device__ __forceinline__ int cm_wuq(int n) { const int h = n / 96, p = n % 96; return p < 64 ? n : h * 96 + 64 + ilv(p - 64, 16); }
__device__ __forceinline__ int cm_wgu(int n) { const int q = n >> 3, w = n & 7; return w < 4 ? 4 * q + w : 768 + 4 * q + (w - 4); }
template <bool NTST = false, class TC>
__device__ __forceinline__ void transpose64(const float* srcA, const float* srcB, int ld, bf16_t* dst, int ldd, TC tcol, float* scr, int lane) {
    const int r = lane >> 3, c4 = (lane & 7) * 4;
    f32x4 va[8], vb[8];
#pragma unroll
    for (int i = 0; i < 8; ++i) { va[i] = srcA ? __builtin_nontemporal_load((const f32x4*)(srcA + (size_t)(8 * i + r) * ld + c4)) : (f32x4){0.f, 0.f, 0.f, 0.f}; vb[i] = srcB ? __builtin_nontemporal_load((const f32x4*)(srcB + (size_t)(8 * i + r) * ld + c4)) : (f32x4){0.f, 0.f, 0.f, 0.f}; }
#pragma unroll
    for (int i = 0; i < 8; ++i) { float* p = scr + (8 * i + r) * 65 + c4; p[0] = va[i].x; p[1] = va[i].y; p[2] = va[i].z; p[3] = va[i].w; p[32] = vb[i].x; p[33] = vb[i].y; p[34] = vb[i].z; p[35] = vb[i].w; }
    asm volatile("s_waitcnt lgkmcnt(0)" ::: "memory");
    const int kc = lane & 7;
#pragma unroll
    for (int j = 0; j < 8; ++j) { const int nl = (lane >> 3) + 8 * j, col = tcol(nl); u32x4 o = {0u, 0u, 0u, 0u};
        if (col >= 0) { const float* sp = scr + (8 * kc) * 65 + col; o.x = pk2(sp[0 * 65], sp[1 * 65]); o.y = pk2(sp[2 * 65], sp[3 * 65]); o.z = pk2(sp[4 * 65], sp[5 * 65]); o.w = pk2(sp[6 * 65], sp[7 * 65]); }
        if (NTST) __builtin_nontemporal_store(o, (u32x4*)(dst + (size_t)nl * ldd + 8 * kc)); else *(u32x4*)(dst + (size_t)nl * ldd + 8 * kc) = o; }
    asm volatile("s_waitcnt lgkmcnt(0)" ::: "memory");
}
typedef int i32x4 __attribute__((ext_vector_type(4)));
constexpr int GU_STRIPS = NE * 24;
__device__ __forceinline__ unsigned f8pack(float a, float b, float c_, float d) {
    a = __builtin_amdgcn_fmed3f(a, -448.f, 448.f); b = __builtin_amdgcn_fmed3f(b, -448.f, 448.f); c_ = __builtin_amdgcn_fmed3f(c_, -448.f, 448.f); d = __builtin_amdgcn_fmed3f(d, -448.f, 448.f);
    int r = __builtin_amdgcn_cvt_pk_fp8_f32(a, b, 0, false); r = __builtin_amdgcn_cvt_pk_fp8_f32(c_, d, r, true); return (unsigned)r;
}
__device__ __forceinline__ unsigned q8pack(float a, float b, float c_, float d, float inv) {
    const unsigned q0 = __float_as_uint(__builtin_fmaf(a, inv, 12582912.f)), q1 = __float_as_uint(__builtin_fmaf(b, inv, 12582912.f)), q2 = __float_as_uint(__builtin_fmaf(c_, inv, 12582912.f)), q3 = __float_as_uint(__builtin_fmaf(d, inv, 12582912.f));
    return (q0 & 255u) | ((q1 & 255u) << 8) | ((q2 & 255u) << 16) | (q3 << 24);
}
template <int NT, bool F8, class TC>
__device__ __forceinline__ void strip_i8(const Ctx& c, float* lds, const float* srcA, const float* srcB, int ld, signed char* dq0, int dld, float* sw0, TC tcol) {
    float* scr = lds + c.wave * (64 * 65); float* cm = lds + 8 * 64 * 65; float* fin = cm + 512;
    const int r = c.lane >> 3, c4 = (c.lane & 7) * 4;
    const bool act_w = 2 * c.wave < NT;
    f32x4 va[2][8], vb[2][8];
#pragma unroll
    for (int t = 0; t < 2; ++t)
#pragma unroll
        for (int i = 0; i < 8; ++i) { const size_t ro = (size_t)(64 * (2 * c.wave + t) + 8 * i + r) * ld + c4;
            va[t][i] = act_w ? __builtin_nontemporal_load((const f32x4*)(srcA + ro)) : (f32x4){0.f, 0.f, 0.f, 0.f}; vb[t][i] = act_w ? __builtin_nontemporal_load((const f32x4*)(srcB + ro)) : (f32x4){0.f, 0.f, 0.f, 0.f}; }
    f32x4 mA = {0.f, 0.f, 0.f, 0.f}, mB = {0.f, 0.f, 0.f, 0.f};
#pragma unroll
    for (int t = 0; t < 2; ++t)
#pragma unroll
        for (int i = 0; i < 8; ++i) { mA = __builtin_elementwise_max(mA, __builtin_elementwise_abs(va[t][i])); mB = __builtin_elementwise_max(mB, __builtin_elementwise_abs(vb[t][i])); }
#pragma unroll
    for (int o = 8; o < 64; o <<= 1)
#pragma unroll
        for (int j = 0; j < 4; ++j) { mA[j] = fmaxf(mA[j], __shfl_xor(mA[j], o)); mB[j] = fmaxf(mB[j], __shfl_xor(mB[j], o)); }
    __syncthreads();
    if (r == 0) { *(f32x4*)(cm + c.wave * 64 + c4) = mA; *(f32x4*)(cm + c.wave * 64 + 32 + c4) = mB; }
    __syncthreads();
    if (c.tid < 64) { float m = cm[c.tid];
#pragma unroll
        for (int w = 1; w < 8; ++w) m = fmaxf(m, cm[w * 64 + c.tid]);
        fin[c.tid] = fmaxf(m, 1e-30f); }
    __syncthreads();
    const int w8 = c.lane >> 3, kc = c.lane & 7;
    if (c.tid < 64) sw0[c.tid] = fin[tcol(c.tid)] * (F8 ? 1.f / 448.f : 1.f / 127.f);
    if (act_w) {
    signed char* dq = dq0 + (size_t)w8 * dld + 128 * c.wave + 8 * kc;
#pragma unroll
    for (int t = 0; t < 2; ++t) {
#pragma unroll
        for (int i = 0; i < 8; ++i) { float* p = scr + (8 * i + r) * 65 + c4; p[0] = va[t][i].x; p[1] = va[t][i].y; p[2] = va[t][i].z; p[3] = va[t][i].w; p[32] = vb[t][i].x; p[33] = vb[t][i].y; p[34] = vb[t][i].z; p[35] = vb[t][i].w; }
        asm volatile("s_waitcnt lgkmcnt(0)" ::: "memory");
#pragma unroll
        for (int j = 0; j < 8; ++j) { const int col = tcol(w8 + 8 * j);
            const float inv = (F8 ? 448.f : 127.f) / fin[col]; const float* sp = scr + (8 * kc) * 65 + col;
            u32x2 o;
            if (F8) { o.x = f8pack(sp[0 * 65] * inv, sp[1 * 65] * inv, sp[2 * 65] * inv, sp[3 * 65] * inv); o.y = f8pack(sp[4 * 65] * inv, sp[5 * 65] * inv, sp[6 * 65] * inv, sp[7 * 65] * inv); }
            else { o.x = q8pack(sp[0 * 65], sp[1 * 65], sp[2 * 65], sp[3 * 65], inv); o.y = q8pack(sp[4 * 65], sp[5 * 65], sp[6 * 65], sp[7 * 65], inv); }
            *(u32x2*)(dq + (size_t)(8 * j) * dld + 64 * t) = o; }
        asm volatile("s_waitcnt lgkmcnt(0)" ::: "memory");
    } }
}
constexpr int DN_STRIPS = NE * 16, EXP_STRIPS = GU_STRIPS + DN_STRIPS;
__device__ __forceinline__ void expert_strip(const Ctx& c, float* lds, int s) {
    if (s < GU_STRIPS) { const int e = s / 24, nb = s % 24; const size_t so = (size_t)e * 1024 * 768 + 32 * nb;
        strip_i8<16, false>(c, lds, c.w_gate() + so, c.w_up() + so, 768, c.wgu_q() + (size_t)e * 1536 * 1024 + (size_t)(64 * nb) * 1024, 1024, c.swgu() + e * 1536 + 64 * nb,
                     [](int nl) { const int qq = nl >> 3, w = nl & 7; return w < 4 ? 4 * qq + w : 32 + 4 * qq + (w - 4); }); }
    else { s -= GU_STRIPS; const int e = s >> 4, nb = s & 15; const float* src = c.w_down() + (size_t)e * 768 * 1024 + 64 * nb;
        strip_i8<12, true>(c, lds, src, src + 32, 1024, c.wdn_q() + (size_t)e * 1024 * 768 + (size_t)(64 * nb) * 768, 768, c.swdn() + e * 1024 + 64 * nb, [](int nl) { return nl; }); }
}
constexpr int QSHORT0 = 80, QSTRIPS = 2, QSTATIC = (256 - QSHORT0) * QSTRIPS;
template <int PART>
__device__ __forceinline__ void p0_weights(const Ctx& c, float* lds, int gw, int ngw) {
    float* scr = lds + c.wave * (64 * 65);
    constexpr int I_WIN = 16 * 40, I_WO = 16 * 16, I_GU = 16 * 24, I_DN = 12 * 16, I_WUQ = 4 * 24, I_WUKV = 4 * 32;
    constexpr int NEXP = NE * I_GU + NE * I_DN, NIT = NEXP + I_WIN + I_WO + I_WUQ + I_WUKV;
    unsigned* qctr = (unsigned*)(c.wsb() + WS_CTL) + 2048; int qbase = 0, qk = 8;
    for (int it = (PART == 1 ? NE * I_GU : NEXP + gw); it < (PART == 1 ? NEXP : NIT); it += (PART == 0 ? ngw : 1)) {
        if (PART == 1) { if (qk == 8) { int p_ = 0; if (c.lane == 0) p_ = (int)__hip_atomic_fetch_add(qctr, 1u, __ATOMIC_RELAXED, __HIP_MEMORY_SCOPE_AGENT); qbase = NE * I_GU + __builtin_amdgcn_readfirstlane(p_) * 8; qk = 0; }
            it = qbase + qk; ++qk; if (it >= NEXP) break; }
        int r = it;
        r -= NEXP;
        if (r < I_WIN) { const int kb = r / 40, nb = r % 40; const float* base = c.w_in() + (size_t)(64 * kb) * 2464; bf16_t* dst = c.win_t() + (size_t)(64 * nb) * 1024 + 64 * kb;
            if (nb < 6) { transpose64(base + 64 * nb, base + 64 * nb + 32, 2464, dst, 1024, [](int nl) { return nl; }, scr, c.lane); }
            else if (nb == 6) { transpose64(base + 384, (const float*)nullptr, 2464, dst, 1024, [](int nl) { return nl < 32 ? ilv(nl, 16) : -1; }, scr, c.lane); }
            else if (nb == 7) { transpose64((const float*)nullptr, (const float*)nullptr, 2464, dst, 1024, [](int) { return -1; }, scr, c.lane); }
            else if (nb < 24) { const int s0 = (nb < 16 ? 416 : 928) + 64 * ((nb - 8) & 7); transpose64(base + s0, base + s0 + 32, 2464, dst, 1024, [](int nl) { return ilv(nl, 32); }, scr, c.lane); }
            else { const int s0 = (nb < 32 ? 1440 : 1952) + 64 * (nb & 7); transpose64(base + s0, base + s0 + 32, 2464, dst, 1024, [](int nl) { return nl; }, scr, c.lane); }
            continue; } r -= I_WIN;
        if (r < I_WO) { const int kb = r / 16, nb = r % 16; const float* src = c.w_o() + (size_t)(64 * kb) * 1024 + 64 * nb;
            transpose64(src, src + 32, 1024, c.wo_t() + (size_t)(64 * nb) * 1024 + 64 * kb, 1024, [](int nl) { return nl; }, scr, c.lane); continue; } r -= I_WO;
        if (r < I_WUQ) { const float* g = c.g_q(); transpose_item(c.w_uq(), 256, 768, c.wuq_t(), 256, [](int n) { return cm_wuq(n); }, [g](int k) { return g[k]; }, scr, r / 24, r % 24, c.lane); continue; } r -= I_WUQ;
        { const float* g = c.g_kv(); transpose_item(c.w_ukv(), 128, 1024, c.wukv_t(), 256, [](int n) { return n; }, [g](int k) { return g[k]; }, scr, r / 32, r % 32, c.lane); }
    }
}
__device__ __forceinline__ void sincos_d(double x, double& s, double& co) {
    const double PIO2_HI = 1.5707963267948966, PIO2_LO = 6.123233995736766e-17;
    const double kd = __builtin_rint(x * 0.6366197723675814); const int k = (int)kd;
    const double r = (x - kd * PIO2_HI) - kd * PIO2_LO, r2 = r * r;
    double sr = r - r * r2 * (1.0 / 6.0 - r2 * (1.0 / 120.0 - r2 * (1.0 / 5040.0 - r2 * (1.0 / 362880.0 - r2 * (1.0 / 39916800.0 - r2 * (1.0 / 6227020800.0 - r2 * (1.0 / 1307674368000.0 - r2 * (1.0 / 355687428096000.0))))))));
    double cr = 1.0 - r2 * (0.5 - r2 * (1.0 / 24.0 - r2 * (1.0 / 720.0 - r2 * (1.0 / 40320.0 - r2 * (1.0 / 3628800.0 - r2 * (1.0 / 479001600.0 - r2 * (1.0 / 87178291200.0 - r2 * (1.0 / 20922789888000.0))))))));
    switch (k & 3) { case 0: s = sr; co = cr; break; case 1: s = cr; co = -sr; break; case 2: s = -sr; co = -cr; break; default: s = -cr; co = sr; break; }
}
__device__ __forceinline__ void p0_tables(const Ctx& c) {
    const int gt = blockIdx.x * 512 + c.tid, ngt = gridDim.x * 512;
    const double r16 = 1.0 / __builtin_sqrt(__builtin_sqrt(10.0));
    const double r8 = 1.0 / __builtin_sqrt(10.0);
    for (int i = gt; i < 4096 * 48; i += ngt) {
        const int t = i / 48, j = i % 48; const int prow = t >> 6, pcol = t & 63;
        double ang;
        if (j < 32) { const int jj = j & 15; double inv = 1.0; for (int q = 0; q < jj; ++q) inv *= r16; ang = (double)(j < 16 ? prow : pcol) * inv; }
        else { const int j2 = j - 32, jj = j2 & 7; double inv = 1.0; for (int q = 0; q < jj; ++q) inv *= r8; ang = (double)(j2 < 8 ? prow : pcol) * inv; }
        double s, co; sincos_d(ang, s, co);
        if (j < 32) { c.tabr()[(t * 32 + j) * 2] = (float)co; c.tabr()[(t * 32 + j) * 2 + 1] = (float)s; }
        else { c.tabm()[(t * 16 + j - 32) * 2] = (float)co; c.tabm()[(t * 16 + j - 32) * 2 + 1] = (float)s; }
    }
}

__device__ __forceinline__ void p1_norm(const Ctx& c) {
    for (int r = c.gw * 2; r < RT; r += c.ngw * 2) {
        const float* src = r < RL ? c.x() + (size_t)r * D : c.ctx() + (size_t)(r - RL) * D; const int b = r < RL ? r / SEQ : 8;
        f32x4 v[2][4]; float s0 = 0.f, s1 = 0.f;
#pragma unroll
        for (int j = 0; j < 4; ++j) { v[0][j] = __builtin_nontemporal_load((const f32x4*)src + c.lane + 64 * j); v[1][j] = __builtin_nontemporal_load((const f32x4*)(src + D) + c.lane + 64 * j); }
#pragma unroll
        for (int j = 0; j < 4; ++j) { s0 += v[0][j].x * v[0][j].x + v[0][j].y * v[0][j].y + v[0][j].z * v[0][j].z + v[0][j].w * v[0][j].w; s1 += v[1][j].x * v[1][j].x + v[1][j].y * v[1][j].y + v[1][j].z * v[1][j].z + v[1][j].w * v[1][j].w; }
        const float ri0 = 1.f / sqrtf(wave_sum(s0) * (1.f / D) + EPS), ri1 = 1.f / sqrtf(wave_sum(s1) * (1.f / D) + EPS);
        const float* md = c.modv() + b * 6144;
#pragma unroll
        for (int j = 0; j < 4; ++j) { const int k = 4 * c.lane + 256 * j;
            const f32x4 g = *(const f32x4*)(c.g_mix() + k), sh = *(const f32x4*)(md + k), scv = *(const f32x4*)(md + 1024 + k);
            const f32x4 gs = g * (scv + 1.f); const f32x4 o0 = v[0][j] * ri0 * gs + sh, o1 = v[1][j] * ri1 * gs + sh;
            u32x2 w0, w1; w0.x = pk2(o0.x, o0.y); w0.y = pk2(o0.z, o0.w); w1.x = pk2(o1.x, o1.y); w1.y = pk2(o1.z, o1.w);
            *(u32x2*)(c.hb() + (size_t)r * D + k) = w0; *(u32x2*)(c.hb() + (size_t)(r + 1) * D + k) = w1; }
    }
}

__device__ __forceinline__ void store8_bf16(bf16_t* p, const float (&v)[8]) { u32x4 w; w.x = pk2(v[0], v[1]); w.y = pk2(v[2], v[3]); w.z = pk2(v[4], v[5]); w.w = pk2(v[6], v[7]); *(u32x4*)p = w; }


namespace pg8 {
typedef short bf16x8 __attribute__((ext_vector_type(8)));
constexpr int BM = 256, BK = 64, HALF = 128, HTB = HALF * BK * 2, STAGE_BYTES = 8 * HTB, NXCD = 8, WGM = 8;
__host__ __device__ __forceinline__ int lds_byte(int r, int c) { const int st = (r >> 4) * 2 + (c >> 5), rr = r & 15, cc = c & 31, ob = rr * 64 + cc * 2; return st * 1024 + (ob ^ (((ob >> 9) & 1) << 5)); }
__host__ __device__ __forceinline__ void stage_rc(int b, int& R, int& C) { const int st = b / 1024, sb = b % 1024, swz = sb ^ (((sb >> 9) & 1) << 5); R = (st >> 1) * 16 + swz / 64; C = (st & 1) * 32 + (swz % 64) / 2; }
__host__ __device__ __forceinline__ int perm32(int rho) { const int n = rho >> 4, i = rho & 15; return 8 * (i >> 2) + 4 * n + (i & 3); }
struct Unit { int pm, pn; };
struct Gemm { const bf16_t* A; const bf16_t* Bt; int lda, ldb, K; const int* rowlist; int gshift, gmask; size_t gstride; };
struct StaticOrder {
    int nM, nN, nwg, G, c;
    __host__ __device__ void init(int M, int N, int G_, int c_) { nM = M / BM; nN = N / BM; nwg = nM * nN; G = G_; c = c_; }
    __host__ __device__ bool next(int i, Unit& u) const {
        const long L = (long)i * G + c; if (L >= nwg) return false;
        int wgid = (int)L; { const int q = nwg / NXCD, r = nwg % NXCD, xcd = wgid % NXCD, off = wgid / NXCD; wgid = (xcd < r ? xcd * (q + 1) : r * (q + 1) + (xcd - r) * q) + off; }
        const int nig = WGM * nN, gid = wgid / nig, fm = gid * WGM, gsz = (nM - fm) < WGM ? (nM - fm) : WGM;
        u.pm = fm + ((wgid % nig) % gsz); u.pn = (wgid % nig) / gsz; return true;
    }
};
struct ExpertOrder : StaticOrder {
    __host__ __device__ bool next(int i, Unit& u) const {
        if (!StaticOrder::next(i, u)) return false;
        const int p = u.pm, x = p >> 5, el = (p >> 4) & 1, b = (p >> 1) & 7, j = p & 1; u.pm = 32 * b + 2 * (2 * x + el) + j; return true;
    }
};
template <class F, bool FENCE = false> struct EpiRow8 {
    static constexpr bool PERM = true;
    F f;
    __device__ __forceinline__ void operator()(const f32x4 (&acc)[2][2][4][2], const Unit& u, int wr, int wc, int fr, int fq) const {
        const int row0 = u.pm * BM + wr * 64 + fr, col0 = u.pn * BM + wc * 32 + 8 * fq;
#pragma unroll
        for (int ai = 0; ai < 2; ++ai)
#pragma unroll
            for (int m = 0; m < 4; ++m)
#pragma unroll
                for (int bj = 0; bj < 2; ++bj) { const f32x4 a = acc[ai][bj][m][0], b = acc[ai][bj][m][1]; const float v[8] = {a[0], a[1], a[2], a[3], b[0], b[1], b[2], b[3]};
                    f(row0 + ai * HALF + m * 16, col0 + bj * HALF, v); if (FENCE && bj == 1) asm volatile("" ::: "memory"); }
    }
};
typedef int i32x8 __attribute__((ext_vector_type(8)));
__device__ __forceinline__ f32x4 mma_f8(bf16x8 a0, bf16x8 a1, bf16x8 b0, bf16x8 b1, f32x4 c) {
    const i32x8 A = __builtin_shufflevector(__builtin_bit_cast(i32x4, a0), __builtin_bit_cast(i32x4, a1), 0, 1, 2, 3, 4, 5, 6, 7), B = __builtin_shufflevector(__builtin_bit_cast(i32x4, b0), __builtin_bit_cast(i32x4, b1), 0, 1, 2, 3, 4, 5, 6, 7);
    return __builtin_amdgcn_mfma_scale_f32_16x16x128_f8f6f4(A, B, c, 0, 0, 0, 0, 0, 0);
}
template <int I8> __device__ __forceinline__ f32x4 mma_step(bf16x8 a, bf16x8 b, f32x4 c) {
    if constexpr (I8 == 1) return __builtin_bit_cast(f32x4, __builtin_amdgcn_mfma_i32_16x16x64_i8(__builtin_bit_cast(i32x4, a), __builtin_bit_cast(i32x4, b), __builtin_bit_cast(i32x4, c), 0, 0, 0));
    else return __builtin_amdgcn_mfma_f32_16x16x32_bf16(a, b, c, 0, 0, 0);
}
template <int I8 = 0, bool GATHER = false, class Epi, class Sched>
__device__ __forceinline__ void gemm_phase(LAS unsigned char* lds, const Gemm g, const Sched& S, const Epi& E, int tid) {
    const int wid = __builtin_amdgcn_readfirstlane(tid >> 6), lane = tid & 63, wr = wid >> 2, wc = wid & 3, fr = lane & 15, fq = lane >> 4;
    int Kv_ = g.K; asm volatile("" : "+s"(Kv_)); const int nt = Kv_ / BK;
    unsigned voffB[2];
#pragma unroll
    for (int i = 0; i < 2; ++i) { int R, C; stage_rc(tid * 16 + i * 8192, R, C); const int Rb = Epi::PERM ? ((R & ~31) + perm32(R & 31)) : R;
        voffB[i] = (unsigned)(Rb * g.ldb + C) * 2u; }
    const size_t kstep = (size_t)(BK * 2);
    const size_t hstepB = (size_t)HALF * g.ldb * 2, tstepB = 2 * hstepB;
    const unsigned ldsw = (unsigned)wid * 1024u;
    const int aoff = lds_byte(wr * 64 + fr, fq * 8), boff = lds_byte(wc * 32 + fr, fq * 8);
    const unsigned lda2 = (unsigned)g.lda * 2u;
#define PG8_SA(b, h) (((b) * 2 + (h)) * HTB)
#define PG8_SB(b, h) ((4 + (b) * 2 + (h)) * HTB)
#define PG8_STAGE(bufoff, gbase, voff) do { _Pragma("unroll") for (int _i = 0; _i < 2; ++_i) { unsigned _vo = (voff)[_i]; asm volatile("" : "+v"(_vo));     \
        __builtin_amdgcn_global_load_lds((const unsigned*)((const char*)(gbase) + _vo), (LAS unsigned*)(lds + (bufoff) + ldsw + _i * 8192), 16, 0, 0); } } while (0)
#define PG8_LDA(dst, b, h) do { if constexpr (I8 == 2) { _Pragma("unroll") for (int m = 0; m < 4; ++m) dst##8[m] = __builtin_shufflevector(*(const LAS i32x4*)(lds + PG8_SA(b, h) + aoff + m * 2048), *(const LAS i32x4*)(lds + PG8_SA(b, h) + aoff + m * 2048 + 1024), 0, 1, 2, 3, 4, 5, 6, 7); } \
        else { _Pragma("unroll") for (int m = 0; m < 4; ++m) _Pragma("unroll") for (int k = 0; k < 2; ++k) dst[m][k] = *(const LAS bf16x8*)(lds + PG8_SA(b, h) + aoff + m * 2048 + k * 1024); } } while (0)
#define PG8_LDB(dst, b, h) do { if constexpr (I8 == 2) { _Pragma("unroll") for (int n = 0; n < 2; ++n) dst##8[n] = __builtin_shufflevector(*(const LAS i32x4*)(lds + PG8_SB(b, h) + boff + n * 2048), *(const LAS i32x4*)(lds + PG8_SB(b, h) + boff + n * 2048 + 1024), 0, 1, 2, 3, 4, 5, 6, 7); } \
        else { _Pragma("unroll") for (int n = 0; n < 2; ++n) _Pragma("unroll") for (int k = 0; k < 2; ++k) dst[n][k] = *(const LAS bf16x8*)(lds + PG8_SB(b, h) + boff + n * 2048 + k * 1024); } } while (0)
#define PG8_MMA(ai, bj, At, Bt) do { __builtin_amdgcn_s_setprio(1); _Pragma("unroll") for (int m = 0; m < 4; ++m) _Pragma("unroll") for (int n = 0; n < 2; ++n) { \
        if constexpr (I8 == 2) acc[ai][bj][m][n] = __builtin_amdgcn_mfma_scale_f32_16x16x128_f8f6f4(Bt##8[n], At##8[m], acc[ai][bj][m][n], 0, 0, 0, 0, 0, 0); \
        else { _Pragma("unroll") for (int k = 0; k < 2; ++k) acc[ai][bj][m][n] = mma_step<I8>(Bt[n][k], At[m][k], acc[ai][bj][m][n]); } } __builtin_amdgcn_s_setprio(0); } while (0)
#define PG8_WAIT_V(n) asm volatile("s_waitcnt vmcnt(" #n ")" ::: "memory")
#define PG8_WAIT_L(n) asm volatile("s_waitcnt lgkmcnt(" #n ")" ::: "memory")
#define PG8_BAR __builtin_amdgcn_s_barrier()
#define PG8_SCHED __builtin_amdgcn_sched_barrier(0)
#define PG8_AOFFS(vo, u) do { _Pragma("unroll") for (int _i = 0; _i < 2; ++_i) { int _R, _C; stage_rc(tid * 16 + _i * 8192, _R, _C); _Pragma("unroll") for (int _h = 0; _h < 2; ++_h) { const int _r = (u).pm * BM + _h * HALF + _R; \
        const int _row = g.rowlist ? g.rowlist[_r] : _r; vo[_h][_i] = (unsigned)_row * lda2 + (unsigned)(_C * 2); } } } while (0)
#define PG8_BBASE(u) ((const char*)g.Bt + ((size_t)(((u).pm >> g.gshift) & g.gmask) * g.gstride) * 2 + (size_t)(u).pn * tstepB)
    Unit cur, nxt; int ui = 0;
    if (!S.next(0, cur)) return;
    f32x4 acc[2][2][4][2];
#pragma unroll
    for (int a = 0; a < 2; ++a)
#pragma unroll
        for (int b = 0; b < 2; ++b)
#pragma unroll
            for (int m = 0; m < 4; ++m)
#pragma unroll
                for (int n = 0; n < 2; ++n) acc[a][b][m][n] = (f32x4){0.f, 0.f, 0.f, 0.f};
    bf16x8 At[4][2], B0[2][2], B1[2][2];
    i32x8 At8[4], B08[2], B18[2];
    unsigned voc[2][2], von[2][2], voA[2];
    const size_t hstepA = (size_t)HALF * lda2, ustepA = 2 * hstepA;
#pragma unroll
    for (int i = 0; i < 2; ++i) { int R, C; stage_rc(tid * 16 + i * 8192, R, C); voA[i] = (unsigned)R * lda2 + (unsigned)(C * 2); }
    if constexpr (GATHER) PG8_AOFFS(voc, cur);
#define PG8_ABASE(u) ((const char*)g.A + (GATHER ? (size_t)0 : (size_t)(u).pm * ustepA))
#define PG8_STAGE_A(bufoff, base, h, vg) do { if constexpr (GATHER) PG8_STAGE(bufoff, base, vg); else PG8_STAGE(bufoff, (base) + (h) * hstepA, voA); } while (0)
    const char* A0 = PG8_ABASE(cur); const char* cB = PG8_BBASE(cur);
    PG8_STAGE(PG8_SB(0, 0), cB, voffB); PG8_STAGE(PG8_SB(0, 1), cB + hstepB, voffB); PG8_STAGE_A(PG8_SA(0, 0), A0, 0, voc[0]); PG8_STAGE_A(PG8_SA(0, 1), A0, 1, voc[1]);
    if (wr == 1) PG8_BAR;
    PG8_WAIT_V(2); PG8_BAR;
    PG8_STAGE(PG8_SB(1, 0), cB + kstep, voffB); PG8_STAGE_A(PG8_SA(1, 0), A0 + kstep, 0, voc[0]); PG8_STAGE(PG8_SB(1, 1), cB + hstepB + kstep, voffB);
    PG8_WAIT_V(6); PG8_BAR;
    for (;;) {
        const bool has_next = S.next(ui + 1, nxt);
        const char* nB = has_next ? PG8_BBASE(nxt) : cB; const char* nA = has_next ? PG8_ABASE(nxt) : A0;
        for (int t = 0; t < nt; t += 2) {
            const bool last = (t == nt - 2);
            const char* a1 = A0 + (size_t)(t + 1) * kstep;
            const char* a2 = last ? nA : A0 + (size_t)(t + 2) * kstep; const char* b2 = last ? nB : cB + (size_t)(t + 2) * kstep;
            const char* a3 = a2 + kstep; const char* b3 = b2 + kstep;
            unsigned vo2[2][2];
            if constexpr (GATHER) {
            if (last) { if (has_next) { PG8_AOFFS(von, nxt); } else { _Pragma("unroll") for (int h = 0; h < 2; ++h) _Pragma("unroll") for (int i = 0; i < 2; ++i) von[h][i] = voc[h][i]; } }
#pragma unroll
            for (int h = 0; h < 2; ++h)
#pragma unroll
                for (int i = 0; i < 2; ++i) vo2[h][i] = last ? von[h][i] : voc[h][i];
            }
            PG8_LDB(B0, 0, 0); PG8_LDB(B1, 0, 1); PG8_SCHED; PG8_LDA(At, 0, 0); PG8_STAGE_A(PG8_SA(1, 1), a1, 1, voc[1]);
            PG8_WAIT_V(8); PG8_WAIT_L(0); PG8_BAR; PG8_MMA(0, 0, At, B0); PG8_MMA(0, 1, At, B1); PG8_BAR; PG8_SCHED;
            PG8_LDA(At, 0, 1); PG8_STAGE(PG8_SB(0, 0), b2, voffB); PG8_STAGE(PG8_SB(0, 1), b2 + hstepB, voffB); PG8_STAGE_A(PG8_SA(0, 0), a2, 0, vo2[0]);
            PG8_WAIT_V(8); PG8_WAIT_L(0); PG8_BAR; PG8_MMA(1, 0, At, B0); PG8_MMA(1, 1, At, B1); PG8_BAR; PG8_SCHED;
            PG8_LDB(B0, 1, 0); PG8_LDB(B1, 1, 1); PG8_SCHED; PG8_LDA(At, 1, 0); PG8_STAGE_A(PG8_SA(0, 1), a2, 1, vo2[1]);
            PG8_WAIT_V(8); PG8_WAIT_L(0); PG8_BAR; PG8_MMA(0, 0, At, B0); PG8_MMA(0, 1, At, B1); PG8_BAR; PG8_SCHED;
            PG8_LDA(At, 1, 1); PG8_STAGE(PG8_SB(1, 0), b3, voffB); PG8_STAGE(PG8_SB(1, 1), b3 + hstepB, voffB); PG8_STAGE_A(PG8_SA(1, 0), a3, 0, vo2[0]);
            PG8_WAIT_V(8); PG8_WAIT_L(0); PG8_BAR; PG8_MMA(1, 0, At, B0); PG8_MMA(1, 1, At, B1); PG8_BAR; PG8_SCHED;
        }
        if (wr == 0) PG8_BAR;
        if constexpr (I8 == 1) {
#pragma unroll
            for (int a = 0; a < 2; ++a)
#pragma unroll
                for (int b = 0; b < 2; ++b)
#pragma unroll
                    for (int m = 0; m < 4; ++m)
#pragma unroll
                        for (int n = 0; n < 2; ++n) acc[a][b][m][n] = __builtin_convertvector(__builtin_bit_cast(i32x4, acc[a][b][m][n]), f32x4); }
        E(acc, cur, wr, wc, fr, fq);
        if (!has_next) break;
#pragma unroll
        for (int a = 0; a < 2; ++a)
#pragma unroll
            for (int b = 0; b < 2; ++b)
#pragma unroll
                for (int m = 0; m < 4; ++m)
#pragma unroll
                    for (int n = 0; n < 2; ++n) acc[a][b][m][n] = (f32x4){0.f, 0.f, 0.f, 0.f};
        cur = nxt; cB = nB; A0 = nA; ++ui;
        if constexpr (GATHER) {
#pragma unroll
        for (int h = 0; h < 2; ++h)
#pragma unroll
            for (int i = 0; i < 2; ++i) voc[h][i] = von[h][i];
        }
        if (wr == 1) PG8_BAR;
    }
    PG8_WAIT_V(0);
    PG8_BAR;
#undef PG8_SA
#undef PG8_SB
#undef PG8_STAGE
#undef PG8_LDA
#undef PG8_LDB
#undef PG8_MMA
#undef PG8_WAIT_V
#undef PG8_WAIT_L
#undef PG8_BAR
#undef PG8_SCHED
#undef PG8_AOFFS
#undef PG8_ABASE
#undef PG8_STAGE_A
#undef PG8_BBASE
}
}
template <class F> __device__ __forceinline__ pg8::EpiRow8<F> make_epi(F f) { return pg8::EpiRow8<F>{f}; }
template <class F> __device__ __forceinline__ pg8::EpiRow8<F, true> make_epi_fenced(F f) { return pg8::EpiRow8<F, true>{f}; }

struct EpiProj {
    static constexpr bool PERM = true;
    bf16_t* proj; float* pstat; const float* tabr; const float* tabm;
    __device__ __forceinline__ void operator()(const f32x4 (&acc)[2][2][4][2], const pg8::Unit& u, int wr, int wc, int fr, int fq) const {
        const int row0 = u.pm * 256 + wr * 64 + fr, pn = u.pn; const bool lat = u.pm < RL / 256;
        const bool rope_r = pn >= 2 && pn < 6 && lat, rope_m = pn == 1 && wc == 0 && lat;
        f32x4 tb[8][2];
        if (rope_r || rope_m) { const int g = rope_r ? ((wc * 32 + 8 * fq) & 63) >> 3 : fq; const float* tab = rope_r ? tabr : tabm; const int nf = rope_r ? 32 : 16;
#pragma unroll
            for (int i = 0; i < 8; ++i) { const int t = (row0 + (i >> 2) * 128 + (i & 3) * 16) & (SEQ - 1); tb[i][0] = *(const f32x4*)(tab + (t * nf + 4 * g) * 2); tb[i][1] = *(const f32x4*)(tab + (t * nf + 4 * g) * 2 + 4); } }
        else {
#pragma unroll
            for (int i = 0; i < 8; ++i) { tb[i][0] = (f32x4){1.f, 0.f, 1.f, 0.f}; tb[i][1] = (f32x4){1.f, 0.f, 1.f, 0.f}; } }
#pragma unroll
        for (int ai = 0; ai < 2; ++ai)
#pragma unroll
            for (int m = 0; m < 4; ++m) {
                const int row = row0 + ai * 128 + m * 16;
                bf16_t* pr = proj + (size_t)row * NPROJ + pn * 256 + wc * 32 + 8 * fq;
                const f32x4 c0 = tb[ai * 4 + m][0], c1 = tb[ai * 4 + m][1]; const float co[4] = {c0.x, c0.z, c1.x, c1.z}, si[4] = {c0.y, c0.w, c1.y, c1.w};
                float v[2][8];
#pragma unroll
                for (int bj = 0; bj < 2; ++bj) { const f32x4 a = acc[ai][bj][m][0], b = acc[ai][bj][m][1]; v[bj][0] = a[0]; v[bj][1] = a[1]; v[bj][2] = a[2]; v[bj][3] = a[3]; v[bj][4] = b[0]; v[bj][5] = b[1]; v[bj][6] = b[2]; v[bj][7] = b[3]; }
                if (pn == 0) {
                    float sq = 0.f;
#pragma unroll
                    for (int bj = 0; bj < 2; ++bj)
#pragma unroll
                        for (int j = 0; j < 8; ++j) sq += v[bj][j] * v[bj][j];
                    sq += __shfl_xor(sq, 16); sq += __shfl_xor(sq, 32);
                    if (fq == 0) pstat[(size_t)row * 8 + wc] = sq;
                } else if (pn == 1) {
                    float sq = 0.f;
#pragma unroll
                    for (int j = 0; j < 8; ++j) sq += v[0][j] * v[0][j];
                    sq += __shfl_xor(sq, 16); sq += __shfl_xor(sq, 32);
                    if (fq == 0) pstat[(size_t)row * 8 + 4 + wc] = sq;
                    if (wc == 0) {
#pragma unroll
                        for (int w = 0; w < 4; ++w) { const float x1 = v[1][w], x2 = v[1][4 + w]; v[1][w] = x1 * co[w] - x2 * si[w]; v[1][4 + w] = x1 * si[w] + x2 * co[w]; } }
                } else if (pn < 6) {
                    const float ksc = pn >= 4 ? 0.125f : 1.f;
#pragma unroll
                    for (int bj = 0; bj < 2; ++bj)
#pragma unroll
                        for (int w = 0; w < 4; ++w) { const float x1 = v[bj][w], x2 = v[bj][4 + w]; v[bj][w] = (x1 * co[w] - x2 * si[w]) * ksc; v[bj][4 + w] = (x1 * si[w] + x2 * co[w]) * ksc; }
                } else if (pn >= 8) {
#pragma unroll
                    for (int bj = 0; bj < 2; ++bj)
#pragma unroll
                        for (int j = 0; j < 8; ++j) v[bj][j] = silu_f(v[bj][j]);
                }
                store8_bf16(pr, v[0]); store8_bf16(pr + 128, v[1]);
            }
    }
};
__device__ __forceinline__ void p2_proj(const Ctx& c, float* lds) {
    pg8::Gemm g{c.hb(), c.win_t(), D, D, D, nullptr, 0, 0, 0};
    pg8::StaticOrder S; S.init(RT, NPROJ, (int)gridDim.x, (int)blockIdx.x);
    EpiProj E{c.proj(), c.pstat(), c.tabr(), c.tabm()};
    pg8::gemm_phase((LAS unsigned char*)lds, g, S, E, c.tid);
    if ((int)gridDim.x == 256 && (int)blockIdx.x >= QSHORT0) { __syncthreads();
        for (int q = 0; q < QSTRIPS; ++q) expert_strip(c, lds, ((int)blockIdx.x - QSHORT0) * QSTRIPS + q);
        __syncthreads(); }
}
template <bool ISQ> struct EpiUp {
    static constexpr bool PERM = true;
    bf16_t* out; const float* pstat; const float* tabm;
    __device__ __forceinline__ void operator()(const f32x4 (&acc)[2][2][4][2], const pg8::Unit& u, int wr, int wc, int fr, int fq) const {
        const int row0 = u.pm * 256 + wr * 64 + fr, col00 = u.pn * 256 + wc * 32 + 8 * fq;
        float sc[8];
#pragma unroll
        for (int i = 0; i < 8; ++i) { const f32x4 ps = *(const f32x4*)(pstat + (size_t)(row0 + (i >> 2) * 128 + (i & 3) * 16) * 8 + (ISQ ? 0 : 4));
            sc[i] = (ISQ ? QSCALE : 1.f) / sqrtf((ps.x + ps.y + ps.z + ps.w) * (ISQ ? 1.f / 256.f : 1.f / 128.f) + EPS); }
#pragma unroll
        for (int ai = 0; ai < 2; ++ai)
#pragma unroll
            for (int m = 0; m < 4; ++m) { const int row = row0 + ai * 128 + m * 16; const float s_ = sc[ai * 4 + m];
#pragma unroll
                for (int bj = 0; bj < 2; ++bj) { const int c0 = col00 + bj * 128; const f32x4 a = acc[ai][bj][m][0], b = acc[ai][bj][m][1];
                    float o[8] = {a[0] * s_, a[1] * s_, a[2] * s_, a[3] * s_, b[0] * s_, b[1] * s_, b[2] * s_, b[3] * s_};
                    if (ISQ) { const int p = c0 - 96 * ((c0 * 683) >> 16);
                        if (p >= 64) { const int t = row & (SEQ - 1), g = (p - 64) >> 3;
                            const f32x4 c0v = *(const f32x4*)(tabm + (t * 16 + 4 * g) * 2), c1v = *(const f32x4*)(tabm + (t * 16 + 4 * g) * 2 + 4);
                            const float co[4] = {c0v.x, c0v.z, c1v.x, c1v.z}, si[4] = {c0v.y, c0v.w, c1v.y, c1v.w};
#pragma unroll
                            for (int w = 0; w < 4; ++w) { const float x1 = o[w], x2 = o[4 + w]; o[w] = x1 * co[w] - x2 * si[w]; o[4 + w] = x1 * si[w] + x2 * co[w]; } } }
                    store8_bf16(out + (size_t)row * (ISQ ? QW : KVW) + c0, o); } }
    }
};
__device__ __forceinline__ void p3_upq(const Ctx& c, float* lds) {
    pg8::Gemm g{c.proj() + PC_CQ, c.wuq_t(), NPROJ, 256, 256, nullptr, 0, 0, 0};
    pg8::StaticOrder S; S.init(RL, QW, (int)gridDim.x, (int)blockIdx.x);
    EpiUp<true> E{c.qb(), c.pstat(), c.tabm()};
    pg8::gemm_phase((LAS unsigned char*)lds, g, S, E, c.tid);
}
__device__ __forceinline__ void p3_upkv(const Ctx& c, float* lds) {
    pg8::Gemm g{c.proj() + PC_CKV, c.wukv_t(), NPROJ, 256, 128, nullptr, 0, 0, 0};
    pg8::StaticOrder S; S.init(RT, KVW, (int)gridDim.x, (int)blockIdx.x);
    EpiUp<false> E{c.kvb(), c.pstat(), c.tabm()};
    pg8::gemm_phase((LAS unsigned char*)lds, g, S, E, c.tid);
}

namespace att {
using bf16x8 = __attribute__((ext_vector_type(8))) short;
using s16x4  = __attribute__((ext_vector_type(4))) short;
using f32x16 = __attribute__((ext_vector_type(16))) float;
constexpr int QBLK = 32, KVBLK = 64, NWV = 8;
constexpr float THR = 8.f;
constexpr int SHM_V = 16384, SHM_K = 16384, SHM_ATTN = 3 * SHM_V + 3 * SHM_K + NWV * 64 * 4;
#define KSWZ(row, colB) ((row) * 256 + ((colB) ^ (((row) & 7) << 4)))
#define SBAR() __builtin_amdgcn_sched_barrier(0)
__device__ __forceinline__ int crow(int r, int hi) { return (r & 3) + 8 * (r >> 2) + 4 * hi; }
__device__ __forceinline__ unsigned cvtpk(float lo, float hi) { unsigned r; asm volatile("v_cvt_pk_bf16_f32 %0, %1, %2" : "=v"(r) : "v"(lo), "v"(hi)); return r; }
__device__ __forceinline__ float max3f(float a, float b, float c) { float r; asm("v_max3_f32 %0, %1, %2, %3" : "=v"(r) : "v"(a), "v"(b), "v"(c)); return r; }
template <bool FIRST>
__device__ __forceinline__ void partialSM(f32x16& p0, f32x16& p1, float& m_reg, f32x16& negm, float& alpha) {
  float pa = max3f(p0[0], p0[1], p0[2]), pb = max3f(p1[0], p1[1], p1[2]);
#pragma unroll
  for (int r = 3; r < 15; r += 2) { pa = max3f(pa, p0[r], p0[r + 1]); pb = max3f(pb, p1[r], p1[r + 1]); }
  float pmax = max3f(pa, pb, fmaxf(p0[15], p1[15]));
  { auto rr = __builtin_amdgcn_permlane32_swap(__float_as_uint(pmax), __float_as_uint(pmax), false, false);
    pmax = fmaxf(__uint_as_float(rr[0]), __uint_as_float(rr[1])); }
  if (!FIRST && __builtin_expect(__all(pmax <= THR), 1)) { alpha = 1.f; }
  else { const float dl = FIRST ? pmax : fmaxf(pmax, 0.f); alpha = FIRST ? 1.f : __builtin_amdgcn_exp2f(-dl); m_reg += dl;
#pragma unroll
    for (int r = 0; r < 16; ++r) { p0[r] -= dl; p1[r] -= dl; }
#pragma unroll
    for (int r = 0; r < 16; ++r) negm[r] = -m_reg;
    asm volatile("" : "+v"(negm)); }
#pragma unroll
  for (int r = 0; r < 16; ++r) p0[r] = __builtin_amdgcn_exp2f(p0[r]);
}
__device__ __forceinline__ void finishSM(f32x16& p0, f32x16& p1, float alpha, float& l_reg, bf16x8& pa0, bf16x8& pa1, bf16x8& pa2, bf16x8& pa3) {
#pragma unroll
  for (int r = 0; r < 16; ++r) p1[r] = __builtin_amdgcn_exp2f(p1[r]);
  float ps = 0;
#pragma unroll
  for (int r = 0; r < 16; ++r) ps += p0[r];
#pragma unroll
  for (int r = 0; r < 16; ++r) ps += p1[r];
  { auto rr = __builtin_amdgcn_permlane32_swap(__float_as_uint(ps), __float_as_uint(ps), false, false);
    ps = __uint_as_float(rr[0]) + __uint_as_float(rr[1]); }
  l_reg = l_reg * alpha + ps;
#define PK4(P, BASE, OUT) do { unsigned a0 = cvtpk(P[BASE + 0], P[BASE + 1]), a1 = cvtpk(P[BASE + 2], P[BASE + 3]);   \
    unsigned b0 = cvtpk(P[BASE + 4], P[BASE + 5]), b1 = cvtpk(P[BASE + 6], P[BASE + 7]);                              \
    auto r0 = __builtin_amdgcn_permlane32_swap(a0, b0, false, false); auto r1 = __builtin_amdgcn_permlane32_swap(a1, b1, false, false); \
    u32x4 w = {r0[0], r1[0], r0[1], r1[1]}; OUT = *reinterpret_cast<bf16x8*>(&w); } while (0)
  PK4(p0, 0, pa0); PK4(p0, 8, pa1); PK4(p1, 0, pa2); PK4(p1, 8, pa3);
#undef PK4
}
__device__ __forceinline__ void qkt(f32x16& p0, f32x16& p1, const char* Ks, const bf16x8* qr, const f32x16& negm, int r32, int hi) {
#pragma unroll
  for (int d0 = 0; d0 < 6; ++d0) { const int cb = (d0 * 16 + hi * 8) * 2;
    const bf16x8 b0 = *reinterpret_cast<const bf16x8*>(Ks + KSWZ(r32, cb));
    const bf16x8 b1 = *reinterpret_cast<const bf16x8*>(Ks + KSWZ(32 + r32, cb));
    if (d0 == 0) { p0 = __builtin_amdgcn_mfma_f32_32x32x16_bf16(b0, qr[0], negm, 0, 0, 0); p1 = __builtin_amdgcn_mfma_f32_32x32x16_bf16(b1, qr[0], negm, 0, 0, 0); }
    else { p0 = __builtin_amdgcn_mfma_f32_32x32x16_bf16(b0, qr[d0], p0, 0, 0, 0); p1 = __builtin_amdgcn_mfma_f32_32x32x16_bf16(b1, qr[d0], p1, 0, 0, 0); } }
}
__device__ __forceinline__ int v_st(int k, int c) { const int kk = (k & ~0xC) | ((k & 4) << 1) | ((k & 8) >> 1); return ((kk >> 3) * 4 + (c >> 5)) * 512 + ((kk & 7) * 32 + (c & 31)) * 2; }
__device__ __forceinline__ int v_rd_base(int lane) { return ((lane & 3) << 3) | (((lane >> 2) & 3) << 6) | (((lane >> 4) & 1) << 5) | (((lane >> 5) & 1) << 8); }
constexpr int v_rd_off(int d0, int ks, int half) { return d0 * 512 + ks * 4096 + half * 2048; }
template <int OFF> __device__ __forceinline__ s16x4 tr_read(int vb) { s16x4 r; asm volatile("ds_read_b64_tr_b16 %0, %1 offset:%2" : "=&v"(r) : "v"(vb), "i"(OFF) : "memory"); return r; }
template <int D0> __device__ __forceinline__ void pv_one(f32x16& od, int vb, bf16x8 pa0, bf16x8 pa1, bf16x8 pa2, bf16x8 pa3) {
  const s16x4 l0 = tr_read<v_rd_off(D0, 0, 0)>(vb), h0 = tr_read<v_rd_off(D0, 0, 1)>(vb), l1 = tr_read<v_rd_off(D0, 1, 0)>(vb), h1 = tr_read<v_rd_off(D0, 1, 1)>(vb);
  const s16x4 l2 = tr_read<v_rd_off(D0, 2, 0)>(vb), h2 = tr_read<v_rd_off(D0, 2, 1)>(vb), l3 = tr_read<v_rd_off(D0, 3, 0)>(vb), h3 = tr_read<v_rd_off(D0, 3, 1)>(vb);
  asm volatile("s_waitcnt lgkmcnt(0)" ::: "memory"); SBAR();
#define PK(L, H) (bf16x8){L[0], L[1], L[2], L[3], H[0], H[1], H[2], H[3]}
  od = __builtin_amdgcn_mfma_f32_32x32x16_bf16(pa0, PK(l0, h0), od, 0, 0, 0);
  od = __builtin_amdgcn_mfma_f32_32x32x16_bf16(pa1, PK(l1, h1), od, 0, 0, 0);
  od = __builtin_amdgcn_mfma_f32_32x32x16_bf16(pa2, PK(l2, h2), od, 0, 0, 0);
  od = __builtin_amdgcn_mfma_f32_32x32x16_bf16(pa3, PK(l3, h3), od, 0, 0, 0);
#undef PK
}
__device__ __forceinline__ void pv_d0(f32x16* o, int vb, bf16x8 pa0, bf16x8 pa1, bf16x8 pa2, bf16x8 pa3) {
  const s16x4 l0 = tr_read<v_rd_off(0, 0, 0)>(vb), h0 = tr_read<v_rd_off(0, 0, 1)>(vb), l1 = tr_read<v_rd_off(0, 1, 0)>(vb), h1 = tr_read<v_rd_off(0, 1, 1)>(vb);
  const s16x4 l2 = tr_read<v_rd_off(0, 2, 0)>(vb), h2 = tr_read<v_rd_off(0, 2, 1)>(vb), l3 = tr_read<v_rd_off(0, 3, 0)>(vb), h3 = tr_read<v_rd_off(0, 3, 1)>(vb);
  const s16x4 m0 = tr_read<v_rd_off(1, 0, 0)>(vb), g0 = tr_read<v_rd_off(1, 0, 1)>(vb), m1 = tr_read<v_rd_off(1, 1, 0)>(vb), g1 = tr_read<v_rd_off(1, 1, 1)>(vb);
  const s16x4 m2 = tr_read<v_rd_off(1, 2, 0)>(vb), g2 = tr_read<v_rd_off(1, 2, 1)>(vb), m3 = tr_read<v_rd_off(1, 3, 0)>(vb), g3 = tr_read<v_rd_off(1, 3, 1)>(vb);
  asm volatile("s_waitcnt lgkmcnt(0)" ::: "memory"); SBAR();
#define PK(L, H) (bf16x8){L[0], L[1], L[2], L[3], H[0], H[1], H[2], H[3]}
  o[0] = __builtin_amdgcn_mfma_f32_32x32x16_bf16(pa0, PK(l0, h0), o[0], 0, 0, 0); o[1] = __builtin_amdgcn_mfma_f32_32x32x16_bf16(pa0, PK(m0, g0), o[1], 0, 0, 0);
  o[0] = __builtin_amdgcn_mfma_f32_32x32x16_bf16(pa1, PK(l1, h1), o[0], 0, 0, 0); o[1] = __builtin_amdgcn_mfma_f32_32x32x16_bf16(pa1, PK(m1, g1), o[1], 0, 0, 0);
  o[0] = __builtin_amdgcn_mfma_f32_32x32x16_bf16(pa2, PK(l2, h2), o[0], 0, 0, 0); o[1] = __builtin_amdgcn_mfma_f32_32x32x16_bf16(pa2, PK(m2, g2), o[1], 0, 0, 0);
  o[0] = __builtin_amdgcn_mfma_f32_32x32x16_bf16(pa3, PK(l3, h3), o[0], 0, 0, 0); o[1] = __builtin_amdgcn_mfma_f32_32x32x16_bf16(pa3, PK(m3, g3), o[1], 0, 0, 0);
#undef PK
}

__device__ __forceinline__ void attn_unit(const bf16_t* __restrict__ Qb, const bf16_t* __restrict__ KN, const bf16_t* __restrict__ KR, const bf16_t* __restrict__ VV, bf16_t* __restrict__ Ob, int b, char* lds, int tid) {
  const int wid = tid >> 6, lane = tid & 63, r32 = lane & 31, hi = lane >> 5;
  char* V_lds = lds; char* K_lds = lds + 3 * SHM_V;
  float* ws = (float*)(lds + 3 * SHM_V + 3 * SHM_K) + wid * 64; float* li_l = ws; float* al_l = ws + 32;
  float m_reg = 0.f, l_reg = 0; f32x16 o[2] = {}; bf16x8 qr[6]; f32x16 negm = {};
  const bf16_t* Qw = Qb + (long)(wid * QBLK + r32) * QW + hi * 8;
#pragma unroll
  for (int d0 = 0; d0 < 6; ++d0) qr[d0] = __builtin_nontemporal_load(reinterpret_cast<const bf16x8*>(Qw + d0 * 16));
  const int srow = tid >> 3, sch = tid & 7;
  const int rrow = (tid & 255) >> 2, rch = tid & 3;
  const int vst = v_st(srow, sch * 8), kst = KSWZ(srow, sch * 16), krst = KSWZ(rrow, 128 + rch * 16);
  const int vb0 = (int)(uintptr_t)V_lds + v_rd_base(lane);
  struct { bf16x8 vs, kn, kr; } sr_[2];
#define ROWBASE(j) ((j) < 64 ? (long)b * SEQ + (long)(j) * 64 : (long)RL + (long)b * LC + (long)((j) - 64) * 64)
#define SLOAD(i, j) do { const long rb_ = ROWBASE(j); sr_[i].vs = *reinterpret_cast<const bf16x8*>(VV + (rb_ + srow) * KVW + sch * 8); \
    sr_[i].kn = *reinterpret_cast<const bf16x8*>(KN + (rb_ + srow) * KVW + sch * 8); sr_[i].kr = *reinterpret_cast<const bf16x8*>(KR + (rb_ + rrow) * NPROJ + rch * 8); } while (0)
#define SWRITE(bb, i) do { *(bf16x8*)(V_lds + (bb) * SHM_V + vst) = sr_[i].vs; *(bf16x8*)(K_lds + (bb) * SHM_K + kst) = sr_[i].kn; \
    if (wid < 4) *(bf16x8*)(K_lds + (bb) * SHM_K + krst) = sr_[i].kr; } while (0)
#define SWAIT() asm volatile("s_waitcnt vmcnt(3)" ::: "memory")
#define RESC(a) do { if (__any((a) < 1.f)) { if (hi == 0) al_l[r32] = (a); asm volatile("s_waitcnt lgkmcnt(0)" ::: "memory"); \
    _Pragma("unroll") for (int d = 0; d < 2; ++d) _Pragma("unroll") for (int r = 0; r < 16; ++r) o[d][r] *= al_l[crow(r, hi)]; } } while (0)
  f32x16 pA0, pA1, pB0, pB1; float alA, alB; bf16x8 pa0, pa1, pa2, pa3; constexpr int NT = (SEQ + LC) / KVBLK;
  if (wid >= 4) __builtin_amdgcn_s_setprio(1);
  int cur = 1, prev = 0, nxt = 2;
  SLOAD(0, 0); SLOAD(1, 1); asm volatile("s_waitcnt vmcnt(0)" ::: "memory"); SWRITE(0, 0); SWRITE(1, 1); SLOAD(0, 2); SLOAD(1, 3); __syncthreads();
  qkt(pA0, pA1, K_lds, qr, negm, r32, hi); partialSM<true>(pA0, pA1, m_reg, negm, alA);
#define HALFSTEP(PX0, PX1, PP0, PP1, ALX, ALP, STG, T) do { \
    __syncthreads(); \
    SBAR(); qkt(PX0, PX1, K_lds + cur * SHM_K, qr, negm, r32, hi); \
    finishSM(PP0, PP1, ALP, l_reg, pa0, pa1, pa2, pa3); SBAR(); \
    if ((T) + 1 < NT) { SWAIT(); SWRITE(nxt, STG); if ((T) + 3 < NT) SLOAD(STG, (T) + 3); } SBAR(); \
    pv_d0(o, vb0 + prev * SHM_V, pa0, pa1, pa2, pa3); partialSM<false>(PX0, PX1, m_reg, negm, ALX); \
    RESC(ALX); { const int t_ = prev; prev = cur; cur = nxt; nxt = t_; } } while (0)
  for (int t = 1; t + 1 < NT; t += 2) {
    HALFSTEP(pB0, pB1, pA0, pA1, alB, alA, 0, t);
    HALFSTEP(pA0, pA1, pB0, pB1, alA, alB, 1, t + 1);
  }
  HALFSTEP(pB0, pB1, pA0, pA1, alB, alA, 0, NT - 1);
  finishSM(pB0, pB1, alB, l_reg, pa0, pa1, pa2, pa3); SBAR();
  pv_d0(o, vb0 + prev * SHM_V, pa0, pa1, pa2, pa3);
#undef HALFSTEP
  if (hi == 0) li_l[r32] = l_reg; asm volatile("s_waitcnt lgkmcnt(0)" ::: "memory");
  float rli[16];
#pragma unroll
  for (int r = 0; r < 16; ++r) rli[r] = __builtin_amdgcn_rcpf(li_l[crow(r, hi)]);
  bf16_t* Ow = Ob + (long)(wid * QBLK) * D;
#pragma unroll
  for (int r = 0; r < 16; ++r) { const int orow = crow(r, hi);
#pragma unroll
    for (int d0 = 0; d0 < 2; ++d0) Ow[(long)orow * D + d0 * 32 + r32] = f2bf(o[d0][r] * rli[r]); }
  __builtin_amdgcn_s_setprio(0);
  __syncthreads();
#undef ROWBASE
#undef SLOAD
#undef SWRITE
#undef SWAIT
#undef RESC
}
#undef KSWZ
#undef SBAR
}


__device__ __forceinline__ float lg2_of(float e) { return log1pf(-exp2f(-e)) * 1.4426950408889634f; }
namespace ret {
using att::bf16x8; using att::s16x4; using att::f32x16; using att::v_st; using att::v_rd_base; using att::v_rd_off; using att::tr_read; using att::crow; using att::cvtpk;
constexpr int TB = 16384;
__device__ __forceinline__ bf16x8 scale8(bf16x8 x, float z) {
    const u32x4 w = __builtin_bit_cast(u32x4, x); u32x4 o;
    o.x = cvtpk(__uint_as_float(w.x << 16) * z, __uint_as_float(w.x & 0xffff0000u) * z); o.y = cvtpk(__uint_as_float(w.y << 16) * z, __uint_as_float(w.y & 0xffff0000u) * z);
    o.z = cvtpk(__uint_as_float(w.z << 16) * z, __uint_as_float(w.z & 0xffff0000u) * z); o.w = cvtpk(__uint_as_float(w.w << 16) * z, __uint_as_float(w.w & 0xffff0000u) * z);
    return __builtin_bit_cast(bf16x8, o);
}
#define RET_PK(L, H) (bf16x8){L[0], L[1], L[2], L[3], H[0], H[1], H[2], H[3]}
__device__ __forceinline__ void tt_mma(f32x16& acc, int va, int vb) {
    const s16x4 al0 = tr_read<v_rd_off(0, 0, 0)>(va), ah0 = tr_read<v_rd_off(0, 0, 1)>(va), al1 = tr_read<v_rd_off(0, 1, 0)>(va), ah1 = tr_read<v_rd_off(0, 1, 1)>(va);
    const s16x4 al2 = tr_read<v_rd_off(0, 2, 0)>(va), ah2 = tr_read<v_rd_off(0, 2, 1)>(va), al3 = tr_read<v_rd_off(0, 3, 0)>(va), ah3 = tr_read<v_rd_off(0, 3, 1)>(va);
    const s16x4 bl0 = tr_read<v_rd_off(0, 0, 0)>(vb), bh0 = tr_read<v_rd_off(0, 0, 1)>(vb), bl1 = tr_read<v_rd_off(0, 1, 0)>(vb), bh1 = tr_read<v_rd_off(0, 1, 1)>(vb);
    const s16x4 bl2 = tr_read<v_rd_off(0, 2, 0)>(vb), bh2 = tr_read<v_rd_off(0, 2, 1)>(vb), bl3 = tr_read<v_rd_off(0, 3, 0)>(vb), bh3 = tr_read<v_rd_off(0, 3, 1)>(vb);
    asm volatile("s_waitcnt lgkmcnt(0)" ::: "memory"); __builtin_amdgcn_sched_barrier(0);
    acc = __builtin_amdgcn_mfma_f32_32x32x16_bf16(RET_PK(al0, ah0), RET_PK(bl0, bh0), acc, 0, 0, 0);
    acc = __builtin_amdgcn_mfma_f32_32x32x16_bf16(RET_PK(al1, ah1), RET_PK(bl1, bh1), acc, 0, 0, 0);
    acc = __builtin_amdgcn_mfma_f32_32x32x16_bf16(RET_PK(al2, ah2), RET_PK(bl2, bh2), acc, 0, 0, 0);
    acc = __builtin_amdgcn_mfma_f32_32x32x16_bf16(RET_PK(al3, ah3), RET_PK(bl3, bh3), acc, 0, 0, 0);
}
__device__ __forceinline__ void scan_seq(const bf16_t* __restrict__ proj, bf16_t* __restrict__ rstT, int b, int h, int dir, float lg2, char* lds, int tid) {
    const int wid = tid >> 6, lane = tid & 63, r32 = lane & 31, hi = lane >> 5;
    const float g128 = __builtin_amdgcn_exp2f(lg2 * 128.f);
    const int key0 = tid >> 3, key1 = 64 + (tid >> 3), ch = tid & 7;
    const float z0 = __builtin_amdgcn_exp2f(lg2 * (float)(dir ? key0 : 127 - key0)), z1 = __builtin_amdgcn_exp2f(lg2 * (float)(dir ? key1 : 127 - key1));
    const int st = v_st(tid >> 3, ch * 8);
    char* KI = lds; char* VI = lds + 4 * TB;
    const int mt = (wid >> 1) & 1, nt = wid & 1;
    const int vaK = (int)(uintptr_t)KI + v_rd_base(lane) + mt * 512, vbV = (int)(uintptr_t)VI + v_rd_base(lane) + nt * 512;
    f32x16 acc = {};
    bf16x8 k0a, k1a, v0a, v1a, k0b, k1b, v0b, v1b, k0c, k1c, v0c, v1c, k0d, k1d, v0d, v1d;
#define RROW(ck) ((ck) < 2 ? (long)RL + (long)b * LC + (long)(dir ? 1 - (ck) : (ck)) * 128 : (long)b * SEQ + (long)(dir ? NCH - 1 - ((ck) - 2) : (ck) - 2) * 128)
#define RLOAD(S, ck) do { const bf16_t* p_ = proj + RROW(ck) * NPROJ + h * 64 + ch * 8; k0##S = *(const bf16x8*)(p_ + (long)key0 * NPROJ + PC_RK); k1##S = *(const bf16x8*)(p_ + (long)key1 * NPROJ + PC_RK); \
        v0##S = *(const bf16x8*)(p_ + (long)key0 * NPROJ + PC_RV); v1##S = *(const bf16x8*)(p_ + (long)key1 * NPROJ + PC_RV); } while (0)
#define RWRITE(S, bb) do { *(bf16x8*)(KI + ((bb) * 2 + 0) * TB + st) = scale8(k0##S, z0); *(bf16x8*)(KI + ((bb) * 2 + 1) * TB + st) = scale8(k1##S, z1); \
        *(bf16x8*)(VI + ((bb) * 2 + 0) * TB + st) = v0##S; *(bf16x8*)(VI + ((bb) * 2 + 1) * TB + st) = v1##S; } while (0)
#define RCOMP(ck, bb) do { if (wid < 4) { \
            if ((ck) >= 2) { const int n = dir ? NCH - 1 - ((ck) - 2) : (ck) - 2; bf16_t* o = rstT + (size_t)n * 4096 + (size_t)(32 * nt + r32) * 64 + 32 * mt + 4 * hi; \
                _Pragma("unroll") for (int g = 0; g < 4; ++g) { u32x2 w; w.x = cvtpk(acc[4 * g], acc[4 * g + 1]); w.y = cvtpk(acc[4 * g + 2], acc[4 * g + 3]); *(u32x2*)(o + 8 * g) = w; } } \
            _Pragma("unroll") for (int r = 0; r < 16; ++r) acc[r] *= g128; \
            tt_mma(acc, vaK + ((bb) * 2 + 0) * TB, vbV + ((bb) * 2 + 0) * TB); \
            tt_mma(acc, vaK + ((bb) * 2 + 1) * TB, vbV + ((bb) * 2 + 1) * TB); } } while (0)
    constexpr int NCK = 2 + NCH;
#define RSTEP(ck, S) do { RCOMP(ck, (ck) & 1); if ((ck) + 1 < NCK) { RWRITE(S, ((ck) + 1) & 1); } if ((ck) + 5 < NCK) RLOAD(S, (ck) + 5); __syncthreads(); } while (0)
    __syncthreads();
    RLOAD(a, 0); RWRITE(a, 0); RLOAD(b, 1); RLOAD(c, 2); RLOAD(d, 3); RLOAD(a, 4); __syncthreads();
    for (int ck = 0; ck < 32; ck += 4) { RSTEP(ck, b); RSTEP(ck + 1, c); RSTEP(ck + 2, d); RSTEP(ck + 3, a); }
    RSTEP(32, b); RSTEP(33, c);
#undef RSTEP
#undef RCOMP
#undef RROW
#undef RLOAD
#undef RWRITE
}

__device__ __forceinline__ int vc_st(int k, int c) { const int kk = (k & ~0xC) | ((k & 4) << 1) | ((k & 8) >> 1); return ((kk >> 3) * 2 + (c >> 5)) * 512 + ((kk & 7) * 32 + (c & 31)) * 2; }
constexpr int vc_rd_off(int ks, int half) { return ks * 2048 + half * 1024; }
constexpr int RBUF = 32768;
struct RetUnit { int b, h, n; };
template <class UF>
__device__ __forceinline__ void ret_group(const bf16_t* __restrict__ proj, const bf16_t* __restrict__ rst, const float* __restrict__ g_ret, const float* __restrict__ exp_f, const float* __restrict__ exp_b,
                                          bf16_t* __restrict__ mix, int nunits, UF unit_of, char* gl, int t4, int w4, int lane) {
    const int r32 = lane & 31, hi = lane >> 5, i = 32 * w4 + r32;
    bf16x8 qn[4];
    int soff[8];
#pragma unroll
    for (int q_ = 0; q_ < 8; ++q_) { const int s_ = ((4 * q_ + w4) * 64 + lane) & 1023;
        if (q_ < 4) { const int img = s_ >> 9, sub = (s_ & 511) >> 5, rw = (s_ & 31) >> 2, cc = s_ & 3; const int kk = (sub >> 1) * 8 + rw, key = (kk & ~0xC) | ((kk & 4) << 1) | ((kk & 8) >> 1);
            soff[q_] = (img * 64 + key) * NPROJ + PC_RV + (sub & 1) * 32 + cc * 8; }
        else { const int row = s_ >> 3, cp = s_ & 7, chn = cp ^ ((row >> 1) & 7); soff[q_] = row * NPROJ + PC_RK + chn * 8; } }
#define RG_LOAD(u, bb) do { const bf16_t* base_ = proj + ((long)(u).b * SEQ + (long)(u).n * 128) * NPROJ + (u).h * 64; \
        _Pragma("unroll") for (int q_ = 0; q_ < 8; ++q_) __builtin_amdgcn_global_load_lds((const unsigned*)(base_ + soff[q_]), (LAS unsigned*)((LAS char*)gl + (bb) * RBUF + (4 * q_ + w4) * 1024), 16, 0, 0); \
        const bf16_t* qp_ = base_ + (long)i * NPROJ + PC_RQ + hi * 8; \
        _Pragma("unroll") for (int ks_ = 0; ks_ < 4; ++ks_) qn[ks_] = *(const bf16x8*)(qp_ + ks_ * 16); } while (0)
    RetUnit u = unit_of(0);
    RG_LOAD(u, 0);
    bf16x8 q[4];
#pragma unroll
    for (int ks = 0; ks < 4; ++ks) q[ks] = qn[ks];
    asm volatile("s_waitcnt vmcnt(0)" ::: "memory"); __syncthreads();
    for (int ui = 0; ui < nunits; ++ui) {
        const int bb = ui & 1; const RetUnit un = unit_of(ui + 1 < nunits ? ui + 1 : ui);
        if (ui + 1 < nunits) RG_LOAD(un, bb ^ 1);
        const float lf = lg2_of(exp_f[u.h]), lb = lg2_of(exp_b[u.h]);
        int io = i, hio = hi; asm volatile("" : "+v"(io), "+v"(hio));
        const long row0 = (long)u.b * SEQ + (long)u.n * 128;
        const bf16_t* rf = rst + (size_t)(((u.b * NH + u.h) * 2 + 0) * NCH + u.n) * 4096 + (size_t)r32 * 64 + hi * 8;
        const bf16_t* rb = rst + (size_t)(((u.b * NH + u.h) * 2 + 1) * NCH + u.n) * 4096 + (size_t)r32 * 64 + hi * 8;
        bf16x8 rff[2][4], rbf[2][4];
#pragma unroll
        for (int et = 0; et < 2; ++et)
#pragma unroll
            for (int ks = 0; ks < 4; ++ks) { rff[et][ks] = *(const bf16x8*)(rf + et * 2048 + ks * 16); rbf[et][ks] = *(const bf16x8*)(rb + et * 2048 + ks * 16); }
        f32x16 acc[2] = {f32x16{}, f32x16{}};
        const char* kt = gl + bb * RBUF + 16384; const int vimg0 = (int)(uintptr_t)(gl + bb * RBUF) + v_rd_base(lane);
#pragma unroll
        for (int t = 0; t < 4; ++t) {
            f32x16 p = {};
            const int krow = 32 * t + r32;
#pragma unroll
            for (int ks = 0; ks < 4; ++ks) { const bf16x8 kf = *(const bf16x8*)(kt + krow * 128 + (((2 * ks + hi) ^ ((krow >> 1) & 7)) << 4)); p = __builtin_amdgcn_mfma_f32_32x32x16_bf16(kf, q[ks], p, 0, 0, 0); }
#pragma unroll
            for (int r = 0; r < 16; ++r) { const int j = 32 * t + (r & 3) + 8 * (r >> 2) + 4 * hio; const int dd = io - j; p[r] *= __builtin_amdgcn_exp2f(dd >= 0 ? lf * (float)dd : lb * (float)(-dd)); }
            bf16x8 pa0, pa1;
#define PK4(P, BASE, OUT) do { unsigned a0 = cvtpk(P[BASE + 0], P[BASE + 1]), a1 = cvtpk(P[BASE + 2], P[BASE + 3]);   \
    unsigned b0 = cvtpk(P[BASE + 4], P[BASE + 5]), b1 = cvtpk(P[BASE + 6], P[BASE + 7]);                              \
    auto r0 = __builtin_amdgcn_permlane32_swap(a0, b0, false, false); auto r1 = __builtin_amdgcn_permlane32_swap(a1, b1, false, false); \
    u32x4 w = {r0[0], r1[0], r0[1], r1[1]}; OUT = *reinterpret_cast<bf16x8*>(&w); } while (0)
            PK4(p, 0, pa0); PK4(p, 8, pa1);
#undef PK4
            const int vimg = vimg0 + (t >> 1) * 8192;
#pragma unroll
            for (int et = 0; et < 2; ++et) {
                s16x4 l0, h0, l1, h1;
                if ((t & 1) == 0) { l0 = tr_read<vc_rd_off(0, 0)>(vimg + et * 512); h0 = tr_read<vc_rd_off(0, 1)>(vimg + et * 512); l1 = tr_read<vc_rd_off(1, 0)>(vimg + et * 512); h1 = tr_read<vc_rd_off(1, 1)>(vimg + et * 512); }
                else { l0 = tr_read<vc_rd_off(2, 0)>(vimg + et * 512); h0 = tr_read<vc_rd_off(2, 1)>(vimg + et * 512); l1 = tr_read<vc_rd_off(3, 0)>(vimg + et * 512); h1 = tr_read<vc_rd_off(3, 1)>(vimg + et * 512); }
                asm volatile("s_waitcnt lgkmcnt(0)" ::: "memory"); __builtin_amdgcn_sched_barrier(0);
                acc[et] = __builtin_amdgcn_mfma_f32_32x32x16_bf16(RET_PK(l0, h0), pa0, acc[et], 0, 0, 0);
                acc[et] = __builtin_amdgcn_mfma_f32_32x32x16_bf16(RET_PK(l1, h1), pa1, acc[et], 0, 0, 0);
            }
            asm volatile("" ::: "memory");
        }
        const float xf = __builtin_amdgcn_exp2f(lf * (float)(i + 1)), xb = __builtin_amdgcn_exp2f(lb * (float)(128 - i));
        const bf16_t* gp = proj + (row0 + i) * NPROJ + PC_RG + u.h * 64; bf16_t* op = mix + (row0 + i) * D + 512 + u.h * 64; const float* gr = g_ret + u.h * 64;
        u32x2 gwv[2][4];
#pragma unroll
        for (int et = 0; et < 2; ++et)
#pragma unroll
            for (int g = 0; g < 4; ++g) gwv[et][g] = *(const u32x2*)(gp + 32 * et + 8 * g + 4 * hi);
        bf16x8 qf[4], qbk[4];
#pragma unroll
        for (int ks = 0; ks < 4; ++ks) { qf[ks] = scale8(q[ks], xf); qbk[ks] = scale8(q[ks], xb); }
#pragma unroll
        for (int et = 0; et < 2; ++et) {
#pragma unroll
            for (int ks = 0; ks < 4; ++ks) acc[et] = __builtin_amdgcn_mfma_f32_32x32x16_bf16(rff[et][ks], qf[ks], acc[et], 0, 0, 0);
#pragma unroll
            for (int ks = 0; ks < 4; ++ks) acc[et] = __builtin_amdgcn_mfma_f32_32x32x16_bf16(rbf[et][ks], qbk[ks], acc[et], 0, 0, 0); }
        float s1 = 0.f;
#pragma unroll
        for (int et = 0; et < 2; ++et)
#pragma unroll
            for (int r = 0; r < 16; ++r) s1 += acc[et][r];
        { auto rr = __builtin_amdgcn_permlane32_swap(__float_as_uint(s1), __float_as_uint(s1), false, false); s1 = __uint_as_float(rr[0]) + __uint_as_float(rr[1]); }
        const float mu = s1 * (1.f / 64.f); float s2 = 0.f;
#pragma unroll
        for (int et = 0; et < 2; ++et)
#pragma unroll
            for (int r = 0; r < 16; ++r) { const float dlt = acc[et][r] - mu; s2 += dlt * dlt; }
        { auto rr = __builtin_amdgcn_permlane32_swap(__float_as_uint(s2), __float_as_uint(s2), false, false); s2 = __uint_as_float(rr[0]) + __uint_as_float(rr[1]); }
        const float rs = 1.f / sqrtf(s2 * (1.f / 64.f) + EPS);
#pragma unroll
        for (int et = 0; et < 2; ++et)
#pragma unroll
            for (int g = 0; g < 4; ++g) { const int e = 32 * et + 8 * g + 4 * hi; const u32x2 gw = gwv[et][g]; const f32x4 gg = *(const f32x4*)(gr + e);
                const float o0 = (acc[et][4 * g] - mu) * rs * gg.x * __uint_as_float(gw.x << 16), o1 = (acc[et][4 * g + 1] - mu) * rs * gg.y * __uint_as_float(gw.x & 0xffff0000u);
                const float o2 = (acc[et][4 * g + 2] - mu) * rs * gg.z * __uint_as_float(gw.y << 16), o3 = (acc[et][4 * g + 3] - mu) * rs * gg.w * __uint_as_float(gw.y & 0xffff0000u);
                u32x2 w; w.x = cvtpk(o0, o1); w.y = cvtpk(o2, o3); *(u32x2*)(op + e) = w; }
        if (ui + 1 < nunits) {
#pragma unroll
            for (int ks = 0; ks < 4; ++ks) q[ks] = qn[ks]; }
        u = un;
        asm volatile("s_waitcnt vmcnt(0)" ::: "memory"); __syncthreads();
    }
#undef RG_LOAD
}
#undef RET_PK
}

__device__ __forceinline__ void p4_attn(const Ctx& c, float* lds) {
    const int G = (int)gridDim.x, bx = (int)blockIdx.x; const int vcu = (G % 8 == 0) ? (bx % 8) * (G / 8) + bx / 8 : bx;
    for (int unit = vcu; unit < NB * NH * 16; unit += G) {
        const int qblk = unit & 15, h = (unit >> 4) & 7, b = unit >> 7;
        att::attn_unit(c.qb() + (size_t)(b * SEQ + qblk * 256) * QW + h * 96, c.kvb() + h * 128, c.proj() + PC_KR, c.kvb() + h * 128 + 64,
                       c.mix() + (size_t)(b * SEQ + qblk * 256) * D + h * 64, b, (char*)lds, c.tid);
    }
}
__device__ __forceinline__ void p3c_scan(const Ctx& c, float* lds) {
    const int bx = (int)blockIdx.x;
    for (int seq = bx >> 1; seq < NB * NH * 2 && (bx & 1) == 0; seq += (int)gridDim.x >> 1) {
        const int dir = seq & 1, h = (seq >> 1) & 7, b = seq >> 4;
        const float lg2 = lg2_of(dir ? c.exp_b()[h] : c.exp_f()[h]);
        ret::scan_seq(c.proj(), c.rst() + (size_t)((b * NH + h) * 2 + dir) * NCH * 4096, b, h, dir, lg2, (char*)lds, c.tid);
    }
    __syncthreads();
    {
      unsigned* qctr = (unsigned*)(c.wsb() + WS_CTL) + 2048; int* qslot = (int*)(lds + 8 * 64 * 65 + 640);
      const int first = (int)gridDim.x == 256 ? QSTATIC : 0;
      int nq = 0; if (c.tid == 0) nq = first + (int)__hip_atomic_fetch_add(qctr, 1u, __ATOMIC_RELAXED, __HIP_MEMORY_SCOPE_AGENT);
      for (;;) { if (c.tid == 0) *qslot = nq;
          __syncthreads(); const int q = *qslot; __syncthreads();
          if (q >= EXP_STRIPS) break;
          if (c.tid == 0) nq = first + (int)__hip_atomic_fetch_add(qctr, 1u, __ATOMIC_RELAXED, __HIP_MEMORY_SCOPE_AGENT);
          expert_strip(c, lds, q); } }
    __syncthreads();
}
__device__ __forceinline__ void p4_ret(const Ctx& c, float* lds) {
    const int tid = c.tid, wid = tid >> 6, lane = tid & 63, grp = wid >> 2, w4 = wid & 3;
    const int G = (int)gridDim.x, bx = (int)blockIdx.x; const int vcu = (G % 8 == 0) ? (bx % 8) * (G / 8) + bx / 8 : bx;
    const int gid = vcu * 2 + grp, ngrp = 2 * G; const int total = NB * NH * NCH;
    const int nun = (total - gid + ngrp - 1) / ngrp;
    __syncthreads();
    ret::ret_group(c.proj(), c.rst(), c.g_ret(), c.exp_f(), c.exp_b(), c.mix(), nun,
                   [gid, ngrp](int k) { const int unit = gid + ngrp * k; return ret::RetUnit{unit >> 8, (unit >> 5) & 7, unit & 31}; }, (char*)lds + grp * 2 * ret::RBUF, tid & 255, w4, lane);
}

struct EpiRes {
    static constexpr bool PERM = true;
    const float* x; bf16_t* out; const float* modv; float* part;
    __device__ __forceinline__ void operator()(const f32x4 (&acc)[2][2][4][2], const pg8::Unit& u, int wr, int wc, int fr, int fq) const {
        const int row0 = u.pm * 256 + wr * 64 + fr, col0 = u.pn * 256 + wc * 32 + 8 * fq; const int b = (u.pm * 256) / SEQ;
        f32x4 ga[2][2];
#pragma unroll
        for (int bj = 0; bj < 2; ++bj) { ga[bj][0] = *(const f32x4*)(modv + b * 6144 + 2048 + col0 + bj * 128); ga[bj][1] = *(const f32x4*)(modv + b * 6144 + 2048 + col0 + bj * 128 + 4); }
#pragma unroll
        for (int ai = 0; ai < 2; ++ai) {
            f32x4 xv[4][2][2];
#pragma unroll
            for (int m = 0; m < 4; ++m)
#pragma unroll
                for (int bj = 0; bj < 2; ++bj) { const float* xr = x + (size_t)(row0 + ai * 128 + m * 16) * D + col0 + bj * 128; xv[m][bj][0] = __builtin_nontemporal_load((const f32x4*)xr); xv[m][bj][1] = __builtin_nontemporal_load((const f32x4*)(xr + 4)); }
#pragma unroll
            for (int m = 0; m < 4; ++m) { float ssq = 0.f, mx = 0.f;
#pragma unroll
                for (int bj = 0; bj < 2; ++bj) { const f32x4 y0 = xv[m][bj][0] + ga[bj][0] * acc[ai][bj][m][0], y1 = xv[m][bj][1] + ga[bj][1] * acc[ai][bj][m][1];
                    const float o[8] = {y0.x, y0.y, y0.z, y0.w, y1.x, y1.y, y1.z, y1.w}; store8_bf16(out + (size_t)(row0 + ai * 128 + m * 16) * D + col0 + bj * 128, o);
                    const f32x4 tm = __builtin_elementwise_max(__builtin_elementwise_abs(y0), __builtin_elementwise_abs(y1)), sq = y0 * y0 + y1 * y1;
                    ssq += (sq.x + sq.y) + (sq.z + sq.w); mx = fmaxf(mx, fmaxf(fmaxf(tm.x, tm.y), fmaxf(tm.z, tm.w))); }
                ssq += __shfl_xor(ssq, 16); ssq += __shfl_xor(ssq, 32); mx = fmaxf(mx, __shfl_xor(mx, 16)); mx = fmaxf(mx, __shfl_xor(mx, 32));
                if (fq == 0) { float* pp = part + (size_t)(row0 + ai * 128 + m * 16) * 32 + u.pn * 4 + wc; pp[0] = ssq; pp[16] = mx; } }
            asm volatile("" ::: "memory");
        }
    }
};
__device__ __forceinline__ void p6_wo(const Ctx& c, float* lds) {
    pg8::Gemm g{c.mix(), c.wo_t(), D, D, D, nullptr, 0, 0, 0};
    pg8::StaticOrder S; S.init(RL, D, (int)gridDim.x, (int)blockIdx.x);
    EpiRes E{c.x(), c.x1b(), c.modv(), c.rpart()};
    pg8::gemm_phase((LAS unsigned char*)lds, g, S, E, c.tid);
}
__device__ __forceinline__ void p7_norm_router(const Ctx& c, float* lds) {
    typedef short bf16x8_t __attribute__((ext_vector_type(8)));
    constexpr int WP = 1032;
    bf16_t* whi = (bf16_t*)lds; bf16_t* wlo = whi + 16 * WP; float* gsl = (float*)(wlo + 16 * WP); float* shl = gsl + 1024; float* gpl = shl + 1024;
    const int G = (int)gridDim.x, bx = (int)blockIdx.x;
    bool first = true;
    for (int blk = bx; blk < RL / 128; blk += G) {
        const int b = (blk * 128) / SEQ; const float* md = c.modv() + b * 6144;
        const int fr = c.lane & 15, fq = c.lane >> 4; const int row = blk * 128 + c.wave * 16 + fr;
        const bf16_t* xr2 = c.x1b() + (size_t)row * D + 16 * fq;
        float wv[32];
        if (first) {
#pragma unroll
            for (int it = 0; it < 32; ++it) wv[it] = c.w_router()[c.tid + 512 * it]; }
        u32x4 xw[32];
#pragma unroll
        for (int i = 0; i < 16; ++i) xw[i] = *(const u32x4*)(xr2 + 64 * (i >> 1) + 8 * (i & 1));
        asm volatile("s_waitcnt lgkmcnt(0)\n\ts_barrier" ::: "memory");
        for (int k = c.tid; k < 1024; k += 512) { gsl[k] = c.g_ffn()[k] * (1.f + md[4096 + k]); shl[k] = md[3072 + k]; }
        if (first) { int tl = c.tid; asm volatile("" : "+v"(tl));
#pragma unroll
            for (int it = 0; it < 32; ++it) { const int i = tl + 512 * it, k = i >> 4, e = i & 15; const float w = wv[it]; const bf16_t h = f2bf(w); whi[e * WP + k] = h; wlo[e * WP + k] = f2bf(w - bf2f(h)); }
            first = false; }
#pragma unroll
        for (int i = 16; i < 32; ++i) xw[i] = *(const u32x4*)(xr2 + 64 * (i >> 1) + 8 * (i & 1));
        asm volatile("s_waitcnt lgkmcnt(0)\n\ts_barrier" ::: "memory");
        if (c.tid < 16) { float gm = 0.f; const int c0_ = (c.tid >> 2) * 256 + (c.tid & 3) * 32;
            for (int k = 0; k < 32; ++k) gm = fmaxf(gm, fmaxf(fabsf(gsl[c0_ + k]), fabsf(gsl[c0_ + 128 + k])));
            gpl[c.tid] = gm; }
        asm volatile("s_waitcnt lgkmcnt(0)\n\ts_barrier" ::: "memory");
        const LAS float* gs_l = (const LAS float*)gsl; const LAS float* sh_l = (const LAS float*)shl;
        float shm = 0.f;
#pragma unroll
        for (int i = 0; i < 4; ++i) { const f32x4 s4 = *(const LAS f32x4*)(sh_l + 4 * c.lane + 256 * i); shm = fmaxf(fmaxf(shm, fmaxf(fabsf(s4.x), fabsf(s4.y))), fmaxf(fabsf(s4.z), fabsf(s4.w))); }
#pragma unroll
        for (int o = 1; o < 64; o <<= 1) shm = fmaxf(shm, __shfl_xor(shm, o));
        const f32x4 ps = *(const f32x4*)(c.rpart() + (size_t)row * 32 + 4 * fq), pm4 = *(const f32x4*)(c.rpart() + (size_t)row * 32 + 16 + 4 * fq);
        float ss = (ps.x + ps.y) + (ps.z + ps.w), mx; { const f32x4 gq = *(const LAS f32x4*)((const LAS float*)gpl + 4 * fq); mx = fmaxf(fmaxf(pm4.x * gq.x, pm4.y * gq.y), fmaxf(pm4.z * gq.z, pm4.w * gq.w)) * 1.00390625f; }
        ss += __shfl_xor(ss, 16); ss += __shfl_xor(ss, 32); mx = fmaxf(mx, __shfl_xor(mx, 16)); mx = fmaxf(mx, __shfl_xor(mx, 32));
        const float rinv = 1.f / sqrtf(ss * (1.f / D) + EPS);
        const float bnd = fmaxf(rinv * mx + shm, 1e-30f), qs = 127.f / bnd;
        if (fq == 0) c.sa()[row] = bnd * (1.f / 127.f);
        f32x4 acc = {0.f, 0.f, 0.f, 0.f};
        const LAS bf16_t* wh_l = (const LAS bf16_t*)whi + fr * WP + 16 * fq; const LAS bf16_t* wl_l = (const LAS bf16_t*)wlo + fr * WP + 16 * fq;
        signed char* hq = c.h2q() + (size_t)row * D + 16 * fq;
#pragma unroll
        for (int ks2 = 0; ks2 < 16; ++ks2) { u32x4 qo;
#pragma unroll
            for (int hf = 0; hf < 2; ++hf) { const int ko = 64 * ks2 + 8 * hf; const u32x4 w = xw[2 * ks2 + hf];
                const f32x4 g0 = *(const LAS f32x4*)(gs_l + 16 * fq + ko), g1 = *(const LAS f32x4*)(gs_l + 16 * fq + ko + 4), s0 = *(const LAS f32x4*)(sh_l + 16 * fq + ko), s1 = *(const LAS f32x4*)(sh_l + 16 * fq + ko + 4);
                float h[8];
                h[0] = __uint_as_float(w.x << 16) * rinv * g0.x + s0.x; h[1] = __uint_as_float(w.x & 0xffff0000u) * rinv * g0.y + s0.y; h[2] = __uint_as_float(w.y << 16) * rinv * g0.z + s0.z; h[3] = __uint_as_float(w.y & 0xffff0000u) * rinv * g0.w + s0.w;
                h[4] = __uint_as_float(w.z << 16) * rinv * g1.x + s1.x; h[5] = __uint_as_float(w.z & 0xffff0000u) * rinv * g1.y + s1.y; h[6] = __uint_as_float(w.w << 16) * rinv * g1.z + s1.z; h[7] = __uint_as_float(w.w & 0xffff0000u) * rinv * g1.w + s1.w;
                const unsigned qa = q8pack(h[0], h[1], h[2], h[3], qs), qb = q8pack(h[4], h[5], h[6], h[7], qs);
                if (hf == 0) { qo.x = qa; qo.y = qb; } else { qo.z = qa; qo.w = qb; }
                u32x4 hi; hi.x = pk2(h[0], h[1]); hi.y = pk2(h[2], h[3]); hi.z = pk2(h[4], h[5]); hi.w = pk2(h[6], h[7]);
                u32x4 lo; lo.x = pk2(h[0] - __uint_as_float(hi.x << 16), h[1] - __uint_as_float(hi.x & 0xffff0000u)); lo.y = pk2(h[2] - __uint_as_float(hi.y << 16), h[3] - __uint_as_float(hi.y & 0xffff0000u));
                lo.z = pk2(h[4] - __uint_as_float(hi.z << 16), h[5] - __uint_as_float(hi.z & 0xffff0000u)); lo.w = pk2(h[6] - __uint_as_float(hi.w << 16), h[7] - __uint_as_float(hi.w & 0xffff0000u));
                const bf16x8_t bh = *(const LAS bf16x8_t*)(wh_l + ko), bl = *(const LAS bf16x8_t*)(wl_l + ko);
                const bf16x8_t ah = __builtin_bit_cast(bf16x8_t, hi), al = __builtin_bit_cast(bf16x8_t, lo);
                acc = __builtin_amdgcn_mfma_f32_16x16x32_bf16(ah, bh, acc, 0, 0, 0);
                acc = __builtin_amdgcn_mfma_f32_16x16x32_bf16(al, bh, acc, 0, 0, 0);
                acc = __builtin_amdgcn_mfma_f32_16x16x32_bf16(ah, bl, acc, 0, 0, 0); }
            *(u32x4*)(hq + 64 * ks2) = qo;
            asm volatile("" ::: "memory"); }
        float ov[4];
#pragma unroll
        for (int i = 0; i < 4; ++i) { float mx = acc[i];
            mx = fmaxf(mx, __shfl_xor(mx, 1)); mx = fmaxf(mx, __shfl_xor(mx, 2)); mx = fmaxf(mx, __shfl_xor(mx, 4)); mx = fmaxf(mx, __shfl_xor(mx, 8));
            const float ex = __expf(acc[i] - mx); float den = ex;
            den += __shfl_xor(den, 1); den += __shfl_xor(den, 2); den += __shfl_xor(den, 4); den += __shfl_xor(den, 8);
            ov[i] = ex / den; }
        const int t0 = (blk * 128 + c.wave * 16 + 4 * fq) & (SEQ - 1);
        *(f32x4*)(c.aff() + (size_t)(b * NE + fr) * SEQ + t0) = (f32x4){ov[0], ov[1], ov[2], ov[3]};
    }
}
__device__ __forceinline__ int block_excl_scan(int v, int& tot, int* lw, int tid) {
    const int lane = tid & 63, wv = tid >> 6; int inc = v;
#pragma unroll
    for (int o = 1; o < 64; o <<= 1) { const int u = __shfl_up(inc, o); if (lane >= o) inc += u; }
    __syncthreads();
    if (lane == 63) lw[wv] = inc;
    __syncthreads();
    int base = 0; tot = 0;
#pragma unroll
    for (int w = 0; w < 8; ++w) { const int x = lw[w]; if (w < wv) base += x; tot += x; }
    return base + inc - v;
}
__device__ __forceinline__ void p8_topk(const Ctx& c, float* lds) {
    int* cnt = (int*)lds;
    int* lw = (int*)lds + 64;
    for (int unit = blockIdx.x; unit < NB * NE; unit += gridDim.x) {
        const int b = unit >> 4, e = unit & 15; const float* a = c.aff() + (size_t)unit * SEQ;
        const f32x4 v0 = *(const f32x4*)(a + 8 * c.tid), v1 = *(const f32x4*)(a + 8 * c.tid + 4);
        unsigned u[8] = {__float_as_uint(v0.x), __float_as_uint(v0.y), __float_as_uint(v0.z), __float_as_uint(v0.w), __float_as_uint(v1.x), __float_as_uint(v1.y), __float_as_uint(v1.z), __float_as_uint(v1.w)};
        __syncthreads();
        if (c.tid < 32) cnt[c.tid] = 0;
        __syncthreads();
        unsigned T = 0u;
        for (int bit = 30; bit >= 0; --bit) {
            const unsigned cand = T | (1u << bit); int cw = 0;
#pragma unroll
            for (int j = 0; j < 8; ++j) cw += __popcll(__ballot(u[j] >= cand));
            if (c.lane == 0) atomicAdd(&cnt[bit], cw);
            __syncthreads();
            if (cnt[bit] >= CAP) T = cand;
        }
        int ngt = 0, neq = 0;
#pragma unroll
        for (int j = 0; j < 8; ++j) { ngt += u[j] > T ? 1 : 0; neq += u[j] == T ? 1 : 0; }
        int tot_gt, tot_eq; const int eq_base = block_excl_scan(neq, tot_eq, lw, c.tid); (void)block_excl_scan(ngt, tot_gt, lw + 16, c.tid);
        const int need = CAP - tot_gt;
        bool sel[8]; int nsel = 0, eqc = eq_base;
#pragma unroll
        for (int j = 0; j < 8; ++j) { const bool isq = u[j] == T; sel[j] = u[j] > T || (isq && eqc < need); eqc += isq ? 1 : 0; nsel += sel[j] ? 1 : 0; }
        int tot_sel; int slot = block_excl_scan(nsel, tot_sel, lw + 32, c.tid);
        int iv[8];
#pragma unroll
        for (int j = 0; j < 8; ++j) { iv[j] = sel[j] ? slot : -1;
            if (sel[j]) { c.seli()[unit * CAP + slot] = b * SEQ + 8 * c.tid + j; c.selg()[unit * CAP + slot] = __uint_as_float(u[j]); c.sels()[unit * CAP + slot] = c.sa()[b * SEQ + 8 * c.tid + j]; ++slot; } }
#pragma unroll
        for (int j = 0; j < 8; ++j) c.inv()[(size_t)(b * SEQ + 8 * c.tid + j) * NE + e] = iv[j];
    }
    __syncthreads();
}
struct EpiGateUpQ {
    static constexpr bool PERM = true;
    unsigned char* act; const float* sels; const float* sw;
    __device__ __forceinline__ void operator()(const f32x4 (&acc)[2][2][4][2], const pg8::Unit& u, int wr, int wc, int fr, int fq) const {
        const int row0 = u.pm * 256 + wr * 64 + fr, col0 = u.pn * 256 + wc * 32 + 8 * fq; const float* swe = sw + ((u.pm >> 1) & 15) * 1536 + col0;
        float rs[8];
#pragma unroll
        for (int i = 0; i < 8; ++i) rs[i] = sels[row0 + (i >> 2) * 128 + (i & 3) * 16];
        const f32x4 sg0 = *(const f32x4*)swe, su0 = *(const f32x4*)(swe + 4), sg1 = *(const f32x4*)(swe + 128), su1 = *(const f32x4*)(swe + 132);
#pragma unroll
        for (int ai = 0; ai < 2; ++ai)
#pragma unroll
            for (int m = 0; m < 4; ++m) { const float r_ = rs[ai * 4 + m];
#pragma unroll
                for (int bj = 0; bj < 2; ++bj) { const f32x4 gt = acc[ai][bj][m][0] * (bj ? sg1 : sg0) * r_, up = acc[ai][bj][m][1] * (bj ? su1 : su0) * r_;
                    *(unsigned*)(act + (size_t)(row0 + ai * 128 + m * 16) * DE + ((col0 + bj * 128) >> 1)) = f8pack(silu_f(gt[0]) * up[0], silu_f(gt[1]) * up[1], silu_f(gt[2]) * up[2], silu_f(gt[3]) * up[3]); } }
    }
};
__device__ __forceinline__ void p9_gateup(const Ctx& c, float* lds) {
    pg8::Gemm g{(const bf16_t*)c.h2q(), (const bf16_t*)c.wgu_q(), D / 2, D / 2, D / 2, c.seli(), 1, 15, (size_t)1536 * 512};
    pg8::ExpertOrder S; S.init(NSLOT, 1536, (int)gridDim.x, (int)blockIdx.x);
    EpiGateUpQ E{(unsigned char*)c.actq(), c.sels(), c.swgu()};
    pg8::gemm_phase<1, true>((LAS unsigned char*)lds, g, S, E, c.tid);
}
struct EpiDownQ {
    static constexpr bool PERM = true;
    bf16_t* yb; const float* rsc; const float* sw;
    __device__ __forceinline__ void operator()(const f32x4 (&acc)[2][2][4][2], const pg8::Unit& u, int wr, int wc, int fr, int fq) const {
        const int row0 = u.pm * 256 + wr * 64 + fr, col0 = u.pn * 256 + wc * 32 + 8 * fq; const float* swe = sw + ((u.pm >> 1) & 15) * 1024 + col0;
        float gg[8];
#pragma unroll
        for (int i = 0; i < 8; ++i) gg[i] = rsc[row0 + (i >> 2) * 128 + (i & 3) * 16];
        const f32x4 s00 = *(const f32x4*)swe, s01 = *(const f32x4*)(swe + 4), s10 = *(const f32x4*)(swe + 128), s11 = *(const f32x4*)(swe + 132);
#pragma unroll
        for (int ai = 0; ai < 2; ++ai)
#pragma unroll
            for (int m = 0; m < 4; ++m) { const float g_ = gg[ai * 4 + m];
#pragma unroll
                for (int bj = 0; bj < 2; ++bj) { const f32x4 a = acc[ai][bj][m][0] * (bj ? s10 : s00) * g_, b = acc[ai][bj][m][1] * (bj ? s11 : s01) * g_; const float o[8] = {a[0], a[1], a[2], a[3], b[0], b[1], b[2], b[3]};
                    store8_bf16(yb + (size_t)(row0 + ai * 128 + m * 16) * D + col0 + bj * 128, o); } }
    }
};
__device__ __forceinline__ void p10_down(const Ctx& c, float* lds) {
    pg8::Gemm g{(const bf16_t*)c.actq(), (const bf16_t*)c.wdn_q(), DE / 2, DE / 2, DE / 2, nullptr, 1, 15, (size_t)1024 * 384};
    pg8::ExpertOrder S; S.init(NSLOT, D, (int)gridDim.x, (int)blockIdx.x);
    EpiDownQ E{c.yb(), c.selg(), c.swdn()};
    pg8::gemm_phase<2>((LAS unsigned char*)lds, g, S, E, c.tid);
}
__device__ __forceinline__ void p11_final(const Ctx& c) {
    for (int r0 = c.gw * 2; r0 < RL; r0 += c.ngw * 2) {
        const int b = r0 / SEQ;
        int sl[2]; f32x4 x1[2][4]; f32x4 acc[2][4];
#pragma unroll
        for (int q = 0; q < 2; ++q) { sl[q] = c.lane < NE ? c.inv()[(size_t)(r0 + q) * NE + c.lane] : -1;
#pragma unroll
            for (int j = 0; j < 4; ++j) { const u32x2 w = __builtin_nontemporal_load((const u32x2*)(c.x1b() + (size_t)(r0 + q) * D + 4 * c.lane + 256 * j));
                x1[q][j] = (f32x4){__uint_as_float(w.x << 16), __uint_as_float(w.x & 0xffff0000u), __uint_as_float(w.y << 16), __uint_as_float(w.y & 0xffff0000u)}; acc[q][j] = (f32x4){0.f, 0.f, 0.f, 0.f}; } }
#pragma unroll
        for (int q = 0; q < 2; ++q) {
            unsigned long long m = __ballot(sl[q] >= 0);
            while (m) { const int e = __builtin_ctzll(m); m &= m - 1; const int slot = __builtin_amdgcn_readlane(sl[q], e);
                const bf16_t* yr = c.yb() + (size_t)((b * NE + e) * CAP + slot) * D;
#pragma unroll
                for (int j = 0; j < 4; ++j) { const u32x2 w = __builtin_nontemporal_load((const u32x2*)(yr + 4 * c.lane + 256 * j));
                    acc[q][j].x += __uint_as_float(w.x << 16); acc[q][j].y += __uint_as_float(w.x & 0xffff0000u); acc[q][j].z += __uint_as_float(w.y << 16); acc[q][j].w += __uint_as_float(w.y & 0xffff0000u); } } }
        const float* md = c.modv() + b * 6144 + 5120; float ss[2] = {0.f, 0.f};
#pragma unroll
        for (int j = 0; j < 4; ++j) { const int k = 4 * c.lane + 256 * j; const f32x4 ga = *(const f32x4*)(md + k);
#pragma unroll
            for (int q = 0; q < 2; ++q) { x1[q][j] = x1[q][j] + ga * acc[q][j]; ss[q] += x1[q][j].x * x1[q][j].x + x1[q][j].y * x1[q][j].y + x1[q][j].z * x1[q][j].z + x1[q][j].w * x1[q][j].w; } }
        const float ri0 = 1.f / sqrtf(wave_sum(ss[0]) * (1.f / D) + EPS), ri1 = 1.f / sqrtf(wave_sum(ss[1]) * (1.f / D) + EPS);
#pragma unroll
        for (int j = 0; j < 4; ++j) { const int k = 4 * c.lane + 256 * j; const f32x4 g = *(const f32x4*)(c.g_final() + k);
            __builtin_nontemporal_store(x1[0][j] * ri0 * g, (f32x4*)(c.out() + (size_t)r0 * D + k)); __builtin_nontemporal_store(x1[1][j] * ri1 * g, (f32x4*)(c.out() + (size_t)(r0 + 1) * D + k)); }
    }
}

#define XB_TMO      128
#define XB_XCNT(j)  (256  + 64 * (j))
#define XB_XSUB(j)  (1280 + 64 * (j))
#define XB_XGEN(j)  (2304 + 64 * (j))
#define XB_TOP      3328
#define XB_TOPGEN   3392
#define XCD_BAR_WORDS 3456
#define XB_SPIN_CAP (1u << 18)

__device__ __forceinline__ unsigned xb_ld(unsigned* p)              { return __hip_atomic_load(p, __ATOMIC_RELAXED, __HIP_MEMORY_SCOPE_AGENT); }
__device__ __forceinline__ unsigned xb_add(unsigned* p, unsigned v) { return __hip_atomic_fetch_add(p, v, __ATOMIC_RELAXED, __HIP_MEMORY_SCOPE_AGENT); }
__device__ __forceinline__ unsigned xb_xcc_id() { return (unsigned)__builtin_amdgcn_s_getreg((3 << 11) | 20) & 0xFu; }
#define XB_SPIN(cond, bar) do { unsigned _sp = 0; while (cond) { __builtin_amdgcn_s_sleep(1); \
    if ((++_sp & 255u) == 0u) { if (xb_ld(&(bar)[XB_TMO])) break; if (_sp > XB_SPIN_CAP) { atomicAdd(&(bar)[XB_TMO], 1u); break; } } } } while (0)

struct XcdBarrier {
    unsigned* bar; unsigned x;
    volatile LAS unsigned* st;
};
__device__ __forceinline__ XcdBarrier xcd_barrier_post(unsigned* bar, volatile LAS unsigned* st, bool t0) {
    XcdBarrier b; b.bar = bar; b.x = xb_xcc_id(); b.st = st;
    if (t0) (void)xb_add(&bar[XB_XCNT(b.x)], 1u);
    return b;
}
__device__ __forceinline__ void xcd_barrier_complete(unsigned* bar, unsigned x, unsigned& nloc, unsigned& nx) {
    const unsigned G = gridDim.x * gridDim.y * gridDim.z;
    unsigned sum, cnt, mine, sp = 0u;
    for (;;) {
        sum = 0u; cnt = 0u; mine = 0u;
#pragma unroll
        for (unsigned j = 0; j < 16; ++j) { const unsigned c = xb_ld(&bar[XB_XCNT(j)]); sum += c; cnt += (c > 0u) ? 1u : 0u; mine = (j == x) ? c : mine; }
        if (sum == G) break;
        __builtin_amdgcn_s_sleep(1);
        if ((++sp & 255u) == 0u) { if (xb_ld(&bar[XB_TMO])) break; if (sp > XB_SPIN_CAP) { atomicAdd(&bar[XB_TMO], 1u); break; } }
    }
    nloc = mine > 0u ? mine : 1u; nx = cnt > 0u ? cnt : 1u;
}
__device__ __forceinline__ void xcd_barrier(const XcdBarrier& b, bool t0) {
    asm volatile("s_waitcnt vmcnt(0)" ::: "memory");
    __syncthreads();
    if (t0) {
        unsigned* bar = b.bar;
        __builtin_amdgcn_s_waitcnt(0);
        unsigned nloc = b.st[0], nx = b.st[1];
        if (nloc == 0u) { xcd_barrier_complete(bar, b.x, nloc, nx); b.st[0] = nloc; b.st[1] = nx; }
        const unsigned old = xb_add(&bar[XB_XSUB(b.x)], 1u);
        const unsigned gen = old / nloc;
        if (old + 1u == (gen + 1u) * nloc) {
            __builtin_amdgcn_fence(__ATOMIC_RELEASE, "agent");
            asm volatile("s_waitcnt vmcnt(0)" ::: "memory");
            const unsigned og = xb_add(&bar[XB_TOP], 1u);
            const unsigned tg = og / nx;
            if (og + 1u == (tg + 1u) * nx) xb_add(&bar[XB_TOPGEN], 1u);
            else XB_SPIN(xb_ld(&bar[XB_TOPGEN]) == tg, bar);
            __builtin_amdgcn_fence(__ATOMIC_ACQUIRE, "agent");
            xb_add(&bar[XB_XGEN(b.x)], 1u);
            asm volatile("s_waitcnt vmcnt(0)" ::: "memory");
        } else {
            XB_SPIN(xb_ld(&bar[XB_XGEN(b.x)]) == gen, bar);
            __builtin_amdgcn_fence(__ATOMIC_ACQUIRE, "agent");
            asm volatile("s_waitcnt vmcnt(0)" ::: "memory");
        }
    }
    __syncthreads();
}

template <int PH0, int PH1> __global__ void __launch_bounds__(512, 2) fwd_kernel(Args args) {
    extern __shared__ __attribute__((aligned(16))) unsigned char lds_raw[];
    float* lds = (float*)lds_raw;
    volatile LAS unsigned* xbst = (volatile LAS unsigned*)((LAS unsigned char*)lds_raw + (LDS_BYTES - 16));
    const int wave_s = __builtin_amdgcn_readfirstlane((int)threadIdx.x >> 6);
#define TID_NOW() ([&]() { unsigned z_ = 0u; asm volatile("" : "+v"(z_)); return wave_s * 64 + (int)__builtin_amdgcn_mbcnt_hi(~0u, __builtin_amdgcn_mbcnt_lo(~0u, z_)); }())
    if (TID_NOW() == 0) { xbst[0] = 0u; xbst[1] = 0u; }
    __syncthreads();
    XcdBarrier bar; bar.bar = nullptr; bar.x = 0; bar.st = nullptr;
    if constexpr (PH1 - PH0 > 1) bar = xcd_barrier_post((unsigned*)(args.ws + WS_CTL) + 4096, xbst, TID_NOW() == 0);
#define GRID_BAR(k) do { if constexpr (PH1 - PH0 > 1) { if (lo <= (k) && (k) + 1 < hi) { xcd_barrier(bar, TID_NOW() == 0); if (BARREP) xcd_barrier(bar, TID_NOW() == 0); } } } while (0)
    const int lo = args.ph_lo, hi = args.ph_hi;
#ifndef PHMASK
#define PHMASK 0xffffffffu
#endif
#ifndef BARREP
#define BARREP 0
#endif
#ifndef REPMASK
#define REPMASK 0u
#endif
#define REP(k) ((REPMASK >> (k)) & 1u)
#define IN(k) (((PHMASK >> (k)) & 1u) && PH0 <= (k) && (k) < PH1 && lo <= (k) && (k) < hi)
#define CTX() Ctx c; { kptr_t kp_ = (kptr_t)__builtin_amdgcn_kernarg_segment_ptr(); asm volatile("" : "+s"(kp_)); c.kp = kp_; int t_ = TID_NOW(); asm volatile("" : "+v"(t_)); int b_ = blockIdx.x; asm volatile("" : "+s"(b_)); c.tid = t_; c.lane = t_ & 63; c.wave = t_ >> 6; c.gw = b_ * 8 + c.wave; c.ngw = gridDim.x * 8; }
    if (IN(0)) { CTX(); p0_mod(c, lds); __syncthreads(); p0_weights<0>(c, lds, c.gw, c.ngw); p0_tables(c); }
    if (REP(0) && IN(0)) { __syncthreads(); CTX(); p0_mod(c, lds); __syncthreads(); p0_weights<0>(c, lds, c.gw, c.ngw); p0_tables(c); }
    GRID_BAR(0);
    if (IN(1)) { CTX(); p1_norm(c); }
    if (REP(1) && IN(1)) { __syncthreads(); CTX(); p1_norm(c); }
    GRID_BAR(1);
    if (IN(2)) { CTX(); p2_proj(c, lds); }
    if (REP(2) && IN(2)) { __syncthreads(); CTX(); p2_proj(c, lds); }
    GRID_BAR(2);
    if (IN(3)) { CTX(); p3_upq(c, lds); }
    if (REP(3) && IN(3)) { __syncthreads(); CTX(); p3_upq(c, lds); }
    if (IN(4)) { CTX(); p3_upkv(c, lds); }
    if (REP(4) && IN(4)) { __syncthreads(); CTX(); p3_upkv(c, lds); }
    if (IN(5)) { CTX(); p3c_scan(c, lds); }
    if (REP(5) && IN(5)) { __syncthreads(); CTX(); p3c_scan(c, lds); }
    GRID_BAR(5);
    if (IN(6)) { CTX(); p4_attn(c, lds); }
    if (REP(6) && IN(6)) { __syncthreads(); CTX(); p4_attn(c, lds); }
    if (IN(7)) { CTX(); p4_ret(c, lds); }
    if (REP(7) && IN(7)) { __syncthreads(); CTX(); p4_ret(c, lds); }
    GRID_BAR(7);
    if (IN(8)) { CTX(); p6_wo(c, lds); }
    if (REP(8) && IN(8)) { __syncthreads(); CTX(); p6_wo(c, lds); }
    GRID_BAR(8);
    if (IN(9)) { CTX(); p7_norm_router(c, lds); }
    if (REP(9) && IN(9)) { __syncthreads(); CTX(); p7_norm_router(c, lds); }
    GRID_BAR(9);
    if (IN(10)) { CTX(); p8_topk(c, lds); }
    if (REP(10) && IN(10)) { __syncthreads(); CTX(); p8_topk(c, lds); }
    GRID_BAR(10);
    if (IN(11)) { CTX(); p9_gateup(c, lds); }
    if (REP(11) && IN(11)) { __syncthreads(); CTX(); p9_gateup(c, lds); }
    GRID_BAR(11);
    if (IN(12)) { CTX(); p10_down(c, lds); }
    if (REP(12) && IN(12)) { __syncthreads(); CTX(); p10_down(c, lds); }
    GRID_BAR(12);
    if (IN(13)) { CTX(); p11_final(c); }
    if (REP(13) && IN(13)) { __syncthreads(); CTX(); p11_final(c); }
#undef IN
}


static hipError_t set_lds_all() { return hipFuncSetAttribute((const void*)fwd_kernel<0, NPH>, hipFuncAttributeMaxDynamicSharedMemorySize, LDS_BYTES); }
static void launch_all(int grid, hipStream_t stream, const Args& a) { hipLaunchKernelGGL((fwd_kernel<0, NPH>), dim3(grid), dim3(512), LDS_BYTES, stream, a); }

extern "C" void kernel_launch(void* const* d_in, const int* in_sizes, int n_in, void* d_out, int out_size, void* d_ws, size_t ws_size, hipStream_t stream) {
    static int grid = 0;
    if (grid == 0) {
        if (n_in != 22 || in_sizes[0] != RL * D || out_size != RL * D || ws_size < WS_END) {
            fprintf(stderr, "kernel_launch: unexpected shapes: n_in %d in0 %d out %d ws %zu (need %zu)\n", n_in, n_in > 0 ? in_sizes[0] : -1, out_size, ws_size, (size_t)WS_END); grid = -1; return; }
        int dev = 0, cus = 0;
        if (hipGetDevice(&dev) != hipSuccess || hipDeviceGetAttribute(&cus, hipDeviceAttributeMultiprocessorCount, dev) != hipSuccess) { grid = -1; return; }
        if (set_lds_all() != hipSuccess) { fprintf(stderr, "kernel_launch: hipFuncSetAttribute failed\n"); grid = -1; return; }
        int per_cu = 0;
        if (MK_SINGLE) { if (hipOccupancyMaxActiveBlocksPerMultiprocessor(&per_cu, (const void*)fwd_kernel<0, NPH>, 512, LDS_BYTES) != hipSuccess || per_cu < 1) { fprintf(stderr, "kernel_launch: occupancy query says %d blocks per CU\n", per_cu); grid = -1; return; } }
        (void)hipGetLastError();
        grid = cus;
    }
    if (grid < 0) return;
    Args a{};
    for (int i = 0; i < 22; ++i) a.in[i] = (const float*)d_in[i];
    a.out = (float*)d_out; a.ws = (unsigned char*)d_ws;
    a.ph_lo = 0; a.ph_hi = NPH;
    if (MK_SINGLE) { if (hipMemsetAsync((char*)d_ws + WS_CTL, 0, CTL_BYTES, stream) != hipSuccess) { fprintf(stderr, "kernel_launch: memset failed\n"); return; } }
    launch_all(grid, stream, a);
}
```

```cpp
#include <hip/hip_runtime.h>
#include <cstdio>
#include <cstdint>

#ifndef MK_SINGLE
#define MK_SINGLE 1
#endif

typedef unsigned short bf16_t;
typedef float f32x4 __attribute__((ext_vector_type(4)));
typedef unsigned u32x4 __attribute__((ext_vector_type(4)));
typedef unsigned u32x2 __attribute__((ext_vector_type(2)));
#define LAS __attribute__((address_space(3)))

constexpr int D = 1024, NB = 8, SEQ = 4096, LC = 256;
constexpr int RL = NB * SEQ, RC = NB * LC, RT = RL + RC;
constexpr int NPROJ = 2560;
constexpr int PC_CQ = 0, PC_CKV = 256, PC_KR = 384, PC_RQ = 512, PC_RK = 1024, PC_RV = 1536, PC_RG = 2048;
constexpr int NH = 8, QW = 768, KVW = 1024;
constexpr int NE = 16, CAP = 512, DE = 768, NSLOT = NB * NE * CAP;
constexpr int NCH = 32;
constexpr float EPS = 1e-6f;
constexpr float QSCALE = 0.10206207261596577f * 1.4426950408889634f;

constexpr size_t MiB = 1u << 20;
constexpr size_t WS_CTL = 0, CTL_BYTES = 64 * 1024;
constexpr size_t WS_MOD = 1 * MiB;
constexpr size_t WS_TABR = 2 * MiB;
constexpr size_t WS_TABM = 3 * MiB;
constexpr size_t WS_PSTAT = 4 * MiB;
constexpr size_t WS_AFF = 6 * MiB;
constexpr size_t WS_SELI = 8 * MiB;
constexpr size_t WS_SELG = 8 * MiB + 512 * 1024;
constexpr size_t WS_INV = 9 * MiB;
constexpr size_t WS_SELS = 11 * MiB;
constexpr size_t WS_WIN = 12 * MiB;
constexpr size_t WS_WUQ = 17 * MiB;
constexpr size_t WS_WUKV = 17 * MiB + 512 * 1024;
constexpr size_t WS_WO = 18 * MiB;
constexpr size_t WS_WGU = 20 * MiB;
constexpr size_t WS_WDN = 68 * MiB;
constexpr size_t WS_H = 92 * MiB;
constexpr size_t WS_RST = 92 * MiB;
constexpr size_t WS_PROJ = 160 * MiB;
constexpr size_t WS_ACT = 160 * MiB;
constexpr size_t WS_YB = 256 * MiB;
constexpr size_t WS_Q = 330 * MiB;
constexpr size_t WS_KV = 378 * MiB;
constexpr size_t WS_MIX = 446 * MiB;
constexpr size_t WS_END = 510 * MiB;
static_assert(WS_PROJ + (size_t)RT * NPROJ * 2 <= WS_Q && WS_Q + (size_t)RL * QW * 2 <= WS_KV && WS_KV + (size_t)RT * KVW * 2 <= WS_MIX, "ws map");
static_assert(WS_H + (size_t)RT * D * 2 <= WS_PROJ && WS_WDN + (size_t)NE * D * DE * 2 <= WS_H && WS_PSTAT + (size_t)RT * 32 <= WS_AFF, "ws map 2");

constexpr int LDS_BYTES = 147456;
constexpr int NPH = 14;

__device__ __forceinline__ float bf2f(bf16_t v) { return __uint_as_float((unsigned)v << 16); }
__device__ __forceinline__ bf16_t f2bf(float f) { unsigned u = __float_as_uint(f); return (bf16_t)((u + 0x7fffu + ((u >> 16) & 1u)) >> 16); }
__device__ __forceinline__ unsigned pk2(float lo, float hi) { unsigned r; asm("v_cvt_pk_bf16_f32 %0, %1, %2" : "=v"(r) : "v"(lo), "v"(hi)); return r; }
__device__ __forceinline__ float wave_sum(float v) {
#pragma unroll
    for (int o = 1; o < 64; o <<= 1) v += __shfl_xor(v, o);
    return v;
}
__device__ __forceinline__ float silu_f(float v) { return v / (1.f + __expf(-v)); }

struct Args {
    const float* in[22]; float* out; unsigned char* ws; int ph_lo, ph_hi;
};

typedef __attribute__((address_space(4))) const char* kptr_t;
typedef const float* cfp_t; typedef float* fp_t; typedef unsigned char* ucp_t;
typedef __attribute__((address_space(4))) const cfp_t* kcfpp; typedef __attribute__((address_space(4))) const fp_t* kfpp; typedef __attribute__((address_space(4))) const ucp_t* kucpp;
static_assert(sizeof(Args) == 200, "Args layout: in[22] @0, out @176, ws @184, ph_lo @192, ph_hi @196");
struct Ctx {
    kptr_t kp; int tid, lane, wave, gw, ngw;
    __device__ __forceinline__ const float* in(int i) const { return *(kcfpp)(kp + 8 * i); }
    __device__ __forceinline__ unsigned char* wsb() const { return *(kucpp)(kp + 184); }
    __device__ __forceinline__ const float* x() const { return in(0); }
    __device__ __forceinline__ const float* cvec() const { return in(1); }
    __device__ __forceinline__ const float* ctx() const { return in(2); }
    __device__ __forceinline__ const float* c_ctx() const { return in(3); }
    __device__ __forceinline__ const float* w_ada() const { return in(4); }
    __device__ __forceinline__ const float* b_ada() const { return in(5); }
    __device__ __forceinline__ const float* g_mix() const { return in(6); }
    __device__ __forceinline__ const float* g_ffn() const { return in(7); }
    __device__ __forceinline__ const float* w_in() const { return in(8); }
    __device__ __forceinline__ const float* g_q() const { return in(9); }
    __device__ __forceinline__ const float* g_kv() const { return in(10); }
    __device__ __forceinline__ const float* w_uq() const { return in(11); }
    __device__ __forceinline__ const float* w_ukv() const { return in(12); }
    __device__ __forceinline__ const float* exp_f() const { return in(13); }
    __device__ __forceinline__ const float* exp_b() const { return in(14); }
    __device__ __forceinline__ const float* g_ret() const { return in(15); }
    __device__ __forceinline__ const float* w_o() const { return in(16); }
    __device__ __forceinline__ const float* w_router() const { return in(17); }
    __device__ __forceinline__ const float* w_gate() const { return in(18); }
    __device__ __forceinline__ const float* w_up() const { return in(19); }
    __device__ __forceinline__ const float* w_down() const { return in(20); }
    __device__ __forceinline__ const float* g_final() const { return in(21); }
    __device__ __forceinline__ float* out() const { return *(kfpp)(kp + 176); }
    __device__ __forceinline__ float* modv() const { return (float*)(wsb() + WS_MOD); }
    __device__ __forceinline__ float* tabr() const { return (float*)(wsb() + WS_TABR); }
    __device__ __forceinline__ float* tabm() const { return (float*)(wsb() + WS_TABM); }
    __device__ __forceinline__ float* pstat() const { return (float*)(wsb() + WS_PSTAT); }
    __device__ __forceinline__ float* aff() const { return (float*)(wsb() + WS_AFF); }
    __device__ __forceinline__ float* selg() const { return (float*)(wsb() + WS_SELG); }
    __device__ __forceinline__ int* seli() const { return (int*)(wsb() + WS_SELI); }
    __device__ __forceinline__ int* inv() const { return (int*)(wsb() + WS_INV); }
    __device__ __forceinline__ float* sels() const { return (float*)(wsb() + WS_SELS); }
    __device__ __forceinline__ float* rpart() const { return (float*)(wsb() + WS_Q); }
    __device__ __forceinline__ bf16_t* win_t() const { return (bf16_t*)(wsb() + WS_WIN); }
    __device__ __forceinline__ bf16_t* wuq_t() const { return (bf16_t*)(wsb() + WS_WUQ); }
    __device__ __forceinline__ bf16_t* wukv_t() const { return (bf16_t*)(wsb() + WS_WUKV); }
    __device__ __forceinline__ bf16_t* wo_t() const { return (bf16_t*)(wsb() + WS_WO); }
    __device__ __forceinline__ bf16_t* wgu_t() const { return (bf16_t*)(wsb() + WS_WGU); }
    __device__ __forceinline__ bf16_t* wdn_t() const { return (bf16_t*)(wsb() + WS_WDN); }
    __device__ __forceinline__ bf16_t* hb() const { return (bf16_t*)(wsb() + WS_H); }
    __device__ __forceinline__ bf16_t* rst() const { return (bf16_t*)(wsb() + WS_RST); }
    __device__ __forceinline__ bf16_t* proj() const { return (bf16_t*)(wsb() + WS_PROJ); }
    __device__ __forceinline__ bf16_t* act() const { return (bf16_t*)(wsb() + WS_ACT); }
    __device__ __forceinline__ bf16_t* yb() const { return (bf16_t*)(wsb() + WS_YB); }
    __device__ __forceinline__ bf16_t* qb() const { return (bf16_t*)(wsb() + WS_Q); }
    __device__ __forceinline__ bf16_t* kvb() const { return (bf16_t*)(wsb() + WS_KV); }
    __device__ __forceinline__ bf16_t* mix() const { return (bf16_t*)(wsb() + WS_MIX); }
    __device__ __forceinline__ bf16_t* x1b() const { return (bf16_t*)(wsb() + WS_H); }
    __device__ __forceinline__ bf16_t* h2() const { return (bf16_t*)(wsb() + WS_MIX); }
    __device__ __forceinline__ signed char* h2q() const { return (signed char*)(wsb() + WS_MIX); }
    __device__ __forceinline__ float* sa() const { return (float*)(wsb() + WS_MIX + 32 * MiB); }
    __device__ __forceinline__ signed char* wgu_q() const { return (signed char*)(wsb() + WS_WGU); }
    __device__ __forceinline__ float* swgu() const { return (float*)(wsb() + WS_WGU + 24 * MiB); }
    __device__ __forceinline__ signed char* wdn_q() const { return (signed char*)(wsb() + WS_WDN); }
    __device__ __forceinline__ float* swdn() const { return (float*)(wsb() + WS_WDN + 12 * MiB); }
    __device__ __forceinline__ signed char* actq() const { return (signed char*)(wsb() + 384 * MiB); }
    __device__ __forceinline__ unsigned char* y8() const { return (unsigned char*)(wsb() + WS_YB); }
    __device__ __forceinline__ float* ysc() const { return (float*)(wsb() + 320 * MiB); }
    __device__ __forceinline__ float* sactg() const { return (float*)(wsb() + 432 * MiB); }
};

__device__ __forceinline__ void p0_mod(const Ctx& c, float* lds) {
    float* sc = lds;
    float* red = lds + 9 * 1024;
    for (int i = c.tid; i < 9 * 1024; i += 512) { const int r = i >> 10, k = i & 1023; const float v = r < 8 ? c.cvec()[r * 1024 + k] : c.c_ctx()[k]; sc[i] = silu_f(v); }
    __syncthreads();
    for (int unit = blockIdx.x; unit < 192; unit += gridDim.x) {
        const int nn = c.tid & 31, n = unit * 32 + nn, kg = c.tid >> 5;
        float acc[9];
#pragma unroll
        for (int r = 0; r < 9; ++r) acc[r] = 0.f;
        for (int k0 = kg; k0 < 1024; k0 += 16 * 8) { float w[8];
#pragma unroll
            for (int i = 0; i < 8; ++i) w[i] = __builtin_nontemporal_load(c.w_ada() + (size_t)(k0 + 16 * i) * 6144 + n);
#pragma unroll
            for (int i = 0; i < 8; ++i)
#pragma unroll
                for (int r = 0; r < 9; ++r) acc[r] += sc[r * 1024 + k0 + 16 * i] * w[i]; }
#pragma unroll
        for (int r = 0; r < 9; ++r) red[(kg * 9 + r) * 32 + nn] = acc[r];
        __syncthreads();
        for (int i = c.tid; i < 9 * 32; i += 512) { const int r = i >> 5, n2 = i & 31; float s = 0.f;
#pragma unroll
            for (int g = 0; g < 16; ++g) s += red[(g * 9 + r) * 32 + n2];
            c.modv()[r * 6144 + unit * 32 + n2] = s + c.b_ada()[unit * 32 + n2]; }
        __syncthreads();
    }
}
template <class CM, class GN>
__device__ __forceinline__ void transpose_item(const float* W, int Ksrc, int Nsrc, bf16_t* WT, int Kdst, CM cm, GN gain, float* scr, int kb, int nb, int lane) {
    const int k0 = 64 * kb, n0 = 32 * nb;
    const int srcc = cm(n0 + (lane & 31));
#pragma unroll 8
    for (int i = 0; i < 32; ++i) { const int kk = 2 * i + (lane >> 5), k = k0 + kk;
        float v = 0.f; if (srcc >= 0 && k < Ksrc) v = W[(size_t)k * Nsrc + srcc] * gain(k);
        scr[kk * 33 + (lane & 31)] = v; }
    asm volatile("s_waitcnt lgkmcnt(0)" ::: "memory");
    const int ch = lane & 7;
#pragma unroll
    for (int j = 0; j < 4; ++j) { const int n = (lane >> 3) + 8 * j; const float* s = scr + (8 * ch) * 33 + n;
        u32x4 o; o.x = pk2(s[0 * 33], s[1 * 33]); o.y = pk2(s[2 * 33], s[3 * 33]); o.z = pk2(s[4 * 33], s[5 * 33]); o.w = pk2(s[6 * 33], s[7 * 33]);
        *(u32x4*)(WT + (size_t)(n0 + n) * Kdst + k0 + 8 * ch) = o; }
    asm volatile("s_waitcnt lgkmcnt(0)" ::: "memory");
}
__device__ __forceinline__ int ilv(int p, int half) { const int g = p >> 3, w = p & 7; return w < 4 ? 4 * g + w : half + 4 * g + (w - 4); }
__device__ __forceinline__ int cm_win(int n) {
    if (n < 384) return n;
    if (n < 416) return 384 + ilv(n - 384, 16);
    if (n < 512) return -1;
    if (n < 1024) { const int j = n - 512; return 416 + (j >> 6) * 64 + ilv(j & 63, 32); }
    if (n < 1536) { const int j = n - 1024; return 928 + (j >> 6) * 64 + ilv(j & 63, 32); }
    if (n < 2048) return 1440 + (n - 1536);
    return 1952 + (n - 2048);
}
__device__ __forceinline__ int cm_wuq(int n) { const int h = n / 96, p = n % 96; return p < 64 ? n : h * 96 + 64 + ilv(p - 64, 16); }
__device__ __forceinline__ int cm_wgu(int n) { const int q = n >> 3, w = n & 7; return w < 4 ? 4 * q + w : 768 + 4 * q + (w - 4); }
template <bool NTST = false, class TC>
__device__ __forceinline__ void transpose64(const float* srcA, const float* srcB, int ld, bf16_t* dst, int ldd, TC tcol, float* scr, int lane) {
    const int r = lane >> 3, c4 = (lane & 7) * 4;
    f32x4 va[8], vb[8];
#pragma unroll
    for (int i = 0; i < 8; ++i) { va[i] = srcA ? __builtin_nontemporal_load((const f32x4*)(srcA + (size_t)(8 * i + r) * ld + c4)) : (f32x4){0.f, 0.f, 0.f, 0.f}; vb[i] = srcB ? __builtin_nontemporal_load((const f32x4*)(srcB + (size_t)(8 * i + r) * ld + c4)) : (f32x4){0.f, 0.f, 0.f, 0.f}; }
#pragma unroll
    for (int i = 0; i < 8; ++i) { float* p = scr + (8 * i + r) * 65 + c4; p[0] = va[i].x; p[1] = va[i].y; p[2] = va[i].z; p[3] = va[i].w; p[32] = vb[i].x; p[33] = vb[i].y; p[34] = vb[i].z; p[35] = vb[i].w; }
    asm volatile("s_waitcnt lgkmcnt(0)" ::: "memory");
    const int kc = lane & 7;
#pragma unroll
    for (int j = 0; j < 8; ++j) { const int nl = (lane >> 3) + 8 * j, col = tcol(nl); u32x4 o = {0u, 0u, 0u, 0u};
        if (col >= 0) { const float* sp = scr + (8 * kc) * 65 + col; o.x = pk2(sp[0 * 65], sp[1 * 65]); o.y = pk2(sp[2 * 65], sp[3 * 65]); o.z = pk2(sp[4 * 65], sp[5 * 65]); o.w = pk2(sp[6 * 65], sp[7 * 65]); }
        if (NTST) __builtin_nontemporal_store(o, (u32x4*)(dst + (size_t)nl * ldd + 8 * kc)); else *(u32x4*)(dst + (size_t)nl * ldd + 8 * kc) = o; }
    asm volatile("s_waitcnt lgkmcnt(0)" ::: "memory");
}
typedef int i32x4 __attribute__((ext_vector_type(4)));
constexpr int GU_STRIPS = NE * 24;
__device__ __forceinline__ unsigned f8pack(float a, float b, float c_, float d) {
    a = __builtin_amdgcn_fmed3f(a, -448.f, 448.f); b = __builtin_amdgcn_fmed3f(b, -448.f, 448.f); c_ = __builtin_amdgcn_fmed3f(c_, -448.f, 448.f); d = __builtin_amdgcn_fmed3f(d, -448.f, 448.f);
    int r = __builtin_amdgcn_cvt_pk_fp8_f32(a, b, 0, false); r = __builtin_amdgcn_cvt_pk_fp8_f32(c_, d, r, true); return (unsigned)r;
}
__device__ __forceinline__ unsigned q8pack(float a, float b, float c_, float d, float inv) {
    const unsigned q0 = __float_as_uint(__builtin_fmaf(a, inv, 12582912.f)), q1 = __float_as_uint(__builtin_fmaf(b, inv, 12582912.f)), q2 = __float_as_uint(__builtin_fmaf(c_, inv, 12582912.f)), q3 = __float_as_uint(__builtin_fmaf(d, inv, 12582912.f));
    return (q0 & 255u) | ((q1 & 255u) << 8) | ((q2 & 255u) << 16) | (q3 << 24);
}
template <int NT, bool F8, class TC>
__device__ __forceinline__ void strip_i8(const Ctx& c, float* lds, const float* srcA, const float* srcB, int ld, signed char* dq0, int dld, float* sw0, TC tcol) {
    float* scr = lds + c.wave * (64 * 65); float* cm = lds + 8 * 64 * 65; float* fin = cm + 512;
    const int r = c.lane >> 3, c4 = (c.lane & 7) * 4;
    const bool act_w = 2 * c.wave < NT;
    f32x4 va[2][8], vb[2][8];
#pragma unroll
    for (int t = 0; t < 2; ++t)
#pragma unroll
        for (int i = 0; i < 8; ++i) { const size_t ro = (size_t)(64 * (2 * c.wave + t) + 8 * i + r) * ld + c4;
            va[t][i] = act_w ? __builtin_nontemporal_load((const f32x4*)(srcA + ro)) : (f32x4){0.f, 0.f, 0.f, 0.f}; vb[t][i] = act_w ? __builtin_nontemporal_load((const f32x4*)(srcB + ro)) : (f32x4){0.f, 0.f, 0.f, 0.f}; }
    f32x4 mA = {0.f, 0.f, 0.f, 0.f}, mB = {0.f, 0.f, 0.f, 0.f};
#pragma unroll
    for (int t = 0; t < 2; ++t)
#pragma unroll
        for (int i = 0; i < 8; ++i) { mA = __builtin_elementwise_max(mA, __builtin_elementwise_abs(va[t][i])); mB = __builtin_elementwise_max(mB, __builtin_elementwise_abs(vb[t][i])); }
#pragma unroll
    for (int o = 8; o < 64; o <<= 1)
#pragma unroll
        for (int j = 0; j < 4; ++j) { mA[j] = fmaxf(mA[j], __shfl_xor(mA[j], o)); mB[j] = fmaxf(mB[j], __shfl_xor(mB[j], o)); }
    __syncthreads();
    if (r == 0) { *(f32x4*)(cm + c.wave * 64 + c4) = mA; *(f32x4*)(cm + c.wave * 64 + 32 + c4) = mB; }
    __syncthreads();
    if (c.tid < 64) { float m = cm[c.tid];
#pragma unroll
        for (int w = 1; w < 8; ++w) m = fmaxf(m, cm[w * 64 + c.tid]);
        fin[c.tid] = fmaxf(m, 1e-30f); }
    __syncthreads();
    const int w8 = c.lane >> 3, kc = c.lane & 7;
    if (c.tid < 64) sw0[c.tid] = fin[tcol(c.tid)] * (F8 ? 1.f / 448.f : 1.f / 127.f);
    if (act_w) {
    signed char* dq = dq0 + (size_t)w8 * dld + 128 * c.wave + 8 * kc;
#pragma unroll
    for (int t = 0; t < 2; ++t) {
#pragma unroll
        for (int i = 0; i < 8; ++i) { float* p = scr + (8 * i + r) * 65 + c4; p[0] = va[t][i].x; p[1] = va[t][i].y; p[2] = va[t][i].z; p[3] = va[t][i].w; p[32] = vb[t][i].x; p[33] = vb[t][i].y; p[34] = vb[t][i].z; p[35] = vb[t][i].w; }
        asm volatile("s_waitcnt lgkmcnt(0)" ::: "memory");
#pragma unroll
        for (int j = 0; j < 8; ++j) { const int col = tcol(w8 + 8 * j);
            const float inv = (F8 ? 448.f : 127.f) / fin[col]; const float* sp = scr + (8 * kc) * 65 + col;
            u32x2 o;
            if (F8) { o.x = f8pack(sp[0 * 65] * inv, sp[1 * 65] * inv, sp[2 * 65] * inv, sp[3 * 65] * inv); o.y = f8pack(sp[4 * 65] * inv, sp[5 * 65] * inv, sp[6 * 65] * inv, sp[7 * 65] * inv); }
            else { o.x = q8pack(sp[0 * 65], sp[1 * 65], sp[2 * 65], sp[3 * 65], inv); o.y = q8pack(sp[4 * 65], sp[5 * 65], sp[6 * 65], sp[7 * 65], inv); }
            *(u32x2*)(dq + (size_t)(8 * j) * dld + 64 * t) = o; }
        asm volatile("s_waitcnt lgkmcnt(0)" ::: "memory");
    } }
}
constexpr int DN_STRIPS = NE * 16, EXP_STRIPS = GU_STRIPS + DN_STRIPS;
__device__ __forceinline__ void expert_strip(const Ctx& c, float* lds, int s) {
    if (s < GU_STRIPS) { const int e = s / 24, nb = s % 24; const size_t so = (size_t)e * 1024 * 768 + 32 * nb;
        strip_i8<16, false>(c, lds, c.w_gate() + so, c.w_up() + so, 768, c.wgu_q() + (size_t)e * 1536 * 1024 + (size_t)(64 * nb) * 1024, 1024, c.swgu() + e * 1536 + 64 * nb,
                     [](int nl) { const int qq = nl >> 3, w = nl & 7; return w < 4 ? 4 * qq + w : 32 + 4 * qq + (w - 4); }); }
    else { s -= GU_STRIPS; const int e = s >> 4, nb = s & 15; const float* src = c.w_down() + (size_t)e * 768 * 1024 + 64 * nb;
        strip_i8<12, true>(c, lds, src, src + 32, 1024, c.wdn_q() + (size_t)e * 1024 * 768 + (size_t)(64 * nb) * 768, 768, c.swdn() + e * 1024 + 64 * nb, [](int nl) { return nl; }); }
}
constexpr int QSHORT0 = 80, QSTRIPS = 2, QSTATIC = (256 - QSHORT0) * QSTRIPS;
template <int PART>
__device__ __forceinline__ void p0_weights(const Ctx& c, float* lds, int gw, int ngw) {
    float* scr = lds + c.wave * (64 * 65);
    constexpr int I_WIN = 16 * 40, I_WO = 16 * 16, I_GU = 16 * 24, I_DN = 12 * 16, I_WUQ = 4 * 24, I_WUKV = 4 * 32;
    constexpr int NEXP = NE * I_GU + NE * I_DN, NIT = NEXP + I_WIN + I_WO + I_WUQ + I_WUKV;
    unsigned* qctr = (unsigned*)(c.wsb() + WS_CTL) + 2048; int qbase = 0, qk = 8;
    for (int it = (PART == 1 ? NE * I_GU : NEXP + gw); it < (PART == 1 ? NEXP : NIT); it += (PART == 0 ? ngw : 1)) {
        if (PART == 1) { if (qk == 8) { int p_ = 0; if (c.lane == 0) p_ = (int)__hip_atomic_fetch_add(qctr, 1u, __ATOMIC_RELAXED, __HIP_MEMORY_SCOPE_AGENT); qbase = NE * I_GU + __builtin_amdgcn_readfirstlane(p_) * 8; qk = 0; }
            it = qbase + qk; ++qk; if (it >= NEXP) break; }
        int r = it;
        r -= NEXP;
        if (r < I_WIN) { const int kb = r / 40, nb = r % 40; const float* base = c.w_in() + (size_t)(64 * kb) * 2464; bf16_t* dst = c.win_t() + (size_t)(64 * nb) * 1024 + 64 * kb;
            if (nb < 6) { transpose64(base + 64 * nb, base + 64 * nb + 32, 2464, dst, 1024, [](int nl) { return nl; }, scr, c.lane); }
            else if (nb == 6) { transpose64(base + 384, (const float*)nullptr, 2464, dst, 1024, [](int nl) { return nl < 32 ? ilv(nl, 16) : -1; }, scr, c.lane); }
            else if (nb == 7) { transpose64((const float*)nullptr, (const float*)nullptr, 2464, dst, 1024, [](int) { return -1; }, scr, c.lane); }
            else if (nb < 24) { const int s0 = (nb < 16 ? 416 : 928) + 64 * ((nb - 8) & 7); transpose64(base + s0, base + s0 + 32, 2464, dst, 1024, [](int nl) { return ilv(nl, 32); }, scr, c.lane); }
            else { const int s0 = (nb < 32 ? 1440 : 1952) + 64 * (nb & 7); transpose64(base + s0, base + s0 + 32, 2464, dst, 1024, [](int nl) { return nl; }, scr, c.lane); }
            continue; } r -= I_WIN;
        if (r < I_WO) { const int kb = r / 16, nb = r % 16; const float* src = c.w_o() + (size_t)(64 * kb) * 1024 + 64 * nb;
            transpose64(src, src + 32, 1024, c.wo_t() + (size_t)(64 * nb) * 1024 + 64 * kb, 1024, [](int nl) { return nl; }, scr, c.lane); continue; } r -= I_WO;
        if (r < I_WUQ) { const float* g = c.g_q(); transpose_item(c.w_uq(), 256, 768, c.wuq_t(), 256, [](int n) { return cm_wuq(n); }, [g](int k) { return g[k]; }, scr, r / 24, r % 24, c.lane); continue; } r -= I_WUQ;
        { const float* g = c.g_kv(); transpose_item(c.w_ukv(), 128, 1024, c.wukv_t(), 256, [](int n) { return n; }, [g](int k) { return g[k]; }, scr, r / 32, r % 32, c.lane); }
    }
}
__device__ __forceinline__ void sincos_d(double x, double& s, double& co) {
    const double PIO2_HI = 1.5707963267948966, PIO2_LO = 6.123233995736766e-17;
    const double kd = __builtin_rint(x * 0.6366197723675814); const int k = (int)kd;
    const double r = (x - kd * PIO2_HI) - kd * PIO2_LO, r2 = r * r;
    double sr = r - r * r2 * (1.0 / 6.0 - r2 * (1.0 / 120.0 - r2 * (1.0 / 5040.0 - r2 * (1.0 / 362880.0 - r2 * (1.0 / 39916800.0 - r2 * (1.0 / 6227020800.0 - r2 * (1.0 / 1307674368000.0 - r2 * (1.0 / 355687428096000.0))))))));
    double cr = 1.0 - r2 * (0.5 - r2 * (1.0 / 24.0 - r2 * (1.0 / 720.0 - r2 * (1.0 / 40320.0 - r2 * (1.0 / 3628800.0 - r2 * (1.0 / 479001600.0 - r2 * (1.0 / 87178291200.0 - r2 * (1.0 / 20922789888000.0))))))));
    switch (k & 3) { case 0: s = sr; co = cr; break; case 1: s = cr; co = -sr; break; case 2: s = -sr; co = -cr; break; default: s = -cr; co = sr; break; }
}
__device__ __forceinline__ void p0_tables(const Ctx& c) {
    const int gt = blockIdx.x * 512 + c.tid, ngt = gridDim.x * 512;
    const double r16 = 1.0 / __builtin_sqrt(__builtin_sqrt(10.0));
    const double r8 = 1.0 / __builtin_sqrt(10.0);
    for (int i = gt; i < 4096 * 48; i += ngt) {
        const int t = i / 48, j = i % 48; const int prow = t >> 6, pcol = t & 63;
        double ang;
        if (j < 32) { const int jj = j & 15; double inv = 1.0; for (int q = 0; q < jj; ++q) inv *= r16; ang = (double)(j < 16 ? prow : pcol) * inv; }
        else { const int j2 = j - 32, jj = j2 & 7; double inv = 1.0; for (int q = 0; q < jj; ++q) inv *= r8; ang = (double)(j2 < 8 ? prow : pcol) * inv; }
        double s, co; sincos_d(ang, s, co);
        if (j < 32) { c.tabr()[(t * 32 + j) * 2] = (float)co; c.tabr()[(t * 32 + j) * 2 + 1] = (float)s; }
        else { c.tabm()[(t * 16 + j - 32) * 2] = (float)co; c.tabm()[(t * 16 + j - 32) * 2 + 1] = (float)s; }
    }
}

__device__ __forceinline__ void p1_norm(const Ctx& c) {
    for (int r = c.gw * 2; r < RT; r += c.ngw * 2) {
        const float* src = r < RL ? c.x() + (size_t)r * D : c.ctx() + (size_t)(r - RL) * D; const int b = r < RL ? r / SEQ : 8;
        f32x4 v[2][4]; float s0 = 0.f, s1 = 0.f;
#pragma unroll
        for (int j = 0; j < 4; ++j) { v[0][j] = __builtin_nontemporal_load((const f32x4*)src + c.lane + 64 * j); v[1][j] = __builtin_nontemporal_load((const f32x4*)(src + D) + c.lane + 64 * j); }
#pragma unroll
        for (int j = 0; j < 4; ++j) { s0 += v[0][j].x * v[0][j].x + v[0][j].y * v[0][j].y + v[0][j].z * v[0][j].z + v[0][j].w * v[0][j].w; s1 += v[1][j].x * v[1][j].x + v[1][j].y * v[1][j].y + v[1][j].z * v[1][j].z + v[1][j].w * v[1][j].w; }
        const float ri0 = 1.f / sqrtf(wave_sum(s0) * (1.f / D) + EPS), ri1 = 1.f / sqrtf(wave_sum(s1) * (1.f / D) + EPS);
        const float* md = c.modv() + b * 6144;
#pragma unroll
        for (int j = 0; j < 4; ++j) { const int k = 4 * c.lane + 256 * j;
            const f32x4 g = *(const f32x4*)(c.g_mix() + k), sh = *(const f32x4*)(md + k), scv = *(const f32x4*)(md + 1024 + k);
            const f32x4 gs = g * (scv + 1.f); const f32x4 o0 = v[0][j] * ri0 * gs + sh, o1 = v[1][j] * ri1 * gs + sh;
            u32x2 w0, w1; w0.x = pk2(o0.x, o0.y); w0.y = pk2(o0.z, o0.w); w1.x = pk2(o1.x, o1.y); w1.y = pk2(o1.z, o1.w);
            *(u32x2*)(c.hb() + (size_t)r * D + k) = w0; *(u32x2*)(c.hb() + (size_t)(r + 1) * D + k) = w1; }
    }
}

__device__ __forceinline__ void store8_bf16(bf16_t* p, const float (&v)[8]) { u32x4 w; w.x = pk2(v[0], v[1]); w.y = pk2(v[2], v[3]); w.z = pk2(v[4], v[5]); w.w = pk2(v[6], v[7]); *(u32x4*)p = w; }


namespace pg8 {
typedef short bf16x8 __attribute__((ext_vector_type(8)));
constexpr int BM = 256, BK = 64, HALF = 128, HTB = HALF * BK * 2, STAGE_BYTES = 8 * HTB, NXCD = 8, WGM = 8;
__host__ __device__ __forceinline__ int lds_byte(int r, int c) { const int st = (r >> 4) * 2 + (c >> 5), rr = r & 15, cc = c & 31, ob = rr * 64 + cc * 2; return st * 1024 + (ob ^ (((ob >> 9) & 1) << 5)); }
__host__ __device__ __forceinline__ void stage_rc(int b, int& R, int& C) { const int st = b / 1024, sb = b % 1024, swz = sb ^ (((sb >> 9) & 1) << 5); R = (st >> 1) * 16 + swz / 64; C = (st & 1) * 32 + (swz % 64) / 2; }
__host__ __device__ __forceinline__ int perm32(int rho) { const int n = rho >> 4, i = rho & 15; return 8 * (i >> 2) + 4 * n + (i & 3); }
struct Unit { int pm, pn; };
struct Gemm { const bf16_t* A; const bf16_t* Bt; int lda, ldb, K; const int* rowlist; int gshift, gmask; size_t gstride; };
struct StaticOrder {
    int nM, nN, nwg, G, c;
    __host__ __device__ void init(int M, int N, int G_, int c_) { nM = M / BM; nN = N / BM; nwg = nM * nN; G = G_; c = c_; }
    __host__ __device__ bool next(int i, Unit& u) const {
        const long L = (long)i * G + c; if (L >= nwg) return false;
        int wgid = (int)L; { const int q = nwg / NXCD, r = nwg % NXCD, xcd = wgid % NXCD, off = wgid / NXCD; wgid = (xcd < r ? xcd * (q + 1) : r * (q + 1) + (xcd - r) * q) + off; }
        const int nig = WGM * nN, gid = wgid / nig, fm = gid * WGM, gsz = (nM - fm) < WGM ? (nM - fm) : WGM;
        u.pm = fm + ((wgid % nig) % gsz); u.pn = (wgid % nig) / gsz; return true;
    }
};
struct ExpertOrder : StaticOrder {
    __host__ __device__ bool next(int i, Unit& u) const {
        if (!StaticOrder::next(i, u)) return false;
        const int p = u.pm, x = p >> 5, el = (p >> 4) & 1, b = (p >> 1) & 7, j = p & 1; u.pm = 32 * b + 2 * (2 * x + el) + j; return true;
    }
};
template <class F, bool FENCE = false> struct EpiRow8 {
    static constexpr bool PERM = true;
    F f;
    __device__ __forceinline__ void operator()(const f32x4 (&acc)[2][2][4][2], const Unit& u, int wr, int wc, int fr, int fq) const {
        const int row0 = u.pm * BM + wr * 64 + fr, col0 = u.pn * BM + wc * 32 + 8 * fq;
#pragma unroll
        for (int ai = 0; ai < 2; ++ai)
#pragma unroll
            for (int m = 0; m < 4; ++m)
#pragma unroll
                for (int bj = 0; bj < 2; ++bj) { const f32x4 a = acc[ai][bj][m][0], b = acc[ai][bj][m][1]; const float v[8] = {a[0], a[1], a[2], a[3], b[0], b[1], b[2], b[3]};
                    f(row0 + ai * HALF + m * 16, col0 + bj * HALF, v); if (FENCE && bj == 1) asm volatile("" ::: "memory"); }
    }
};
typedef int i32x8 __attribute__((ext_vector_type(8)));
__device__ __forceinline__ f32x4 mma_f8(bf16x8 a0, bf16x8 a1, bf16x8 b0, bf16x8 b1, f32x4 c) {
    const i32x8 A = __builtin_shufflevector(__builtin_bit_cast(i32x4, a0), __builtin_bit_cast(i32x4, a1), 0, 1, 2, 3, 4, 5, 6, 7), B = __builtin_shufflevector(__builtin_bit_cast(i32x4, b0), __builtin_bit_cast(i32x4, b1), 0, 1, 2, 3, 4, 5, 6, 7);
    return __builtin_amdgcn_mfma_scale_f32_16x16x128_f8f6f4(A, B, c, 0, 0, 0, 0, 0, 0);
}
template <int I8> __device__ __forceinline__ f32x4 mma_step(bf16x8 a, bf16x8 b, f32x4 c) {
    if constexpr (I8 == 1) return __builtin_bit_cast(f32x4, __builtin_amdgcn_mfma_i32_16x16x64_i8(__builtin_bit_cast(i32x4, a), __builtin_bit_cast(i32x4, b), __builtin_bit_cast(i32x4, c), 0, 0, 0));
    else return __builtin_amdgcn_mfma_f32_16x16x32_bf16(a, b, c, 0, 0, 0);
}
template <int I8 = 0, bool GATHER = false, class Epi, class Sched>
__device__ __forceinline__ void gemm_phase(LAS unsigned char* lds, const Gemm g, const Sched& S, const Epi& E, int tid) {
    const int wid = __builtin_amdgcn_readfirstlane(tid >> 6), lane = tid & 63, wr = wid >> 2, wc = wid & 3, fr = lane & 15, fq = lane >> 4;
    int Kv_ = g.K; asm volatile("" : "+s"(Kv_)); const int nt = Kv_ / BK;
    unsigned voffB[2];
#pragma unroll
    for (int i = 0; i < 2; ++i) { int R, C; stage_rc(tid * 16 + i * 8192, R, C); const int Rb = Epi::PERM ? ((R & ~31) + perm32(R & 31)) : R;
        voffB[i] = (unsigned)(Rb * g.ldb + C) * 2u; }
    const size_t kstep = (size_t)(BK * 2);
    const size_t hstepB = (size_t)HALF * g.ldb * 2, tstepB = 2 * hstepB;
    const unsigned ldsw = (unsigned)wid * 1024u;
    const int aoff = lds_byte(wr * 64 + fr, fq * 8), boff = lds_byte(wc * 32 + fr, fq * 8);
    const unsigned lda2 = (unsigned)g.lda * 2u;
#define PG8_SA(b, h) (((b) * 2 + (h)) * HTB)
#define PG8_SB(b, h) ((4 + (b) * 2 + (h)) * HTB)
#define PG8_STAGE(bufoff, gbase, voff) do { _Pragma("unroll") for (int _i = 0; _i < 2; ++_i) { unsigned _vo = (voff)[_i]; asm volatile("" : "+v"(_vo));     \
        __builtin_amdgcn_global_load_lds((const unsigned*)((const char*)(gbase) + _vo), (LAS unsigned*)(lds + (bufoff) + ldsw + _i * 8192), 16, 0, 0); } } while (0)
#define PG8_LDA(dst, b, h) do { if constexpr (I8 == 2) { _Pragma("unroll") for (int m = 0; m < 4; ++m) dst##8[m] = __builtin_shufflevector(*(const LAS i32x4*)(lds + PG8_SA(b, h) + aoff + m * 2048), *(const LAS i32x4*)(lds + PG8_SA(b, h) + aoff + m * 2048 + 1024), 0, 1, 2, 3, 4, 5, 6, 7); } \
        else { _Pragma("unroll") for (int m = 0; m < 4; ++m) _Pragma("unroll") for (int k = 0; k < 2; ++k) dst[m][k] = *(const LAS bf16x8*)(lds + PG8_SA(b, h) + aoff + m * 2048 + k * 1024); } } while (0)
#define PG8_LDB(dst, b, h) do { if constexpr (I8 == 2) { _Pragma("unroll") for (int n = 0; n < 2; ++n) dst##8[n] = __builtin_shufflevector(*(const LAS i32x4*)(lds + PG8_SB(b, h) + boff + n * 2048), *(const LAS i32x4*)(lds + PG8_SB(b, h) + boff + n * 2048 + 1024), 0, 1, 2, 3, 4, 5, 6, 7); } \
        else { _Pragma("unroll") for (int n = 0; n < 2; ++n) _Pragma("unroll") for (int k = 0; k < 2; ++k) dst[n][k] = *(const LAS bf16x8*)(lds + PG8_SB(b, h) + boff + n * 2048 + k * 1024); } } while (0)
#define PG8_MMA(ai, bj, At, Bt) do { __builtin_amdgcn_s_setprio(1); _Pragma("unroll") for (int m = 0; m < 4; ++m) _Pragma("unroll") for (int n = 0; n < 2; ++n) { \
        if constexpr (I8 == 2) acc[ai][bj][m][n] = __builtin_amdgcn_mfma_scale_f32_16x16x128_f8f6f4(Bt##8[n], At##8[m], acc[ai][bj][m][n], 0, 0, 0, 0, 0, 0); \
        else { _Pragma("unroll") for (int k = 0; k < 2; ++k) acc[ai][bj][m][n] = mma_step<I8>(Bt[n][k], At[m][k], acc[ai][bj][m][n]); } } __builtin_amdgcn_s_setprio(0); } while (0)
#define PG8_WAIT_V(n) asm volatile("s_waitcnt vmcnt(" #n ")" ::: "memory")
#define PG8_WAIT_L(n) asm volatile("s_waitcnt lgkmcnt(" #n ")" ::: "memory")
#define PG8_BAR __builtin_amdgcn_s_barrier()
#define PG8_SCHED __builtin_amdgcn_sched_barrier(0)
#define PG8_AOFFS(vo, u) do { _Pragma("unroll") for (int _i = 0; _i < 2; ++_i) { int _R, _C; stage_rc(tid * 16 + _i * 8192, _R, _C); _Pragma("unroll") for (int _h = 0; _h < 2; ++_h) { const int _r = (u).pm * BM + _h * HALF + _R; \
        const int _row = g.rowlist ? g.rowlist[_r] : _r; vo[_h][_i] = (unsigned)_row * lda2 + (unsigned)(_C * 2); } } } while (0)
#define PG8_BBASE(u) ((const char*)g.Bt + ((size_t)(((u).pm >> g.gshift) & g.gmask) * g.gstride) * 2 + (size_t)(u).pn * tstepB)
    Unit cur, nxt; int ui = 0;
    if (!S.next(0, cur)) return;
    f32x4 acc[2][2][4][2];
#pragma unroll
    for (int a = 0; a < 2; ++a)
#pragma unroll
        for (int b = 0; b < 2; ++b)
#pragma unroll
            for (int m = 0; m < 4; ++m)
#pragma unroll
                for (int n = 0; n < 2; ++n) acc[a][b][m][n] = (f32x4){0.f, 0.f, 0.f, 0.f};
    bf16x8 At[4][2], B0[2][2], B1[2][2];
    i32x8 At8[4], B08[2], B18[2];
    unsigned voc[2][2], von[2][2], voA[2];
    const size_t hstepA = (size_t)HALF * lda2, ustepA = 2 * hstepA;
#pragma unroll
    for (int i = 0; i < 2; ++i) { int R, C; stage_rc(tid * 16 + i * 8192, R, C); voA[i] = (unsigned)R * lda2 + (unsigned)(C * 2); }
    if constexpr (GATHER) PG8_AOFFS(voc, cur);
#define PG8_ABASE(u) ((const char*)g.A + (GATHER ? (size_t)0 : (size_t)(u).pm * ustepA))
#define PG8_STAGE_A(bufoff, base, h, vg) do { if constexpr (GATHER) PG8_STAGE(bufoff, base, vg); else PG8_STAGE(bufoff, (base) + (h) * hstepA, voA); } while (0)
    const char* A0 = PG8_ABASE(cur); const char* cB = PG8_BBASE(cur);
    PG8_STAGE(PG8_SB(0, 0), cB, voffB); PG8_STAGE(PG8_SB(0, 1), cB + hstepB, voffB); PG8_STAGE_A(PG8_SA(0, 0), A0, 0, voc[0]); PG8_STAGE_A(PG8_SA(0, 1), A0, 1, voc[1]);
    if (wr == 1) PG8_BAR;
    PG8_WAIT_V(2); PG8_BAR;
    PG8_STAGE(PG8_SB(1, 0), cB + kstep, voffB); PG8_STAGE_A(PG8_SA(1, 0), A0 + kstep, 0, voc[0]); PG8_STAGE(PG8_SB(1, 1), cB + hstepB + kstep, voffB);
    PG8_WAIT_V(6); PG8_BAR;
    for (;;) {
        const bool has_next = S.next(ui + 1, nxt);
        const char* nB = has_next ? PG8_BBASE(nxt) : cB; const char* nA = has_next ? PG8_ABASE(nxt) : A0;
        for (int t = 0; t < nt; t += 2) {
            const bool last = (t == nt - 2);
            const char* a1 = A0 + (size_t)(t + 1) * kstep;
            const char* a2 = last ? nA : A0 + (size_t)(t + 2) * kstep; const char* b2 = last ? nB : cB + (size_t)(t + 2) * kstep;
            const char* a3 = a2 + kstep; const char* b3 = b2 + kstep;
            unsigned vo2[2][2];
            if constexpr (GATHER) {
            if (last) { if (has_next) { PG8_AOFFS(von, nxt); } else { _Pragma("unroll") for (int h = 0; h < 2; ++h) _Pragma("unroll") for (int i = 0; i < 2; ++i) von[h][i] = voc[h][i]; } }
#pragma unroll
            for (int h = 0; h < 2; ++h)
#pragma unroll
                for (int i = 0; i < 2; ++i) vo2[h][i] = last ? von[h][i] : voc[h][i];
            }
            PG8_LDB(B0, 0, 0); PG8_LDB(B1, 0, 1); PG8_SCHED; PG8_LDA(At, 0, 0); PG8_STAGE_A(PG8_SA(1, 1), a1, 1, voc[1]);
            PG8_WAIT_V(8); PG8_WAIT_L(0); PG8_BAR; PG8_MMA(0, 0, At, B0); PG8_MMA(0, 1, At, B1); PG8_BAR; PG8_SCHED;
            PG8_LDA(At, 0, 1); PG8_STAGE(PG8_SB(0, 0), b2, voffB); PG8_STAGE(PG8_SB(0, 1), b2 + hstepB, voffB); PG8_STAGE_A(PG8_SA(0, 0), a2, 0, vo2[0]);
            PG8_WAIT_V(8); PG8_WAIT_L(0); PG8_BAR; PG8_MMA(1, 0, At, B0); PG8_MMA(1, 1, At, B1); PG8_BAR; PG8_SCHED;
            PG8_LDB(B0, 1, 0); PG8_LDB(B1, 1, 1); PG8_SCHED; PG8_LDA(At, 1, 0); PG8_STAGE_A(PG8_SA(0, 1), a2, 1, vo2[1]);
            PG8_WAIT_V(8); PG8_WAIT_L(0); PG8_BAR; PG8_MMA(0, 0, At, B0); PG8_MMA(0, 1, At, B1); PG8_BAR; PG8_SCHED;
            PG8_LDA(At, 1, 1); PG8_STAGE(PG8_SB(1, 0), b3, voffB); PG8_STAGE(PG8_SB(1, 1), b3 + hstepB, voffB); PG8_STAGE_A(PG8_SA(1, 0), a3, 0, vo2[0]);
            PG8_WAIT_V(8); PG8_WAIT_L(0); PG8_BAR; PG8_MMA(1, 0, At, B0); PG8_MMA(1, 1, At, B1); PG8_BAR; PG8_SCHED;
        }
        if (wr == 0) PG8_BAR;
        if constexpr (I8 == 1) {
#pragma unroll
            for (int a = 0; a < 2; ++a)
#pragma unroll
                for (int b = 0; b < 2; ++b)
#pragma unroll
                    for (int m = 0; m < 4; ++m)
#pragma unroll
                        for (int n = 0; n < 2; ++n) acc[a][b][m][n] = __builtin_convertvector(__builtin_bit_cast(i32x4, acc[a][b][m][n]), f32x4); }
        E(acc, cur, wr, wc, fr, fq);
        if (!has_next) break;
#pragma unroll
        for (int a = 0; a < 2; ++a)
#pragma unroll
            for (int b = 0; b < 2; ++b)
#pragma unroll
                for (int m = 0; m < 4; ++m)
#pragma unroll
                    for (int n = 0; n < 2; ++n) acc[a][b][m][n] = (f32x4){0.f, 0.f, 0.f, 0.f};
        cur = nxt; cB = nB; A0 = nA; ++ui;
        if constexpr (GATHER) {
#pragma unroll
        for (int h = 0; h < 2; ++h)
#pragma unroll
            for (int i = 0; i < 2; ++i) voc[h][i] = von[h][i];
        }
        if (wr == 1) PG8_BAR;
    }
    PG8_WAIT_V(0);
    PG8_BAR;
#undef PG8_SA
#undef PG8_SB
#undef PG8_STAGE
#undef PG8_LDA
#undef PG8_LDB
#undef PG8_MMA
#undef PG8_WAIT_V
#undef PG8_WAIT_L
#undef PG8_BAR
#undef PG8_SCHED
#undef PG8_AOFFS
#undef PG8_ABASE
#undef PG8_STAGE_A
#undef PG8_BBASE
}
}
template <class F> __device__ __forceinline__ pg8::EpiRow8<F> make_epi(F f) { return pg8::EpiRow8<F>{f}; }
template <class F> __device__ __forceinline__ pg8::EpiRow8<F, true> make_epi_fenced(F f) { return pg8::EpiRow8<F, true>{f}; }

struct EpiProj {
    static constexpr bool PERM = true;
    bf16_t* proj; float* pstat; const float* tabr; const float* tabm;
    __device__ __forceinline__ void operator()(const f32x4 (&acc)[2][2][4][2], const pg8::Unit& u, int wr, int wc, int fr, int fq) const {
        const int row0 = u.pm * 256 + wr * 64 + fr, pn = u.pn; const bool lat = u.pm < RL / 256;
        const bool rope_r = pn >= 2 && pn < 6 && lat, rope_m = pn == 1 && wc == 0 && lat;
        f32x4 tb[8][2];
        if (rope_r || rope_m) { const int g = rope_r ? ((wc * 32 + 8 * fq) & 63) >> 3 : fq; const float* tab = rope_r ? tabr : tabm; const int nf = rope_r ? 32 : 16;
#pragma unroll
            for (int i = 0; i < 8; ++i) { const int t = (row0 + (i >> 2) * 128 + (i & 3) * 16) & (SEQ - 1); tb[i][0] = *(const f32x4*)(tab + (t * nf + 4 * g) * 2); tb[i][1] = *(const f32x4*)(tab + (t * nf + 4 * g) * 2 + 4); } }
        else {
#pragma unroll
            for (int i = 0; i < 8; ++i) { tb[i][0] = (f32x4){1.f, 0.f, 1.f, 0.f}; tb[i][1] = (f32x4){1.f, 0.f, 1.f, 0.f}; } }
#pragma unroll
        for (int ai = 0; ai < 2; ++ai)
#pragma unroll
            for (int m = 0; m < 4; ++m) {
                const int row = row0 + ai * 128 + m * 16;
                bf16_t* pr = proj + (size_t)row * NPROJ + pn * 256 + wc * 32 + 8 * fq;
                const f32x4 c0 = tb[ai * 4 + m][0], c1 = tb[ai * 4 + m][1]; const float co[4] = {c0.x, c0.z, c1.x, c1.z}, si[4] = {c0.y, c0.w, c1.y, c1.w};
                float v[2][8];
#pragma unroll
                for (int bj = 0; bj < 2; ++bj) { const f32x4 a = acc[ai][bj][m][0], b = acc[ai][bj][m][1]; v[bj][0] = a[0]; v[bj][1] = a[1]; v[bj][2] = a[2]; v[bj][3] = a[3]; v[bj][4] = b[0]; v[bj][5] = b[1]; v[bj][6] = b[2]; v[bj][7] = b[3]; }
                if (pn == 0) {
                    float sq = 0.f;
#pragma unroll
                    for (int bj = 0; bj < 2; ++bj)
#pragma unroll
                        for (int j = 0; j < 8; ++j) sq += v[bj][j] * v[bj][j];
                    sq += __shfl_xor(sq, 16); sq += __shfl_xor(sq, 32);
                    if (fq == 0) pstat[(size_t)row * 8 + wc] = sq;
                } else if (pn == 1) {
                    float sq = 0.f;
#pragma unroll
                    for (int j = 0; j < 8; ++j) sq += v[0][j] * v[0][j];
                    sq += __shfl_xor(sq, 16); sq += __shfl_xor(sq, 32);
                    if (fq == 0) pstat[(size_t)row * 8 + 4 + wc] = sq;
                    if (wc == 0) {
#pragma unroll
                        for (int w = 0; w < 4; ++w) { const float x1 = v[1][w], x2 = v[1][4 + w]; v[1][w] = x1 * co[w] - x2 * si[w]; v[1][4 + w] = x1 * si[w] + x2 * co[w]; } }
                } else if (pn < 6) {
                    const float ksc = pn >= 4 ? 0.125f : 1.f;
#pragma unroll
                    for (int bj = 0; bj < 2; ++bj)
#pragma unroll
                        for (int w = 0; w < 4; ++w) { const float x1 = v[bj][w], x2 = v[bj][4 + w]; v[bj][w] = (x1 * co[w] - x2 * si[w]) * ksc; v[bj][4 + w] = (x1 * si[w] + x2 * co[w]) * ksc; }
                } else if (pn >= 8) {
#pragma unroll
                    for (int bj = 0; bj < 2; ++bj)
#pragma unroll
                        for (int j = 0; j < 8; ++j) v[bj][j] = silu_f(v[bj][j]);
                }
                store8_bf16(pr, v[0]); store8_bf16(pr + 128, v[1]);
            }
    }
};
__device__ __forceinline__ void p2_proj(const Ctx& c, float* lds) {
    pg8::Gemm g{c.hb(), c.win_t(), D, D, D, nullptr, 0, 0, 0};
    pg8::StaticOrder S; S.init(RT, NPROJ, (int)gridDim.x, (int)blockIdx.x);
    EpiProj E{c.proj(), c.pstat(), c.tabr(), c.tabm()};
    pg8::gemm_phase((LAS unsigned char*)lds, g, S, E, c.tid);
    if ((int)gridDim.x == 256 && (int)blockIdx.x >= QSHORT0) { __syncthreads();
        for (int q = 0; q < QSTRIPS; ++q) expert_strip(c, lds, ((int)blockIdx.x - QSHORT0) * QSTRIPS + q);
        __syncthreads(); }
}
template <bool ISQ> struct EpiUp {
    static constexpr bool PERM = true;
    bf16_t* out; const float* pstat; const float* tabm;
    __device__ __forceinline__ void operator()(const f32x4 (&acc)[2][2][4][2], const pg8::Unit& u, int wr, int wc, int fr, int fq) const {
        const int row0 = u.pm * 256 + wr * 64 + fr, col00 = u.pn * 256 + wc * 32 + 8 * fq;
        float sc[8];
#pragma unroll
        for (int i = 0; i < 8; ++i) { const f32x4 ps = *(const f32x4*)(pstat + (size_t)(row0 + (i >> 2) * 128 + (i & 3) * 16) * 8 + (ISQ ? 0 : 4));
            sc[i] = (ISQ ? QSCALE : 1.f) / sqrtf((ps.x + ps.y + ps.z + ps.w) * (ISQ ? 1.f / 256.f : 1.f / 128.f) + EPS); }
#pragma unroll
        for (int ai = 0; ai < 2; ++ai)
#pragma unroll
            for (int m = 0; m < 4; ++m) { const int row = row0 + ai * 128 + m * 16; const float s_ = sc[ai * 4 + m];
#pragma unroll
                for (int bj = 0; bj < 2; ++bj) { const int c0 = col00 + bj * 128; const f32x4 a = acc[ai][bj][m][0], b = acc[ai][bj][m][1];
                    float o[8] = {a[0] * s_, a[1] * s_, a[2] * s_, a[3] * s_, b[0] * s_, b[1] * s_, b[2] * s_, b[3] * s_};
                    if (ISQ) { const int p = c0 - 96 * ((c0 * 683) >> 16);
                        if (p >= 64) { const int t = row & (SEQ - 1), g = (p - 64) >> 3;
                            const f32x4 c0v = *(const f32x4*)(tabm + (t * 16 + 4 * g) * 2), c1v = *(const f32x4*)(tabm + (t * 16 + 4 * g) * 2 + 4);
                            const float co[4] = {c0v.x, c0v.z, c1v.x, c1v.z}, si[4] = {c0v.y, c0v.w, c1v.y, c1v.w};
#pragma unroll
                            for (int w = 0; w < 4; ++w) { const float x1 = o[w], x2 = o[4 + w]; o[w] = x1 * co[w] - x2 * si[w]; o[4 + w] = x1 * si[w] + x2 * co[w]; } } }
                    store8_bf16(out + (size_t)row * (ISQ ? QW : KVW) + c0, o); } }
    }
};
__device__ __forceinline__ void p3_upq(const Ctx& c, float* lds) {
    pg8::Gemm g{c.proj() + PC_CQ, c.wuq_t(), NPROJ, 256, 256, nullptr, 0, 0, 0};
    pg8::StaticOrder S; S.init(RL, QW, (int)gridDim.x, (int)blockIdx.x);
    EpiUp<true> E{c.qb(), c.pstat(), c.tabm()};
    pg8::gemm_phase((LAS unsigned char*)lds, g, S, E, c.tid);
}
__device__ __forceinline__ void p3_upkv(const Ctx& c, float* lds) {
    pg8::Gemm g{c.proj() + PC_CKV, c.wukv_t(), NPROJ, 256, 128, nullptr, 0, 0, 0};
    pg8::StaticOrder S; S.init(RT, KVW, (int)gridDim.x, (int)blockIdx.x);
    EpiUp<false> E{c.kvb(), c.pstat(), c.tabm()};
    pg8::gemm_phase((LAS unsigned char*)lds, g, S, E, c.tid);
}

namespace att {
using bf16x8 = __attribute__((ext_vector_type(8))) short;
using s16x4  = __attribute__((ext_vector_type(4))) short;
using f32x16 = __attribute__((ext_vector_type(16))) float;
constexpr int QBLK = 32, KVBLK = 64, NWV = 8;
constexpr float THR = 8.f;
constexpr int SHM_V = 16384, SHM_K = 16384, SHM_ATTN = 3 * SHM_V + 3 * SHM_K + NWV * 64 * 4;
#define KSWZ(row, colB) ((row) * 256 + ((colB) ^ (((row) & 7) << 4)))
#define SBAR() __builtin_amdgcn_sched_barrier(0)
__device__ __forceinline__ int crow(int r, int hi) { return (r & 3) + 8 * (r >> 2) + 4 * hi; }
__device__ __forceinline__ unsigned cvtpk(float lo, float hi) { unsigned r; asm volatile("v_cvt_pk_bf16_f32 %0, %1, %2" : "=v"(r) : "v"(lo), "v"(hi)); return r; }
__device__ __forceinline__ float max3f(float a, float b, float c) { float r; asm("v_max3_f32 %0, %1, %2, %3" : "=v"(r) : "v"(a), "v"(b), "v"(c)); return r; }
template <bool FIRST>
__device__ __forceinline__ void partialSM(f32x16& p0, f32x16& p1, float& m_reg, f32x16& negm, float& alpha) {
  float pa = max3f(p0[0], p0[1], p0[2]), pb = max3f(p1[0], p1[1], p1[2]);
#pragma unroll
  for (int r = 3; r < 15; r += 2) { pa = max3f(pa, p0[r], p0[r + 1]); pb = max3f(pb, p1[r], p1[r + 1]); }
  float pmax = max3f(pa, pb, fmaxf(p0[15], p1[15]));
  { auto rr = __builtin_amdgcn_permlane32_swap(__float_as_uint(pmax), __float_as_uint(pmax), false, false);
    pmax = fmaxf(__uint_as_float(rr[0]), __uint_as_float(rr[1])); }
  if (!FIRST && __builtin_expect(__all(pmax <= THR), 1)) { alpha = 1.f; }
  else { const float dl = FIRST ? pmax : fmaxf(pmax, 0.f); alpha = FIRST ? 1.f : __builtin_amdgcn_exp2f(-dl); m_reg += dl;
#pragma unroll
    for (int r = 0; r < 16; ++r) { p0[r] -= dl; p1[r] -= dl; }
#pragma unroll
    for (int r = 0; r < 16; ++r) negm[r] = -m_reg;
    asm volatile("" : "+v"(negm)); }
#pragma unroll
  for (int r = 0; r < 16; ++r) p0[r] = __builtin_amdgcn_exp2f(p0[r]);
}
__device__ __forceinline__ void finishSM(f32x16& p0, f32x16& p1, float alpha, float& l_reg, bf16x8& pa0, bf16x8& pa1, bf16x8& pa2, bf16x8& pa3) {
#pragma unroll
  for (int r = 0; r < 16; ++r) p1[r] = __builtin_amdgcn_exp2f(p1[r]);
  float ps = 0;
#pragma unroll
  for (int r = 0; r < 16; ++r) ps += p0[r];
#pragma unroll
  for (int r = 0; r < 16; ++r) ps += p1[r];
  { auto rr = __builtin_amdgcn_permlane32_swap(__float_as_uint(ps), __float_as_uint(ps), false, false);
    ps = __uint_as_float(rr[0]) + __uint_as_float(rr[1]); }
  l_reg = l_reg * alpha + ps;
#define PK4(P, BASE, OUT) do { unsigned a0 = cvtpk(P[BASE + 0], P[BASE + 1]), a1 = cvtpk(P[BASE + 2], P[BASE + 3]);   \
    unsigned b0 = cvtpk(P[BASE + 4], P[BASE + 5]), b1 = cvtpk(P[BASE + 6], P[BASE + 7]);                              \
    auto r0 = __builtin_amdgcn_permlane32_swap(a0, b0, false, false); auto r1 = __builtin_amdgcn_permlane32_swap(a1, b1, false, false); \
    u32x4 w = {r0[0], r1[0], r0[1], r1[1]}; OUT = *reinterpret_cast<bf16x8*>(&w); } while (0)
  PK4(p0, 0, pa0); PK4(p0, 8, pa1); PK4(p1, 0, pa2); PK4(p1, 8, pa3);
#undef PK4
}
__device__ __forceinline__ void qkt(f32x16& p0, f32x16& p1, const char* Ks, const bf16x8* qr, const f32x16& negm, int r32, int hi) {
#pragma unroll
  for (int d0 = 0; d0 < 6; ++d0) { const int cb = (d0 * 16 + hi * 8) * 2;
    const bf16x8 b0 = *reinterpret_cast<const bf16x8*>(Ks + KSWZ(r32, cb));
    const bf16x8 b1 = *reinterpret_cast<const bf16x8*>(Ks + KSWZ(32 + r32, cb));
    if (d0 == 0) { p0 = __builtin_amdgcn_mfma_f32_32x32x16_bf16(b0, qr[0], negm, 0, 0, 0); p1 = __builtin_amdgcn_mfma_f32_32x32x16_bf16(b1, qr[0], negm, 0, 0, 0); }
    else { p0 = __builtin_amdgcn_mfma_f32_32x32x16_bf16(b0, qr[d0], p0, 0, 0, 0); p1 = __builtin_amdgcn_mfma_f32_32x32x16_bf16(b1, qr[d0], p1, 0, 0, 0); } }
}
__device__ __forceinline__ int v_st(int k, int c) { const int kk = (k & ~0xC) | ((k & 4) << 1) | ((k & 8) >> 1); return ((kk >> 3) * 4 + (c >> 5)) * 512 + ((kk & 7) * 32 + (c & 31)) * 2; }
__device__ __forceinline__ int v_rd_base(int lane) { return ((lane & 3) << 3) | (((lane >> 2) & 3) << 6) | (((lane >> 4) & 1) << 5) | (((lane >> 5) & 1) << 8); }
constexpr int v_rd_off(int d0, int ks, int half) { return d0 * 512 + ks * 4096 + half * 2048; }
template <int OFF> __device__ __forceinline__ s16x4 tr_read(int vb) { s16x4 r; asm volatile("ds_read_b64_tr_b16 %0, %1 offset:%2" : "=&v"(r) : "v"(vb), "i"(OFF) : "memory"); return r; }
template <int D0> __device__ __forceinline__ void pv_one(f32x16& od, int vb, bf16x8 pa0, bf16x8 pa1, bf16x8 pa2, bf16x8 pa3) {
  const s16x4 l0 = tr_read<v_rd_off(D0, 0, 0)>(vb), h0 = tr_read<v_rd_off(D0, 0, 1)>(vb), l1 = tr_read<v_rd_off(D0, 1, 0)>(vb), h1 = tr_read<v_rd_off(D0, 1, 1)>(vb);
  const s16x4 l2 = tr_read<v_rd_off(D0, 2, 0)>(vb), h2 = tr_read<v_rd_off(D0, 2, 1)>(vb), l3 = tr_read<v_rd_off(D0, 3, 0)>(vb), h3 = tr_read<v_rd_off(D0, 3, 1)>(vb);
  asm volatile("s_waitcnt lgkmcnt(0)" ::: "memory"); SBAR();
#define PK(L, H) (bf16x8){L[0], L[1], L[2], L[3], H[0], H[1], H[2], H[3]}
  od = __builtin_amdgcn_mfma_f32_32x32x16_bf16(pa0, PK(l0, h0), od, 0, 0, 0);
  od = __builtin_amdgcn_mfma_f32_32x32x16_bf16(pa1, PK(l1, h1), od, 0, 0, 0);
  od = __builtin_amdgcn_mfma_f32_32x32x16_bf16(pa2, PK(l2, h2), od, 0, 0, 0);
  od = __builtin_amdgcn_mfma_f32_32x32x16_bf16(pa3, PK(l3, h3), od, 0, 0, 0);
#undef PK
}
__device__ __forceinline__ void pv_d0(f32x16* o, int vb, bf16x8 pa0, bf16x8 pa1, bf16x8 pa2, bf16x8 pa3) {
  const s16x4 l0 = tr_read<v_rd_off(0, 0, 0)>(vb), h0 = tr_read<v_rd_off(0, 0, 1)>(vb), l1 = tr_read<v_rd_off(0, 1, 0)>(vb), h1 = tr_read<v_rd_off(0, 1, 1)>(vb);
  const s16x4 l2 = tr_read<v_rd_off(0, 2, 0)>(vb), h2 = tr_read<v_rd_off(0, 2, 1)>(vb), l3 = tr_read<v_rd_off(0, 3, 0)>(vb), h3 = tr_read<v_rd_off(0, 3, 1)>(vb);
  const s16x4 m0 = tr_read<v_rd_off(1, 0, 0)>(vb), g0 = tr_read<v_rd_off(1, 0, 1)>(vb), m1 = tr_read<v_rd_off(1, 1, 0)>(vb), g1 = tr_read<v_rd_off(1, 1, 1)>(vb);
  const s16x4 m2 = tr_read<v_rd_off(1, 2, 0)>(vb), g2 = tr_read<v_rd_off(1, 2, 1)>(vb), m3 = tr_read<v_rd_off(1, 3, 0)>(vb), g3 = tr_read<v_rd_off(1, 3, 1)>(vb);
  asm volatile("s_waitcnt lgkmcnt(0)" ::: "memory"); SBAR();
#define PK(L, H) (bf16x8){L[0], L[1], L[2], L[3], H[0], H[1], H[2], H[3]}
  o[0] = __builtin_amdgcn_mfma_f32_32x32x16_bf16(pa0, PK(l0, h0), o[0], 0, 0, 0); o[1] = __builtin_amdgcn_mfma_f32_32x32x16_bf16(pa0, PK(m0, g0), o[1], 0, 0, 0);
  o[0] = __builtin_amdgcn_mfma_f32_32x32x16_bf16(pa1, PK(l1, h1), o[0], 0, 0, 0); o[1] = __builtin_amdgcn_mfma_f32_32x32x16_bf16(pa1, PK(m1, g1), o[1], 0, 0, 0);
  o[0] = __builtin_amdgcn_mfma_f32_32x32x16_bf16(pa2, PK(l2, h2), o[0], 0, 0, 0); o[1] = __builtin_amdgcn_mfma_f32_32x32x16_bf16(pa2, PK(m2, g2), o[1], 0, 0, 0);
  o[0] = __builtin_amdgcn_mfma_f32_32x32x16_bf16(pa3, PK(l3, h3), o[0], 0, 0, 0); o[1] = __builtin_amdgcn_mfma_f32_32x32x16_bf16(pa3, PK(m3, g3), o[1], 0, 0, 0);
#undef PK
}

__device__ __forceinline__ void attn_unit(const bf16_t* __restrict__ Qb, const bf16_t* __restrict__ KN, const bf16_t* __restrict__ KR, const bf16_t* __restrict__ VV, bf16_t* __restrict__ Ob, int b, char* lds, int tid) {
  const int wid = tid >> 6, lane = tid & 63, r32 = lane & 31, hi = lane >> 5;
  char* V_lds = lds; char* K_lds = lds + 3 * SHM_V;
  float* ws = (float*)(lds + 3 * SHM_V + 3 * SHM_K) + wid * 64; float* li_l = ws; float* al_l = ws + 32;
  float m_reg = 0.f, l_reg = 0; f32x16 o[2] = {}; bf16x8 qr[6]; f32x16 negm = {};
  const bf16_t* Qw = Qb + (long)(wid * QBLK + r32) * QW + hi * 8;
#pragma unroll
  for (int d0 = 0; d0 < 6; ++d0) qr[d0] = __builtin_nontemporal_load(reinterpret_cast<const bf16x8*>(Qw + d0 * 16));
  const int srow = tid >> 3, sch = tid & 7;
  const int rrow = (tid & 255) >> 2, rch = tid & 3;
  const int vst = v_st(srow, sch * 8), kst = KSWZ(srow, sch * 16), krst = KSWZ(rrow, 128 + rch * 16);
  const int vb0 = (int)(uintptr_t)V_lds + v_rd_base(lane);
  struct { bf16x8 vs, kn, kr; } sr_[2];
#define ROWBASE(j) ((j) < 64 ? (long)b * SEQ + (long)(j) * 64 : (long)RL + (long)b * LC + (long)((j) - 64) * 64)
#define SLOAD(i, j) do { const long rb_ = ROWBASE(j); sr_[i].vs = *reinterpret_cast<const bf16x8*>(VV + (rb_ + srow) * KVW + sch * 8); \
    sr_[i].kn = *reinterpret_cast<const bf16x8*>(KN + (rb_ + srow) * KVW + sch * 8); sr_[i].kr = *reinterpret_cast<const bf16x8*>(KR + (rb_ + rrow) * NPROJ + rch * 8); } while (0)
#define SWRITE(bb, i) do { *(bf16x8*)(V_lds + (bb) * SHM_V + vst) = sr_[i].vs; *(bf16x8*)(K_lds + (bb) * SHM_K + kst) = sr_[i].kn; \
    if (wid < 4) *(bf16x8*)(K_lds + (bb) * SHM_K + krst) = sr_[i].kr; } while (0)
#define SWAIT() asm volatile("s_waitcnt vmcnt(3)" ::: "memory")
#define RESC(a) do { if (__any((a) < 1.f)) { if (hi == 0) al_l[r32] = (a); asm volatile("s_waitcnt lgkmcnt(0)" ::: "memory"); \
    _Pragma("unroll") for (int d = 0; d < 2; ++d) _Pragma("unroll") for (int r = 0; r < 16; ++r) o[d][r] *= al_l[crow(r, hi)]; } } while (0)
  f32x16 pA0, pA1, pB0, pB1; float alA, alB; bf16x8 pa0, pa1, pa2, pa3; constexpr int NT = (SEQ + LC) / KVBLK;
  if (wid >= 4) __builtin_amdgcn_s_setprio(1);
  int cur = 1, prev = 0, nxt = 2;
  SLOAD(0, 0); SLOAD(1, 1); asm volatile("s_waitcnt vmcnt(0)" ::: "memory"); SWRITE(0, 0); SWRITE(1, 1); SLOAD(0, 2); SLOAD(1, 3); __syncthreads();
  qkt(pA0, pA1, K_lds, qr, negm, r32, hi); partialSM<true>(pA0, pA1, m_reg, negm, alA);
#define HALFSTEP(PX0, PX1, PP0, PP1, ALX, ALP, STG, T) do { \
    __syncthreads(); \
    SBAR(); qkt(PX0, PX1, K_lds + cur * SHM_K, qr, negm, r32, hi); \
    finishSM(PP0, PP1, ALP, l_reg, pa0, pa1, pa2, pa3); SBAR(); \
    if ((T) + 1 < NT) { SWAIT(); SWRITE(nxt, STG); if ((T) + 3 < NT) SLOAD(STG, (T) + 3); } SBAR(); \
    pv_d0(o, vb0 + prev * SHM_V, pa0, pa1, pa2, pa3); partialSM<false>(PX0, PX1, m_reg, negm, ALX); \
    RESC(ALX); { const int t_ = prev; prev = cur; cur = nxt; nxt = t_; } } while (0)
  for (int t = 1; t + 1 < NT; t += 2) {
    HALFSTEP(pB0, pB1, pA0, pA1, alB, alA, 0, t);
    HALFSTEP(pA0, pA1, pB0, pB1, alA, alB, 1, t + 1);
  }
  HALFSTEP(pB0, pB1, pA0, pA1, alB, alA, 0, NT - 1);
  finishSM(pB0, pB1, alB, l_reg, pa0, pa1, pa2, pa3); SBAR();
  pv_d0(o, vb0 + prev * SHM_V, pa0, pa1, pa2, pa3);
#undef HALFSTEP
  if (hi == 0) li_l[r32] = l_reg; asm volatile("s_waitcnt lgkmcnt(0)" ::: "memory");
  float rli[16];
#pragma unroll
  for (int r = 0; r < 16; ++r) rli[r] = __builtin_amdgcn_rcpf(li_l[crow(r, hi)]);
  bf16_t* Ow = Ob + (long)(wid * QBLK) * D;
#pragma unroll
  for (int r = 0; r < 16; ++r) { const int orow = crow(r, hi);
#pragma unroll
    for (int d0 = 0; d0 < 2; ++d0) Ow[(long)orow * D + d0 * 32 + r32] = f2bf(o[d0][r] * rli[r]); }
  __builtin_amdgcn_s_setprio(0);
  __syncthreads();
#undef ROWBASE
#undef SLOAD
#undef SWRITE
#undef SWAIT
#undef RESC
}
#undef KSWZ
#undef SBAR
}


__device__ __forceinline__ float lg2_of(float e) { return log1pf(-exp2f(-e)) * 1.4426950408889634f; }
namespace ret {
using att::bf16x8; using att::s16x4; using att::f32x16; using att::v_st; using att::v_rd_base; using att::v_rd_off; using att::tr_read; using att::crow; using att::cvtpk;
constexpr int TB = 16384;
__device__ __forceinline__ bf16x8 scale8(bf16x8 x, float z) {
    const u32x4 w = __builtin_bit_cast(u32x4, x); u32x4 o;
    o.x = cvtpk(__uint_as_float(w.x << 16) * z, __uint_as_float(w.x & 0xffff0000u) * z); o.y = cvtpk(__uint_as_float(w.y << 16) * z, __uint_as_float(w.y & 0xffff0000u) * z);
    o.z = cvtpk(__uint_as_float(w.z << 16) * z, __uint_as_float(w.z & 0xffff0000u) * z); o.w = cvtpk(__uint_as_float(w.w << 16) * z, __uint_as_float(w.w & 0xffff0000u) * z);
    return __builtin_bit_cast(bf16x8, o);
}
#define RET_PK(L, H) (bf16x8){L[0], L[1], L[2], L[3], H[0], H[1], H[2], H[3]}
__device__ __forceinline__ void tt_mma(f32x16& acc, int va, int vb) {
    const s16x4 al0 = tr_read<v_rd_off(0, 0, 0)>(va), ah0 = tr_read<v_rd_off(0, 0, 1)>(va), al1 = tr_read<v_rd_off(0, 1, 0)>(va), ah1 = tr_read<v_rd_off(0, 1, 1)>(va);
    const s16x4 al2 = tr_read<v_rd_off(0, 2, 0)>(va), ah2 = tr_read<v_rd_off(0, 2, 1)>(va), al3 = tr_read<v_rd_off(0, 3, 0)>(va), ah3 = tr_read<v_rd_off(0, 3, 1)>(va);
    const s16x4 bl0 = tr_read<v_rd_off(0, 0, 0)>(vb), bh0 = tr_read<v_rd_off(0, 0, 1)>(vb), bl1 = tr_read<v_rd_off(0, 1, 0)>(vb), bh1 = tr_read<v_rd_off(0, 1, 1)>(vb);
    const s16x4 bl2 = tr_read<v_rd_off(0, 2, 0)>(vb), bh2 = tr_read<v_rd_off(0, 2, 1)>(vb), bl3 = tr_read<v_rd_off(0, 3, 0)>(vb), bh3 = tr_read<v_rd_off(0, 3, 1)>(vb);
    asm volatile("s_waitcnt lgkmcnt(0)" ::: "memory"); __builtin_amdgcn_sched_barrier(0);
    acc = __builtin_amdgcn_mfma_f32_32x32x16_bf16(RET_PK(al0, ah0), RET_PK(bl0, bh0), acc, 0, 0, 0);
    acc = __builtin_amdgcn_mfma_f32_32x32x16_bf16(RET_PK(al1, ah1), RET_PK(bl1, bh1), acc, 0, 0, 0);
    acc = __builtin_amdgcn_mfma_f32_32x32x16_bf16(RET_PK(al2, ah2), RET_PK(bl2, bh2), acc, 0, 0, 0);
    acc = __builtin_amdgcn_mfma_f32_32x32x16_bf16(RET_PK(al3, ah3), RET_PK(bl3, bh3), acc, 0, 0, 0);
}
__device__ __forceinline__ void scan_seq(const bf16_t* __restrict__ proj, bf16_t* __restrict__ rstT, int b, int h, int dir, float lg2, char* lds, int tid) {
    const int wid = tid >> 6, lane = tid & 63, r32 = lane & 31, hi = lane >> 5;
    const float g128 = __builtin_amdgcn_exp2f(lg2 * 128.f);
    const int key0 = tid >> 3, key1 = 64 + (tid >> 3), ch = tid & 7;
    const float z0 = __builtin_amdgcn_exp2f(lg2 * (float)(dir ? key0 : 127 - key0)), z1 = __builtin_amdgcn_exp2f(lg2 * (float)(dir ? key1 : 127 - key1));
    const int st = v_st(tid >> 3, ch * 8);
    char* KI = lds; char* VI = lds + 4 * TB;
    const int mt = (wid >> 1) & 1, nt = wid & 1;
    const int vaK = (int)(uintptr_t)KI + v_rd_base(lane) + mt * 512, vbV = (int)(uintptr_t)VI + v_rd_base(lane) + nt * 512;
    f32x16 acc = {};
    bf16x8 k0a, k1a, v0a, v1a, k0b, k1b, v0b, v1b, k0c, k1c, v0c, v1c, k0d, k1d, v0d, v1d;
#define RROW(ck) ((ck) < 2 ? (long)RL + (long)b * LC + (long)(dir ? 1 - (ck) : (ck)) * 128 : (long)b * SEQ + (long)(dir ? NCH - 1 - ((ck) - 2) : (ck) - 2) * 128)
#define RLOAD(S, ck) do { const bf16_t* p_ = proj + RROW(ck) * NPROJ + h * 64 + ch * 8; k0##S = *(const bf16x8*)(p_ + (long)key0 * NPROJ + PC_RK); k1##S = *(const bf16x8*)(p_ + (long)key1 * NPROJ + PC_RK); \
        v0##S = *(const bf16x8*)(p_ + (long)key0 * NPROJ + PC_RV); v1##S = *(const bf16x8*)(p_ + (long)key1 * NPROJ + PC_RV); } while (0)
#define RWRITE(S, bb) do { *(bf16x8*)(KI + ((bb) * 2 + 0) * TB + st) = scale8(k0##S, z0); *(bf16x8*)(KI + ((bb) * 2 + 1) * TB + st) = scale8(k1##S, z1); \
        *(bf16x8*)(VI + ((bb) * 2 + 0) * TB + st) = v0##S; *(bf16x8*)(VI + ((bb) * 2 + 1) * TB + st) = v1##S; } while (0)
#define RCOMP(ck, bb) do { if (wid < 4) { \
            if ((ck) >= 2) { const int n = dir ? NCH - 1 - ((ck) - 2) : (ck) - 2; bf16_t* o = rstT + (size_t)n * 4096 + (size_t)(32 * nt + r32) * 64 + 32 * mt + 4 * hi; \
                _Pragma("unroll") for (int g = 0; g < 4; ++g) { u32x2 w; w.x = cvtpk(acc[4 * g], acc[4 * g + 1]); w.y = cvtpk(acc[4 * g + 2], acc[4 * g + 3]); *(u32x2*)(o + 8 * g) = w; } } \
            _Pragma("unroll") for (int r = 0; r < 16; ++r) acc[r] *= g128; \
            tt_mma(acc, vaK + ((bb) * 2 + 0) * TB, vbV + ((bb) * 2 + 0) * TB); \
            tt_mma(acc, vaK + ((bb) * 2 + 1) * TB, vbV + ((bb) * 2 + 1) * TB); } } while (0)
    constexpr int NCK = 2 + NCH;
#define RSTEP(ck, S) do { RCOMP(ck, (ck) & 1); if ((ck) + 1 < NCK) { RWRITE(S, ((ck) + 1) & 1); } if ((ck) + 5 < NCK) RLOAD(S, (ck) + 5); __syncthreads(); } while (0)
    __syncthreads();
    RLOAD(a, 0); RWRITE(a, 0); RLOAD(b, 1); RLOAD(c, 2); RLOAD(d, 3); RLOAD(a, 4); __syncthreads();
    for (int ck = 0; ck < 32; ck += 4) { RSTEP(ck, b); RSTEP(ck + 1, c); RSTEP(ck + 2, d); RSTEP(ck + 3, a); }
    RSTEP(32, b); RSTEP(33, c);
#undef RSTEP
#undef RCOMP
#undef RROW
#undef RLOAD
#undef RWRITE
}

__device__ __forceinline__ int vc_st(int k, int c) { const int kk = (k & ~0xC) | ((k & 4) << 1) | ((k & 8) >> 1); return ((kk >> 3) * 2 + (c >> 5)) * 512 + ((kk & 7) * 32 + (c & 31)) * 2; }
constexpr int vc_rd_off(int ks, int half) { return ks * 2048 + half * 1024; }
constexpr int RBUF = 32768;
struct RetUnit { int b, h, n; };
template <class UF>
__device__ __forceinline__ void ret_group(const bf16_t* __restrict__ proj, const bf16_t* __restrict__ rst, const float* __restrict__ g_ret, const float* __restrict__ exp_f, const float* __restrict__ exp_b,
                                          bf16_t* __restrict__ mix, int nunits, UF unit_of, char* gl, int t4, int w4, int lane) {
    const int r32 = lane & 31, hi = lane >> 5, i = 32 * w4 + r32;
    bf16x8 qn[4];
    int soff[8];
#pragma unroll
    for (int q_ = 0; q_ < 8; ++q_) { const int s_ = ((4 * q_ + w4) * 64 + lane) & 1023;
        if (q_ < 4) { const int img = s_ >> 9, sub = (s_ & 511) >> 5, rw = (s_ & 31) >> 2, cc = s_ & 3; const int kk = (sub >> 1) * 8 + rw, key = (kk & ~0xC) | ((kk & 4) << 1) | ((kk & 8) >> 1);
            soff[q_] = (img * 64 + key) * NPROJ + PC_RV + (sub & 1) * 32 + cc * 8; }
        else { const int row = s_ >> 3, cp = s_ & 7, chn = cp ^ ((row >> 1) & 7); soff[q_] = row * NPROJ + PC_RK + chn * 8; } }
#define RG_LOAD(u, bb) do { const bf16_t* base_ = proj + ((long)(u).b * SEQ + (long)(u).n * 128) * NPROJ + (u).h * 64; \
        _Pragma("unroll") for (int q_ = 0; q_ < 8; ++q_) __builtin_amdgcn_global_load_lds((const unsigned*)(base_ + soff[q_]), (LAS unsigned*)((LAS char*)gl + (bb) * RBUF + (4 * q_ + w4) * 1024), 16, 0, 0); \
        const bf16_t* qp_ = base_ + (long)i * NPROJ + PC_RQ + hi * 8; \
        _Pragma("unroll") for (int ks_ = 0; ks_ < 4; ++ks_) qn[ks_] = *(const bf16x8*)(qp_ + ks_ * 16); } while (0)
    RetUnit u = unit_of(0);
    RG_LOAD(u, 0);
    bf16x8 q[4];
#pragma unroll
    for (int ks = 0; ks < 4; ++ks) q[ks] = qn[ks];
    asm volatile("s_waitcnt vmcnt(0)" ::: "memory"); __syncthreads();
    for (int ui = 0; ui < nunits; ++ui) {
        const int bb = ui & 1; const RetUnit un = unit_of(ui + 1 < nunits ? ui + 1 : ui);
        if (ui + 1 < nunits) RG_LOAD(un, bb ^ 1);
        const float lf = lg2_of(exp_f[u.h]), lb = lg2_of(exp_b[u.h]);
        int io = i, hio = hi; asm volatile("" : "+v"(io), "+v"(hio));
        const long row0 = (long)u.b * SEQ + (long)u.n * 128;
        const bf16_t* rf = rst + (size_t)(((u.b * NH + u.h) * 2 + 0) * NCH + u.n) * 4096 + (size_t)r32 * 64 + hi * 8;
        const bf16_t* rb = rst + (size_t)(((u.b * NH + u.h) * 2 + 1) * NCH + u.n) * 4096 + (size_t)r32 * 64 + hi * 8;
        bf16x8 rff[2][4], rbf[2][4];
#pragma unroll
        for (int et = 0; et < 2; ++et)
#pragma unroll
            for (int ks = 0; ks < 4; ++ks) { rff[et][ks] = *(const bf16x8*)(rf + et * 2048 + ks * 16); rbf[et][ks] = *(const bf16x8*)(rb + et * 2048 + ks * 16); }
        f32x16 acc[2] = {f32x16{}, f32x16{}};
        const char* kt = gl + bb * RBUF + 16384; const int vimg0 = (int)(uintptr_t)(gl + bb * RBUF) + v_rd_base(lane);
#pragma unroll
        for (int t = 0; t < 4; ++t) {
            f32x16 p = {};
            const int krow = 32 * t + r32;
#pragma unroll
            for (int ks = 0; ks < 4; ++ks) { const bf16x8 kf = *(const bf16x8*)(kt + krow * 128 + (((2 * ks + hi) ^ ((krow >> 1) & 7)) << 4)); p = __builtin_amdgcn_mfma_f32_32x32x16_bf16(kf, q[ks], p, 0, 0, 0); }
#pragma unroll
            for (int r = 0; r < 16; ++r) { const int j = 32 * t + (r & 3) + 8 * (r >> 2) + 4 * hio; const int dd = io - j; p[r] *= __builtin_amdgcn_exp2f(dd >= 0 ? lf * (float)dd : lb * (float)(-dd)); }
            bf16x8 pa0, pa1;
#define PK4(P, BASE, OUT) do { unsigned a0 = cvtpk(P[BASE + 0], P[BASE + 1]), a1 = cvtpk(P[BASE + 2], P[BASE + 3]);   \
    unsigned b0 = cvtpk(P[BASE + 4], P[BASE + 5]), b1 = cvtpk(P[BASE + 6], P[BASE + 7]);                              \
    auto r0 = __builtin_amdgcn_permlane32_swap(a0, b0, false, false); auto r1 = __builtin_amdgcn_permlane32_swap(a1, b1, false, false); \
    u32x4 w = {r0[0], r1[0], r0[1], r1[1]}; OUT = *reinterpret_cast<bf16x8*>(&w); } while (0)
            PK4(p, 0, pa0); PK4(p, 8, pa1);
#undef PK4
            const int vimg = vimg0 + (t >> 1) * 8192;
#pragma unroll
            for (int et = 0; et < 2; ++et) {
                s16x4 l0, h0, l1, h1;
                if ((t & 1) == 0) { l0 = tr_read<vc_rd_off(0, 0)>(vimg + et * 512); h0 = tr_read<vc_rd_off(0, 1)>(vimg + et * 512); l1 = tr_read<vc_rd_off(1, 0)>(vimg + et * 512); h1 = tr_read<vc_rd_off(1, 1)>(vimg + et * 512); }
                else { l0 = tr_read<vc_rd_off(2, 0)>(vimg + et * 512); h0 = tr_read<vc_rd_off(2, 1)>(vimg + et * 512); l1 = tr_read<vc_rd_off(3, 0)>(vimg + et * 512); h1 = tr_read<vc_rd_off(3, 1)>(vimg + et * 512); }
                asm volatile("s_waitcnt lgkmcnt(0)" ::: "memory"); __builtin_amdgcn_sched_barrier(0);
                acc[et] = __builtin_amdgcn_mfma_f32_32x32x16_bf16(RET_PK(l0, h0), pa0, acc[et], 0, 0, 0);
                acc[et] = __builtin_amdgcn_mfma_f32_32x32x16_bf16(RET_PK(l1, h1), pa1, acc[et], 0, 0, 0);
            }
            asm volatile("" ::: "memory");
        }
        const float xf = __builtin_amdgcn_exp2f(lf * (float)(i + 1)), xb = __builtin_amdgcn_exp2f(lb * (float)(128 - i));
        const bf16_t* gp = proj + (row0 + i) * NPROJ + PC_RG + u.h * 64; bf16_t* op = mix + (row0 + i) * D + 512 + u.h * 64; const float* gr = g_ret + u.h * 64;
        u32x2 gwv[2][4];
#pragma unroll
        for (int et = 0; et < 2; ++et)
#pragma unroll
            for (int g = 0; g < 4; ++g) gwv[et][g] = *(const u32x2*)(gp + 32 * et + 8 * g + 4 * hi);
        bf16x8 qf[4], qbk[4];
#pragma unroll
        for (int ks = 0; ks < 4; ++ks) { qf[ks] = scale8(q[ks], xf); qbk[ks] = scale8(q[ks], xb); }
#pragma unroll
        for (int et = 0; et < 2; ++et) {
#pragma unroll
            for (int ks = 0; ks < 4; ++ks) acc[et] = __builtin_amdgcn_mfma_f32_32x32x16_bf16(rff[et][ks], qf[ks], acc[et], 0, 0, 0);
#pragma unroll
            for (int ks = 0; ks < 4; ++ks) acc[et] = __builtin_amdgcn_mfma_f32_32x32x16_bf16(rbf[et][ks], qbk[ks], acc[et], 0, 0, 0); }
        float s1 = 0.f;
#pragma unroll
        for (int et = 0; et < 2; ++et)
#pragma unroll
            for (int r = 0; r < 16; ++r) s1 += acc[et][r];
        { auto rr = __builtin_amdgcn_permlane32_swap(__float_as_uint(s1), __float_as_uint(s1), false, false); s1 = __uint_as_float(rr[0]) + __uint_as_float(rr[1]); }
        const float mu = s1 * (1.f / 64.f); float s2 = 0.f;
#pragma unroll
        for (int et = 0; et < 2; ++et)
#pragma unroll
            for (int r = 0; r < 16; ++r) { const float dlt = acc[et][r] - mu; s2 += dlt * dlt; }
        { auto rr = __builtin_amdgcn_permlane32_swap(__float_as_uint(s2), __float_as_uint(s2), false, false); s2 = __uint_as_float(rr[0]) + __uint_as_float(rr[1]); }
        const float rs = 1.f / sqrtf(s2 * (1.f / 64.f) + EPS);
#pragma unroll
        for (int et = 0; et < 2; ++et)
#pragma unroll
            for (int g = 0; g < 4; ++g) { const int e = 32 * et + 8 * g + 4 * hi; const u32x2 gw = gwv[et][g]; const f32x4 gg = *(const f32x4*)(gr + e);
                const float o0 = (acc[et][4 * g] - mu) * rs * gg.x * __uint_as_float(gw.x << 16), o1 = (acc[et][4 * g + 1] - mu) * rs * gg.y * __uint_as_float(gw.x & 0xffff0000u);
                const float o2 = (acc[et][4 * g + 2] - mu) * rs * gg.z * __uint_as_float(gw.y << 16), o3 = (acc[et][4 * g + 3] - mu) * rs * gg.w * __uint_as_float(gw.y & 0xffff0000u);
                u32x2 w; w.x = cvtpk(o0, o1); w.y = cvtpk(o2, o3); *(u32x2*)(op + e) = w; }
        if (ui + 1 < nunits) {
#pragma unroll
            for (int ks = 0; ks < 4; ++ks) q[ks] = qn[ks]; }
        u = un;
        asm volatile("s_waitcnt vmcnt(0)" ::: "memory"); __syncthreads();
    }
#undef RG_LOAD
}
#undef RET_PK
}

__device__ __forceinline__ void p4_attn(const Ctx& c, float* lds) {
    const int G = (int)gridDim.x, bx = (int)blockIdx.x; const int vcu = (G % 8 == 0) ? (bx % 8) * (G / 8) + bx / 8 : bx;
    for (int unit = vcu; unit < NB * NH * 16; unit += G) {
        const int qblk = unit & 15, h = (unit >> 4) & 7, b = unit >> 7;
        att::attn_unit(c.qb() + (size_t)(b * SEQ + qblk * 256) * QW + h * 96, c.kvb() + h * 128, c.proj() + PC_KR, c.kvb() + h * 128 + 64,
                       c.mix() + (size_t)(b * SEQ + qblk * 256) * D + h * 64, b, (char*)lds, c.tid);
    }
}
__device__ __forceinline__ void p3c_scan(const Ctx& c, float* lds) {
    const int bx = (int)blockIdx.x;
    for (int seq = bx >> 1; seq < NB * NH * 2 && (bx & 1) == 0; seq += (int)gridDim.x >> 1) {
        const int dir = seq & 1, h = (seq >> 1) & 7, b = seq >> 4;
        const float lg2 = lg2_of(dir ? c.exp_b()[h] : c.exp_f()[h]);
        ret::scan_seq(c.proj(), c.rst() + (size_t)((b * NH + h) * 2 + dir) * NCH * 4096, b, h, dir, lg2, (char*)lds, c.tid);
    }
    __syncthreads();
    {
      unsigned* qctr = (unsigned*)(c.wsb() + WS_CTL) + 2048; int* qslot = (int*)(lds + 8 * 64 * 65 + 640);
      const int first = (int)gridDim.x == 256 ? QSTATIC : 0;
      int nq = 0; if (c.tid == 0) nq = first + (int)__hip_atomic_fetch_add(qctr, 1u, __ATOMIC_RELAXED, __HIP_MEMORY_SCOPE_AGENT);
      for (;;) { if (c.tid == 0) *qslot = nq;
          __syncthreads(); const int q = *qslot; __syncthreads();
          if (q >= EXP_STRIPS) break;
          if (c.tid == 0) nq = first + (int)__hip_atomic_fetch_add(qctr, 1u, __ATOMIC_RELAXED, __HIP_MEMORY_SCOPE_AGENT);
          expert_strip(c, lds, q); } }
    __syncthreads();
}
__device__ __forceinline__ void p4_ret(const Ctx& c, float* lds) {
    const int tid = c.tid, wid = tid >> 6, lane = tid & 63, grp = wid >> 2, w4 = wid & 3;
    const int G = (int)gridDim.x, bx = (int)blockIdx.x; const int vcu = (G % 8 == 0) ? (bx % 8) * (G / 8) + bx / 8 : bx;
    const int gid = vcu * 2 + grp, ngrp = 2 * G; const int total = NB * NH * NCH;
    const int nun = (total - gid + ngrp - 1) / ngrp;
    __syncthreads();
    ret::ret_group(c.proj(), c.rst(), c.g_ret(), c.exp_f(), c.exp_b(), c.mix(), nun,
                   [gid, ngrp](int k) { const int unit = gid + ngrp * k; return ret::RetUnit{unit >> 8, (unit >> 5) & 7, unit & 31}; }, (char*)lds + grp * 2 * ret::RBUF, tid & 255, w4, lane);
}

struct EpiRes {
    static constexpr bool PERM = true;
    const float* x; bf16_t* out; const float* modv; float* part;
    __device__ __forceinline__ void operator()(const f32x4 (&acc)[2][2][4][2], const pg8::Unit& u, int wr, int wc, int fr, int fq) const {
        const int row0 = u.pm * 256 + wr * 64 + fr, col0 = u.pn * 256 + wc * 32 + 8 * fq; const int b = (u.pm * 256) / SEQ;
        f32x4 ga[2][2];
#pragma unroll
        for (int bj = 0; bj < 2; ++bj) { ga[bj][0] = *(const f32x4*)(modv + b * 6144 + 2048 + col0 + bj * 128); ga[bj][1] = *(const f32x4*)(modv + b * 6144 + 2048 + col0 + bj * 128 + 4); }
#pragma unroll
        for (int ai = 0; ai < 2; ++ai) {
            f32x4 xv[4][2][2];
#pragma unroll
            for (int m = 0; m < 4; ++m)
#pragma unroll
                for (int bj = 0; bj < 2; ++bj) { const float* xr = x + (size_t)(row0 + ai * 128 + m * 16) * D + col0 + bj * 128; xv[m][bj][0] = __builtin_nontemporal_load((const f32x4*)xr); xv[m][bj][1] = __builtin_nontemporal_load((const f32x4*)(xr + 4)); }
#pragma unroll
            for (int m = 0; m < 4; ++m) { float ssq = 0.f, mx = 0.f;
#pragma unroll
                for (int bj = 0; bj < 2; ++bj) { const f32x4 y0 = xv[m][bj][0] + ga[bj][0] * acc[ai][bj][m][0], y1 = xv[m][bj][1] + ga[bj][1] * acc[ai][bj][m][1];
                    const float o[8] = {y0.x, y0.y, y0.z, y0.w, y1.x, y1.y, y1.z, y1.w}; store8_bf16(out + (size_t)(row0 + ai * 128 + m * 16) * D + col0 + bj * 128, o);
                    const f32x4 tm = __builtin_elementwise_max(__builtin_elementwise_abs(y0), __builtin_elementwise_abs(y1)), sq = y0 * y0 + y1 * y1;
                    ssq += (sq.x + sq.y) + (sq.z + sq.w); mx = fmaxf(mx, fmaxf(fmaxf(tm.x, tm.y), fmaxf(tm.z, tm.w))); }
                ssq += __shfl_xor(ssq, 16); ssq += __shfl_xor(ssq, 32); mx = fmaxf(mx, __shfl_xor(mx, 16)); mx = fmaxf(mx, __shfl_xor(mx, 32));
                if (fq == 0) { float* pp = part + (size_t)(row0 + ai * 128 + m * 16) * 32 + u.pn * 4 + wc; pp[0] = ssq; pp[16] = mx; } }
            asm volatile("" ::: "memory");
        }
    }
};
__device__ __forceinline__ void p6_wo(const Ctx& c, float* lds) {
    pg8::Gemm g{c.mix(), c.wo_t(), D, D, D, nullptr, 0, 0, 0};
    pg8::StaticOrder S; S.init(RL, D, (int)gridDim.x, (int)blockIdx.x);
    EpiRes E{c.x(), c.x1b(), c.modv(), c.rpart()};
    pg8::gemm_phase((LAS unsigned char*)lds, g, S, E, c.tid);
}
__device__ __forceinline__ void p7_norm_router(const Ctx& c, float* lds) {
    typedef short bf16x8_t __attribute__((ext_vector_type(8)));
    constexpr int WP = 1032;
    bf16_t* whi = (bf16_t*)lds; bf16_t* wlo = whi + 16 * WP; float* gsl = (float*)(wlo + 16 * WP); float* shl = gsl + 1024; float* gpl = shl + 1024;
    const int G = (int)gridDim.x, bx = (int)blockIdx.x;
    bool first = true;
    for (int blk = bx; blk < RL / 128; blk += G) {
        const int b = (blk * 128) / SEQ; const float* md = c.modv() + b * 6144;
        const int fr = c.lane & 15, fq = c.lane >> 4; const int row = blk * 128 + c.wave * 16 + fr;
        const bf16_t* xr2 = c.x1b() + (size_t)row * D + 16 * fq;
        float wv[32];
        if (first) {
#pragma unroll
            for (int it = 0; it < 32; ++it) wv[it] = c.w_router()[c.tid + 512 * it]; }
        u32x4 xw[32];
#pragma unroll
        for (int i = 0; i < 16; ++i) xw[i] = *(const u32x4*)(xr2 + 64 * (i >> 1) + 8 * (i & 1));
        asm volatile("s_waitcnt lgkmcnt(0)\n\ts_barrier" ::: "memory");
        for (int k = c.tid; k < 1024; k += 512) { gsl[k] = c.g_ffn()[k] * (1.f + md[4096 + k]); shl[k] = md[3072 + k]; }
        if (first) { int tl = c.tid; asm volatile("" : "+v"(tl));
#pragma unroll
            for (int it = 0; it < 32; ++it) { const int i = tl + 512 * it, k = i >> 4, e = i & 15; const float w = wv[it]; const bf16_t h = f2bf(w); whi[e * WP + k] = h; wlo[e * WP + k] = f2bf(w - bf2f(h)); }
            first = false; }
#pragma unroll
        for (int i = 16; i < 32; ++i) xw[i] = *(const u32x4*)(xr2 + 64 * (i >> 1) + 8 * (i & 1));
        asm volatile("s_waitcnt lgkmcnt(0)\n\ts_barrier" ::: "memory");
        if (c.tid < 16) { float gm = 0.f; const int c0_ = (c.tid >> 2) * 256 + (c.tid & 3) * 32;
            for (int k = 0; k < 32; ++k) gm = fmaxf(gm, fmaxf(fabsf(gsl[c0_ + k]), fabsf(gsl[c0_ + 128 + k])));
            gpl[c.tid] = gm; }
        asm volatile("s_waitcnt lgkmcnt(0)\n\ts_barrier" ::: "memory");
        const LAS float* gs_l = (const LAS float*)gsl; const LAS float* sh_l = (const LAS float*)shl;
        float shm = 0.f;
#pragma unroll
        for (int i = 0; i < 4; ++i) { const f32x4 s4 = *(const LAS f32x4*)(sh_l + 4 * c.lane + 256 * i); shm = fmaxf(fmaxf(shm, fmaxf(fabsf(s4.x), fabsf(s4.y))), fmaxf(fabsf(s4.z), fabsf(s4.w))); }
#pragma unroll
        for (int o = 1; o < 64; o <<= 1) shm = fmaxf(shm, __shfl_xor(shm, o));
        const f32x4 ps = *(const f32x4*)(c.rpart() + (size_t)row * 32 + 4 * fq), pm4 = *(const f32x4*)(c.rpart() + (size_t)row * 32 + 16 + 4 * fq);
        float ss = (ps.x + ps.y) + (ps.z + ps.w), mx; { const f32x4 gq = *(const LAS f32x4*)((const LAS float*)gpl + 4 * fq); mx = fmaxf(fmaxf(pm4.x * gq.x, pm4.y * gq.y), fmaxf(pm4.z * gq.z, pm4.w * gq.w)) * 1.00390625f; }
        ss += __shfl_xor(ss, 16); ss += __shfl_xor(ss, 32); mx = fmaxf(mx, __shfl_xor(mx, 16)); mx = fmaxf(mx, __shfl_xor(mx, 32));
        const float rinv = 1.f / sqrtf(ss * (1.f / D) + EPS);
        const float bnd = fmaxf(rinv * mx + shm, 1e-30f), qs = 127.f / bnd;
        if (fq == 0) c.sa()[row] = bnd * (1.f / 127.f);
        f32x4 acc = {0.f, 0.f, 0.f, 0.f};
        const LAS bf16_t* wh_l = (const LAS bf16_t*)whi + fr * WP + 16 * fq; const LAS bf16_t* wl_l = (const LAS bf16_t*)wlo + fr * WP + 16 * fq;
        signed char* hq = c.h2q() + (size_t)row * D + 16 * fq;
#pragma unroll
        for (int ks2 = 0; ks2 < 16; ++ks2) { u32x4 qo;
#pragma unroll
            for (int hf = 0; hf < 2; ++hf) { const int ko = 64 * ks2 + 8 * hf; const u32x4 w = xw[2 * ks2 + hf];
                const f32x4 g0 = *(const LAS f32x4*)(gs_l + 16 * fq + ko), g1 = *(const LAS f32x4*)(gs_l + 16 * fq + ko + 4), s0 = *(const LAS f32x4*)(sh_l + 16 * fq + ko), s1 = *(const LAS f32x4*)(sh_l + 16 * fq + ko + 4);
                float h[8];
                h[0] = __uint_as_float(w.x << 16) * rinv * g0.x + s0.x; h[1] = __uint_as_float(w.x & 0xffff0000u) * rinv * g0.y + s0.y; h[2] = __uint_as_float(w.y << 16) * rinv * g0.z + s0.z; h[3] = __uint_as_float(w.y & 0xffff0000u) * rinv * g0.w + s0.w;
                h[4] = __uint_as_float(w.z << 16) * rinv * g1.x + s1.x; h[5] = __uint_as_float(w.z & 0xffff0000u) * rinv * g1.y + s1.y; h[6] = __uint_as_float(w.w << 16) * rinv * g1.z + s1.z; h[7] = __uint_as_float(w.w & 0xffff0000u) * rinv * g1.w + s1.w;
                const unsigned qa = q8pack(h[0], h[1], h[2], h[3], qs), qb = q8pack(h[4], h[5], h[6], h[7], qs);
                if (hf == 0) { qo.x = qa; qo.y = qb; } else { qo.z = qa; qo.w = qb; }
                u32x4 hi; hi.x = pk2(h[0], h[1]); hi.y = pk2(h[2], h[3]); hi.z = pk2(h[4], h[5]); hi.w = pk2(h[6], h[7]);
                u32x4 lo; lo.x = pk2(h[0] - __uint_as_float(hi.x << 16), h[1] - __uint_as_float(hi.x & 0xffff0000u)); lo.y = pk2(h[2] - __uint_as_float(hi.y << 16), h[3] - __uint_as_float(hi.y & 0xffff0000u));
                lo.z = pk2(h[4] - __uint_as_float(hi.z << 16), h[5] - __uint_as_float(hi.z & 0xffff0000u)); lo.w = pk2(h[6] - __uint_as_float(hi.w << 16), h[7] - __uint_as_float(hi.w & 0xffff0000u));
                const bf16x8_t bh = *(const LAS bf16x8_t*)(wh_l + ko), bl = *(const LAS bf16x8_t*)(wl_l + ko);
                const bf16x8_t ah = __builtin_bit_cast(bf16x8_t, hi), al = __builtin_bit_cast(bf16x8_t, lo);
                acc = __builtin_amdgcn_mfma_f32_16x16x32_bf16(ah, bh, acc, 0, 0, 0);
                acc = __builtin_amdgcn_mfma_f32_16x16x32_bf16(al, bh, acc, 0, 0, 0);
                acc = __builtin_amdgcn_mfma_f32_16x16x32_bf16(ah, bl, acc, 0, 0, 0); }
            *(u32x4*)(hq + 64 * ks2) = qo;
            asm volatile("" ::: "memory"); }
        float ov[4];
#pragma unroll
        for (int i = 0; i < 4; ++i) { float mx = acc[i];
            mx = fmaxf(mx, __shfl_xor(mx, 1)); mx = fmaxf(mx, __shfl_xor(mx, 2)); mx = fmaxf(mx, __shfl_xor(mx, 4)); mx = fmaxf(mx, __shfl_xor(mx, 8));
            const float ex = __expf(acc[i] - mx); float den = ex;
            den += __shfl_xor(den, 1); den += __shfl_xor(den, 2); den += __shfl_xor(den, 4); den += __shfl_xor(den, 8);
            ov[i] = ex / den; }
        const int t0 = (blk * 128 + c.wave * 16 + 4 * fq) & (SEQ - 1);
        *(f32x4*)(c.aff() + (size_t)(b * NE + fr) * SEQ + t0) = (f32x4){ov[0], ov[1], ov[2], ov[3]};
    }
}
__device__ __forceinline__ int block_excl_scan(int v, int& tot, int* lw, int tid) {
    const int lane = tid & 63, wv = tid >> 6; int inc = v;
#pragma unroll
    for (int o = 1; o < 64; o <<= 1) { const int u = __shfl_up(inc, o); if (lane >= o) inc += u; }
    __syncthreads();
    if (lane == 63) lw[wv] = inc;
    __syncthreads();
    int base = 0; tot = 0;
#pragma unroll
    for (int w = 0; w < 8; ++w) { const int x = lw[w]; if (w < wv) base += x; tot += x; }
    return base + inc - v;
}
__device__ __forceinline__ void p8_topk(const Ctx& c, float* lds) {
    int* cnt = (int*)lds;
    int* lw = (int*)lds + 64;
    for (int unit = blockIdx.x; unit < NB * NE; unit += gridDim.x) {
        const int b = unit >> 4, e = unit & 15; const float* a = c.aff() + (size_t)unit * SEQ;
        const f32x4 v0 = *(const f32x4*)(a + 8 * c.tid), v1 = *(const f32x4*)(a + 8 * c.tid + 4);
        unsigned u[8] = {__float_as_uint(v0.x), __float_as_uint(v0.y), __float_as_uint(v0.z), __float_as_uint(v0.w), __float_as_uint(v1.x), __float_as_uint(v1.y), __float_as_uint(v1.z), __float_as_uint(v1.w)};
        __syncthreads();
        if (c.tid < 32) cnt[c.tid] = 0;
        __syncthreads();
        unsigned T = 0u;
        for (int bit = 30; bit >= 0; --bit) {
            const unsigned cand = T | (1u << bit); int cw = 0;
#pragma unroll
            for (int j = 0; j < 8; ++j) cw += __popcll(__ballot(u[j] >= cand));
            if (c.lane == 0) atomicAdd(&cnt[bit], cw);
            __syncthreads();
            if (cnt[bit] >= CAP) T = cand;
        }
        int ngt = 0, neq = 0;
#pragma unroll
        for (int j = 0; j < 8; ++j) { ngt += u[j] > T ? 1 : 0; neq += u[j] == T ? 1 : 0; }
        int tot_gt, tot_eq; const int eq_base = block_excl_scan(neq, tot_eq, lw, c.tid); (void)block_excl_scan(ngt, tot_gt, lw + 16, c.tid);
        const int need = CAP - tot_gt;
        bool sel[8]; int nsel = 0, eqc = eq_base;
#pragma unroll
        for (int j = 0; j < 8; ++j) { const bool isq = u[j] == T; sel[j] = u[j] > T || (isq && eqc < need); eqc += isq ? 1 : 0; nsel += sel[j] ? 1 : 0; }
        int tot_sel; int slot = block_excl_scan(nsel, tot_sel, lw + 32, c.tid);
        int iv[8];
#pragma unroll
        for (int j = 0; j < 8; ++j) { iv[j] = sel[j] ? slot : -1;
            if (sel[j]) { c.seli()[unit * CAP + slot] = b * SEQ + 8 * c.tid + j; c.selg()[unit * CAP + slot] = __uint_as_float(u[j]); c.sels()[unit * CAP + slot] = c.sa()[b * SEQ + 8 * c.tid + j]; ++slot; } }
#pragma unroll
        for (int j = 0; j < 8; ++j) c.inv()[(size_t)(b * SEQ + 8 * c.tid + j) * NE + e] = iv[j];
    }
    __syncthreads();
}
struct EpiGateUpQ {
    static constexpr bool PERM = true;
    unsigned char* act; const float* sels; const float* sw;
    __device__ __forceinline__ void operator()(const f32x4 (&acc)[2][2][4][2], const pg8::Unit& u, int wr, int wc, int fr, int fq) const {
        const int row0 = u.pm * 256 + wr * 64 + fr, col0 = u.pn * 256 + wc * 32 + 8 * fq; const float* swe = sw + ((u.pm >> 1) & 15) * 1536 + col0;
        float rs[8];
#pragma unroll
        for (int i = 0; i < 8; ++i) rs[i] = sels[row0 + (i >> 2) * 128 + (i & 3) * 16];
        const f32x4 sg0 = *(const f32x4*)swe, su0 = *(const f32x4*)(swe + 4), sg1 = *(const f32x4*)(swe + 128), su1 = *(const f32x4*)(swe + 132);
#pragma unroll
        for (int ai = 0; ai < 2; ++ai)
#pragma unroll
            for (int m = 0; m < 4; ++m) { const float r_ = rs[ai * 4 + m];
#pragma unroll
                for (int bj = 0; bj < 2; ++bj) { const f32x4 gt = acc[ai][bj][m][0] * (bj ? sg1 : sg0) * r_, up = acc[ai][bj][m][1] * (bj ? su1 : su0) * r_;
                    *(unsigned*)(act + (size_t)(row0 + ai * 128 + m * 16) * DE + ((col0 + bj * 128) >> 1)) = f8pack(silu_f(gt[0]) * up[0], silu_f(gt[1]) * up[1], silu_f(gt[2]) * up[2], silu_f(gt[3]) * up[3]); } }
    }
};
__device__ __forceinline__ void p9_gateup(const Ctx& c, float* lds) {
    pg8::Gemm g{(const bf16_t*)c.h2q(), (const bf16_t*)c.wgu_q(), D / 2, D / 2, D / 2, c.seli(), 1, 15, (size_t)1536 * 512};
    pg8::ExpertOrder S; S.init(NSLOT, 1536, (int)gridDim.x, (int)blockIdx.x);
    EpiGateUpQ E{(unsigned char*)c.actq(), c.sels(), c.swgu()};
    pg8::gemm_phase<1, true>((LAS unsigned char*)lds, g, S, E, c.tid);
}
struct EpiDownQ {
    static constexpr bool PERM = true;
    unsigned char* y8; float* ysc; const float* rsc; const float* sw;
    __device__ __forceinline__ void operator()(const f32x4 (&acc)[2][2][4][2], const pg8::Unit& u, int wr, int wc, int fr, int fq) const {
        const int row0 = u.pm * 256 + wr * 64 + fr, col0 = u.pn * 256 + wc * 32 + 8 * fq; const float* swe = sw + ((u.pm >> 1) & 15) * 1024 + col0;
        float gg[8];
#pragma unroll
        for (int i = 0; i < 8; ++i) gg[i] = rsc[row0 + (i >> 2) * 128 + (i & 3) * 16];
        const f32x4 s00 = *(const f32x4*)swe, s01 = *(const f32x4*)(swe + 4), s10 = *(const f32x4*)(swe + 128), s11 = *(const f32x4*)(swe + 132);
#pragma unroll
        for (int ai = 0; ai < 2; ++ai)
#pragma unroll
            for (int m = 0; m < 4; ++m) { const float g_ = gg[ai * 4 + m]; const int row = row0 + ai * 128 + m * 16;
                const f32x4 a0 = acc[ai][0][m][0] * s00 * g_, b0 = acc[ai][0][m][1] * s01 * g_, a1 = acc[ai][1][m][0] * s10 * g_, b1 = acc[ai][1][m][1] * s11 * g_;
                const f32x4 m4 = __builtin_elementwise_max(__builtin_elementwise_max(__builtin_elementwise_abs(a0), __builtin_elementwise_abs(b0)), __builtin_elementwise_max(__builtin_elementwise_abs(a1), __builtin_elementwise_abs(b1)));
                float mx = fmaxf(fmaxf(m4.x, m4.y), fmaxf(m4.z, m4.w)); mx = fmaxf(mx, __shfl_xor(mx, 16)); mx = fmaxf(mx, __shfl_xor(mx, 32));
                const float inv = mx > 0.f ? 448.f / mx : 0.f;
                u32x2 w0, w1; w0.x = f8pack(a0.x * inv, a0.y * inv, a0.z * inv, a0.w * inv); w0.y = f8pack(b0.x * inv, b0.y * inv, b0.z * inv, b0.w * inv);
                w1.x = f8pack(a1.x * inv, a1.y * inv, a1.z * inv, a1.w * inv); w1.y = f8pack(b1.x * inv, b1.y * inv, b1.z * inv, b1.w * inv);
                *(u32x2*)(y8 + (size_t)row * D + col0) = w0; *(u32x2*)(y8 + (size_t)row * D + col0 + 128) = w1;
                if (fq == 0) ysc[(size_t)row * 16 + u.pn * 4 + wc] = mx * (1.f / 448.f); }
    }
};
__device__ __forceinline__ void p10_down(const Ctx& c, float* lds) {
    pg8::Gemm g{(const bf16_t*)c.actq(), (const bf16_t*)c.wdn_q(), DE / 2, DE / 2, DE / 2, nullptr, 1, 15, (size_t)1024 * 384};
    pg8::ExpertOrder S; S.init(NSLOT, D, (int)gridDim.x, (int)blockIdx.x);
    EpiDownQ E{c.y8(), c.ysc(), c.selg(), c.swdn()};
    pg8::gemm_phase<2>((LAS unsigned char*)lds, g, S, E, c.tid);
}
__device__ __forceinline__ void p11_final(const Ctx& c) {
    for (int r0 = c.gw * 2; r0 < RL; r0 += c.ngw * 2) {
        const int b = r0 / SEQ;
        int sl[2]; f32x4 x1[2][4]; f32x4 acc[2][4];
#pragma unroll
        for (int q = 0; q < 2; ++q) { sl[q] = c.lane < NE ? c.inv()[(size_t)(r0 + q) * NE + c.lane] : -1;
#pragma unroll
            for (int j = 0; j < 4; ++j) { const u32x2 w = __builtin_nontemporal_load((const u32x2*)(c.x1b() + (size_t)(r0 + q) * D + 4 * c.lane + 256 * j));
                x1[q][j] = (f32x4){__uint_as_float(w.x << 16), __uint_as_float(w.x & 0xffff0000u), __uint_as_float(w.y << 16), __uint_as_float(w.y & 0xffff0000u)}; acc[q][j] = (f32x4){0.f, 0.f, 0.f, 0.f}; } }
#pragma unroll
        for (int q = 0; q < 2; ++q) {
            unsigned long long m = __ballot(sl[q] >= 0);
            while (m) { const int e = __builtin_ctzll(m); m &= m - 1; const int slot = __builtin_amdgcn_readlane(sl[q], e);
                const size_t yrow = (size_t)((b * NE + e) * CAP + slot); const unsigned char* yr = c.y8() + yrow * D; const float* ys = c.ysc() + yrow * 16 + ((c.lane & 31) >> 3);
                unsigned w[4]; float sc[4];
#pragma unroll
                for (int j = 0; j < 4; ++j) { w[j] = __builtin_nontemporal_load((const unsigned*)(yr + 4 * c.lane + 256 * j)); sc[j] = ys[4 * j]; }
#pragma unroll
                for (int j = 0; j < 4; ++j) { const auto lo = __builtin_amdgcn_cvt_pk_f32_fp8((int)w[j], false), hi = __builtin_amdgcn_cvt_pk_f32_fp8((int)w[j], true);
                    acc[q][j].x += lo[0] * sc[j]; acc[q][j].y += lo[1] * sc[j]; acc[q][j].z += hi[0] * sc[j]; acc[q][j].w += hi[1] * sc[j]; } } }
        const float* md = c.modv() + b * 6144 + 5120; float ss[2] = {0.f, 0.f};
#pragma unroll
        for (int j = 0; j < 4; ++j) { const int k = 4 * c.lane + 256 * j; const f32x4 ga = *(const f32x4*)(md + k);
#pragma unroll
            for (int q = 0; q < 2; ++q) { x1[q][j] = x1[q][j] + ga * acc[q][j]; ss[q] += x1[q][j].x * x1[q][j].x + x1[q][j].y * x1[q][j].y + x1[q][j].z * x1[q][j].z + x1[q][j].w * x1[q][j].w; } }
        const float ri0 = 1.f / sqrtf(wave_sum(ss[0]) * (1.f / D) + EPS), ri1 = 1.f / sqrtf(wave_sum(ss[1]) * (1.f / D) + EPS);
#pragma unroll
        for (int j = 0; j < 4; ++j) { const int k = 4 * c.lane + 256 * j; const f32x4 g = *(const f32x4*)(c.g_final() + k);
            __builtin_nontemporal_store(x1[0][j] * ri0 * g, (f32x4*)(c.out() + (size_t)r0 * D + k)); __builtin_nontemporal_store(x1[1][j] * ri1 * g, (f32x4*)(c.out() + (size_t)(r0 + 1) * D + k)); }
    }
}

#define XB_TMO      128
#define XB_XCNT(j)  (256  + 64 * (j))
#define XB_XSUB(j)  (1280 + 64 * (j))
#define XB_XGEN(j)  (2304 + 64 * (j))
#define XB_TOP      3328
#define XB_TOPGEN   3392
#define XCD_BAR_WORDS 3456
#define XB_SPIN_CAP (1u << 18)

__device__ __forceinline__ unsigned xb_ld(unsigned* p)              { return __hip_atomic_load(p, __ATOMIC_RELAXED, __HIP_MEMORY_SCOPE_AGENT); }
__device__ __forceinline__ unsigned xb_add(unsigned* p, unsigned v) { return __hip_atomic_fetch_add(p, v, __ATOMIC_RELAXED, __HIP_MEMORY_SCOPE_AGENT); }
__device__ __forceinline__ unsigned xb_xcc_id() { return (unsigned)__builtin_amdgcn_s_getreg((3 << 11) | 20) & 0xFu; }
#define XB_SPIN(cond, bar) do { unsigned _sp = 0; while (cond) { __builtin_amdgcn_s_sleep(1); \
    if ((++_sp & 255u) == 0u) { if (xb_ld(&(bar)[XB_TMO])) break; if (_sp > XB_SPIN_CAP) { atomicAdd(&(bar)[XB_TMO], 1u); break; } } } } while (0)

struct XcdBarrier {
    unsigned* bar; unsigned x;
    volatile LAS unsigned* st;
};
__device__ __forceinline__ XcdBarrier xcd_barrier_post(unsigned* bar, volatile LAS unsigned* st, bool t0) {
    XcdBarrier b; b.bar = bar; b.x = xb_xcc_id(); b.st = st;
    if (t0) (void)xb_add(&bar[XB_XCNT(b.x)], 1u);
    return b;
}
__device__ __forceinline__ void xcd_barrier_complete(unsigned* bar, unsigned x, unsigned& nloc, unsigned& nx) {
    const unsigned G = gridDim.x * gridDim.y * gridDim.z;
    unsigned sum, cnt, mine, sp = 0u;
    for (;;) {
        sum = 0u; cnt = 0u; mine = 0u;
#pragma unroll
        for (unsigned j = 0; j < 16; ++j) { const unsigned c = xb_ld(&bar[XB_XCNT(j)]); sum += c; cnt += (c > 0u) ? 1u : 0u; mine = (j == x) ? c : mine; }
        if (sum == G) break;
        __builtin_amdgcn_s_sleep(1);
        if ((++sp & 255u) == 0u) { if (xb_ld(&bar[XB_TMO])) break; if (sp > XB_SPIN_CAP) { atomicAdd(&bar[XB_TMO], 1u); break; } }
    }
    nloc = mine > 0u ? mine : 1u; nx = cnt > 0u ? cnt : 1u;
}
__device__ __forceinline__ void xcd_barrier(const XcdBarrier& b, bool t0) {
    asm volatile("s_waitcnt vmcnt(0)" ::: "memory");
    __syncthreads();
    if (t0) {
        unsigned* bar = b.bar;
        __builtin_amdgcn_s_waitcnt(0);
        unsigned nloc = b.st[0], nx = b.st[1];
        if (nloc == 0u) { xcd_barrier_complete(bar, b.x, nloc, nx); b.st[0] = nloc; b.st[1] = nx; }
        const unsigned old = xb_add(&bar[XB_XSUB(b.x)], 1u);
        const unsigned gen = old / nloc;
        if (old + 1u == (gen + 1u) * nloc) {
            __builtin_amdgcn_fence(__ATOMIC_RELEASE, "agent");
            asm volatile("s_waitcnt vmcnt(0)" ::: "memory");
            const unsigned og = xb_add(&bar[XB_TOP], 1u);
            const unsigned tg = og / nx;
            if (og + 1u == (tg + 1u) * nx) xb_add(&bar[XB_TOPGEN], 1u);
            else XB_SPIN(xb_ld(&bar[XB_TOPGEN]) == tg, bar);
            __builtin_amdgcn_fence(__ATOMIC_ACQUIRE, "agent");
            xb_add(&bar[XB_XGEN(b.x)], 1u);
            asm volatile("s_waitcnt vmcnt(0)" ::: "memory");
        } else {
            XB_SPIN(xb_ld(&bar[XB_XGEN(b.x)]) == gen, bar);
            __builtin_amdgcn_fence(__ATOMIC_ACQUIRE, "agent");
            asm volatile("s_waitcnt vmcnt(0)" ::: "memory");
        }
    }
    __syncthreads();
}

template <int PH0, int PH1> __global__ void __launch_bounds__(512, 2) fwd_kernel(Args args) {
    extern __shared__ __attribute__((aligned(16))) unsigned char lds_raw[];
    float* lds = (float*)lds_raw;
    volatile LAS unsigned* xbst = (volatile LAS unsigned*)((LAS unsigned char*)lds_raw + (LDS_BYTES - 16));
    const int wave_s = __builtin_amdgcn_readfirstlane((int)threadIdx.x >> 6);
#define TID_NOW() ([&]() { unsigned z_ = 0u; asm volatile("" : "+v"(z_)); return wave_s * 64 + (int)__builtin_amdgcn_mbcnt_hi(~0u, __builtin_amdgcn_mbcnt_lo(~0u, z_)); }())
    if (TID_NOW() == 0) { xbst[0] = 0u; xbst[1] = 0u; }
    __syncthreads();
    XcdBarrier bar; bar.bar = nullptr; bar.x = 0; bar.st = nullptr;
    if constexpr (PH1 - PH0 > 1) bar = xcd_barrier_post((unsigned*)(args.ws + WS_CTL) + 4096, xbst, TID_NOW() == 0);
#define GRID_BAR(k) do { if constexpr (PH1 - PH0 > 1) { if (lo <= (k) && (k) + 1 < hi) { xcd_barrier(bar, TID_NOW() == 0); if (BARREP) xcd_barrier(bar, TID_NOW() == 0); } } } while (0)
    const int lo = args.ph_lo, hi = args.ph_hi;
#ifndef PHMASK
#define PHMASK 0xffffffffu
#endif
#ifndef BARREP
#define BARREP 0
#endif
#ifndef REPMASK
#define REPMASK 0u
#endif
#define REP(k) ((REPMASK >> (k)) & 1u)
#define IN(k) (((PHMASK >> (k)) & 1u) && PH0 <= (k) && (k) < PH1 && lo <= (k) && (k) < hi)
#define CTX() Ctx c; { kptr_t kp_ = (kptr_t)__builtin_amdgcn_kernarg_segment_ptr(); asm volatile("" : "+s"(kp_)); c.kp = kp_; int t_ = TID_NOW(); asm volatile("" : "+v"(t_)); int b_ = blockIdx.x; asm volatile("" : "+s"(b_)); c.tid = t_; c.lane = t_ & 63; c.wave = t_ >> 6; c.gw = b_ * 8 + c.wave; c.ngw = gridDim.x * 8; }
    if (IN(0)) { CTX(); p0_mod(c, lds); __syncthreads(); p0_weights<0>(c, lds, c.gw, c.ngw); p0_tables(c); }
    if (REP(0) && IN(0)) { __syncthreads(); CTX(); p0_mod(c, lds); __syncthreads(); p0_weights<0>(c, lds, c.gw, c.ngw); p0_tables(c); }
    GRID_BAR(0);
    if (IN(1)) { CTX(); p1_norm(c); }
    if (REP(1) && IN(1)) { __syncthreads(); CTX(); p1_norm(c); }
    GRID_BAR(1);
    if (IN(2)) { CTX(); p2_proj(c, lds); }
    if (REP(2) && IN(2)) { __syncthreads(); CTX(); p2_proj(c, lds); }
    GRID_BAR(2);
    if (IN(3)) { CTX(); p3_upq(c, lds); }
    if (REP(3) && IN(3)) { __syncthreads(); CTX(); p3_upq(c, lds); }
    if (IN(4)) { CTX(); p3_upkv(c, lds); }
    if (REP(4) && IN(4)) { __syncthreads(); CTX(); p3_upkv(c, lds); }
    if (IN(5)) { CTX(); p3c_scan(c, lds); }
    if (REP(5) && IN(5)) { __syncthreads(); CTX(); p3c_scan(c, lds); }
    GRID_BAR(5);
    if (IN(6)) { CTX(); p4_attn(c, lds); }
    if (REP(6) && IN(6)) { __syncthreads(); CTX(); p4_attn(c, lds); }
    if (IN(7)) { CTX(); p4_ret(c, lds); }
    if (REP(7) && IN(7)) { __syncthreads(); CTX(); p4_ret(c, lds); }
    GRID_BAR(7);
    if (IN(8)) { CTX(); p6_wo(c, lds); }
    if (REP(8) && IN(8)) { __syncthreads(); CTX(); p6_wo(c, lds); }
    GRID_BAR(8);
    if (IN(9)) { CTX(); p7_norm_router(c, lds); }
    if (REP(9) && IN(9)) { __syncthreads(); CTX(); p7_norm_router(c, lds); }
    GRID_BAR(9);
    if (IN(10)) { CTX(); p8_topk(c, lds); }
    if (REP(10) && IN(10)) { __syncthreads(); CTX(); p8_topk(c, lds); }
    GRID_BAR(10);
    if (IN(11)) { CTX(); p9_gateup(c, lds); }
    if (REP(11) && IN(11)) { __syncthreads(); CTX(); p9_gateup(c, lds); }
    GRID_BAR(11);
    if (IN(12)) { CTX(); p10_down(c, lds); }
    if (REP(12) && IN(12)) { __syncthreads(); CTX(); p10_down(c, lds); }
    GRID_BAR(12);
    if (IN(13)) { CTX(); p11_final(c); }
    if (REP(13) && IN(13)) { __syncthreads(); CTX(); p11_final(c); }
#undef IN
}


static hipError_t set_lds_all() { return hipFuncSetAttribute((const void*)fwd_kernel<0, NPH>, hipFuncAttributeMaxDynamicSharedMemorySize, LDS_BYTES); }
static void launch_all(int grid, hipStream_t stream, const Args& a) { hipLaunchKernelGGL((fwd_kernel<0, NPH>), dim3(grid), dim3(512), LDS_BYTES, stream, a); }

extern "C" void kernel_launch(void* const* d_in, const int* in_sizes, int n_in, void* d_out, int out_size, void* d_ws, size_t ws_size, hipStream_t stream) {
    static int grid = 0;
    if (grid == 0) {
        if (n_in != 22 || in_sizes[0] != RL * D || out_size != RL * D || ws_size < WS_END) {
            fprintf(stderr, "kernel_launch: unexpected shapes: n_in %d in0 %d out %d ws %zu (need %zu)\n", n_in, n_in > 0 ? in_sizes[0] : -1, out_size, ws_size, (size_t)WS_END); grid = -1; return; }
        int dev = 0, cus = 0;
        if (hipGetDevice(&dev) != hipSuccess || hipDeviceGetAttribute(&cus, hipDeviceAttributeMultiprocessorCount, dev) != hipSuccess) { grid = -1; return; }
        if (set_lds_all() != hipSuccess) { fprintf(stderr, "kernel_launch: hipFuncSetAttribute failed\n"); grid = -1; return; }
        int per_cu = 0;
        if (MK_SINGLE) { if (hipOccupancyMaxActiveBlocksPerMultiprocessor(&per_cu, (const void*)fwd_kernel<0, NPH>, 512, LDS_BYTES) != hipSuccess || per_cu < 1) { fprintf(stderr, "kernel_launch: occupancy query says %d blocks per CU\n", per_cu); grid = -1; return; } }
        (void)hipGetLastError();
        grid = cus;
    }
    if (grid < 0) return;
    Args a{};
    for (int i = 0; i < 22; ++i) a.in[i] = (const float*)d_in[i];
    a.out = (float*)d_out; a.ws = (unsigned char*)d_ws;
    a.ph_lo = 0; a.ph_hi = NPH;
    if (MK_SINGLE) { if (hipMemsetAsync((char*)d_ws + WS_CTL, 0, CTL_BYTES, stream) != hipSuccess) { fprintf(stderr, "kernel_launch: memset failed\n"); return; } }
    launch_all(grid, stream, a);
}
```

```cpp
#include <hip/hip_runtime.h>
#include <cstdio>
#include <cstdint>

#ifndef MK_SINGLE
#define MK_SINGLE 1
#endif

typedef unsigned short bf16_t;
typedef float f32x4 __attribute__((ext_vector_type(4)));
typedef unsigned u32x4 __attribute__((ext_vector_type(4)));
typedef unsigned u32x2 __attribute__((ext_vector_type(2)));
#define LAS __attribute__((address_space(3)))

constexpr int D = 1024, NB = 8, SEQ = 4096, LC = 256;
constexpr int RL = NB * SEQ, RC = NB * LC, RT = RL + RC;
constexpr int NPROJ = 2560;
constexpr int PC_CQ = 0, PC_CKV = 256, PC_KR = 384, PC_RQ = 512, PC_RK = 1024, PC_RV = 1536, PC_RG = 2048;
constexpr int NH = 8, QW = 768, KVW = 1024;
constexpr int NE = 16, CAP = 512, DE = 768, NSLOT = NB * NE * CAP;
constexpr int NCH = 32;
constexpr float EPS = 1e-6f;
constexpr float QSCALE = 0.10206207261596577f * 1.4426950408889634f;

constexpr size_t MiB = 1u << 20;
constexpr size_t WS_CTL = 0, CTL_BYTES = 64 * 1024;
constexpr size_t WS_MOD = 1 * MiB;
constexpr size_t WS_TABR = 2 * MiB;
constexpr size_t WS_TABM = 3 * MiB;
constexpr size_t WS_PSTAT = 4 * MiB;
constexpr size_t WS_AFF = 6 * MiB;
constexpr size_t WS_SELI = 8 * MiB;
constexpr size_t WS_SELG = 8 * MiB + 512 * 1024;
constexpr size_t WS_INV = 9 * MiB;
constexpr size_t WS_SELS = 11 * MiB;
constexpr size_t WS_WIN = 12 * MiB;
constexpr size_t WS_WUQ = 17 * MiB;
constexpr size_t WS_WUKV = 17 * MiB + 512 * 1024;
constexpr size_t WS_WO = 18 * MiB;
constexpr size_t WS_WGU = 20 * MiB;
constexpr size_t WS_WDN = 68 * MiB;
constexpr size_t WS_H = 92 * MiB;
constexpr size_t WS_RST = 92 * MiB;
constexpr size_t WS_PROJ = 160 * MiB;
constexpr size_t WS_ACT = 160 * MiB;
constexpr size_t WS_YB = 256 * MiB;
constexpr size_t WS_Q = 330 * MiB;
constexpr size_t WS_KV = 378 * MiB;
constexpr size_t WS_MIX = 446 * MiB;
constexpr size_t WS_END = 510 * MiB;
static_assert(WS_PROJ + (size_t)RT * NPROJ * 2 <= WS_Q && WS_Q + (size_t)RL * QW * 2 <= WS_KV && WS_KV + (size_t)RT * KVW * 2 <= WS_MIX, "ws map");
static_assert(WS_H + (size_t)RT * D * 2 <= WS_PROJ && WS_WDN + (size_t)NE * D * DE * 2 <= WS_H && WS_PSTAT + (size_t)RT * 32 <= WS_AFF, "ws map 2");

constexpr int LDS_BYTES = 147456;
constexpr int NPH = 14;

__device__ __forceinline__ float bf2f(bf16_t v) { return __uint_as_float((unsigned)v << 16); }
__device__ __forceinline__ bf16_t f2bf(float f) { unsigned u = __float_as_uint(f); return (bf16_t)((u + 0x7fffu + ((u >> 16) & 1u)) >> 16); }
__device__ __forceinline__ unsigned pk2(float lo, float hi) { unsigned r; asm("v_cvt_pk_bf16_f32 %0, %1, %2" : "=v"(r) : "v"(lo), "v"(hi)); return r; }
__device__ __forceinline__ float wave_sum(float v) {
#pragma unroll
    for (int o = 1; o < 64; o <<= 1) v += __shfl_xor(v, o);
    return v;
}
__device__ __forceinline__ float silu_f(float v) { return v / (1.f + __expf(-v)); }

struct Args {
    const float* in[22]; float* out; unsigned char* ws; int ph_lo, ph_hi;
};

typedef __attribute__((address_space(4))) const char* kptr_t;
typedef const float* cfp_t; typedef float* fp_t; typedef unsigned char* ucp_t;
typedef __attribute__((address_space(4))) const cfp_t* kcfpp; typedef __attribute__((address_space(4))) const fp_t* kfpp; typedef __attribute__((address_space(4))) const ucp_t* kucpp;
static_assert(sizeof(Args) == 200, "Args layout: in[22] @0, out @176, ws @184, ph_lo @192, ph_hi @196");
struct Ctx {
    kptr_t kp; int tid, lane, wave, gw, ngw;
    __device__ __forceinline__ const float* in(int i) const { return *(kcfpp)(kp + 8 * i); }
    __device__ __forceinline__ unsigned char* wsb() const { return *(kucpp)(kp + 184); }
    __device__ __forceinline__ const float* x() const { return in(0); }
    __device__ __forceinline__ const float* cvec() const { return in(1); }
    __device__ __forceinline__ const float* ctx() const { return in(2); }
    __device__ __forceinline__ const float* c_ctx() const { return in(3); }
    __device__ __forceinline__ const float* w_ada() const { return in(4); }
    __device__ __forceinline__ const float* b_ada() const { return in(5); }
    __device__ __forceinline__ const float* g_mix() const { return in(6); }
    __device__ __forceinline__ const float* g_ffn() const { return in(7); }
    __device__ __forceinline__ const float* w_in() const { return in(8); }
    __device__ __forceinline__ const float* g_q() const { return in(9); }
    __device__ __forceinline__ const float* g_kv() const { return in(10); }
    __device__ __forceinline__ const float* w_uq() const { return in(11); }
    __device__ __forceinline__ const float* w_ukv() const { return in(12); }
    __device__ __forceinline__ const float* exp_f() const { return in(13); }
    __device__ __forceinline__ const float* exp_b() const { return in(14); }
    __device__ __forceinline__ const float* g_ret() const { return in(15); }
    __device__ __forceinline__ const float* w_o() const { return in(16); }
    __device__ __forceinline__ const float* w_router() const { return in(17); }
    __device__ __forceinline__ const float* w_gate() const { return in(18); }
    __device__ __forceinline__ const float* w_up() const { return in(19); }
    __device__ __forceinline__ const float* w_down() const { return in(20); }
    __device__ __forceinline__ const float* g_final() const { return in(21); }
    __device__ __forceinline__ float* out() const { return *(kfpp)(kp + 176); }
    __device__ __forceinline__ float* modv() const { return (float*)(wsb() + WS_MOD); }
    __device__ __forceinline__ float* tabr() const { return (float*)(wsb() + WS_TABR); }
    __device__ __forceinline__ float* tabm() const { return (float*)(wsb() + WS_TABM); }
    __device__ __forceinline__ float* pstat() const { return (float*)(wsb() + WS_PSTAT); }
    __device__ __forceinline__ float* aff() const { return (float*)(wsb() + WS_AFF); }
    __device__ __forceinline__ float* selg() const { return (float*)(wsb() + WS_SELG); }
    __device__ __forceinline__ int* seli() const { return (int*)(wsb() + WS_SELI); }
    __device__ __forceinline__ int* inv() const { return (int*)(wsb() + WS_INV); }
    __device__ __forceinline__ float* sels() const { return (float*)(wsb() + WS_SELS); }
    __device__ __forceinline__ float* rpart() const { return (float*)(wsb() + WS_Q); }
    __device__ __forceinline__ bf16_t* win_t() const { return (bf16_t*)(wsb() + WS_WIN); }
    __device__ __forceinline__ bf16_t* wuq_t() const { return (bf16_t*)(wsb() + WS_WUQ); }
    __device__ __forceinline__ bf16_t* wukv_t() const { return (bf16_t*)(wsb() + WS_WUKV); }
    __device__ __forceinline__ bf16_t* wo_t() const { return (bf16_t*)(wsb() + WS_WO); }
    __device__ __forceinline__ bf16_t* wgu_t() const { return (bf16_t*)(wsb() + WS_WGU); }
    __device__ __forceinline__ bf16_t* wdn_t() const { return (bf16_t*)(wsb() + WS_WDN); }
    __device__ __forceinline__ bf16_t* hb() const { return (bf16_t*)(wsb() + WS_H); }
    __device__ __forceinline__ bf16_t* rst() const { return (bf16_t*)(wsb() + WS_RST); }
    __device__ __forceinline__ bf16_t* proj() const { return (bf16_t*)(wsb() + WS_PROJ); }
    __device__ __forceinline__ bf16_t* act() const { return (bf16_t*)(wsb() + WS_ACT); }
    __device__ __forceinline__ bf16_t* yb() const { return (bf16_t*)(wsb() + WS_YB); }
    __device__ __forceinline__ bf16_t* qb() const { return (bf16_t*)(wsb() + WS_Q); }
    __device__ __forceinline__ bf16_t* kvb() const { return (bf16_t*)(wsb() + WS_KV); }
    __device__ __forceinline__ bf16_t* mix() const { return (bf16_t*)(wsb() + WS_MIX); }
    __device__ __forceinline__ bf16_t* x1b() const { return (bf16_t*)(wsb() + WS_H); }
    __device__ __forceinline__ bf16_t* h2() const { return (bf16_t*)(wsb() + WS_MIX); }
    __device__ __forceinline__ signed char* h2q() const { return (signed char*)(wsb() + WS_MIX); }
    __device__ __forceinline__ float* sa() const { return (float*)(wsb() + WS_MIX + 32 * MiB); }
    __device__ __forceinline__ signed char* wgu_q() const { return (signed char*)(wsb() + WS_WGU); }
    __device__ __forceinline__ float* swgu() const { return (float*)(wsb() + WS_WGU + 24 * MiB); }
    __device__ __forceinline__ signed char* wdn_q() const { return (signed char*)(wsb() + WS_WDN); }
    __device__ __forceinline__ float* swdn() const { return (float*)(wsb() + WS_WDN + 12 * MiB); }
    __device__ __forceinline__ signed char* actq() const { return (signed char*)(wsb() + 384 * MiB); }
    __device__ __forceinline__ unsigned char* y8() const { return (unsigned char*)(wsb() + WS_YB); }
    __device__ __forceinline__ float* ysc() const { return (float*)(wsb() + 320 * MiB); }
    __device__ __forceinline__ float* sactg() const { return (float*)(wsb() + 432 * MiB); }
};

__device__ __forceinline__ void p0_mod(const Ctx& c, float* lds) {
    float* sc = lds;
    float* red = lds + 9 * 1024;
    for (int i = c.tid; i < 9 * 1024; i += 512) { const int r = i >> 10, k = i & 1023; const float v = r < 8 ? c.cvec()[r * 1024 + k] : c.c_ctx()[k]; sc[i] = silu_f(v); }
    __syncthreads();
    for (int unit = blockIdx.x; unit < 192; unit += gridDim.x) {
        const int nn = c.tid & 31, n = unit * 32 + nn, kg = c.tid >> 5;
        float acc[9];
#pragma unroll
        for (int r = 0; r < 9; ++r) acc[r] = 0.f;
        for (int k0 = kg; k0 < 1024; k0 += 16 * 8) { float w[8];
#pragma unroll
            for (int i = 0; i < 8; ++i) w[i] = __builtin_nontemporal_load(c.w_ada() + (size_t)(k0 + 16 * i) * 6144 + n);
#pragma unroll
            for (int i = 0; i < 8; ++i)
#pragma unroll
                for (int r = 0; r < 9; ++r) acc[r] += sc[r * 1024 + k0 + 16 * i] * w[i]; }
#pragma unroll
        for (int r = 0; r < 9; ++r) red[(kg * 9 + r) * 32 + nn] = acc[r];
        __syncthreads();
        for (int i = c.tid; i < 9 * 32; i += 512) { const int r = i >> 5, n2 = i & 31; float s = 0.f;
#pragma unroll
            for (int g = 0; g < 16; ++g) s += red[(g * 9 + r) * 32 + n2];
            c.modv()[r * 6144 + unit * 32 + n2] = s + c.b_ada()[unit * 32 + n2]; }
        __syncthreads();
    }
}
template <class CM, class GN>
__device__ __forceinline__ void transpose_item(const float* W, int Ksrc, int Nsrc, bf16_t* WT, int Kdst, CM cm, GN gain, float* scr, int kb, int nb, int lane) {
    const int k0 = 64 * kb, n0 = 32 * nb;
    const int srcc = cm(n0 + (lane & 31));
#pragma unroll 8
    for (int i = 0; i < 32; ++i) { const int kk = 2 * i + (lane >> 5), k = k0 + kk;
        float v = 0.f; if (srcc >= 0 && k < Ksrc) v = W[(size_t)k * Nsrc + srcc] * gain(k);
        scr[kk * 33 + (lane & 31)] = v; }
    asm volatile("s_waitcnt lgkmcnt(0)" ::: "memory");
    const int ch = lane & 7;
#pragma unroll
    for (int j = 0; j < 4; ++j) { const int n = (lane >> 3) + 8 * j; const float* s = scr + (8 * ch) * 33 + n;
        u32x4 o; o.x = pk2(s[0 * 33], s[1 * 33]); o.y = pk2(s[2 * 33], s[3 * 33]); o.z = pk2(s[4 * 33], s[5 * 33]); o.w = pk2(s[6 * 33], s[7 * 33]);
        *(u32x4*)(WT + (size_t)(n0 + n) * Kdst + k0 + 8 * ch) = o; }
    asm volatile("s_waitcnt lgkmcnt(0)" ::: "memory");
}
__device__ __forceinline__ int ilv(int p, int half) { const int g = p >> 3, w = p & 7; return w < 4 ? 4 * g + w : half + 4 * g + (w - 4); }
__device__ __forceinline__ int cm_win(int n) {
    if (n < 384) return n;
    if (n < 416) return 384 + ilv(n - 384, 16);
    if (n < 512) return -1;
    if (n < 1024) { const int j = n - 512; return 416 + (j >> 6) * 64 + ilv(j & 63, 32); }
    if (n < 1536) { const int j = n - 1024; return 928 + (j >> 6) * 64 + ilv(j & 63, 32); }
    if (n < 2048) return 1440 + (n - 1536);
    return 1952 + (n - 2048);
}
__device__ __forceinline__ int cm_wuq(int n) { const int h = n / 96, p = n % 96; return p < 64 ? n : h * 96 + 64 + ilv(p - 64, 16); }
__device__ __forceinline__ int cm_wgu(int n) { const int q = n >> 3, w = n & 7; return w < 4 ? 4 * q + w : 768 + 4 * q + (w - 4); }
template <bool NTST = false, class TC>
__device__ __forceinline__ void transpose64(const float* srcA, const float* srcB, int ld, bf16_t* dst, int ldd, TC tcol, float* scr, int lane) {
    const int r = lane >> 3, c4 = (lane & 7) * 4;
    f32x4 va[8], vb[8];
#pragma unroll
    for (int i = 0; i < 8; ++i) { va[i] = srcA ? __builtin_nontemporal_load((const f32x4*)(srcA + (size_t)(8 * i + r) * ld + c4)) : (f32x4){0.f, 0.f, 0.f, 0.f}; vb[i] = srcB ? __builtin_nontemporal_load((const f32x4*)(srcB + (size_t)(8 * i + r) * ld + c4)) : (f32x4){0.f, 0.f, 0.f, 0.f}; }
#pragma unroll
    for (int i = 0; i < 8; ++i) { float* p = scr + (8 * i + r) * 65 + c4; p[0] = va[i].x; p[1] = va[i].y; p[2] = va[i].z; p[3] = va[i].w; p[32] = vb[i].x; p[33] = vb[i].y; p[34] = vb[i].z; p[35] = vb[i].w; }
    asm volatile("s_waitcnt lgkmcnt(0)" ::: "memory");
    const int kc = lane & 7;
#pragma unroll
    for (int j = 0; j < 8; ++j) { const int nl = (lane >> 3) + 8 * j, col = tcol(nl); u32x4 o = {0u, 0u, 0u, 0u};
        if (col >= 0) { const float* sp = scr + (8 * kc) * 65 + col; o.x = pk2(sp[0 * 65], sp[1 * 65]); o.y = pk2(sp[2 * 65], sp[3 * 65]); o.z = pk2(sp[4 * 65], sp[5 * 65]); o.w = pk2(sp[6 * 65], sp[7 * 65]); }
        if (NTST) __builtin_nontemporal_store(o, (u32x4*)(dst + (size_t)nl * ldd + 8 * kc)); else *(u32x4*)(dst + (size_t)nl * ldd + 8 * kc) = o; }
    asm volatile("s_waitcnt lgkmcnt(0)" ::: "memory");
}
typedef int i32x4 __attribute__((ext_vector_type(4)));
constexpr int GU_STRIPS = NE * 24;
__device__ __forceinline__ unsigned f8pack(float a, float b, float c_, float d) {
    a = __builtin_amdgcn_fmed3f(a, -448.f, 448.f); b = __builtin_amdgcn_fmed3f(b, -448.f, 448.f); c_ = __builtin_amdgcn_fmed3f(c_, -448.f, 448.f); d = __builtin_amdgcn_fmed3f(d, -448.f, 448.f);
    int r = __builtin_amdgcn_cvt_pk_fp8_f32(a, b, 0, false); r = __builtin_amdgcn_cvt_pk_fp8_f32(c_, d, r, true); return (unsigned)r;
}
__device__ __forceinline__ unsigned q8pack(float a, float b, float c_, float d, float inv) {
    const unsigned q0 = __float_as_uint(__builtin_fmaf(a, inv, 12582912.f)), q1 = __float_as_uint(__builtin_fmaf(b, inv, 12582912.f)), q2 = __float_as_uint(__builtin_fmaf(c_, inv, 12582912.f)), q3 = __float_as_uint(__builtin_fmaf(d, inv, 12582912.f));
    return (q0 & 255u) | ((q1 & 255u) << 8) | ((q2 & 255u) << 16) | (q3 << 24);
}
template <int NT, bool F8, class TC>
__device__ __forceinline__ void strip_i8(const Ctx& c, float* lds, const float* srcA, const float* srcB, int ld, signed char* dq0, int dld, float* sw0, TC tcol) {
    float* scr = lds + c.wave * (64 * 65); float* cm = lds + 8 * 64 * 65; float* fin = cm + 512;
    const int r = c.lane >> 3, c4 = (c.lane & 7) * 4;
    const bool act_w = 2 * c.wave < NT;
    f32x4 va[2][8], vb[2][8];
#pragma unroll
    for (int t = 0; t < 2; ++t)
#pragma unroll
        for (int i = 0; i < 8; ++i) { const size_t ro = (size_t)(64 * (2 * c.wave + t) + 8 * i + r) * ld + c4;
            va[t][i] = act_w ? __builtin_nontemporal_load((const f32x4*)(srcA + ro)) : (f32x4){0.f, 0.f, 0.f, 0.f}; vb[t][i] = act_w ? __builtin_nontemporal_load((const f32x4*)(srcB + ro)) : (f32x4){0.f, 0.f, 0.f, 0.f}; }
    f32x4 mA = {0.f, 0.f, 0.f, 0.f}, mB = {0.f, 0.f, 0.f, 0.f};
#pragma unroll
    for (int t = 0; t < 2; ++t)
#pragma unroll
        for (int i = 0; i < 8; ++i) { mA = __builtin_elementwise_max(mA, __builtin_elementwise_abs(va[t][i])); mB = __builtin_elementwise_max(mB, __builtin_elementwise_abs(vb[t][i])); }
#pragma unroll
    for (int o = 8; o < 64; o <<= 1)
#pragma unroll
        for (int j = 0; j < 4; ++j) { mA[j] = fmaxf(mA[j], __shfl_xor(mA[j], o)); mB[j] = fmaxf(mB[j], __shfl_xor(mB[j], o)); }
    __syncthreads();
    if (r == 0) { *(f32x4*)(cm + c.wave * 64 + c4) = mA; *(f32x4*)(cm + c.wave * 64 + 32 + c4) = mB; }
    __syncthreads();
    if (c.tid < 64) { float m = cm[c.tid];
#pragma unroll
        for (int w = 1; w < 8; ++w) m = fmaxf(m, cm[w * 64 + c.tid]);
        fin[c.tid] = fmaxf(m, 1e-30f); }
    __syncthreads();
    const int w8 = c.lane >> 3, kc = c.lane & 7;
    if (c.tid < 64) sw0[c.tid] = fin[tcol(c.tid)] * (F8 ? 1.f / 448.f : 1.f / 127.f);
    if (act_w) {
    signed char* dq = dq0 + (size_t)w8 * dld + 128 * c.wave + 8 * kc;
#pragma unroll
    for (int t = 0; t < 2; ++t) {
#pragma unroll
        for (int i = 0; i < 8; ++i) { float* p = scr + (8 * i + r) * 65 + c4; p[0] = va[t][i].x; p[1] = va[t][i].y; p[2] = va[t][i].z; p[3] = va[t][i].w; p[32] = vb[t][i].x; p[33] = vb[t][i].y; p[34] = vb[t][i].z; p[35] = vb[t][i].w; }
        asm volatile("s_waitcnt lgkmcnt(0)" ::: "memory");
#pragma unroll
        for (int j = 0; j < 8; ++j) { const int col = tcol(w8 + 8 * j);
            const float inv = (F8 ? 448.f : 127.f) / fin[col]; const float* sp = scr + (8 * kc) * 65 + col;
            u32x2 o;
            if (F8) { o.x = f8pack(sp[0 * 65] * inv, sp[1 * 65] * inv, sp[2 * 65] * inv, sp[3 * 65] * inv); o.y = f8pack(sp[4 * 65] * inv, sp[5 * 65] * inv, sp[6 * 65] * inv, sp[7 * 65] * inv); }
            else { o.x = q8pack(sp[0 * 65], sp[1 * 65], sp[2 * 65], sp[3 * 65], inv); o.y = q8pack(sp[4 * 65], sp[5 * 65], sp[6 * 65], sp[7 * 65], inv); }
            *(u32x2*)(dq + (size_t)(8 * j) * dld + 64 * t) = o; }
        asm volatile("s_waitcnt lgkmcnt(0)" ::: "memory");
    } }
}
constexpr int DN_STRIPS = NE * 16, EXP_STRIPS = GU_STRIPS + DN_STRIPS;
__device__ __forceinline__ void expert_strip(const Ctx& c, float* lds, int s) {
    if (s < GU_STRIPS) { const int e = s / 24, nb = s % 24; const size_t so = (size_t)e * 1024 * 768 + 32 * nb;
        strip_i8<16, false>(c, lds, c.w_gate() + so, c.w_up() + so, 768, c.wgu_q() + (size_t)e * 1536 * 1024 + (size_t)(64 * nb) * 1024, 1024, c.swgu() + e * 1536 + 64 * nb,
                     [](int nl) { const int qq = nl >> 3, w = nl & 7; return w < 4 ? 4 * qq + w : 32 + 4 * qq + (w - 4); }); }
    else { s -= GU_STRIPS; const int e = s >> 4, nb = s & 15; const float* src = c.w_down() + (size_t)e * 768 * 1024 + 64 * nb;
        strip_i8<12, true>(c, lds, src, src + 32, 1024, c.wdn_q() + (size_t)e * 1024 * 768 + (size_t)(64 * nb) * 768, 768, c.swdn() + e * 1024 + 64 * nb, [](int nl) { return nl; }); }
}
constexpr int QSHORT0 = 80, QSTRIPS = 2, QSTATIC = (256 - QSHORT0) * QSTRIPS;
template <int PART>
__device__ __forceinline__ void p0_weights(const Ctx& c, float* lds, int gw, int ngw) {
    float* scr = lds + c.wave * (64 * 65);
    constexpr int I_WIN = 16 * 40, I_WO = 16 * 16, I_GU = 16 * 24, I_DN = 12 * 16, I_WUQ = 4 * 24, I_WUKV = 4 * 32;
    constexpr int NEXP = NE * I_GU + NE * I_DN, NIT = NEXP + I_WIN + I_WO + I_WUQ + I_WUKV;
    unsigned* qctr = (unsigned*)(c.wsb() + WS_CTL) + 2048; int qbase = 0, qk = 8;
    for (int it = (PART == 1 ? NE * I_GU : NEXP + gw); it < (PART == 1 ? NEXP : NIT); it += (PART == 0 ? ngw : 1)) {
        if (PART == 1) { if (qk == 8) { int p_ = 0; if (c.lane == 0) p_ = (int)__hip_atomic_fetch_add(qctr, 1u, __ATOMIC_RELAXED, __HIP_MEMORY_SCOPE_AGENT); qbase = NE * I_GU + __builtin_amdgcn_readfirstlane(p_) * 8; qk = 0; }
            it = qbase + qk; ++qk; if (it >= NEXP) break; }
        int r = it;
        r -= NEXP;
        if (r < I_WIN) { const int kb = r / 40, nb = r % 40; const float* base = c.w_in() + (size_t)(64 * kb) * 2464; bf16_t* dst = c.win_t() + (size_t)(64 * nb) * 1024 + 64 * kb;
            if (nb < 6) { transpose64(base + 64 * nb, base + 64 * nb + 32, 2464, dst, 1024, [](int nl) { return nl; }, scr, c.lane); }
            else if (nb == 6) { transpose64(base + 384, (const float*)nullptr, 2464, dst, 1024, [](int nl) { return nl < 32 ? ilv(nl, 16) : -1; }, scr, c.lane); }
            else if (nb == 7) { transpose64((const float*)nullptr, (const float*)nullptr, 2464, dst, 1024, [](int) { return -1; }, scr, c.lane); }
            else if (nb < 24) { const int s0 = (nb < 16 ? 416 : 928) + 64 * ((nb - 8) & 7); transpose64(base + s0, base + s0 + 32, 2464, dst, 1024, [](int nl) { return ilv(nl, 32); }, scr, c.lane); }
            else { const int s0 = (nb < 32 ? 1440 : 1952) + 64 * (nb & 7); transpose64(base + s0, base + s0 + 32, 2464, dst, 1024, [](int nl) { return nl; }, scr, c.lane); }
            continue; } r -= I_WIN;
        if (r < I_WO) { const int kb = r / 16, nb = r % 16; const float* src = c.w_o() + (size_t)(64 * kb) * 1024 + 64 * nb;
            transpose64(src, src + 32, 1024, c.wo_t() + (size_t)(64 * nb) * 1024 + 64 * kb, 1024, [](int nl) { return nl; }, scr, c.lane); continue; } r -= I_WO;
        if (r < I_WUQ) { const float* g = c.g_q(); transpose_item(c.w_uq(), 256, 768, c.wuq_t(), 256, [](int n) { return cm_wuq(n); }, [g](int k) { return g[k]; }, scr, r / 24, r % 24, c.lane); continue; } r -= I_WUQ;
        { const float* g = c.g_kv(); transpose_item(c.w_ukv(), 128, 1024, c.wukv_t(), 256, [](int n) { return n; }, [g](int k) { return g[k]; }, scr, r / 32, r % 32, c.lane); }
    }
}
__device__ __forceinline__ void sincos_d(double x, double& s, double& co) {
    const double PIO2_HI = 1.5707963267948966, PIO2_LO = 6.123233995736766e-17;
    const double kd = __builtin_rint(x * 0.6366197723675814); const int k = (int)kd;
    const double r = (x - kd * PIO2_HI) - kd * PIO2_LO, r2 = r * r;
    double sr = r - r * r2 * (1.0 / 6.0 - r2 * (1.0 / 120.0 - r2 * (1.0 / 5040.0 - r2 * (1.0 / 362880.0 - r2 * (1.0 / 39916800.0 - r2 * (1.0 / 6227020800.0 - r2 * (1.0 / 1307674368000.0 - r2 * (1.0 / 355687428096000.0))))))));
    double cr = 1.0 - r2 * (0.5 - r2 * (1.0 / 24.0 - r2 * (1.0 / 720.0 - r2 * (1.0 / 40320.0 - r2 * (1.0 / 3628800.0 - r2 * (1.0 / 479001600.0 - r2 * (1.0 / 87178291200.0 - r2 * (1.0 / 20922789888000.0))))))));
    switch (k & 3) { case 0: s = sr; co = cr; break; case 1: s = cr; co = -sr; break; case 2: s = -sr; co = -cr; break; default: s = -cr; co = sr; break; }
}
__device__ __forceinline__ void p0_tables(const Ctx& c) {
    const int gt = blockIdx.x * 512 + c.tid, ngt = gridDim.x * 512;
    const double r16 = 1.0 / __builtin_sqrt(__builtin_sqrt(10.0));
    const double r8 = 1.0 / __builtin_sqrt(10.0);
    for (int i = gt; i < 4096 * 48; i += ngt) {
        const int t = i / 48, j = i % 48; const int prow = t >> 6, pcol = t & 63;
        double ang;
        if (j < 32) { const int jj = j & 15; double inv = 1.0; for (int q = 0; q < jj; ++q) inv *= r16; ang = (double)(j < 16 ? prow : pcol) * inv; }
        else { const int j2 = j - 32, jj = j2 & 7; double inv = 1.0; for (int q = 0; q < jj; ++q) inv *= r8; ang = (double)(j2 < 8 ? prow : pcol) * inv; }
        double s, co; sincos_d(ang, s, co);
        if (j < 32) { c.tabr()[(t * 32 + j) * 2] = (float)co; c.tabr()[(t * 32 + j) * 2 + 1] = (float)s; }
        else { c.tabm()[(t * 16 + j - 32) * 2] = (float)co; c.tabm()[(t * 16 + j - 32) * 2 + 1] = (float)s; }
    }
}

__device__ __forceinline__ void p1_norm(const Ctx& c) {
    for (int r = c.gw * 2; r < RT; r += c.ngw * 2) {
        const float* src = r < RL ? c.x() + (size_t)r * D : c.ctx() + (size_t)(r - RL) * D; const int b = r < RL ? r / SEQ : 8;
        f32x4 v[2][4]; float s0 = 0.f, s1 = 0.f;
#pragma unroll
        for (int j = 0; j < 4; ++j) { v[0][j] = __builtin_nontemporal_load((const f32x4*)src + c.lane + 64 * j); v[1][j] = __builtin_nontemporal_load((const f32x4*)(src + D) + c.lane + 64 * j); }
#pragma unroll
        for (int j = 0; j < 4; ++j) { s0 += v[0][j].x * v[0][j].x + v[0][j].y * v[0][j].y + v[0][j].z * v[0][j].z + v[0][j].w * v[0][j].w; s1 += v[1][j].x * v[1][j].x + v[1][j].y * v[1][j].y + v[1][j].z * v[1][j].z + v[1][j].w * v[1][j].w; }
        const float ri0 = 1.f / sqrtf(wave_sum(s0) * (1.f / D) + EPS), ri1 = 1.f / sqrtf(wave_sum(s1) * (1.f / D) + EPS);
        const float* md = c.modv() + b * 6144;
#pragma unroll
        for (int j = 0; j < 4; ++j) { const int k = 4 * c.lane + 256 * j;
            const f32x4 g = *(const f32x4*)(c.g_mix() + k), sh = *(const f32x4*)(md + k), scv = *(const f32x4*)(md + 1024 + k);
            const f32x4 gs = g * (scv + 1.f); const f32x4 o0 = v[0][j] * ri0 * gs + sh, o1 = v[1][j] * ri1 * gs + sh;
            u32x2 w0, w1; w0.x = pk2(o0.x, o0.y); w0.y = pk2(o0.z, o0.w); w1.x = pk2(o1.x, o1.y); w1.y = pk2(o1.z, o1.w);
            *(u32x2*)(c.hb() + (size_t)r * D + k) = w0; *(u32x2*)(c.hb() + (size_t)(r + 1) * D + k) = w1; }
    }
}

__device__ __forceinline__ void store8_bf16(bf16_t* p, const float (&v)[8]) { u32x4 w; w.x = pk2(v[0], v[1]); w.y = pk2(v[2], v[3]); w.z = pk2(v[4], v[5]); w.w = pk2(v[6], v[7]); *(u32x4*)p = w; }


namespace pg8 {
typedef short bf16x8 __attribute__((ext_vector_type(8)));
constexpr int BM = 256, BK = 64, HALF = 128, HTB = HALF * BK * 2, STAGE_BYTES = 8 * HTB, NXCD = 8, WGM = 8;
__host__ __device__ __forceinline__ int lds_byte(int r, int c) { const int st = (r >> 4) * 2 + (c >> 5), rr = r & 15, cc = c & 31, ob = rr * 64 + cc * 2; return st * 1024 + (ob ^ (((ob >> 9) & 1) << 5)); }
__host__ __device__ __forceinline__ void stage_rc(int b, int& R, int& C) { const int st = b / 1024, sb = b % 1024, swz = sb ^ (((sb >> 9) & 1) << 5); R = (st >> 1) * 16 + swz / 64; C = (st & 1) * 32 + (swz % 64) / 2; }
__host__ __device__ __forceinline__ int perm32(int rho) { const int n = rho >> 4, i = rho & 15; return 8 * (i >> 2) + 4 * n + (i & 3); }
struct Unit { int pm, pn; };
struct Gemm { const bf16_t* A; const bf16_t* Bt; int lda, ldb, K; const int* rowlist; int gshift, gmask; size_t gstride; };
struct StaticOrder {
    int nM, nN, nwg, G, c;
    __host__ __device__ void init(int M, int N, int G_, int c_) { nM = M / BM; nN = N / BM; nwg = nM * nN; G = G_; c = c_; }
    __host__ __device__ bool next(int i, Unit& u) const {
        const long L = (long)i * G + c; if (L >= nwg) return false;
        int wgid = (int)L; { const int q = nwg / NXCD, r = nwg % NXCD, xcd = wgid % NXCD, off = wgid / NXCD; wgid = (xcd < r ? xcd * (q + 1) : r * (q + 1) + (xcd - r) * q) + off; }
        const int nig = WGM * nN, gid = wgid / nig, fm = gid * WGM, gsz = (nM - fm) < WGM ? (nM - fm) : WGM;
        u.pm = fm + ((wgid % nig) % gsz); u.pn = (wgid % nig) / gsz; return true;
    }
};
struct ExpertOrder : StaticOrder {
    __host__ __device__ bool next(int i, Unit& u) const {
        if (!StaticOrder::next(i, u)) return false;
        const int p = u.pm, x = p >> 5, el = (p >> 4) & 1, b = (p >> 1) & 7, j = p & 1; u.pm = 32 * b + 2 * (2 * x + el) + j; return true;
    }
};
template <class F, bool FENCE = false> struct EpiRow8 {
    static constexpr bool PERM = true;
    F f;
    __device__ __forceinline__ void operator()(const f32x4 (&acc)[2][2][4][2], const Unit& u, int wr, int wc, int fr, int fq) const {
        const int row0 = u.pm * BM + wr * 64 + fr, col0 = u.pn * BM + wc * 32 + 8 * fq;
#pragma unroll
        for (int ai = 0; ai < 2; ++ai)
#pragma unroll
            for (int m = 0; m < 4; ++m)
#pragma unroll
                for (int bj = 0; bj < 2; ++bj) { const f32x4 a = acc[ai][bj][m][0], b = acc[ai][bj][m][1]; const float v[8] = {a[0], a[1], a[2], a[3], b[0], b[1], b[2], b[3]};
                    f(row0 + ai * HALF + m * 16, col0 + bj * HALF, v); if (FENCE && bj == 1) asm volatile("" ::: "memory"); }
    }
};
typedef int i32x8 __attribute__((ext_vector_type(8)));
__device__ __forceinline__ f32x4 mma_f8(bf16x8 a0, bf16x8 a1, bf16x8 b0, bf16x8 b1, f32x4 c) {
    const i32x8 A = __builtin_shufflevector(__builtin_bit_cast(i32x4, a0), __builtin_bit_cast(i32x4, a1), 0, 1, 2, 3, 4, 5, 6, 7), B = __builtin_shufflevector(__builtin_bit_cast(i32x4, b0), __builtin_bit_cast(i32x4, b1), 0, 1, 2, 3, 4, 5, 6, 7);
    return __builtin_amdgcn_mfma_scale_f32_16x16x128_f8f6f4(A, B, c, 0, 0, 0, 0, 0, 0);
}
template <int I8> __device__ __forceinline__ f32x4 mma_step(bf16x8 a, bf16x8 b, f32x4 c) {
    if constexpr (I8 == 1) return __builtin_bit_cast(f32x4, __builtin_amdgcn_mfma_i32_16x16x64_i8(__builtin_bit_cast(i32x4, a), __builtin_bit_cast(i32x4, b), __builtin_bit_cast(i32x4, c), 0, 0, 0));
    else return __builtin_amdgcn_mfma_f32_16x16x32_bf16(a, b, c, 0, 0, 0);
}
template <int I8 = 0, bool GATHER = false, class Epi, class Sched>
__device__ __forceinline__ void gemm_phase(LAS unsigned char* lds, const Gemm g, const Sched& S, const Epi& E, int tid) {
    const int wid = __builtin_amdgcn_readfirstlane(tid >> 6), lane = tid & 63, wr = wid >> 2, wc = wid & 3, fr = lane & 15, fq = lane >> 4;
    int Kv_ = g.K; asm volatile("" : "+s"(Kv_)); const int nt = Kv_ / BK;
    unsigned voffB[2];
#pragma unroll
    for (int i = 0; i < 2; ++i) { int R, C; stage_rc(tid * 16 + i * 8192, R, C); const int Rb = Epi::PERM ? ((R & ~31) + perm32(R & 31)) : R;
        voffB[i] = (unsigned)(Rb * g.ldb + C) * 2u; }
    const size_t kstep = (size_t)(BK * 2);
    const size_t hstepB = (size_t)HALF * g.ldb * 2, tstepB = 2 * hstepB;
    const unsigned ldsw = (unsigned)wid * 1024u;
    const int aoff = lds_byte(wr * 64 + fr, fq * 8), boff = lds_byte(wc * 32 + fr, fq * 8);
    const unsigned lda2 = (unsigned)g.lda * 2u;
#define PG8_SA(b, h) (((b) * 2 + (h)) * HTB)
#define PG8_SB(b, h) ((4 + (b) * 2 + (h)) * HTB)
#define PG8_STAGE(bufoff, gbase, voff) do { _Pragma("unroll") for (int _i = 0; _i < 2; ++_i) { unsigned _vo = (voff)[_i]; asm volatile("" : "+v"(_vo));     \
        __builtin_amdgcn_global_load_lds((const unsigned*)((const char*)(gbase) + _vo), (LAS unsigned*)(lds + (bufoff) + ldsw + _i * 8192), 16, 0, 0); } } while (0)
#define PG8_LDA(dst, b, h) do { if constexpr (I8 == 2) { _Pragma("unroll") for (int m = 0; m < 4; ++m) dst##8[m] = __builtin_shufflevector(*(const LAS i32x4*)(lds + PG8_SA(b, h) + aoff + m * 2048), *(const LAS i32x4*)(lds + PG8_SA(b, h) + aoff + m * 2048 + 1024), 0, 1, 2, 3, 4, 5, 6, 7); } \
        else { _Pragma("unroll") for (int m = 0; m < 4; ++m) _Pragma("unroll") for (int k = 0; k < 2; ++k) dst[m][k] = *(const LAS bf16x8*)(lds + PG8_SA(b, h) + aoff + m * 2048 + k * 1024); } } while (0)
#define PG8_LDB(dst, b, h) do { if constexpr (I8 == 2) { _Pragma("unroll") for (int n = 0; n < 2; ++n) dst##8[n] = __builtin_shufflevector(*(const LAS i32x4*)(lds + PG8_SB(b, h) + boff + n * 2048), *(const LAS i32x4*)(lds + PG8_SB(b, h) + boff + n * 2048 + 1024), 0, 1, 2, 3, 4, 5, 6, 7); } \
        else { _Pragma("unroll") for (int n = 0; n < 2; ++n) _Pragma("unroll") for (int k = 0; k < 2; ++k) dst[n][k] = *(const LAS bf16x8*)(lds + PG8_SB(b, h) + boff + n * 2048 + k * 1024); } } while (0)
#define PG8_MMA(ai, bj, At, Bt) do { __builtin_amdgcn_s_setprio(1); _Pragma("unroll") for (int m = 0; m < 4; ++m) _Pragma("unroll") for (int n = 0; n < 2; ++n) { \
        if constexpr (I8 == 2) acc[ai][bj][m][n] = __builtin_amdgcn_mfma_scale_f32_16x16x128_f8f6f4(Bt##8[n], At##8[m], acc[ai][bj][m][n], 0, 0, 0, 0, 0, 0); \
        else { _Pragma("unroll") for (int k = 0; k < 2; ++k) acc[ai][bj][m][n] = mma_step<I8>(Bt[n][k], At[m][k], acc[ai][bj][m][n]); } } __builtin_amdgcn_s_setprio(0); } while (0)
#define PG8_WAIT_V(n) asm volatile("s_waitcnt vmcnt(" #n ")" ::: "memory")
#define PG8_WAIT_L(n) asm volatile("s_waitcnt lgkmcnt(" #n ")" ::: "memory")
#define PG8_BAR __builtin_amdgcn_s_barrier()
#define PG8_SCHED __builtin_amdgcn_sched_barrier(0)
#define PG8_AOFFS(vo, u) do { _Pragma("unroll") for (int _i = 0; _i < 2; ++_i) { int _R, _C; stage_rc(tid * 16 + _i * 8192, _R, _C); _Pragma("unroll") for (int _h = 0; _h < 2; ++_h) { const int _r = (u).pm * BM + _h * HALF + _R; \
        const int _row = g.rowlist ? g.rowlist[_r] : _r; vo[_h][_i] = (unsigned)_row * lda2 + (unsigned)(_C * 2); } } } while (0)
#define PG8_BBASE(u) ((const char*)g.Bt + ((size_t)(((u).pm >> g.gshift) & g.gmask) * g.gstride) * 2 + (size_t)(u).pn * tstepB)
    Unit cur, nxt; int ui = 0;
    if (!S.next(0, cur)) return;
    f32x4 acc[2][2][4][2];
#pragma unroll
    for (int a = 0; a < 2; ++a)
#pragma unroll
        for (int b = 0; b < 2; ++b)
#pragma unroll
            for (int m = 0; m < 4; ++m)
#pragma unroll
                for (int n = 0; n < 2; ++n) acc[a][b][m][n] = (f32x4){0.f, 0.f, 0.f, 0.f};
    bf16x8 At[4][2], B0[2][2], B1[2][2];
    i32x8 At8[4], B08[2], B18[2];
    unsigned voc[2][2], von[2][2], voA[2];
    const size_t hstepA = (size_t)HALF * lda2, ustepA = 2 * hstepA;
#pragma unroll
    for (int i = 0; i < 2; ++i) { int R, C; stage_rc(tid * 16 + i * 8192, R, C); voA[i] = (unsigned)R * lda2 + (unsigned)(C * 2); }
    if constexpr (GATHER) PG8_AOFFS(voc, cur);
#define PG8_ABASE(u) ((const char*)g.A + (GATHER ? (size_t)0 : (size_t)(u).pm * ustepA))
#define PG8_STAGE_A(bufoff, base, h, vg) do { if constexpr (GATHER) PG8_STAGE(bufoff, base, vg); else PG8_STAGE(bufoff, (base) + (h) * hstepA, voA); } while (0)
    const char* A0 = PG8_ABASE(cur); const char* cB = PG8_BBASE(cur);
    PG8_STAGE(PG8_SB(0, 0), cB, voffB); PG8_STAGE(PG8_SB(0, 1), cB + hstepB, voffB); PG8_STAGE_A(PG8_SA(0, 0), A0, 0, voc[0]); PG8_STAGE_A(PG8_SA(0, 1), A0, 1, voc[1]);
    if (wr == 1) PG8_BAR;
    PG8_WAIT_V(2); PG8_BAR;
    PG8_STAGE(PG8_SB(1, 0), cB + kstep, voffB); PG8_STAGE_A(PG8_SA(1, 0), A0 + kstep, 0, voc[0]); PG8_STAGE(PG8_SB(1, 1), cB + hstepB + kstep, voffB);
    PG8_WAIT_V(6); PG8_BAR;
    for (;;) {
        const bool has_next = S.next(ui + 1, nxt);
        const char* nB = has_next ? PG8_BBASE(nxt) : cB; const char* nA = has_next ? PG8_ABASE(nxt) : A0;
        for (int t = 0; t < nt; t += 2) {
            const bool last = (t == nt - 2);
            const char* a1 = A0 + (size_t)(t + 1) * kstep;
            const char* a2 = last ? nA : A0 + (size_t)(t + 2) * kstep; const char* b2 = last ? nB : cB + (size_t)(t + 2) * kstep;
            const char* a3 = a2 + kstep; const char* b3 = b2 + kstep;
            unsigned vo2[2][2];
            if constexpr (GATHER) {
            if (last) { if (has_next) { PG8_AOFFS(von, nxt); } else { _Pragma("unroll") for (int h = 0; h < 2; ++h) _Pragma("unroll") for (int i = 0; i < 2; ++i) von[h][i] = voc[h][i]; } }
#pragma unroll
            for (int h = 0; h < 2; ++h)
#pragma unroll
                for (int i = 0; i < 2; ++i) vo2[h][i] = last ? von[h][i] : voc[h][i];
            }
            PG8_LDB(B0, 0, 0); PG8_LDB(B1, 0, 1); PG8_SCHED; PG8_LDA(At, 0, 0); PG8_STAGE_A(PG8_SA(1, 1), a1, 1, voc[1]);
            PG8_WAIT_V(8); PG8_WAIT_L(0); PG8_BAR; PG8_MMA(0, 0, At, B0); PG8_MMA(0, 1, At, B1); PG8_BAR; PG8_SCHED;
            PG8_LDA(At, 0, 1); PG8_STAGE(PG8_SB(0, 0), b2, voffB); PG8_STAGE(PG8_SB(0, 1), b2 + hstepB, voffB); PG8_STAGE_A(PG8_SA(0, 0), a2, 0, vo2[0]);
            PG8_WAIT_V(8); PG8_WAIT_L(0); PG8_BAR; PG8_MMA(1, 0, At, B0); PG8_MMA(1, 1, At, B1); PG8_BAR; PG8_SCHED;
            PG8_LDB(B0, 1, 0); PG8_LDB(B1, 1, 1); PG8_SCHED; PG8_LDA(At, 1, 0); PG8_STAGE_A(PG8_SA(0, 1), a2, 1, vo2[1]);
            PG8_WAIT_V(8); PG8_WAIT_L(0); PG8_BAR; PG8_MMA(0, 0, At, B0); PG8_MMA(0, 1, At, B1); PG8_BAR; PG8_SCHED;
            PG8_LDA(At, 1, 1); PG8_STAGE(PG8_SB(1, 0), b3, voffB); PG8_STAGE(PG8_SB(1, 1), b3 + hstepB, voffB); PG8_STAGE_A(PG8_SA(1, 0), a3, 0, vo2[0]);
            PG8_WAIT_V(8); PG8_WAIT_L(0); PG8_BAR; PG8_MMA(1, 0, At, B0); PG8_MMA(1, 1, At, B1); PG8_BAR; PG8_SCHED;
        }
        if (wr == 0) PG8_BAR;
        if constexpr (I8 == 1) {
#pragma unroll
            for (int a = 0; a < 2; ++a)
#pragma unroll
                for (int b = 0; b < 2; ++b)
#pragma unroll
                    for (int m = 0; m < 4; ++m)
#pragma unroll
                        for (int n = 0; n < 2; ++n) acc[a][b][m][n] = __builtin_convertvector(__builtin_bit_cast(i32x4, acc[a][b][m][n]), f32x4); }
        E(acc, cur, wr, wc, fr, fq);
        if (!has_next) break;
#pragma unroll
        for (int a = 0; a < 2; ++a)
#pragma unroll
            for (int b = 0; b < 2; ++b)
#pragma unroll
                for (int m = 0; m < 4; ++m)
#pragma unroll
                    for (int n = 0; n < 2; ++n) acc[a][b][m][n] = (f32x4){0.f, 0.f, 0.f, 0.f};
        cur = nxt; cB = nB; A0 = nA; ++ui;
        if constexpr (GATHER) {
#pragma unroll
        for (int h = 0; h < 2; ++h)
#pragma unroll
            for (int i = 0; i < 2; ++i) voc[h][i] = von[h][i];
        }
        if (wr == 1) PG8_BAR;
    }
    PG8_WAIT_V(0);
    PG8_BAR;
#undef PG8_SA
#undef PG8_SB
#undef PG8_STAGE
#undef PG8_LDA
#undef PG8_LDB
#undef PG8_MMA
#undef PG8_WAIT_V
#undef PG8_WAIT_L
#undef PG8_BAR
#undef PG8_SCHED
#undef PG8_AOFFS
#undef PG8_ABASE
#undef PG8_STAGE_A
#undef PG8_BBASE
}
}
template <class F> __device__ __forceinline__ pg8::EpiRow8<F> make_epi(F f) { return pg8::EpiRow8<F>{f}; }
template <class F> __device__ __forceinline__ pg8::EpiRow8<F, true> make_epi_fenced(F f) { return pg8::EpiRow8<F, true>{f}; }

struct EpiProj {
    static constexpr bool PERM = true;
    bf16_t* proj; float* pstat; const float* tabr; const float* tabm;
    __device__ __forceinline__ void operator()(const f32x4 (&acc)[2][2][4][2], const pg8::Unit& u, int wr, int wc, int fr, int fq) const {
        const int row0 = u.pm * 256 + wr * 64 + fr, pn = u.pn; const bool lat = u.pm < RL / 256;
        const bool rope_r = pn >= 2 && pn < 6 && lat, rope_m = pn == 1 && wc == 0 && lat;
        f32x4 tb[8][2];
        if (rope_r || rope_m) { const int g = rope_r ? ((wc * 32 + 8 * fq) & 63) >> 3 : fq; const float* tab = rope_r ? tabr : tabm; const int nf = rope_r ? 32 : 16;
#pragma unroll
            for (int i = 0; i < 8; ++i) { const int t = (row0 + (i >> 2) * 128 + (i & 3) * 16) & (SEQ - 1); tb[i][0] = *(const f32x4*)(tab + (t * nf + 4 * g) * 2); tb[i][1] = *(const f32x4*)(tab + (t * nf + 4 * g) * 2 + 4); } }
        else {
#pragma unroll
            for (int i = 0; i < 8; ++i) { tb[i][0] = (f32x4){1.f, 0.f, 1.f, 0.f}; tb[i][1] = (f32x4){1.f, 0.f, 1.f, 0.f}; } }
#pragma unroll
        for (int ai = 0; ai < 2; ++ai)
#pragma unroll
            for (int m = 0; m < 4; ++m) {
                const int row = row0 + ai * 128 + m * 16;
                bf16_t* pr = proj + (size_t)row * NPROJ + pn * 256 + wc * 32 + 8 * fq;
                const f32x4 c0 = tb[ai * 4 + m][0], c1 = tb[ai * 4 + m][1]; const float co[4] = {c0.x, c0.z, c1.x, c1.z}, si[4] = {c0.y, c0.w, c1.y, c1.w};
                float v[2][8];
#pragma unroll
                for (int bj = 0; bj < 2; ++bj) { const f32x4 a = acc[ai][bj][m][0], b = acc[ai][bj][m][1]; v[bj][0] = a[0]; v[bj][1] = a[1]; v[bj][2] = a[2]; v[bj][3] = a[3]; v[bj][4] = b[0]; v[bj][5] = b[1]; v[bj][6] = b[2]; v[bj][7] = b[3]; }
                if (pn == 0) {
                    float sq = 0.f;
#pragma unroll
                    for (int bj = 0; bj < 2; ++bj)
#pragma unroll
                        for (int j = 0; j < 8; ++j) sq += v[bj][j] * v[bj][j];
                    sq += __shfl_xor(sq, 16); sq += __shfl_xor(sq, 32);
                    if (fq == 0) pstat[(size_t)row * 8 + wc] = sq;
                } else if (pn == 1) {
                    float sq = 0.f;
#pragma unroll
                    for (int j = 0; j < 8; ++j) sq += v[0][j] * v[0][j];
                    sq += __shfl_xor(sq, 16); sq += __shfl_xor(sq, 32);
                    if (fq == 0) pstat[(size_t)row * 8 + 4 + wc] = sq;
                    if (wc == 0) {
#pragma unroll
                        for (int w = 0; w < 4; ++w) { const float x1 = v[1][w], x2 = v[1][4 + w]; v[1][w] = x1 * co[w] - x2 * si[w]; v[1][4 + w] = x1 * si[w] + x2 * co[w]; } }
                } else if (pn < 6) {
                    const float ksc = pn >= 4 ? 0.125f : 1.f;
#pragma unroll
                    for (int bj = 0; bj < 2; ++bj)
#pragma unroll
                        for (int w = 0; w < 4; ++w) { const float x1 = v[bj][w], x2 = v[bj][4 + w]; v[bj][w] = (x1 * co[w] - x2 * si[w]) * ksc; v[bj][4 + w] = (x1 * si[w] + x2 * co[w]) * ksc; }
                } else if (pn >= 8) {
#pragma unroll
                    for (int bj = 0; bj < 2; ++bj)
#pragma unroll
                        for (int j = 0; j < 8; ++j) v[bj][j] = silu_f(v[bj][j]);
                }
                store8_bf16(pr, v[0]); store8_bf16(pr + 128, v[1]);
            }
    }
};
__device__ __forceinline__ void p2_proj(const Ctx& c, float* lds) {
    pg8::Gemm g{c.hb(), c.win_t(), D, D, D, nullptr, 0, 0, 0};
    pg8::StaticOrder S; S.init(RT, NPROJ, (int)gridDim.x, (int)blockIdx.x);
    EpiProj E{c.proj(), c.pstat(), c.tabr(), c.tabm()};
    pg8::gemm_phase((LAS unsigned char*)lds, g, S, E, c.tid);
    if ((int)gridDim.x == 256 && (int)blockIdx.x >= QSHORT0) { __syncthreads();
        for (int q = 0; q < QSTRIPS; ++q) expert_strip(c, lds, ((int)blockIdx.x - QSHORT0) * QSTRIPS + q);
        __syncthreads(); }
}
template <bool ISQ> struct EpiUp {
    static constexpr bool PERM = true;
    bf16_t* out; const float* pstat; const float* tabm;
    __device__ __forceinline__ void operator()(const f32x4 (&acc)[2][2][4][2], const pg8::Unit& u, int wr, int wc, int fr, int fq) const {
        const int row0 = u.pm * 256 + wr * 64 + fr, col00 = u.pn * 256 + wc * 32 + 8 * fq;
        float sc[8];
#pragma unroll
        for (int i = 0; i < 8; ++i) { const f32x4 ps = *(const f32x4*)(pstat + (size_t)(row0 + (i >> 2) * 128 + (i & 3) * 16) * 8 + (ISQ ? 0 : 4));
            sc[i] = (ISQ ? QSCALE : 1.f) / sqrtf((ps.x + ps.y + ps.z + ps.w) * (ISQ ? 1.f / 256.f : 1.f / 128.f) + EPS); }
#pragma unroll
        for (int ai = 0; ai < 2; ++ai)
#pragma unroll
            for (int m = 0; m < 4; ++m) { const int row = row0 + ai * 128 + m * 16; const float s_ = sc[ai * 4 + m];
#pragma unroll
                for (int bj = 0; bj < 2; ++bj) { const int c0 = col00 + bj * 128; const f32x4 a = acc[ai][bj][m][0], b = acc[ai][bj][m][1];
                    float o[8] = {a[0] * s_, a[1] * s_, a[2] * s_, a[3] * s_, b[0] * s_, b[1] * s_, b[2] * s_, b[3] * s_};
                    if (ISQ) { const int p = c0 - 96 * ((c0 * 683) >> 16);
                        if (p >= 64) { const int t = row & (SEQ - 1), g = (p - 64) >> 3;
                            const f32x4 c0v = *(const f32x4*)(tabm + (t * 16 + 4 * g) * 2), c1v = *(const f32x4*)(tabm + (t * 16 + 4 * g) * 2 + 4);
                            const float co[4] = {c0v.x, c0v.z, c1v.x, c1v.z}, si[4] = {c0v.y, c0v.w, c1v.y, c1v.w};
#pragma unroll
                            for (int w = 0; w < 4; ++w) { const float x1 = o[w], x2 = o[4 + w]; o[w] = x1 * co[w] - x2 * si[w]; o[4 + w] = x1 * si[w] + x2 * co[w]; } } }
                    store8_bf16(out + (size_t)row * (ISQ ? QW : KVW) + c0, o); } }
    }
};
__device__ __forceinline__ void p3_upq(const Ctx& c, float* lds) {
    pg8::Gemm g{c.proj() + PC_CQ, c.wuq_t(), NPROJ, 256, 256, nullptr, 0, 0, 0};
    pg8::StaticOrder S; S.init(RL, QW, (int)gridDim.x, (int)blockIdx.x);
    EpiUp<true> E{c.qb(), c.pstat(), c.tabm()};
    pg8::gemm_phase((LAS unsigned char*)lds, g, S, E, c.tid);
}
__device__ __forceinline__ void p3_upkv(const Ctx& c, float* lds) {
    pg8::Gemm g{c.proj() + PC_CKV, c.wukv_t(), NPROJ, 256, 128, nullptr, 0, 0, 0};
    pg8::StaticOrder S; S.init(RT, KVW, (int)gridDim.x, (int)blockIdx.x);
    EpiUp<false> E{c.kvb(), c.pstat(), c.tabm()};
    pg8::gemm_phase((LAS unsigned char*)lds, g, S, E, c.tid);
}

namespace att {
using bf16x8 = __attribute__((ext_vector_type(8))) short;
using s16x4  = __attribute__((ext_vector_type(4))) short;
using f32x16 = __attribute__((ext_vector_type(16))) float;
constexpr int QBLK = 32, KVBLK = 64, NWV = 8;
constexpr float THR = 8.f;
constexpr int SHM_V = 16384, SHM_K = 16384, SHM_ATTN = 3 * SHM_V + 3 * SHM_K + NWV * 64 * 4;
#define KSWZ(row, colB) ((row) * 256 + ((colB) ^ (((row) & 7) << 4)))
#define SBAR() __builtin_amdgcn_sched_barrier(0)
__device__ __forceinline__ int crow(int r, int hi) { return (r & 3) + 8 * (r >> 2) + 4 * hi; }
__device__ __forceinline__ unsigned cvtpk(float lo, float hi) { unsigned r; asm volatile("v_cvt_pk_bf16_f32 %0, %1, %2" : "=v"(r) : "v"(lo), "v"(hi)); return r; }
__device__ __forceinline__ float max3f(float a, float b, float c) { float r; asm("v_max3_f32 %0, %1, %2, %3" : "=v"(r) : "v"(a), "v"(b), "v"(c)); return r; }
template <bool FIRST>
__device__ __forceinline__ void partialSM(f32x16& p0, f32x16& p1, float& m_reg, f32x16& negm, float& alpha) {
  float pa = max3f(p0[0], p0[1], p0[2]), pb = max3f(p1[0], p1[1], p1[2]);
#pragma unroll
  for (int r = 3; r < 15; r += 2) { pa = max3f(pa, p0[r], p0[r + 1]); pb = max3f(pb, p1[r], p1[r + 1]); }
  float pmax = max3f(pa, pb, fmaxf(p0[15], p1[15]));
  { auto rr = __builtin_amdgcn_permlane32_swap(__float_as_uint(pmax), __float_as_uint(pmax), false, false);
    pmax = fmaxf(__uint_as_float(rr[0]), __uint_as_float(rr[1])); }
  if (!FIRST && __builtin_expect(__all(pmax <= THR), 1)) { alpha = 1.f; }
  else { const float dl = FIRST ? pmax : fmaxf(pmax, 0.f); alpha = FIRST ? 1.f : __builtin_amdgcn_exp2f(-dl); m_reg += dl;
#pragma unroll
    for (int r = 0; r < 16; ++r) { p0[r] -= dl; p1[r] -= dl; }
#pragma unroll
    for (int r = 0; r < 16; ++r) negm[r] = -m_reg;
    asm volatile("" : "+v"(negm)); }
#pragma unroll
  for (int r = 0; r < 16; ++r) p0[r] = __builtin_amdgcn_exp2f(p0[r]);
}
__device__ __forceinline__ void finishSM(f32x16& p0, f32x16& p1, float alpha, float& l_reg, bf16x8& pa0, bf16x8& pa1, bf16x8& pa2, bf16x8& pa3) {
#pragma unroll
  for (int r = 0; r < 16; ++r) p1[r] = __builtin_amdgcn_exp2f(p1[r]);
  float ps = 0;
#pragma unroll
  for (int r = 0; r < 16; ++r) ps += p0[r];
#pragma unroll
  for (int r = 0; r < 16; ++r) ps += p1[r];
  { auto rr = __builtin_amdgcn_permlane32_swap(__float_as_uint(ps), __float_as_uint(ps), false, false);
    ps = __uint_as_float(rr[0]) + __uint_as_float(rr[1]); }
  l_reg = l_reg * alpha + ps;
#define PK4(P, BASE, OUT) do { unsigned a0 = cvtpk(P[BASE + 0], P[BASE + 1]), a1 = cvtpk(P[BASE + 2], P[BASE + 3]);   \
    unsigned b0 = cvtpk(P[BASE + 4], P[BASE + 5]), b1 = cvtpk(P[BASE + 6], P[BASE + 7]);                              \
    auto r0 = __builtin_amdgcn_permlane32_swap(a0, b0, false, false); auto r1 = __builtin_amdgcn_permlane32_swap(a1, b1, false, false); \
    u32x4 w = {r0[0], r1[0], r0[1], r1[1]}; OUT = *reinterpret_cast<bf16x8*>(&w); } while (0)
  PK4(p0, 0, pa0); PK4(p0, 8, pa1); PK4(p1, 0, pa2); PK4(p1, 8, pa3);
#undef PK4
}
__device__ __forceinline__ void qkt(f32x16& p0, f32x16& p1, const char* Ks, const bf16x8* qr, const f32x16& negm, int r32, int hi) {
#pragma unroll
  for (int d0 = 0; d0 < 6; ++d0) { const int cb = (d0 * 16 + hi * 8) * 2;
    const bf16x8 b0 = *reinterpret_cast<const bf16x8*>(Ks + KSWZ(r32, cb));
    const bf16x8 b1 = *reinterpret_cast<const bf16x8*>(Ks + KSWZ(32 + r32, cb));
    if (d0 == 0) { p0 = __builtin_amdgcn_mfma_f32_32x32x16_bf16(b0, qr[0], negm, 0, 0, 0); p1 = __builtin_amdgcn_mfma_f32_32x32x16_bf16(b1, qr[0], negm, 0, 0, 0); }
    else { p0 = __builtin_amdgcn_mfma_f32_32x32x16_bf16(b0, qr[d0], p0, 0, 0, 0); p1 = __builtin_amdgcn_mfma_f32_32x32x16_bf16(b1, qr[d0], p1, 0, 0, 0); } }
}
__device__ __forceinline__ int v_st(int k, int c) { const int kk = (k & ~0xC) | ((k & 4) << 1) | ((k & 8) >> 1); return ((kk >> 3) * 4 + (c >> 5)) * 512 + ((kk & 7) * 32 + (c & 31)) * 2; }
__device__ __forceinline__ int v_rd_base(int lane) { return ((lane & 3) << 3) | (((lane >> 2) & 3) << 6) | (((lane >> 4) & 1) << 5) | (((lane >> 5) & 1) << 8); }
constexpr int v_rd_off(int d0, int ks, int half) { return d0 * 512 + ks * 4096 + half * 2048; }
template <int OFF> __device__ __forceinline__ s16x4 tr_read(int vb) { s16x4 r; asm volatile("ds_read_b64_tr_b16 %0, %1 offset:%2" : "=&v"(r) : "v"(vb), "i"(OFF) : "memory"); return r; }
template <int D0> __device__ __forceinline__ void pv_one(f32x16& od, int vb, bf16x8 pa0, bf16x8 pa1, bf16x8 pa2, bf16x8 pa3) {
  const s16x4 l0 = tr_read<v_rd_off(D0, 0, 0)>(vb), h0 = tr_read<v_rd_off(D0, 0, 1)>(vb), l1 = tr_read<v_rd_off(D0, 1, 0)>(vb), h1 = tr_read<v_rd_off(D0, 1, 1)>(vb);
  const s16x4 l2 = tr_read<v_rd_off(D0, 2, 0)>(vb), h2 = tr_read<v_rd_off(D0, 2, 1)>(vb), l3 = tr_read<v_rd_off(D0, 3, 0)>(vb), h3 = tr_read<v_rd_off(D0, 3, 1)>(vb);
  asm volatile("s_waitcnt lgkmcnt(0)" ::: "memory"); SBAR();
#define PK(L, H) (bf16x8){L[0], L[1], L[2], L[3], H[0], H[1], H[2], H[3]}
  od = __builtin_amdgcn_mfma_f32_32x32x16_bf16(pa0, PK(l0, h0), od, 0, 0, 0);
  od = __builtin_amdgcn_mfma_f32_32x32x16_bf16(pa1, PK(l1, h1), od, 0, 0, 0);
  od = __builtin_amdgcn_mfma_f32_32x32x16_bf16(pa2, PK(l2, h2), od, 0, 0, 0);
  od = __builtin_amdgcn_mfma_f32_32x32x16_bf16(pa3, PK(l3, h3), od, 0, 0, 0);
#undef PK
}
__device__ __forceinline__ void pv_d0(f32x16* o, int vb, bf16x8 pa0, bf16x8 pa1, bf16x8 pa2, bf16x8 pa3) {
  const s16x4 l0 = tr_read<v_rd_off(0, 0, 0)>(vb), h0 = tr_read<v_rd_off(0, 0, 1)>(vb), l1 = tr_read<v_rd_off(0, 1, 0)>(vb), h1 = tr_read<v_rd_off(0, 1, 1)>(vb);
  const s16x4 l2 = tr_read<v_rd_off(0, 2, 0)>(vb), h2 = tr_read<v_rd_off(0, 2, 1)>(vb), l3 = tr_read<v_rd_off(0, 3, 0)>(vb), h3 = tr_read<v_rd_off(0, 3, 1)>(vb);
  const s16x4 m0 = tr_read<v_rd_off(1, 0, 0)>(vb), g0 = tr_read<v_rd_off(1, 0, 1)>(vb), m1 = tr_read<v_rd_off(1, 1, 0)>(vb), g1 = tr_read<v_rd_off(1, 1, 1)>(vb);
  const s16x4 m2 = tr_read<v_rd_off(1, 2, 0)>(vb), g2 = tr_read<v_rd_off(1, 2, 1)>(vb), m3 = tr_read<v_rd_off(1, 3, 0)>(vb), g3 = tr_read<v_rd_off(1, 3, 1)>(vb);
  asm volatile("s_waitcnt lgkmcnt(0)" ::: "memory"); SBAR();
#define PK(L, H) (bf16x8){L[0], L[1], L[2], L[3], H[0], H[1], H[2], H[3]}
  o[0] = __builtin_amdgcn_mfma_f32_32x32x16_bf16(pa0, PK(l0, h0), o[0], 0, 0, 0); o[1] = __builtin_amdgcn_mfma_f32_32x32x16_bf16(pa0, PK(m0, g0), o[1], 0, 0, 0);
  o[0] = __builtin_amdgcn_mfma_f32_32x32x16_bf16(pa1, PK(l1, h1), o[0], 0, 0, 0); o[1] = __builtin_amdgcn_mfma_f32_32x32x16_bf16(pa1, PK(m1, g1), o[1], 0, 0, 0);
  o[0] = __builtin_amdgcn_mfma_f32_32x32x16_bf16(pa2, PK(l2, h2), o[0], 0, 0, 0); o[1] = __builtin_amdgcn_mfma_f32_32x32x16_bf16(pa2, PK(m2, g2), o[1], 0, 0, 0);
  o[0] = __builtin_amdgcn_mfma_f32_32x32x16_bf16(pa3, PK(l3, h3), o[0], 0, 0, 0); o[1] = __builtin_amdgcn_mfma_f32_32x32x16_bf16(pa3, PK(m3, g3), o[1], 0, 0, 0);
#undef PK
}

__device__ __forceinline__ void attn_unit(const bf16_t* __restrict__ Qb, const bf16_t* __restrict__ KN, const bf16_t* __restrict__ KR, const bf16_t* __restrict__ VV, bf16_t* __restrict__ Ob, int b, char* lds, int tid) {
  const int wid = tid >> 6, lane = tid & 63, r32 = lane & 31, hi = lane >> 5;
  char* V_lds = lds; char* K_lds = lds + 3 * SHM_V;
  float* ws = (float*)(lds + 3 * SHM_V + 3 * SHM_K) + wid * 64; float* li_l = ws; float* al_l = ws + 32;
  float m_reg = 0.f, l_reg = 0; f32x16 o[2] = {}; bf16x8 qr[6]; f32x16 negm = {};
  const bf16_t* Qw = Qb + (long)(wid * QBLK + r32) * QW + hi * 8;
#pragma unroll
  for (int d0 = 0; d0 < 6; ++d0) qr[d0] = __builtin_nontemporal_load(reinterpret_cast<const bf16x8*>(Qw + d0 * 16));
  const int srow = tid >> 3, sch = tid & 7;
  const int rrow = (tid & 255) >> 2, rch = tid & 3;
  const int vst = v_st(srow, sch * 8), kst = KSWZ(srow, sch * 16), krst = KSWZ(rrow, 128 + rch * 16);
  const int vb0 = (int)(uintptr_t)V_lds + v_rd_base(lane);
  struct { bf16x8 vs, kn, kr; } sr_[2];
#define ROWBASE(j) ((j) < 64 ? (long)b * SEQ + (long)(j) * 64 : (long)RL + (long)b * LC + (long)((j) - 64) * 64)
#define SLOAD(i, j) do { const long rb_ = ROWBASE(j); sr_[i].vs = *reinterpret_cast<const bf16x8*>(VV + (rb_ + srow) * KVW + sch * 8); \
    sr_[i].kn = *reinterpret_cast<const bf16x8*>(KN + (rb_ + srow) * KVW + sch * 8); sr_[i].kr = *reinterpret_cast<const bf16x8*>(KR + (rb_ + rrow) * NPROJ + rch * 8); } while (0)
#define SWRITE(bb, i) do { *(bf16x8*)(V_lds + (bb) * SHM_V + vst) = sr_[i].vs; *(bf16x8*)(K_lds + (bb) * SHM_K + kst) = sr_[i].kn; \
    if (wid < 4) *(bf16x8*)(K_lds + (bb) * SHM_K + krst) = sr_[i].kr; } while (0)
#define SWAIT() asm volatile("s_waitcnt vmcnt(3)" ::: "memory")
#define RESC(a) do { if (__any((a) < 1.f)) { if (hi == 0) al_l[r32] = (a); asm volatile("s_waitcnt lgkmcnt(0)" ::: "memory"); \
    _Pragma("unroll") for (int d = 0; d < 2; ++d) _Pragma("unroll") for (int r = 0; r < 16; ++r) o[d][r] *= al_l[crow(r, hi)]; } } while (0)
  f32x16 pA0, pA1, pB0, pB1; float alA, alB; bf16x8 pa0, pa1, pa2, pa3; constexpr int NT = (SEQ + LC) / KVBLK;
  if (wid >= 4) __builtin_amdgcn_s_setprio(1);
  int cur = 1, prev = 0, nxt = 2;
  SLOAD(0, 0); SLOAD(1, 1); asm volatile("s_waitcnt vmcnt(0)" ::: "memory"); SWRITE(0, 0); SWRITE(1, 1); SLOAD(0, 2); SLOAD(1, 3); __syncthreads();
  qkt(pA0, pA1, K_lds, qr, negm, r32, hi); partialSM<true>(pA0, pA1, m_reg, negm, alA);
#define HALFSTEP(PX0, PX1, PP0, PP1, ALX, ALP, STG, T) do { \
    __syncthreads(); \
    SBAR(); qkt(PX0, PX1, K_lds + cur * SHM_K, qr, negm, r32, hi); \
    finishSM(PP0, PP1, ALP, l_reg, pa0, pa1, pa2, pa3); SBAR(); \
    if ((T) + 1 < NT) { SWAIT(); SWRITE(nxt, STG); if ((T) + 3 < NT) SLOAD(STG, (T) + 3); } SBAR(); \
    pv_d0(o, vb0 + prev * SHM_V, pa0, pa1, pa2, pa3); partialSM<false>(PX0, PX1, m_reg, negm, ALX); \
    RESC(ALX); { const int t_ = prev; prev = cur; cur = nxt; nxt = t_; } } while (0)
  for (int t = 1; t + 1 < NT; t += 2) {
    HALFSTEP(pB0, pB1, pA0, pA1, alB, alA, 0, t);
    HALFSTEP(pA0, pA1, pB0, pB1, alA, alB, 1, t + 1);
  }
  HALFSTEP(pB0, pB1, pA0, pA1, alB, alA, 0, NT - 1);
  finishSM(pB0, pB1, alB, l_reg, pa0, pa1, pa2, pa3); SBAR();
  pv_d0(o, vb0 + prev * SHM_V, pa0, pa1, pa2, pa3);
#undef HALFSTEP
  if (hi == 0) li_l[r32] = l_reg; asm volatile("s_waitcnt lgkmcnt(0)" ::: "memory");
  float rli[16];
#pragma unroll
  for (int r = 0; r < 16; ++r) rli[r] = __builtin_amdgcn_rcpf(li_l[crow(r, hi)]);
  bf16_t* Ow = Ob + (long)(wid * QBLK) * D;
#pragma unroll
  for (int r = 0; r < 16; ++r) { const int orow = crow(r, hi);
#pragma unroll
    for (int d0 = 0; d0 < 2; ++d0) Ow[(long)orow * D + d0 * 32 + r32] = f2bf(o[d0][r] * rli[r]); }
  __builtin_amdgcn_s_setprio(0);
  __syncthreads();
#undef ROWBASE
#undef SLOAD
#undef SWRITE
#undef SWAIT
#undef RESC
}
#undef KSWZ
#undef SBAR
}


__device__ __forceinline__ float lg2_of(float e) { return log1pf(-exp2f(-e)) * 1.4426950408889634f; }
namespace ret {
using att::bf16x8; using att::s16x4; using att::f32x16; using att::v_st; using att::v_rd_base; using att::v_rd_off; using att::tr_read; using att::crow; using att::cvtpk;
constexpr int TB = 16384;
__device__ __forceinline__ bf16x8 scale8(bf16x8 x, float z) {
    const u32x4 w = __builtin_bit_cast(u32x4, x); u32x4 o;
    o.x = cvtpk(__uint_as_float(w.x << 16) * z, __uint_as_float(w.x & 0xffff0000u) * z); o.y = cvtpk(__uint_as_float(w.y << 16) * z, __uint_as_float(w.y & 0xffff0000u) * z);
    o.z = cvtpk(__uint_as_float(w.z << 16) * z, __uint_as_float(w.z & 0xffff0000u) * z); o.w = cvtpk(__uint_as_float(w.w << 16) * z, __uint_as_float(w.w & 0xffff0000u) * z);
    return __builtin_bit_cast(bf16x8, o);
}
#define RET_PK(L, H) (bf16x8){L[0], L[1], L[2], L[3], H[0], H[1], H[2], H[3]}
__device__ __forceinline__ void tt_mma(f32x16& acc, int va, int vb) {
    const s16x4 al0 = tr_read<v_rd_off(0, 0, 0)>(va), ah0 = tr_read<v_rd_off(0, 0, 1)>(va), al1 = tr_read<v_rd_off(0, 1, 0)>(va), ah1 = tr_read<v_rd_off(0, 1, 1)>(va);
    const s16x4 al2 = tr_read<v_rd_off(0, 2, 0)>(va), ah2 = tr_read<v_rd_off(0, 2, 1)>(va), al3 = tr_read<v_rd_off(0, 3, 0)>(va), ah3 = tr_read<v_rd_off(0, 3, 1)>(va);
    const s16x4 bl0 = tr_read<v_rd_off(0, 0, 0)>(vb), bh0 = tr_read<v_rd_off(0, 0, 1)>(vb), bl1 = tr_read<v_rd_off(0, 1, 0)>(vb), bh1 = tr_read<v_rd_off(0, 1, 1)>(vb);
    const s16x4 bl2 = tr_read<v_rd_off(0, 2, 0)>(vb), bh2 = tr_read<v_rd_off(0, 2, 1)>(vb), bl3 = tr_read<v_rd_off(0, 3, 0)>(vb), bh3 = tr_read<v_rd_off(0, 3, 1)>(vb);
    asm volatile("s_waitcnt lgkmcnt(0)" ::: "memory"); __builtin_amdgcn_sched_barrier(0);
    acc = __builtin_amdgcn_mfma_f32_32x32x16_bf16(RET_PK(al0, ah0), RET_PK(bl0, bh0), acc, 0, 0, 0);
    acc = __builtin_amdgcn_mfma_f32_32x32x16_bf16(RET_PK(al1, ah1), RET_PK(bl1, bh1), acc, 0, 0, 0);
    acc = __builtin_amdgcn_mfma_f32_32x32x16_bf16(RET_PK(al2, ah2), RET_PK(bl2, bh2), acc, 0, 0, 0);
    acc = __builtin_amdgcn_mfma_f32_32x32x16_bf16(RET_PK(al3, ah3), RET_PK(bl3, bh3), acc, 0, 0, 0);
}
__device__ __forceinline__ void scan_seq(const bf16_t* __restrict__ proj, bf16_t* __restrict__ rstT, int b, int h, int dir, float lg2, char* lds, int tid) {
    const int wid = tid >> 6, lane = tid & 63, r32 = lane & 31, hi = lane >> 5;
    const float g128 = __builtin_amdgcn_exp2f(lg2 * 128.f);
    const int key0 = tid >> 3, key1 = 64 + (tid >> 3), ch = tid & 7;
    const float z0 = __builtin_amdgcn_exp2f(lg2 * (float)(dir ? key0 : 127 - key0)), z1 = __builtin_amdgcn_exp2f(lg2 * (float)(dir ? key1 : 127 - key1));
    const int st = v_st(tid >> 3, ch * 8);
    char* KI = lds; char* VI = lds + 4 * TB;
    const int mt = (wid >> 1) & 1, nt = wid & 1;
    const int vaK = (int)(uintptr_t)KI + v_rd_base(lane) + mt * 512, vbV = (int)(uintptr_t)VI + v_rd_base(lane) + nt * 512;
    f32x16 acc = {};
    bf16x8 k0a, k1a, v0a, v1a, k0b, k1b, v0b, v1b, k0c, k1c, v0c, v1c, k0d, k1d, v0d, v1d;
#define RROW(ck) ((ck) < 2 ? (long)RL + (long)b * LC + (long)(dir ? 1 - (ck) : (ck)) * 128 : (long)b * SEQ + (long)(dir ? NCH - 1 - ((ck) - 2) : (ck) - 2) * 128)
#define RLOAD(S, ck) do { const bf16_t* p_ = proj + RROW(ck) * NPROJ + h * 64 + ch * 8; k0##S = *(const bf16x8*)(p_ + (long)key0 * NPROJ + PC_RK); k1##S = *(const bf16x8*)(p_ + (long)key1 * NPROJ + PC_RK); \
        v0##S = *(const bf16x8*)(p_ + (long)key0 * NPROJ + PC_RV); v1##S = *(const bf16x8*)(p_ + (long)key1 * NPROJ + PC_RV); } while (0)
#define RWRITE(S, bb) do { *(bf16x8*)(KI + ((bb) * 2 + 0) * TB + st) = scale8(k0##S, z0); *(bf16x8*)(KI + ((bb) * 2 + 1) * TB + st) = scale8(k1##S, z1); \
        *(bf16x8*)(VI + ((bb) * 2 + 0) * TB + st) = v0##S; *(bf16x8*)(VI + ((bb) * 2 + 1) * TB + st) = v1##S; } while (0)
#define RCOMP(ck, bb) do { if (wid < 4) { \
            if ((ck) >= 2) { const int n = dir ? NCH - 1 - ((ck) - 2) : (ck) - 2; bf16_t* o = rstT + (size_t)n * 4096 + (size_t)(32 * nt + r32) * 64 + 32 * mt + 4 * hi; \
                _Pragma("unroll") for (int g = 0; g < 4; ++g) { u32x2 w; w.x = cvtpk(acc[4 * g], acc[4 * g + 1]); w.y = cvtpk(acc[4 * g + 2], acc[4 * g + 3]); *(u32x2*)(o + 8 * g) = w; } } \
            _Pragma("unroll") for (int r = 0; r < 16; ++r) acc[r] *= g128; \
            tt_mma(acc, vaK + ((bb) * 2 + 0) * TB, vbV + ((bb) * 2 + 0) * TB); \
            tt_mma(acc, vaK + ((bb) * 2 + 1) * TB, vbV + ((bb) * 2 + 1) * TB); } } while (0)
    constexpr int NCK = 2 + NCH;
#define RSTEP(ck, S) do { RCOMP(ck, (ck) & 1); if ((ck) + 1 < NCK) { RWRITE(S, ((ck) + 1) & 1); } if ((ck) + 5 < NCK) RLOAD(S, (ck) + 5); asm volatile("s_waitcnt lgkmcnt(0)\n\ts_barrier" ::: "memory"); } while (0)
    __syncthreads();
    RLOAD(a, 0); RWRITE(a, 0); RLOAD(b, 1); RLOAD(c, 2); RLOAD(d, 3); RLOAD(a, 4); __syncthreads();
    for (int ck = 0; ck < 32; ck += 4) { RSTEP(ck, b); RSTEP(ck + 1, c); RSTEP(ck + 2, d); RSTEP(ck + 3, a); }
    RSTEP(32, b); RSTEP(33, c);
#undef RSTEP
#undef RCOMP
#undef RROW
#undef RLOAD
#undef RWRITE
}

__device__ __forceinline__ int vc_st(int k, int c) { const int kk = (k & ~0xC) | ((k & 4) << 1) | ((k & 8) >> 1); return ((kk >> 3) * 2 + (c >> 5)) * 512 + ((kk & 7) * 32 + (c & 31)) * 2; }
constexpr int vc_rd_off(int ks, int half) { return ks * 2048 + half * 1024; }
constexpr int RBUF = 32768;
struct RetUnit { int b, h, n; };
template <class UF>
__device__ __forceinline__ void ret_group(const bf16_t* __restrict__ proj, const bf16_t* __restrict__ rst, const float* __restrict__ g_ret, const float* __restrict__ exp_f, const float* __restrict__ exp_b,
                                          bf16_t* __restrict__ mix, int nunits, UF unit_of, char* gl, int t4, int w4, int lane) {
    const int r32 = lane & 31, hi = lane >> 5, i = 32 * w4 + r32;
    bf16x8 qn[4];
    int soff[8];
#pragma unroll
    for (int q_ = 0; q_ < 8; ++q_) { const int s_ = ((4 * q_ + w4) * 64 + lane) & 1023;
        if (q_ < 4) { const int img = s_ >> 9, sub = (s_ & 511) >> 5, rw = (s_ & 31) >> 2, cc = s_ & 3; const int kk = (sub >> 1) * 8 + rw, key = (kk & ~0xC) | ((kk & 4) << 1) | ((kk & 8) >> 1);
            soff[q_] = (img * 64 + key) * NPROJ + PC_RV + (sub & 1) * 32 + cc * 8; }
        else { const int row = s_ >> 3, cp = s_ & 7, chn = cp ^ ((row >> 1) & 7); soff[q_] = row * NPROJ + PC_RK + chn * 8; } }
#define RG_LOAD(u, bb) do { const bf16_t* base_ = proj + ((long)(u).b * SEQ + (long)(u).n * 128) * NPROJ + (u).h * 64; \
        _Pragma("unroll") for (int q_ = 0; q_ < 8; ++q_) __builtin_amdgcn_global_load_lds((const unsigned*)(base_ + soff[q_]), (LAS unsigned*)((LAS char*)gl + (bb) * RBUF + (4 * q_ + w4) * 1024), 16, 0, 0); \
        const bf16_t* qp_ = base_ + (long)i * NPROJ + PC_RQ + hi * 8; \
        _Pragma("unroll") for (int ks_ = 0; ks_ < 4; ++ks_) qn[ks_] = *(const bf16x8*)(qp_ + ks_ * 16); } while (0)
    RetUnit u = unit_of(0);
    RG_LOAD(u, 0);
    bf16x8 q[4];
#pragma unroll
    for (int ks = 0; ks < 4; ++ks) q[ks] = qn[ks];
    asm volatile("s_waitcnt vmcnt(0)" ::: "memory"); __syncthreads();
    for (int ui = 0; ui < nunits; ++ui) {
        const int bb = ui & 1; const RetUnit un = unit_of(ui + 1 < nunits ? ui + 1 : ui);
        if (ui + 1 < nunits) RG_LOAD(un, bb ^ 1);
        const float lf = lg2_of(exp_f[u.h]), lb = lg2_of(exp_b[u.h]);
        int io = i, hio = hi; asm volatile("" : "+v"(io), "+v"(hio));
        const long row0 = (long)u.b * SEQ + (long)u.n * 128;
        const bf16_t* rf = rst + (size_t)(((u.b * NH + u.h) * 2 + 0) * NCH + u.n) * 4096 + (size_t)r32 * 64 + hi * 8;
        const bf16_t* rb = rst + (size_t)(((u.b * NH + u.h) * 2 + 1) * NCH + u.n) * 4096 + (size_t)r32 * 64 + hi * 8;
        bf16x8 rff[2][4], rbf[2][4];
#pragma unroll
        for (int et = 0; et < 2; ++et)
#pragma unroll
            for (int ks = 0; ks < 4; ++ks) { rff[et][ks] = *(const bf16x8*)(rf + et * 2048 + ks * 16); rbf[et][ks] = *(const bf16x8*)(rb + et * 2048 + ks * 16); }
        f32x16 acc[2] = {f32x16{}, f32x16{}};
        const char* kt = gl + bb * RBUF + 16384; const int vimg0 = (int)(uintptr_t)(gl + bb * RBUF) + v_rd_base(lane);
#pragma unroll
        for (int t = 0; t < 4; ++t) {
            f32x16 p = {};
            const int krow = 32 * t + r32;
#pragma unroll
            for (int ks = 0; ks < 4; ++ks) { const bf16x8 kf = *(const bf16x8*)(kt + krow * 128 + (((2 * ks + hi) ^ ((krow >> 1) & 7)) << 4)); p = __builtin_amdgcn_mfma_f32_32x32x16_bf16(kf, q[ks], p, 0, 0, 0); }
#pragma unroll
            for (int r = 0; r < 16; ++r) { const int j = 32 * t + (r & 3) + 8 * (r >> 2) + 4 * hio; const int dd = io - j; p[r] *= __builtin_amdgcn_exp2f(dd >= 0 ? lf * (float)dd : lb * (float)(-dd)); }
            bf16x8 pa0, pa1;
#define PK4(P, BASE, OUT) do { unsigned a0 = cvtpk(P[BASE + 0], P[BASE + 1]), a1 = cvtpk(P[BASE + 2], P[BASE + 3]);   \
    unsigned b0 = cvtpk(P[BASE + 4], P[BASE + 5]), b1 = cvtpk(P[BASE + 6], P[BASE + 7]);                              \
    auto r0 = __builtin_amdgcn_permlane32_swap(a0, b0, false, false); auto r1 = __builtin_amdgcn_permlane32_swap(a1, b1, false, false); \
    u32x4 w = {r0[0], r1[0], r0[1], r1[1]}; OUT = *reinterpret_cast<bf16x8*>(&w); } while (0)
            PK4(p, 0, pa0); PK4(p, 8, pa1);
#undef PK4
            const int vimg = vimg0 + (t >> 1) * 8192;
#pragma unroll
            for (int et = 0; et < 2; ++et) {
                s16x4 l0, h0, l1, h1;
                if ((t & 1) == 0) { l0 = tr_read<vc_rd_off(0, 0)>(vimg + et * 512); h0 = tr_read<vc_rd_off(0, 1)>(vimg + et * 512); l1 = tr_read<vc_rd_off(1, 0)>(vimg + et * 512); h1 = tr_read<vc_rd_off(1, 1)>(vimg + et * 512); }
                else { l0 = tr_read<vc_rd_off(2, 0)>(vimg + et * 512); h0 = tr_read<vc_rd_off(2, 1)>(vimg + et * 512); l1 = tr_read<vc_rd_off(3, 0)>(vimg + et * 512); h1 = tr_read<vc_rd_off(3, 1)>(vimg + et * 512); }
                asm volatile("s_waitcnt lgkmcnt(0)" ::: "memory"); __builtin_amdgcn_sched_barrier(0);
                acc[et] = __builtin_amdgcn_mfma_f32_32x32x16_bf16(RET_PK(l0, h0), pa0, acc[et], 0, 0, 0);
                acc[et] = __builtin_amdgcn_mfma_f32_32x32x16_bf16(RET_PK(l1, h1), pa1, acc[et], 0, 0, 0);
            }
            asm volatile("" ::: "memory");
        }
        const float xf = __builtin_amdgcn_exp2f(lf * (float)(i + 1)), xb = __builtin_amdgcn_exp2f(lb * (float)(128 - i));
        const bf16_t* gp = proj + (row0 + i) * NPROJ + PC_RG + u.h * 64; bf16_t* op = mix + (row0 + i) * D + 512 + u.h * 64; const float* gr = g_ret + u.h * 64;
        u32x2 gwv[2][4];
#pragma unroll
        for (int et = 0; et < 2; ++et)
#pragma unroll
            for (int g = 0; g < 4; ++g) gwv[et][g] = *(const u32x2*)(gp + 32 * et + 8 * g + 4 * hi);
        bf16x8 qf[4], qbk[4];
#pragma unroll
        for (int ks = 0; ks < 4; ++ks) { qf[ks] = scale8(q[ks], xf); qbk[ks] = scale8(q[ks], xb); }
#pragma unroll
        for (int et = 0; et < 2; ++et) {
#pragma unroll
            for (int ks = 0; ks < 4; ++ks) acc[et] = __builtin_amdgcn_mfma_f32_32x32x16_bf16(rff[et][ks], qf[ks], acc[et], 0, 0, 0);
#pragma unroll
            for (int ks = 0; ks < 4; ++ks) acc[et] = __builtin_amdgcn_mfma_f32_32x32x16_bf16(rbf[et][ks], qbk[ks], acc[et], 0, 0, 0); }
        float s1 = 0.f;
#pragma unroll
        for (int et = 0; et < 2; ++et)
#pragma unroll
            for (int r = 0; r < 16; ++r) s1 += acc[et][r];
        { auto rr = __builtin_amdgcn_permlane32_swap(__float_as_uint(s1), __float_as_uint(s1), false, false); s1 = __uint_as_float(rr[0]) + __uint_as_float(rr[1]); }
        const float mu = s1 * (1.f / 64.f); float s2 = 0.f;
#pragma unroll
        for (int et = 0; et < 2; ++et)
#pragma unroll
            for (int r = 0; r < 16; ++r) { const float dlt = acc[et][r] - mu; s2 += dlt * dlt; }
        { auto rr = __builtin_amdgcn_permlane32_swap(__float_as_uint(s2), __float_as_uint(s2), false, false); s2 = __uint_as_float(rr[0]) + __uint_as_float(rr[1]); }
        const float rs = 1.f / sqrtf(s2 * (1.f / 64.f) + EPS);
#pragma unroll
        for (int et = 0; et < 2; ++et)
#pragma unroll
            for (int g = 0; g < 4; ++g) { const int e = 32 * et + 8 * g + 4 * hi; const u32x2 gw = gwv[et][g]; const f32x4 gg = *(const f32x4*)(gr + e);
                const float o0 = (acc[et][4 * g] - mu) * rs * gg.x * __uint_as_float(gw.x << 16), o1 = (acc[et][4 * g + 1] - mu) * rs * gg.y * __uint_as_float(gw.x & 0xffff0000u);
                const float o2 = (acc[et][4 * g + 2] - mu) * rs * gg.z * __uint_as_float(gw.y << 16), o3 = (acc[et][4 * g + 3] - mu) * rs * gg.w * __uint_as_float(gw.y & 0xffff0000u);
                u32x2 w; w.x = cvtpk(o0, o1); w.y = cvtpk(o2, o3); *(u32x2*)(op + e) = w; }
        if (ui + 1 < nunits) {
#pragma unroll
            for (int ks = 0; ks < 4; ++ks) q[ks] = qn[ks]; }
        u = un;
        asm volatile("s_waitcnt vmcnt(0)" ::: "memory"); __syncthreads();
    }
#undef RG_LOAD
}
#undef RET_PK
}

__device__ __forceinline__ void p4_attn(const Ctx& c, float* lds) {
    const int G = (int)gridDim.x, bx = (int)blockIdx.x; const int vcu = (G % 8 == 0) ? (bx % 8) * (G / 8) + bx / 8 : bx;
    for (int unit = vcu; unit < NB * NH * 16; unit += G) {
        const int qblk = unit & 15, h = (unit >> 4) & 7, b = unit >> 7;
        att::attn_unit(c.qb() + (size_t)(b * SEQ + qblk * 256) * QW + h * 96, c.kvb() + h * 128, c.proj() + PC_KR, c.kvb() + h * 128 + 64,
                       c.mix() + (size_t)(b * SEQ + qblk * 256) * D + h * 64, b, (char*)lds, c.tid);
    }
}
__device__ __forceinline__ void p3c_scan(const Ctx& c, float* lds) {
    const int bx = (int)blockIdx.x;
    for (int seq = bx >> 1; seq < NB * NH * 2 && (bx & 1) == 0; seq += (int)gridDim.x >> 1) {
        const int dir = seq & 1, h = (seq >> 1) & 7, b = seq >> 4;
        const float lg2 = lg2_of(dir ? c.exp_b()[h] : c.exp_f()[h]);
        ret::scan_seq(c.proj(), c.rst() + (size_t)((b * NH + h) * 2 + dir) * NCH * 4096, b, h, dir, lg2, (char*)lds, c.tid);
    }
    __syncthreads();
    {
      unsigned* qctr = (unsigned*)(c.wsb() + WS_CTL) + 2048; int* qslot = (int*)(lds + 8 * 64 * 65 + 640);
      const int first = (int)gridDim.x == 256 ? QSTATIC : 0;
      int nq = 0; if (c.tid == 0) nq = first + (int)__hip_atomic_fetch_add(qctr, 1u, __ATOMIC_RELAXED, __HIP_MEMORY_SCOPE_AGENT);
      for (;;) { if (c.tid == 0) *qslot = nq;
          __syncthreads(); const int q = *qslot; __syncthreads();
          if (q >= EXP_STRIPS) break;
          if (c.tid == 0) nq = first + (int)__hip_atomic_fetch_add(qctr, 1u, __ATOMIC_RELAXED, __HIP_MEMORY_SCOPE_AGENT);
          expert_strip(c, lds, q); } }
    __syncthreads();
}
__device__ __forceinline__ void p4_ret(const Ctx& c, float* lds) {
    const int tid = c.tid, wid = tid >> 6, lane = tid & 63, grp = wid >> 2, w4 = wid & 3;
    const int G = (int)gridDim.x, bx = (int)blockIdx.x; const int vcu = (G % 8 == 0) ? (bx % 8) * (G / 8) + bx / 8 : bx;
    const int gid = vcu * 2 + grp, ngrp = 2 * G; const int total = NB * NH * NCH;
    const int nun = (total - gid + ngrp - 1) / ngrp;
    __syncthreads();
    ret::ret_group(c.proj(), c.rst(), c.g_ret(), c.exp_f(), c.exp_b(), c.mix(), nun,
                   [gid, ngrp](int k) { const int unit = gid + ngrp * k; return ret::RetUnit{unit >> 8, (unit >> 5) & 7, unit & 31}; }, (char*)lds + grp * 2 * ret::RBUF, tid & 255, w4, lane);
}

struct EpiRes {
    static constexpr bool PERM = true;
    const float* x; bf16_t* out; const float* modv; float* part;
    __device__ __forceinline__ void operator()(const f32x4 (&acc)[2][2][4][2], const pg8::Unit& u, int wr, int wc, int fr, int fq) const {
        const int row0 = u.pm * 256 + wr * 64 + fr, col0 = u.pn * 256 + wc * 32 + 8 * fq; const int b = (u.pm * 256) / SEQ;
        f32x4 ga[2][2];
#pragma unroll
        for (int bj = 0; bj < 2; ++bj) { ga[bj][0] = *(const f32x4*)(modv + b * 6144 + 2048 + col0 + bj * 128); ga[bj][1] = *(const f32x4*)(modv + b * 6144 + 2048 + col0 + bj * 128 + 4); }
#pragma unroll
        for (int ai = 0; ai < 2; ++ai) {
            f32x4 xv[4][2][2];
#pragma unroll
            for (int m = 0; m < 4; ++m)
#pragma unroll
                for (int bj = 0; bj < 2; ++bj) { const float* xr = x + (size_t)(row0 + ai * 128 + m * 16) * D + col0 + bj * 128; xv[m][bj][0] = __builtin_nontemporal_load((const f32x4*)xr); xv[m][bj][1] = __builtin_nontemporal_load((const f32x4*)(xr + 4)); }
#pragma unroll
            for (int m = 0; m < 4; ++m) { float ssq = 0.f, mx = 0.f;
#pragma unroll
                for (int bj = 0; bj < 2; ++bj) { const f32x4 y0 = xv[m][bj][0] + ga[bj][0] * acc[ai][bj][m][0], y1 = xv[m][bj][1] + ga[bj][1] * acc[ai][bj][m][1];
                    const float o[8] = {y0.x, y0.y, y0.z, y0.w, y1.x, y1.y, y1.z, y1.w}; store8_bf16(out + (size_t)(row0 + ai * 128 + m * 16) * D + col0 + bj * 128, o);
                    const f32x4 tm = __builtin_elementwise_max(__builtin_elementwise_abs(y0), __builtin_elementwise_abs(y1)), sq = y0 * y0 + y1 * y1;
                    ssq += (sq.x + sq.y) + (sq.z + sq.w); mx = fmaxf(mx, fmaxf(fmaxf(tm.x, tm.y), fmaxf(tm.z, tm.w))); }
                ssq += __shfl_xor(ssq, 16); ssq += __shfl_xor(ssq, 32); mx = fmaxf(mx, __shfl_xor(mx, 16)); mx = fmaxf(mx, __shfl_xor(mx, 32));
                if (fq == 0) { float* pp = part + (size_t)(row0 + ai * 128 + m * 16) * 32 + u.pn * 4 + wc; pp[0] = ssq; pp[16] = mx; } }
            asm volatile("" ::: "memory");
        }
    }
};
__device__ __forceinline__ void p6_wo(const Ctx& c, float* lds) {
    pg8::Gemm g{c.mix(), c.wo_t(), D, D, D, nullptr, 0, 0, 0};
    pg8::StaticOrder S; S.init(RL, D, (int)gridDim.x, (int)blockIdx.x);
    EpiRes E{c.x(), c.x1b(), c.modv(), c.rpart()};
    pg8::gemm_phase((LAS unsigned char*)lds, g, S, E, c.tid);
}
__device__ __forceinline__ void p7_norm_router(const Ctx& c, float* lds) {
    typedef short bf16x8_t __attribute__((ext_vector_type(8)));
    constexpr int WP = 1032;
    bf16_t* whi = (bf16_t*)lds; bf16_t* wlo = whi + 16 * WP; float* gsl = (float*)(wlo + 16 * WP); float* shl = gsl + 1024; float* gpl = shl + 1024;
    const int G = (int)gridDim.x, bx = (int)blockIdx.x;
    bool first = true;
    for (int blk = bx; blk < RL / 128; blk += G) {
        const int b = (blk * 128) / SEQ; const float* md = c.modv() + b * 6144;
        const int fr = c.lane & 15, fq = c.lane >> 4; const int row = blk * 128 + c.wave * 16 + fr;
        const bf16_t* xr2 = c.x1b() + (size_t)row * D + 16 * fq;
        float wv[32];
        if (first) {
#pragma unroll
            for (int it = 0; it < 32; ++it) wv[it] = c.w_router()[c.tid + 512 * it]; }
        u32x4 xw[32];
#pragma unroll
        for (int i = 0; i < 16; ++i) xw[i] = *(const u32x4*)(xr2 + 64 * (i >> 1) + 8 * (i & 1));
        asm volatile("s_waitcnt lgkmcnt(0)\n\ts_barrier" ::: "memory");
        for (int k = c.tid; k < 1024; k += 512) { gsl[k] = c.g_ffn()[k] * (1.f + md[4096 + k]); shl[k] = md[3072 + k]; }
        if (first) { int tl = c.tid; asm volatile("" : "+v"(tl));
#pragma unroll
            for (int it = 0; it < 32; ++it) { const int i = tl + 512 * it, k = i >> 4, e = i & 15; const float w = wv[it]; const bf16_t h = f2bf(w); whi[e * WP + k] = h; wlo[e * WP + k] = f2bf(w - bf2f(h)); }
            first = false; }
#pragma unroll
        for (int i = 16; i < 32; ++i) xw[i] = *(const u32x4*)(xr2 + 64 * (i >> 1) + 8 * (i & 1));
        asm volatile("s_waitcnt lgkmcnt(0)\n\ts_barrier" ::: "memory");
        if (c.tid < 16) { float gm = 0.f; const int c0_ = (c.tid >> 2) * 256 + (c.tid & 3) * 32;
            for (int k = 0; k < 32; ++k) gm = fmaxf(gm, fmaxf(fabsf(gsl[c0_ + k]), fabsf(gsl[c0_ + 128 + k])));
            gpl[c.tid] = gm; }
        asm volatile("s_waitcnt lgkmcnt(0)\n\ts_barrier" ::: "memory");
        const LAS float* gs_l = (const LAS float*)gsl; const LAS float* sh_l = (const LAS float*)shl;
        float shm = 0.f;
#pragma unroll
        for (int i = 0; i < 4; ++i) { const f32x4 s4 = *(const LAS f32x4*)(sh_l + 4 * c.lane + 256 * i); shm = fmaxf(fmaxf(shm, fmaxf(fabsf(s4.x), fabsf(s4.y))), fmaxf(fabsf(s4.z), fabsf(s4.w))); }
#pragma unroll
        for (int o = 1; o < 64; o <<= 1) shm = fmaxf(shm, __shfl_xor(shm, o));
        const f32x4 ps = *(const f32x4*)(c.rpart() + (size_t)row * 32 + 4 * fq), pm4 = *(const f32x4*)(c.rpart() + (size_t)row * 32 + 16 + 4 * fq);
        float ss = (ps.x + ps.y) + (ps.z + ps.w), mx; { const f32x4 gq = *(const LAS f32x4*)((const LAS float*)gpl + 4 * fq); mx = fmaxf(fmaxf(pm4.x * gq.x, pm4.y * gq.y), fmaxf(pm4.z * gq.z, pm4.w * gq.w)) * 1.00390625f; }
        ss += __shfl_xor(ss, 16); ss += __shfl_xor(ss, 32); mx = fmaxf(mx, __shfl_xor(mx, 16)); mx = fmaxf(mx, __shfl_xor(mx, 32));
        const float rinv = 1.f / sqrtf(ss * (1.f / D) + EPS);
        const float bnd = fmaxf(rinv * mx + shm, 1e-30f), qs = 127.f / bnd;
        if (fq == 0) c.sa()[row] = bnd * (1.f / 127.f);
        f32x4 acc = {0.f, 0.f, 0.f, 0.f};
        const LAS bf16_t* wh_l = (const LAS bf16_t*)whi + fr * WP + 16 * fq; const LAS bf16_t* wl_l = (const LAS bf16_t*)wlo + fr * WP + 16 * fq;
        signed char* hq = c.h2q() + (size_t)row * D + 16 * fq;
#pragma unroll
        for (int ks2 = 0; ks2 < 16; ++ks2) { u32x4 qo;
#pragma unroll
            for (int hf = 0; hf < 2; ++hf) { const int ko = 64 * ks2 + 8 * hf; const u32x4 w = xw[2 * ks2 + hf];
                const f32x4 g0 = *(const LAS f32x4*)(gs_l + 16 * fq + ko), g1 = *(const LAS f32x4*)(gs_l + 16 * fq + ko + 4), s0 = *(const LAS f32x4*)(sh_l + 16 * fq + ko), s1 = *(const LAS f32x4*)(sh_l + 16 * fq + ko + 4);
                float h[8];
                h[0] = __uint_as_float(w.x << 16) * rinv * g0.x + s0.x; h[1] = __uint_as_float(w.x & 0xffff0000u) * rinv * g0.y + s0.y; h[2] = __uint_as_float(w.y << 16) * rinv * g0.z + s0.z; h[3] = __uint_as_float(w.y & 0xffff0000u) * rinv * g0.w + s0.w;
                h[4] = __uint_as_float(w.z << 16) * rinv * g1.x + s1.x; h[5] = __uint_as_float(w.z & 0xffff0000u) * rinv * g1.y + s1.y; h[6] = __uint_as_float(w.w << 16) * rinv * g1.z + s1.z; h[7] = __uint_as_float(w.w & 0xffff0000u) * rinv * g1.w + s1.w;
                const unsigned qa = q8pack(h[0], h[1], h[2], h[3], qs), qb = q8pack(h[4], h[5], h[6], h[7], qs);
                if (hf == 0) { qo.x = qa; qo.y = qb; } else { qo.z = qa; qo.w = qb; }
                u32x4 hi; hi.x = pk2(h[0], h[1]); hi.y = pk2(h[2], h[3]); hi.z = pk2(h[4], h[5]); hi.w = pk2(h[6], h[7]);
                u32x4 lo; lo.x = pk2(h[0] - __uint_as_float(hi.x << 16), h[1] - __uint_as_float(hi.x & 0xffff0000u)); lo.y = pk2(h[2] - __uint_as_float(hi.y << 16), h[3] - __uint_as_float(hi.y & 0xffff0000u));
                lo.z = pk2(h[4] - __uint_as_float(hi.z << 16), h[5] - __uint_as_float(hi.z & 0xffff0000u)); lo.w = pk2(h[6] - __uint_as_float(hi.w << 16), h[7] - __uint_as_float(hi.w & 0xffff0000u));
                const bf16x8_t bh = *(const LAS bf16x8_t*)(wh_l + ko), bl = *(const LAS bf16x8_t*)(wl_l + ko);
                const bf16x8_t ah = __builtin_bit_cast(bf16x8_t, hi), al = __builtin_bit_cast(bf16x8_t, lo);
                acc = __builtin_amdgcn_mfma_f32_16x16x32_bf16(ah, bh, acc, 0, 0, 0);
                acc = __builtin_amdgcn_mfma_f32_16x16x32_bf16(al, bh, acc, 0, 0, 0);
                acc = __builtin_amdgcn_mfma_f32_16x16x32_bf16(ah, bl, acc, 0, 0, 0); }
            *(u32x4*)(hq + 64 * ks2) = qo;
            asm volatile("" ::: "memory"); }
        float ov[4];
#pragma unroll
        for (int i = 0; i < 4; ++i) { float mx = acc[i];
            mx = fmaxf(mx, __shfl_xor(mx, 1)); mx = fmaxf(mx, __shfl_xor(mx, 2)); mx = fmaxf(mx, __shfl_xor(mx, 4)); mx = fmaxf(mx, __shfl_xor(mx, 8));
            const float ex = __expf(acc[i] - mx); float den = ex;
            den += __shfl_xor(den, 1); den += __shfl_xor(den, 2); den += __shfl_xor(den, 4); den += __shfl_xor(den, 8);
            ov[i] = ex / den; }
        const int t0 = (blk * 128 + c.wave * 16 + 4 * fq) & (SEQ - 1);
        *(f32x4*)(c.aff() + (size_t)(b * NE + fr) * SEQ + t0) = (f32x4){ov[0], ov[1], ov[2], ov[3]};
    }
}
__device__ __forceinline__ int block_excl_scan(int v, int& tot, int* lw, int tid) {
    const int lane = tid & 63, wv = tid >> 6; int inc = v;
#pragma unroll
    for (int o = 1; o < 64; o <<= 1) { const int u = __shfl_up(inc, o); if (lane >= o) inc += u; }
    __syncthreads();
    if (lane == 63) lw[wv] = inc;
    __syncthreads();
    int base = 0; tot = 0;
#pragma unroll
    for (int w = 0; w < 8; ++w) { const int x = lw[w]; if (w < wv) base += x; tot += x; }
    return base + inc - v;
}
__device__ __forceinline__ void p8_topk(const Ctx& c, float* lds) {
    int* cnt = (int*)lds;
    int* lw = (int*)lds + 64;
    for (int unit = blockIdx.x; unit < NB * NE; unit += gridDim.x) {
        const int b = unit >> 4, e = unit & 15; const float* a = c.aff() + (size_t)unit * SEQ;
        const f32x4 v0 = *(const f32x4*)(a + 8 * c.tid), v1 = *(const f32x4*)(a + 8 * c.tid + 4);
        unsigned u[8] = {__float_as_uint(v0.x), __float_as_uint(v0.y), __float_as_uint(v0.z), __float_as_uint(v0.w), __float_as_uint(v1.x), __float_as_uint(v1.y), __float_as_uint(v1.z), __float_as_uint(v1.w)};
        __syncthreads();
        if (c.tid < 32) cnt[c.tid] = 0;
        __syncthreads();
        unsigned T = 0u;
        for (int bit = 30; bit >= 0; --bit) {
            const unsigned cand = T | (1u << bit); int cw = 0;
#pragma unroll
            for (int j = 0; j < 8; ++j) cw += __popcll(__ballot(u[j] >= cand));
            if (c.lane == 0) atomicAdd(&cnt[bit], cw);
            __syncthreads();
            if (cnt[bit] >= CAP) T = cand;
        }
        int ngt = 0, neq = 0;
#pragma unroll
        for (int j = 0; j < 8; ++j) { ngt += u[j] > T ? 1 : 0; neq += u[j] == T ? 1 : 0; }
        int tot_gt, tot_eq; const int eq_base = block_excl_scan(neq, tot_eq, lw, c.tid); (void)block_excl_scan(ngt, tot_gt, lw + 16, c.tid);
        const int need = CAP - tot_gt;
        bool sel[8]; int nsel = 0, eqc = eq_base;
#pragma unroll
        for (int j = 0; j < 8; ++j) { const bool isq = u[j] == T; sel[j] = u[j] > T || (isq && eqc < need); eqc += isq ? 1 : 0; nsel += sel[j] ? 1 : 0; }
        int tot_sel; int slot = block_excl_scan(nsel, tot_sel, lw + 32, c.tid);
        int iv[8];
#pragma unroll
        for (int j = 0; j < 8; ++j) { iv[j] = sel[j] ? slot : -1;
            if (sel[j]) { c.seli()[unit * CAP + slot] = b * SEQ + 8 * c.tid + j; c.selg()[unit * CAP + slot] = __uint_as_float(u[j]); c.sels()[unit * CAP + slot] = c.sa()[b * SEQ + 8 * c.tid + j]; ++slot; } }
#pragma unroll
        for (int j = 0; j < 8; ++j) c.inv()[(size_t)(b * SEQ + 8 * c.tid + j) * NE + e] = iv[j];
    }
    __syncthreads();
}
struct EpiGateUpQ {
    static constexpr bool PERM = true;
    unsigned char* act; const float* sels; const float* sw;
    __device__ __forceinline__ void operator()(const f32x4 (&acc)[2][2][4][2], const pg8::Unit& u, int wr, int wc, int fr, int fq) const {
        const int row0 = u.pm * 256 + wr * 64 + fr, col0 = u.pn * 256 + wc * 32 + 8 * fq; const float* swe = sw + ((u.pm >> 1) & 15) * 1536 + col0;
        float rs[8];
#pragma unroll
        for (int i = 0; i < 8; ++i) rs[i] = sels[row0 + (i >> 2) * 128 + (i & 3) * 16];
        const f32x4 sg0 = *(const f32x4*)swe, su0 = *(const f32x4*)(swe + 4), sg1 = *(const f32x4*)(swe + 128), su1 = *(const f32x4*)(swe + 132);
#pragma unroll
        for (int ai = 0; ai < 2; ++ai)
#pragma unroll
            for (int m = 0; m < 4; ++m) { const float r_ = rs[ai * 4 + m];
#pragma unroll
                for (int bj = 0; bj < 2; ++bj) { const f32x4 gt = acc[ai][bj][m][0] * (bj ? sg1 : sg0) * r_, up = acc[ai][bj][m][1] * (bj ? su1 : su0) * r_;
                    *(unsigned*)(act + (size_t)(row0 + ai * 128 + m * 16) * DE + ((col0 + bj * 128) >> 1)) = f8pack(silu_f(gt[0]) * up[0], silu_f(gt[1]) * up[1], silu_f(gt[2]) * up[2], silu_f(gt[3]) * up[3]); } }
    }
};
__device__ __forceinline__ void p9_gateup(const Ctx& c, float* lds) {
    pg8::Gemm g{(const bf16_t*)c.h2q(), (const bf16_t*)c.wgu_q(), D / 2, D / 2, D / 2, c.seli(), 1, 15, (size_t)1536 * 512};
    pg8::ExpertOrder S; S.init(NSLOT, 1536, (int)gridDim.x, (int)blockIdx.x);
    EpiGateUpQ E{(unsigned char*)c.actq(), c.sels(), c.swgu()};
    pg8::gemm_phase<1, true>((LAS unsigned char*)lds, g, S, E, c.tid);
}
struct EpiDownQ {
    static constexpr bool PERM = true;
    unsigned char* y8; float* ysc; const float* rsc; const float* sw;
    __device__ __forceinline__ void operator()(const f32x4 (&acc)[2][2][4][2], const pg8::Unit& u, int wr, int wc, int fr, int fq) const {
        const int row0 = u.pm * 256 + wr * 64 + fr, col0 = u.pn * 256 + wc * 32 + 8 * fq; const float* swe = sw + ((u.pm >> 1) & 15) * 1024 + col0;
        float gg[8];
#pragma unroll
        for (int i = 0; i < 8; ++i) gg[i] = rsc[row0 + (i >> 2) * 128 + (i & 3) * 16];
        const f32x4 s00 = *(const f32x4*)swe, s01 = *(const f32x4*)(swe + 4), s10 = *(const f32x4*)(swe + 128), s11 = *(const f32x4*)(swe + 132);
#pragma unroll
        for (int ai = 0; ai < 2; ++ai)
#pragma unroll
            for (int m = 0; m < 4; ++m) { const float g_ = gg[ai * 4 + m]; const int row = row0 + ai * 128 + m * 16;
                const f32x4 a0 = acc[ai][0][m][0] * s00 * g_, b0 = acc[ai][0][m][1] * s01 * g_, a1 = acc[ai][1][m][0] * s10 * g_, b1 = acc[ai][1][m][1] * s11 * g_;
                const f32x4 m4 = __builtin_elementwise_max(__builtin_elementwise_max(__builtin_elementwise_abs(a0), __builtin_elementwise_abs(b0)), __builtin_elementwise_max(__builtin_elementwise_abs(a1), __builtin_elementwise_abs(b1)));
                float mx = fmaxf(fmaxf(m4.x, m4.y), fmaxf(m4.z, m4.w)); mx = fmaxf(mx, __shfl_xor(mx, 16)); mx = fmaxf(mx, __shfl_xor(mx, 32));
                const float inv = mx > 0.f ? 448.f / mx : 0.f;
                u32x2 w0, w1; w0.x = f8pack(a0.x * inv, a0.y * inv, a0.z * inv, a0.w * inv); w0.y = f8pack(b0.x * inv, b0.y * inv, b0.z * inv, b0.w * inv);
                w1.x = f8pack(a1.x * inv, a1.y * inv, a1.z * inv, a1.w * inv); w1.y = f8pack(b1.x * inv, b1.y * inv, b1.z * inv, b1.w * inv);
                *(u32x2*)(y8 + (size_t)row * D + col0) = w0; *(u32x2*)(y8 + (size_t)row * D + col0 + 128) = w1;
                if (fq == 0) ysc[(size_t)row * 16 + u.pn * 4 + wc] = mx * (1.f / 448.f); }
    }
};
__device__ __forceinline__ void p10_down(const Ctx& c, float* lds) {
    pg8::Gemm g{(const bf16_t*)c.actq(), (const bf16_t*)c.wdn_q(), DE / 2, DE / 2, DE / 2, nullptr, 1, 15, (size_t)1024 * 384};
    pg8::ExpertOrder S; S.init(NSLOT, D, (int)gridDim.x, (int)blockIdx.x);
    EpiDownQ E{c.y8(), c.ysc(), c.selg(), c.swdn()};
    pg8::gemm_phase<2>((LAS unsigned char*)lds, g, S, E, c.tid);
}
__device__ __forceinline__ void p11_final(const Ctx& c) {
    for (int r0 = c.gw * 2; r0 < RL; r0 += c.ngw * 2) {
        const int b = r0 / SEQ;
        int sl[2]; f32x4 x1[2][4]; f32x4 acc[2][4];
#pragma unroll
        for (int q = 0; q < 2; ++q) { sl[q] = c.lane < NE ? c.inv()[(size_t)(r0 + q) * NE + c.lane] : -1;
#pragma unroll
            for (int j = 0; j < 4; ++j) { const u32x2 w = __builtin_nontemporal_load((const u32x2*)(c.x1b() + (size_t)(r0 + q) * D + 4 * c.lane + 256 * j));
                x1[q][j] = (f32x4){__uint_as_float(w.x << 16), __uint_as_float(w.x & 0xffff0000u), __uint_as_float(w.y << 16), __uint_as_float(w.y & 0xffff0000u)}; acc[q][j] = (f32x4){0.f, 0.f, 0.f, 0.f}; } }
#pragma unroll
        for (int q = 0; q < 2; ++q) {
            unsigned long long m = __ballot(sl[q] >= 0);
            while (m) { const int e = __builtin_ctzll(m); m &= m - 1; const int slot = __builtin_amdgcn_readlane(sl[q], e);
                const size_t yrow = (size_t)((b * NE + e) * CAP + slot); const unsigned char* yr = c.y8() + yrow * D; const float* ys = c.ysc() + yrow * 16 + ((c.lane & 31) >> 3);
                unsigned w[4]; float sc[4];
#pragma unroll
                for (int j = 0; j < 4; ++j) { w[j] = __builtin_nontemporal_load((const unsigned*)(yr + 4 * c.lane + 256 * j)); sc[j] = ys[4 * j]; }
#pragma unroll
                for (int j = 0; j < 4; ++j) { const auto lo = __builtin_amdgcn_cvt_pk_f32_fp8((int)w[j], false), hi = __builtin_amdgcn_cvt_pk_f32_fp8((int)w[j], true);
                    acc[q][j].x += lo[0] * sc[j]; acc[q][j].y += lo[1] * sc[j]; acc[q][j].z += hi[0] * sc[j]; acc[q][j].w += hi[1] * sc[j]; } } }
        const float* md = c.modv() + b * 6144 + 5120; float ss[2] = {0.f, 0.f};
#pragma unroll
        for (int j = 0; j < 4; ++j) { const int k = 4 * c.lane + 256 * j; const f32x4 ga = *(const f32x4*)(md + k);
#pragma unroll
            for (int q = 0; q < 2; ++q) { x1[q][j] = x1[q][j] + ga * acc[q][j]; ss[q] += x1[q][j].x * x1[q][j].x + x1[q][j].y * x1[q][j].y + x1[q][j].z * x1[q][j].z + x1[q][j].w * x1[q][j].w; } }
        const float ri0 = 1.f / sqrtf(wave_sum(ss[0]) * (1.f / D) + EPS), ri1 = 1.f / sqrtf(wave_sum(ss[1]) * (1.f / D) + EPS);
#pragma unroll
        for (int j = 0; j < 4; ++j) { const int k = 4 * c.lane + 256 * j; const f32x4 g = *(const f32x4*)(c.g_final() + k);
            __builtin_nontemporal_store(x1[0][j] * ri0 * g, (f32x4*)(c.out() + (size_t)r0 * D + k)); __builtin_nontemporal_store(x1[1][j] * ri1 * g, (f32x4*)(c.out() + (size_t)(r0 + 1) * D + k)); }
    }
}

#define XB_TMO      128
#define XB_XCNT(j)  (256  + 64 * (j))
#define XB_XSUB(j)  (1280 + 64 * (j))
#define XB_XGEN(j)  (2304 + 64 * (j))
#define XB_TOP      3328
#define XB_TOPGEN   3392
#define XCD_BAR_WORDS 3456
#define XB_SPIN_CAP (1u << 18)

__device__ __forceinline__ unsigned xb_ld(unsigned* p)              { return __hip_atomic_load(p, __ATOMIC_RELAXED, __HIP_MEMORY_SCOPE_AGENT); }
__device__ __forceinline__ unsigned xb_add(unsigned* p, unsigned v) { return __hip_atomic_fetch_add(p, v, __ATOMIC_RELAXED, __HIP_MEMORY_SCOPE_AGENT); }
__device__ __forceinline__ unsigned xb_xcc_id() { return (unsigned)__builtin_amdgcn_s_getreg((3 << 11) | 20) & 0xFu; }
#define XB_SPIN(cond, bar) do { unsigned _sp = 0; while (cond) { __builtin_amdgcn_s_sleep(1); \
    if ((++_sp & 255u) == 0u) { if (xb_ld(&(bar)[XB_TMO])) break; if (_sp > XB_SPIN_CAP) { atomicAdd(&(bar)[XB_TMO], 1u); break; } } } } while (0)

struct XcdBarrier {
    unsigned* bar; unsigned x;
    volatile LAS unsigned* st;
};
__device__ __forceinline__ XcdBarrier xcd_barrier_post(unsigned* bar, volatile LAS unsigned* st, bool t0) {
    XcdBarrier b; b.bar = bar; b.x = xb_xcc_id(); b.st = st;
    if (t0) (void)xb_add(&bar[XB_XCNT(b.x)], 1u);
    return b;
}
__device__ __forceinline__ void xcd_barrier_complete(unsigned* bar, unsigned x, unsigned& nloc, unsigned& nx) {
    const unsigned G = gridDim.x * gridDim.y * gridDim.z;
    unsigned sum, cnt, mine, sp = 0u;
    for (;;) {
        sum = 0u; cnt = 0u; mine = 0u;
#pragma unroll
        for (unsigned j = 0; j < 16; ++j) { const unsigned c = xb_ld(&bar[XB_XCNT(j)]); sum += c; cnt += (c > 0u) ? 1u : 0u; mine = (j == x) ? c : mine; }
        if (sum == G) break;
        __builtin_amdgcn_s_sleep(1);
        if ((++sp & 255u) == 0u) { if (xb_ld(&bar[XB_TMO])) break; if (sp > XB_SPIN_CAP) { atomicAdd(&bar[XB_TMO], 1u); break; } }
    }
    nloc = mine > 0u ? mine : 1u; nx = cnt > 0u ? cnt : 1u;
}
__device__ __forceinline__ void xcd_barrier(const XcdBarrier& b, bool t0) {
    asm volatile("s_waitcnt vmcnt(0)" ::: "memory");
    __syncthreads();
    if (t0) {
        unsigned* bar = b.bar;
        __builtin_amdgcn_s_waitcnt(0);
        unsigned nloc = b.st[0], nx = b.st[1];
        if (nloc == 0u) { xcd_barrier_complete(bar, b.x, nloc, nx); b.st[0] = nloc; b.st[1] = nx; }
        const unsigned old = xb_add(&bar[XB_XSUB(b.x)], 1u);
        const unsigned gen = old / nloc;
        if (old + 1u == (gen + 1u) * nloc) {
            __builtin_amdgcn_fence(__ATOMIC_RELEASE, "agent");
            asm volatile("s_waitcnt vmcnt(0)" ::: "memory");
            const unsigned og = xb_add(&bar[XB_TOP], 1u);
            const unsigned tg = og / nx;
            if (og + 1u == (tg + 1u) * nx) xb_add(&bar[XB_TOPGEN], 1u);
            else XB_SPIN(xb_ld(&bar[XB_TOPGEN]) == tg, bar);
            __builtin_amdgcn_fence(__ATOMIC_ACQUIRE, "agent");
            xb_add(&bar[XB_XGEN(b.x)], 1u);
            asm volatile("s_waitcnt vmcnt(0)" ::: "memory");
        } else {
            XB_SPIN(xb_ld(&bar[XB_XGEN(b.x)]) == gen, bar);
            __builtin_amdgcn_fence(__ATOMIC_ACQUIRE, "agent");
            asm volatile("s_waitcnt vmcnt(0)" ::: "memory");
        }
    }
    __syncthreads();
}

template <int PH0, int PH1> __global__ void __launch_bounds__(512, 2) fwd_kernel(Args args) {
    extern __shared__ __attribute__((aligned(16))) unsigned char lds_raw[];
    float* lds = (float*)lds_raw;
    volatile LAS unsigned* xbst = (volatile LAS unsigned*)((LAS unsigned char*)lds_raw + (LDS_BYTES - 16));
    const int wave_s = __builtin_amdgcn_readfirstlane((int)threadIdx.x >> 6);
#define TID_NOW() ([&]() { unsigned z_ = 0u; asm volatile("" : "+v"(z_)); return wave_s * 64 + (int)__builtin_amdgcn_mbcnt_hi(~0u, __builtin_amdgcn_mbcnt_lo(~0u, z_)); }())
    if (TID_NOW() == 0) { xbst[0] = 0u; xbst[1] = 0u; }
    __syncthreads();
    XcdBarrier bar; bar.bar = nullptr; bar.x = 0; bar.st = nullptr;
    if constexpr (PH1 - PH0 > 1) bar = xcd_barrier_post((unsigned*)(args.ws + WS_CTL) + 4096, xbst, TID_NOW() == 0);
#define GRID_BAR(k) do { if constexpr (PH1 - PH0 > 1) { if (lo <= (k) && (k) + 1 < hi) { xcd_barrier(bar, TID_NOW() == 0); if (BARREP) xcd_barrier(bar, TID_NOW() == 0); } } } while (0)
    const int lo = args.ph_lo, hi = args.ph_hi;
#ifndef PHMASK
#define PHMASK 0xffffffffu
#endif
#ifndef BARREP
#define BARREP 0
#endif
#ifndef REPMASK
#define REPMASK 0u
#endif
#define REP(k) ((REPMASK >> (k)) & 1u)
#define IN(k) (((PHMASK >> (k)) & 1u) && PH0 <= (k) && (k) < PH1 && lo <= (k) && (k) < hi)
#define CTX() Ctx c; { kptr_t kp_ = (kptr_t)__builtin_amdgcn_kernarg_segment_ptr(); asm volatile("" : "+s"(kp_)); c.kp = kp_; int t_ = TID_NOW(); asm volatile("" : "+v"(t_)); int b_ = blockIdx.x; asm volatile("" : "+s"(b_)); c.tid = t_; c.lane = t_ & 63; c.wave = t_ >> 6; c.gw = b_ * 8 + c.wave; c.ngw = gridDim.x * 8; }
    if (IN(0)) { CTX(); p0_mod(c, lds); __syncthreads(); p0_weights<0>(c, lds, c.gw, c.ngw); p0_tables(c); }
    if (REP(0) && IN(0)) { __syncthreads(); CTX(); p0_mod(c, lds); __syncthreads(); p0_weights<0>(c, lds, c.gw, c.ngw); p0_tables(c); }
    GRID_BAR(0);
    if (IN(1)) { CTX(); p1_norm(c); }
    if (REP(1) && IN(1)) { __syncthreads(); CTX(); p1_norm(c); }
    GRID_BAR(1);
    if (IN(2)) { CTX(); p2_proj(c, lds); }
    if (REP(2) && IN(2)) { __syncthreads(); CTX(); p2_proj(c, lds); }
    GRID_BAR(2);
    if (IN(3)) { CTX(); p3_upq(c, lds); }
    if (REP(3) && IN(3)) { __syncthreads(); CTX(); p3_upq(c, lds); }
    if (IN(4)) { CTX(); p3_upkv(c, lds); }
    if (REP(4) && IN(4)) { __syncthreads(); CTX(); p3_upkv(c, lds); }
    if (IN(5)) { CTX(); p3c_scan(c, lds); }
    if (REP(5) && IN(5)) { __syncthreads(); CTX(); p3c_scan(c, lds); }
    GRID_BAR(5);
    if (IN(6)) { CTX(); p4_attn(c, lds); }
    if (REP(6) && IN(6)) { __syncthreads(); CTX(); p4_attn(c, lds); }
    if (IN(7)) { CTX(); p4_ret(c, lds); }
    if (REP(7) && IN(7)) { __syncthreads(); CTX(); p4_ret(c, lds); }
    GRID_BAR(7);
    if (IN(8)) { CTX(); p6_wo(c, lds); }
    if (REP(8) && IN(8)) { __syncthreads(); CTX(); p6_wo(c, lds); }
    GRID_BAR(8);
    if (IN(9)) { CTX(); p7_norm_router(c, lds); }
    if (REP(9) && IN(9)) { __syncthreads(); CTX(); p7_norm_router(c, lds); }
    GRID_BAR(9);
    if (IN(10)) { CTX(); p8_topk(c, lds); }
    if (REP(10) && IN(10)) { __syncthreads(); CTX(); p8_topk(c, lds); }
    GRID_BAR(10);
    if (IN(11)) { CTX(); p9_gateup(c, lds); }
    if (REP(11) && IN(11)) { __syncthreads(); CTX(); p9_gateup(c, lds); }
    GRID_BAR(11);
    if (IN(12)) { CTX(); p10_down(c, lds); }
    if (REP(12) && IN(12)) { __syncthreads(); CTX(); p10_down(c, lds); }
    GRID_BAR(12);
    if (IN(13)) { CTX(); p11_final(c); }
    if (REP(13) && IN(13)) { __syncthreads(); CTX(); p11_final(c); }
#undef IN
}


static hipError_t set_lds_all() { return hipFuncSetAttribute((const void*)fwd_kernel<0, NPH>, hipFuncAttributeMaxDynamicSharedMemorySize, LDS_BYTES); }
static void launch_all(int grid, hipStream_t stream, const Args& a) { hipLaunchKernelGGL((fwd_kernel<0, NPH>), dim3(grid), dim3(512), LDS_BYTES, stream, a); }

extern "C" void kernel_launch(void* const* d_in, const int* in_sizes, int n_in, void* d_out, int out_size, void* d_ws, size_t ws_size, hipStream_t stream) {
    static int grid = 0;
    if (grid == 0) {
        if (n_in != 22 || in_sizes[0] != RL * D || out_size != RL * D || ws_size < WS_END) {
            fprintf(stderr, "kernel_launch: unexpected shapes: n_in %d in0 %d out %d ws %zu (need %zu)\n", n_in, n_in > 0 ? in_sizes[0] : -1, out_size, ws_size, (size_t)WS_END); grid = -1; return; }
        int dev = 0, cus = 0;
        if (hipGetDevice(&dev) != hipSuccess || hipDeviceGetAttribute(&cus, hipDeviceAttributeMultiprocessorCount, dev) != hipSuccess) { grid = -1; return; }
        if (set_lds_all() != hipSuccess) { fprintf(stderr, "kernel_launch: hipFuncSetAttribute failed\n"); grid = -1; return; }
        int per_cu = 0;
        if (MK_SINGLE) { if (hipOccupancyMaxActiveBlocksPerMultiprocessor(&per_cu, (const void*)fwd_kernel<0, NPH>, 512, LDS_BYTES) != hipSuccess || per_cu < 1) { fprintf(stderr, "kernel_launch: occupancy query says %d blocks per CU\n", per_cu); grid = -1; return; } }
        (void)hipGetLastError();
        grid = cus;
    }
    if (grid < 0) return;
    Args a{};
    for (int i = 0; i < 22; ++i) a.in[i] = (const float*)d_in[i];
    a.out = (float*)d_out; a.ws = (unsigned char*)d_ws;
    a.ph_lo = 0; a.ph_hi = NPH;
    if (MK_SINGLE) { if (hipMemsetAsync((char*)d_ws + WS_CTL, 0, CTL_BYTES, stream) != hipSuccess) { fprintf(stderr, "kernel_launch: memset failed\n"); return; } }
    launch_all(grid, stream, a);
}
```

```cpp
#include <hip/hip_runtime.h>
#include <cstdio>
#include <cstdint>

#ifndef MK_SINGLE
#define MK_SINGLE 1
#endif

typedef unsigned short bf16_t;
typedef float f32x4 __attribute__((ext_vector_type(4)));
typedef unsigned u32x4 __attribute__((ext_vector_type(4)));
typedef unsigned u32x2 __attribute__((ext_vector_type(2)));
#define LAS __attribute__((address_space(3)))

constexpr int D = 1024, NB = 8, SEQ = 4096, LC = 256;
constexpr int RL = NB * SEQ, RC = NB * LC, RT = RL + RC;
constexpr int NPROJ = 2560;
constexpr int PC_CQ = 0, PC_CKV = 256, PC_KR = 384, PC_RQ = 512, PC_RK = 1024, PC_RV = 1536, PC_RG = 2048;
constexpr int NH = 8, QW = 768, KVW = 1024;
constexpr int NE = 16, CAP = 512, DE = 768, NSLOT = NB * NE * CAP;
constexpr int NCH = 32;
constexpr float EPS = 1e-6f;
constexpr float QSCALE = 0.10206207261596577f * 1.4426950408889634f;

constexpr size_t MiB = 1u << 20;
constexpr size_t WS_CTL = 0, CTL_BYTES = 64 * 1024;
constexpr size_t WS_MOD = 1 * MiB;
constexpr size_t WS_TABR = 2 * MiB;
constexpr size_t WS_TABM = 3 * MiB;
constexpr size_t WS_PSTAT = 4 * MiB;
constexpr size_t WS_AFF = 6 * MiB;
constexpr size_t WS_SELI = 8 * MiB;
constexpr size_t WS_SELG = 8 * MiB + 512 * 1024;
constexpr size_t WS_INV = 9 * MiB;
constexpr size_t WS_SELS = 11 * MiB;
constexpr size_t WS_WIN = 12 * MiB;
constexpr size_t WS_WUQ = 17 * MiB;
constexpr size_t WS_WUKV = 17 * MiB + 512 * 1024;
constexpr size_t WS_WO = 18 * MiB;
constexpr size_t WS_WGU = 20 * MiB;
constexpr size_t WS_WDN = 68 * MiB;
constexpr size_t WS_H = 92 * MiB;
constexpr size_t WS_RST = 92 * MiB;
constexpr size_t WS_PROJ = 160 * MiB;
constexpr size_t WS_ACT = 160 * MiB;
constexpr size_t WS_YB = 256 * MiB;
constexpr size_t WS_Q = 330 * MiB;
constexpr size_t WS_KV = 378 * MiB;
constexpr size_t WS_MIX = 446 * MiB;
constexpr size_t WS_END = 510 * MiB;
static_assert(WS_PROJ + (size_t)RT * NPROJ * 2 <= WS_Q && WS_Q + (size_t)RL * QW * 2 <= WS_KV && WS_KV + (size_t)RT * KVW * 2 <= WS_MIX, "ws map");
static_assert(WS_H + (size_t)RT * D * 2 <= WS_PROJ && WS_WDN + (size_t)NE * D * DE * 2 <= WS_H && WS_PSTAT + (size_t)RT * 32 <= WS_AFF, "ws map 2");

constexpr int LDS_BYTES = 147456;
constexpr int NPH = 14;

__device__ __forceinline__ float bf2f(bf16_t v) { return __uint_as_float((unsigned)v << 16); }
__device__ __forceinline__ bf16_t f2bf(float f) { unsigned u = __float_as_uint(f); return (bf16_t)((u + 0x7fffu + ((u >> 16) & 1u)) >> 16); }
__device__ __forceinline__ unsigned pk2(float lo, float hi) { unsigned r; asm("v_cvt_pk_bf16_f32 %0, %1, %2" : "=v"(r) : "v"(lo), "v"(hi)); return r; }
__device__ __forceinline__ float wave_sum(float v) {
#pragma unroll
    for (int o = 1; o < 64; o <<= 1) v += __shfl_xor(v, o);
    return v;
}
__device__ __forceinline__ float silu_f(float v) { return v / (1.f + __expf(-v)); }

struct Args {
    const float* in[22]; float* out; unsigned char* ws; int ph_lo, ph_hi;
};

typedef __attribute__((address_space(4))) const char* kptr_t;
typedef const float* cfp_t; typedef float* fp_t; typedef unsigned char* ucp_t;
typedef __attribute__((address_space(4))) const cfp_t* kcfpp; typedef __attribute__((address_space(4))) const fp_t* kfpp; typedef __attribute__((address_space(4))) const ucp_t* kucpp;
static_assert(sizeof(Args) == 200, "Args layout: in[22] @0, out @176, ws @184, ph_lo @192, ph_hi @196");
struct Ctx {
    kptr_t kp; int tid, lane, wave, gw, ngw;
    __device__ __forceinline__ const float* in(int i) const { return *(kcfpp)(kp + 8 * i); }
    __device__ __forceinline__ unsigned char* wsb() const { return *(kucpp)(kp + 184); }
    __device__ __forceinline__ const float* x() const { return in(0); }
    __device__ __forceinline__ const float* cvec() const { return in(1); }
    __device__ __forceinline__ const float* ctx() const { return in(2); }
    __device__ __forceinline__ const float* c_ctx() const { return in(3); }
    __device__ __forceinline__ const float* w_ada() const { return in(4); }
    __device__ __forceinline__ const float* b_ada() const { return in(5); }
    __device__ __forceinline__ const float* g_mix() const { return in(6); }
    __device__ __forceinline__ const float* g_ffn() const { return in(7); }
    __device__ __forceinline__ const float* w_in() const { return in(8); }
    __device__ __forceinline__ const float* g_q() const { return in(9); }
    __device__ __forceinline__ const float* g_kv() const { return in(10); }
    __device__ __forceinline__ const float* w_uq() const { return in(11); }
    __device__ __forceinline__ const float* w_ukv() const { return in(12); }
    __device__ __forceinline__ const float* exp_f() const { return in(13); }
    __device__ __forceinline__ const float* exp_b() const { return in(14); }
    __device__ __forceinline__ const float* g_ret() const { return in(15); }
    __device__ __forceinline__ const float* w_o() const { return in(16); }
    __device__ __forceinline__ const float* w_router() const { return in(17); }
    __device__ __forceinline__ const float* w_gate() const { return in(18); }
    __device__ __forceinline__ const float* w_up() const { return in(19); }
    __device__ __forceinline__ const float* w_down() const { return in(20); }
    __device__ __forceinline__ const float* g_final() const { return in(21); }
    __device__ __forceinline__ float* out() const { return *(kfpp)(kp + 176); }
    __device__ __forceinline__ float* modv() const { return (float*)(wsb() + WS_MOD); }
    __device__ __forceinline__ float* tabr() const { return (float*)(wsb() + WS_TABR); }
    __device__ __forceinline__ float* tabm() const { return (float*)(wsb() + WS_TABM); }
    __device__ __forceinline__ float* pstat() const { return (float*)(wsb() + WS_PSTAT); }
    __device__ __forceinline__ float* aff() const { return (float*)(wsb() + WS_AFF); }
    __device__ __forceinline__ float* selg() const { return (float*)(wsb() + WS_SELG); }
    __device__ __forceinline__ int* seli() const { return (int*)(wsb() + WS_SELI); }
    __device__ __forceinline__ int* inv() const { return (int*)(wsb() + WS_INV); }
    __device__ __forceinline__ float* sels() const { return (float*)(wsb() + WS_SELS); }
    __device__ __forceinline__ float* rpart() const { return (float*)(wsb() + WS_Q); }
    __device__ __forceinline__ bf16_t* win_t() const { return (bf16_t*)(wsb() + WS_WIN); }
    __device__ __forceinline__ bf16_t* wuq_t() const { return (bf16_t*)(wsb() + WS_WUQ); }
    __device__ __forceinline__ bf16_t* wukv_t() const { return (bf16_t*)(wsb() + WS_WUKV); }
    __device__ __forceinline__ bf16_t* wo_t() const { return (bf16_t*)(wsb() + WS_WO); }
    __device__ __forceinline__ bf16_t* wgu_t() const { return (bf16_t*)(wsb() + WS_WGU); }
    __device__ __forceinline__ bf16_t* wdn_t() const { return (bf16_t*)(wsb() + WS_WDN); }
    __device__ __forceinline__ bf16_t* hb() const { return (bf16_t*)(wsb() + WS_H); }
    __device__ __forceinline__ bf16_t* rst() const { return (bf16_t*)(wsb() + WS_RST); }
    __device__ __forceinline__ bf16_t* proj() const { return (bf16_t*)(wsb() + WS_PROJ); }
    __device__ __forceinline__ bf16_t* act() const { return (bf16_t*)(wsb() + WS_ACT); }
    __device__ __forceinline__ bf16_t* yb() const { return (bf16_t*)(wsb() + WS_YB); }
    __device__ __forceinline__ bf16_t* qb() const { return (bf16_t*)(wsb() + WS_Q); }
    __device__ __forceinline__ bf16_t* kvb() const { return (bf16_t*)(wsb() + WS_KV); }
    __device__ __forceinline__ bf16_t* mix() const { return (bf16_t*)(wsb() + WS_MIX); }
    __device__ __forceinline__ bf16_t* x1b() const { return (bf16_t*)(wsb() + WS_H); }
    __device__ __forceinline__ bf16_t* h2() const { return (bf16_t*)(wsb() + WS_MIX); }
    __device__ __forceinline__ signed char* h2q() const { return (signed char*)(wsb() + WS_MIX); }
    __device__ __forceinline__ float* sa() const { return (float*)(wsb() + WS_MIX + 32 * MiB); }
    __device__ __forceinline__ signed char* wgu_q() const { return (signed char*)(wsb() + WS_WGU); }
    __device__ __forceinline__ float* swgu() const { return (float*)(wsb() + WS_WGU + 24 * MiB); }
    __device__ __forceinline__ signed char* wdn_q() const { return (signed char*)(wsb() + WS_WDN); }
    __device__ __forceinline__ float* swdn() const { return (float*)(wsb() + WS_WDN + 12 * MiB); }
    __device__ __forceinline__ signed char* actq() const { return (signed char*)(wsb() + 384 * MiB); }
    __device__ __forceinline__ unsigned char* y8() const { return (unsigned char*)(wsb() + WS_YB); }
    __device__ __forceinline__ float* ysc() const { return (float*)(wsb() + 320 * MiB); }
    __device__ __forceinline__ float* sactg() const { return (float*)(wsb() + 432 * MiB); }
};

__device__ __forceinline__ void p0_mod(const Ctx& c, float* lds) {
    float* sc = lds;
    float* red = lds + 9 * 1024;
    for (int i = c.tid; i < 9 * 1024; i += 512) { const int r = i >> 10, k = i & 1023; const float v = r < 8 ? c.cvec()[r * 1024 + k] : c.c_ctx()[k]; sc[i] = silu_f(v); }
    __syncthreads();
    for (int unit = blockIdx.x; unit < 192; unit += gridDim.x) {
        const int nn = c.tid & 31, n = unit * 32 + nn, kg = c.tid >> 5;
        float acc[9];
#pragma unroll
        for (int r = 0; r < 9; ++r) acc[r] = 0.f;
        for (int k0 = kg; k0 < 1024; k0 += 16 * 8) { float w[8];
#pragma unroll
            for (int i = 0; i < 8; ++i) w[i] = __builtin_nontemporal_load(c.w_ada() + (size_t)(k0 + 16 * i) * 6144 + n);
#pragma unroll
            for (int i = 0; i < 8; ++i)
#pragma unroll
                for (int r = 0; r < 9; ++r) acc[r] += sc[r * 1024 + k0 + 16 * i] * w[i]; }
#pragma unroll
        for (int r = 0; r < 9; ++r) red[(kg * 9 + r) * 32 + nn] = acc[r];
        __syncthreads();
        for (int i = c.tid; i < 9 * 32; i += 512) { const int r = i >> 5, n2 = i & 31; float s = 0.f;
#pragma unroll
            for (int g = 0; g < 16; ++g) s += red[(g * 9 + r) * 32 + n2];
            c.modv()[r * 6144 + unit * 32 + n2] = s + c.b_ada()[unit * 32 + n2]; }
        __syncthreads();
    }
}
template <class CM, class GN>
__device__ __forceinline__ void transpose_item(const float* W, int Ksrc, int Nsrc, bf16_t* WT, int Kdst, CM cm, GN gain, float* scr, int kb, int nb, int lane) {
    const int k0 = 64 * kb, n0 = 32 * nb;
    const int srcc = cm(n0 + (lane & 31));
#pragma unroll 8
    for (int i = 0; i < 32; ++i) { const int kk = 2 * i + (lane >> 5), k = k0 + kk;
        float v = 0.f; if (srcc >= 0 && k < Ksrc) v = W[(size_t)k * Nsrc + srcc] * gain(k);
        scr[kk * 33 + (lane & 31)] = v; }
    asm volatile("s_waitcnt lgkmcnt(0)" ::: "memory");
    const int ch = lane & 7;
#pragma unroll
    for (int j = 0; j < 4; ++j) { const int n = (lane >> 3) + 8 * j; const float* s = scr + (8 * ch) * 33 + n;
        u32x4 o; o.x = pk2(s[0 * 33], s[1 * 33]); o.y = pk2(s[2 * 33], s[3 * 33]); o.z = pk2(s[4 * 33], s[5 * 33]); o.w = pk2(s[6 * 33], s[7 * 33]);
        *(u32x4*)(WT + (size_t)(n0 + n) * Kdst + k0 + 8 * ch) = o; }
    asm volatile("s_waitcnt lgkmcnt(0)" ::: "memory");
}
__device__ __forceinline__ int ilv(int p, int half) { const int g = p >> 3, w = p & 7; return w < 4 ? 4 * g + w : half + 4 * g + (w - 4); }
__device__ __forceinline__ int cm_win(int n) {
    if (n < 384) return n;
    if (n < 416) return 384 + ilv(n - 384, 16);
    if (n < 512) return -1;
    if (n < 1024) { const int j = n - 512; return 416 + (j >> 6) * 64 + ilv(j & 63, 32); }
    if (n < 1536) { const int j = n - 1024; return 928 + (j >> 6) * 64 + ilv(j & 63, 32); }
    if (n < 2048) return 1440 + (n - 1536);
    return 1952 + (n - 2048);
}
__device__ __forceinline__ int cm_wuq(int n) { const int h = n / 96, p = n % 96; return p < 64 ? n : h * 96 + 64 + ilv(p - 64, 16); }
__device__ __forceinline__ int cm_wgu(int n) { const int q = n >> 3, w = n & 7; return w < 4 ? 4 * q + w : 768 + 4 * q + (w - 4); }
template <bool NTST = false, class TC>
__device__ __forceinline__ void transpose64(const float* srcA, const float* srcB, int ld, bf16_t* dst, int ldd, TC tcol, float* scr, int lane) {
    const int r = lane >> 3, c4 = (lane & 7) * 4;
    f32x4 va[8], vb[8];
#pragma unroll
    for (int i = 0; i < 8; ++i) { va[i] = srcA ? __builtin_nontemporal_load((const f32x4*)(srcA + (size_t)(8 * i + r) * ld + c4)) : (f32x4){0.f, 0.f, 0.f, 0.f}; vb[i] = srcB ? __builtin_nontemporal_load((const f32x4*)(srcB + (size_t)(8 * i + r) * ld + c4)) : (f32x4){0.f, 0.f, 0.f, 0.f}; }
#pragma unroll
    for (int i = 0; i < 8; ++i) { float* p = scr + (8 * i + r) * 65 + c4; p[0] = va[i].x; p[1] = va[i].y; p[2] = va[i].z; p[3] = va[i].w; p[32] = vb[i].x; p[33] = vb[i].y; p[34] = vb[i].z; p[35] = vb[i].w; }
    asm volatile("s_waitcnt lgkmcnt(0)" ::: "memory");
    const int kc = lane & 7;
#pragma unroll
    for (int j = 0; j < 8; ++j) { const int nl = (lane >> 3) + 8 * j, col = tcol(nl); u32x4 o = {0u, 0u, 0u, 0u};
        if (col >= 0) { const float* sp = scr + (8 * kc) * 65 + col; o.x = pk2(sp[0 * 65], sp[1 * 65]); o.y = pk2(sp[2 * 65], sp[3 * 65]); o.z = pk2(sp[4 * 65], sp[5 * 65]); o.w = pk2(sp[6 * 65], sp[7 * 65]); }
        if (NTST) __builtin_nontemporal_store(o, (u32x4*)(dst + (size_t)nl * ldd + 8 * kc)); else *(u32x4*)(dst + (size_t)nl * ldd + 8 * kc) = o; }
    asm volatile("s_waitcnt lgkmcnt(0)" ::: "memory");
}
typedef int i32x4 __attribute__((ext_vector_type(4)));
constexpr int GU_STRIPS = NE * 24;
__device__ __forceinline__ unsigned f8pack(float a, float b, float c_, float d) {
    a = __builtin_amdgcn_fmed3f(a, -448.f, 448.f); b = __builtin_amdgcn_fmed3f(b, -448.f, 448.f); c_ = __builtin_amdgcn_fmed3f(c_, -448.f, 448.f); d = __builtin_amdgcn_fmed3f(d, -448.f, 448.f);
    int r = __builtin_amdgcn_cvt_pk_fp8_f32(a, b, 0, false); r = __builtin_amdgcn_cvt_pk_fp8_f32(c_, d, r, true); return (unsigned)r;
}
__device__ __forceinline__ unsigned q8pack(float a, float b, float c_, float d, float inv) {
    const unsigned q0 = __float_as_uint(__builtin_fmaf(a, inv, 12582912.f)), q1 = __float_as_uint(__builtin_fmaf(b, inv, 12582912.f)), q2 = __float_as_uint(__builtin_fmaf(c_, inv, 12582912.f)), q3 = __float_as_uint(__builtin_fmaf(d, inv, 12582912.f));
    return (q0 & 255u) | ((q1 & 255u) << 8) | ((q2 & 255u) << 16) | (q3 << 24);
}
template <int NT, bool F8, class TC>
__device__ __forceinline__ void strip_i8(const Ctx& c, float* lds, const float* srcA, const float* srcB, int ld, signed char* dq0, int dld, float* sw0, TC tcol) {
    float* scr = lds + c.wave * (64 * 65); float* cm = lds + 8 * 64 * 65; float* fin = cm + 512;
    const int r = c.lane >> 3, c4 = (c.lane & 7) * 4;
    const bool act_w = 2 * c.wave < NT;
    f32x4 va[2][8], vb[2][8];
#pragma unroll
    for (int t = 0; t < 2; ++t)
#pragma unroll
        for (int i = 0; i < 8; ++i) { const size_t ro = (size_t)(64 * (2 * c.wave + t) + 8 * i + r) * ld + c4;
            va[t][i] = act_w ? __builtin_nontemporal_load((const f32x4*)(srcA + ro)) : (f32x4){0.f, 0.f, 0.f, 0.f}; vb[t][i] = act_w ? __builtin_nontemporal_load((const f32x4*)(srcB + ro)) : (f32x4){0.f, 0.f, 0.f, 0.f}; }
    f32x4 mA = {0.f, 0.f, 0.f, 0.f}, mB = {0.f, 0.f, 0.f, 0.f};
#pragma unroll
    for (int t = 0; t < 2; ++t)
#pragma unroll
        for (int i = 0; i < 8; ++i) { mA = __builtin_elementwise_max(mA, __builtin_elementwise_abs(va[t][i])); mB = __builtin_elementwise_max(mB, __builtin_elementwise_abs(vb[t][i])); }
#pragma unroll
    for (int o = 8; o < 64; o <<= 1)
#pragma unroll
        for (int j = 0; j < 4; ++j) { mA[j] = fmaxf(mA[j], __shfl_xor(mA[j], o)); mB[j] = fmaxf(mB[j], __shfl_xor(mB[j], o)); }
    __syncthreads();
    if (r == 0) { *(f32x4*)(cm + c.wave * 64 + c4) = mA; *(f32x4*)(cm + c.wave * 64 + 32 + c4) = mB; }
    __syncthreads();
    if (c.tid < 64) { float m = cm[c.tid];
#pragma unroll
        for (int w = 1; w < 8; ++w) m = fmaxf(m, cm[w * 64 + c.tid]);
        fin[c.tid] = fmaxf(m, 1e-30f); }
    __syncthreads();
    const int w8 = c.lane >> 3, kc = c.lane & 7;
    if (c.tid < 64) sw0[c.tid] = fin[tcol(c.tid)] * (F8 ? 1.f / 448.f : 1.f / 127.f);
    if (act_w) {
    signed char* dq = dq0 + (size_t)w8 * dld + 128 * c.wave + 8 * kc;
#pragma unroll
    for (int t = 0; t < 2; ++t) {
#pragma unroll
        for (int i = 0; i < 8; ++i) { float* p = scr + (8 * i + r) * 65 + c4; p[0] = va[t][i].x; p[1] = va[t][i].y; p[2] = va[t][i].z; p[3] = va[t][i].w; p[32] = vb[t][i].x; p[33] = vb[t][i].y; p[34] = vb[t][i].z; p[35] = vb[t][i].w; }
        asm volatile("s_waitcnt lgkmcnt(0)" ::: "memory");
#pragma unroll
        for (int j = 0; j < 8; ++j) { const int col = tcol(w8 + 8 * j);
            const float inv = (F8 ? 448.f : 127.f) / fin[col]; const float* sp = scr + (8 * kc) * 65 + col;
            u32x2 o;
            if (F8) { o.x = f8pack(sp[0 * 65] * inv, sp[1 * 65] * inv, sp[2 * 65] * inv, sp[3 * 65] * inv); o.y = f8pack(sp[4 * 65] * inv, sp[5 * 65] * inv, sp[6 * 65] * inv, sp[7 * 65] * inv); }
            else { o.x = q8pack(sp[0 * 65], sp[1 * 65], sp[2 * 65], sp[3 * 65], inv); o.y = q8pack(sp[4 * 65], sp[5 * 65], sp[6 * 65], sp[7 * 65], inv); }
            *(u32x2*)(dq + (size_t)(8 * j) * dld + 64 * t) = o; }
        asm volatile("s_waitcnt lgkmcnt(0)" ::: "memory");
    } }
}
constexpr int DN_STRIPS = NE * 16, EXP_STRIPS = GU_STRIPS + DN_STRIPS;
__device__ __forceinline__ void expert_strip(const Ctx& c, float* lds, int s) {
    if (s < GU_STRIPS) { const int e = s / 24, nb = s % 24; const size_t so = (size_t)e * 1024 * 768 + 32 * nb;
        strip_i8<16, false>(c, lds, c.w_gate() + so, c.w_up() + so, 768, c.wgu_q() + (size_t)e * 1536 * 1024 + (size_t)(64 * nb) * 1024, 1024, c.swgu() + e * 1536 + 64 * nb,
                     [](int nl) { const int qq = nl >> 3, w = nl & 7; return w < 4 ? 4 * qq + w : 32 + 4 * qq + (w - 4); }); }
    else { s -= GU_STRIPS; const int e = s >> 4, nb = s & 15; const float* src = c.w_down() + (size_t)e * 768 * 1024 + 64 * nb;
        strip_i8<12, true>(c, lds, src, src + 32, 1024, c.wdn_q() + (size_t)e * 1024 * 768 + (size_t)(64 * nb) * 768, 768, c.swdn() + e * 1024 + 64 * nb, [](int nl) { return nl; }); }
}
constexpr int QSHORT0 = 80, QSTRIPS = 0, QSTATIC = (256 - QSHORT0) * QSTRIPS;
template <int PART>
__device__ __forceinline__ void p0_weights(const Ctx& c, float* lds, int gw, int ngw) {
    float* scr = lds + c.wave * (64 * 65);
    constexpr int I_WIN = 16 * 40, I_WO = 16 * 16, I_GU = 16 * 24, I_DN = 12 * 16, I_WUQ = 4 * 24, I_WUKV = 4 * 32;
    constexpr int NEXP = NE * I_GU + NE * I_DN, NIT = NEXP + I_WIN + I_WO + I_WUQ + I_WUKV;
    unsigned* qctr = (unsigned*)(c.wsb() + WS_CTL) + 2048; int qbase = 0, qk = 8;
    for (int it = (PART == 1 ? NE * I_GU : NEXP + gw); it < (PART == 1 ? NEXP : NIT); it += (PART == 0 ? ngw : 1)) {
        if (PART == 1) { if (qk == 8) { int p_ = 0; if (c.lane == 0) p_ = (int)__hip_atomic_fetch_add(qctr, 1u, __ATOMIC_RELAXED, __HIP_MEMORY_SCOPE_AGENT); qbase = NE * I_GU + __builtin_amdgcn_readfirstlane(p_) * 8; qk = 0; }
            it = qbase + qk; ++qk; if (it >= NEXP) break; }
        int r = it;
        r -= NEXP;
        if (r < I_WIN) { const int kb = r / 40, nb = r % 40; const float* base = c.w_in() + (size_t)(64 * kb) * 2464; bf16_t* dst = c.win_t() + (size_t)(64 * nb) * 1024 + 64 * kb;
            if (nb < 6) { transpose64(base + 64 * nb, base + 64 * nb + 32, 2464, dst, 1024, [](int nl) { return nl; }, scr, c.lane); }
            else if (nb == 6) { transpose64(base + 384, (const float*)nullptr, 2464, dst, 1024, [](int nl) { return nl < 32 ? ilv(nl, 16) : -1; }, scr, c.lane); }
            else if (nb == 7) { transpose64((const float*)nullptr, (const float*)nullptr, 2464, dst, 1024, [](int) { return -1; }, scr, c.lane); }
            else if (nb < 24) { const int s0 = (nb < 16 ? 416 : 928) + 64 * ((nb - 8) & 7); transpose64(base + s0, base + s0 + 32, 2464, dst, 1024, [](int nl) { return ilv(nl, 32); }, scr, c.lane); }
            else { const int s0 = (nb < 32 ? 1440 : 1952) + 64 * (nb & 7); transpose64(base + s0, base + s0 + 32, 2464, dst, 1024, [](int nl) { return nl; }, scr, c.lane); }
            continue; } r -= I_WIN;
        if (r < I_WO) { const int kb = r / 16, nb = r % 16; const float* src = c.w_o() + (size_t)(64 * kb) * 1024 + 64 * nb;
            transpose64(src, src + 32, 1024, c.wo_t() + (size_t)(64 * nb) * 1024 + 64 * kb, 1024, [](int nl) { return nl; }, scr, c.lane); continue; } r -= I_WO;
        if (r < I_WUQ) { const float* g = c.g_q(); transpose_item(c.w_uq(), 256, 768, c.wuq_t(), 256, [](int n) { return cm_wuq(n); }, [g](int k) { return g[k]; }, scr, r / 24, r % 24, c.lane); continue; } r -= I_WUQ;
        { const float* g = c.g_kv(); transpose_item(c.w_ukv(), 128, 1024, c.wukv_t(), 256, [](int n) { return n; }, [g](int k) { return g[k]; }, scr, r / 32, r % 32, c.lane); }
    }
}
__device__ __forceinline__ void sincos_d(double x, double& s, double& co) {
    const double PIO2_HI = 1.5707963267948966, PIO2_LO = 6.123233995736766e-17;
    const double kd = __builtin_rint(x * 0.6366197723675814); const int k = (int)kd;
    const double r = (x - kd * PIO2_HI) - kd * PIO2_LO, r2 = r * r;
    double sr = r - r * r2 * (1.0 / 6.0 - r2 * (1.0 / 120.0 - r2 * (1.0 / 5040.0 - r2 * (1.0 / 362880.0 - r2 * (1.0 / 39916800.0 - r2 * (1.0 / 6227020800.0 - r2 * (1.0 / 1307674368000.0 - r2 * (1.0 / 355687428096000.0))))))));
    double cr = 1.0 - r2 * (0.5 - r2 * (1.0 / 24.0 - r2 * (1.0 / 720.0 - r2 * (1.0 / 40320.0 - r2 * (1.0 / 3628800.0 - r2 * (1.0 / 479001600.0 - r2 * (1.0 / 87178291200.0 - r2 * (1.0 / 20922789888000.0))))))));
    switch (k & 3) { case 0: s = sr; co = cr; break; case 1: s = cr; co = -sr; break; case 2: s = -sr; co = -cr; break; default: s = -cr; co = sr; break; }
}
__device__ __forceinline__ void p0_tables(const Ctx& c) {
    const int gt = blockIdx.x * 512 + c.tid, ngt = gridDim.x * 512;
    const double r16 = 1.0 / __builtin_sqrt(__builtin_sqrt(10.0));
    const double r8 = 1.0 / __builtin_sqrt(10.0);
    for (int i = gt; i < 4096 * 48; i += ngt) {
        const int t = i / 48, j = i % 48; const int prow = t >> 6, pcol = t & 63;
        double ang;
        if (j < 32) { const int jj = j & 15; double inv = 1.0; for (int q = 0; q < jj; ++q) inv *= r16; ang = (double)(j < 16 ? prow : pcol) * inv; }
        else { const int j2 = j - 32, jj = j2 & 7; double inv = 1.0; for (int q = 0; q < jj; ++q) inv *= r8; ang = (double)(j2 < 8 ? prow : pcol) * inv; }
        double s, co; sincos_d(ang, s, co);
        if (j < 32) { c.tabr()[(t * 32 + j) * 2] = (float)co; c.tabr()[(t * 32 + j) * 2 + 1] = (float)s; }
        else { c.tabm()[(t * 16 + j - 32) * 2] = (float)co; c.tabm()[(t * 16 + j - 32) * 2 + 1] = (float)s; }
    }
}

__device__ __forceinline__ void p1_norm(const Ctx& c) {
    for (int r = c.gw * 2; r < RT; r += c.ngw * 2) {
        const float* src = r < RL ? c.x() + (size_t)r * D : c.ctx() + (size_t)(r - RL) * D; const int b = r < RL ? r / SEQ : 8;
        f32x4 v[2][4]; float s0 = 0.f, s1 = 0.f;
#pragma unroll
        for (int j = 0; j < 4; ++j) { v[0][j] = __builtin_nontemporal_load((const f32x4*)src + c.lane + 64 * j); v[1][j] = __builtin_nontemporal_load((const f32x4*)(src + D) + c.lane + 64 * j); }
#pragma unroll
        for (int j = 0; j < 4; ++j) { s0 += v[0][j].x * v[0][j].x + v[0][j].y * v[0][j].y + v[0][j].z * v[0][j].z + v[0][j].w * v[0][j].w; s1 += v[1][j].x * v[1][j].x + v[1][j].y * v[1][j].y + v[1][j].z * v[1][j].z + v[1][j].w * v[1][j].w; }
        const float ri0 = 1.f / sqrtf(wave_sum(s0) * (1.f / D) + EPS), ri1 = 1.f / sqrtf(wave_sum(s1) * (1.f / D) + EPS);
        const float* md = c.modv() + b * 6144;
#pragma unroll
        for (int j = 0; j < 4; ++j) { const int k = 4 * c.lane + 256 * j;
            const f32x4 g = *(const f32x4*)(c.g_mix() + k), sh = *(const f32x4*)(md + k), scv = *(const f32x4*)(md + 1024 + k);
            const f32x4 gs = g * (scv + 1.f); const f32x4 o0 = v[0][j] * ri0 * gs + sh, o1 = v[1][j] * ri1 * gs + sh;
            u32x2 w0, w1; w0.x = pk2(o0.x, o0.y); w0.y = pk2(o0.z, o0.w); w1.x = pk2(o1.x, o1.y); w1.y = pk2(o1.z, o1.w);
            *(u32x2*)(c.hb() + (size_t)r * D + k) = w0; *(u32x2*)(c.hb() + (size_t)(r + 1) * D + k) = w1; }
    }
}

__device__ __forceinline__ void store8_bf16(bf16_t* p, const float (&v)[8]) { u32x4 w; w.x = pk2(v[0], v[1]); w.y = pk2(v[2], v[3]); w.z = pk2(v[4], v[5]); w.w = pk2(v[6], v[7]); *(u32x4*)p = w; }


namespace pg8 {
typedef short bf16x8 __attribute__((ext_vector_type(8)));
constexpr int BM = 256, BK = 64, HALF = 128, HTB = HALF * BK * 2, STAGE_BYTES = 8 * HTB, NXCD = 8, WGM = 8;
__host__ __device__ __forceinline__ int lds_byte(int r, int c) { const int st = (r >> 4) * 2 + (c >> 5), rr = r & 15, cc = c & 31, ob = rr * 64 + cc * 2; return st * 1024 + (ob ^ (((ob >> 9) & 1) << 5)); }
__host__ __device__ __forceinline__ void stage_rc(int b, int& R, int& C) { const int st = b / 1024, sb = b % 1024, swz = sb ^ (((sb >> 9) & 1) << 5); R = (st >> 1) * 16 + swz / 64; C = (st & 1) * 32 + (swz % 64) / 2; }
__host__ __device__ __forceinline__ int perm32(int rho) { const int n = rho >> 4, i = rho & 15; return 8 * (i >> 2) + 4 * n + (i & 3); }
struct Unit { int pm, pn; };
struct Gemm { const bf16_t* A; const bf16_t* Bt; int lda, ldb, K; const int* rowlist; int gshift, gmask; size_t gstride; };
struct StaticOrder {
    int nM, nN, nwg, G, c;
    __host__ __device__ void init(int M, int N, int G_, int c_) { nM = M / BM; nN = N / BM; nwg = nM * nN; G = G_; c = c_; }
    __host__ __device__ bool next(int i, Unit& u) const {
        const long L = (long)i * G + c; if (L >= nwg) return false;
        int wgid = (int)L; { const int q = nwg / NXCD, r = nwg % NXCD, xcd = wgid % NXCD, off = wgid / NXCD; wgid = (xcd < r ? xcd * (q + 1) : r * (q + 1) + (xcd - r) * q) + off; }
        const int nig = WGM * nN, gid = wgid / nig, fm = gid * WGM, gsz = (nM - fm) < WGM ? (nM - fm) : WGM;
        u.pm = fm + ((wgid % nig) % gsz); u.pn = (wgid % nig) / gsz; return true;
    }
};
struct ExpertOrder : StaticOrder {
    __host__ __device__ bool next(int i, Unit& u) const {
        if (!StaticOrder::next(i, u)) return false;
        const int p = u.pm, x = p >> 5, el = (p >> 4) & 1, b = (p >> 1) & 7, j = p & 1; u.pm = 32 * b + 2 * (2 * x + el) + j; return true;
    }
};
template <class F, bool FENCE = false> struct EpiRow8 {
    static constexpr bool PERM = true;
    F f;
    __device__ __forceinline__ void operator()(const f32x4 (&acc)[2][2][4][2], const Unit& u, int wr, int wc, int fr, int fq) const {
        const int row0 = u.pm * BM + wr * 64 + fr, col0 = u.pn * BM + wc * 32 + 8 * fq;
#pragma unroll
        for (int ai = 0; ai < 2; ++ai)
#pragma unroll
            for (int m = 0; m < 4; ++m)
#pragma unroll
                for (int bj = 0; bj < 2; ++bj) { const f32x4 a = acc[ai][bj][m][0], b = acc[ai][bj][m][1]; const float v[8] = {a[0], a[1], a[2], a[3], b[0], b[1], b[2], b[3]};
                    f(row0 + ai * HALF + m * 16, col0 + bj * HALF, v); if (FENCE && bj == 1) asm volatile("" ::: "memory"); }
    }
};
typedef int i32x8 __attribute__((ext_vector_type(8)));
__device__ __forceinline__ f32x4 mma_f8(bf16x8 a0, bf16x8 a1, bf16x8 b0, bf16x8 b1, f32x4 c) {
    const i32x8 A = __builtin_shufflevector(__builtin_bit_cast(i32x4, a0), __builtin_bit_cast(i32x4, a1), 0, 1, 2, 3, 4, 5, 6, 7), B = __builtin_shufflevector(__builtin_bit_cast(i32x4, b0), __builtin_bit_cast(i32x4, b1), 0, 1, 2, 3, 4, 5, 6, 7);
    return __builtin_amdgcn_mfma_scale_f32_16x16x128_f8f6f4(A, B, c, 0, 0, 0, 0, 0, 0);
}
template <int I8> __device__ __forceinline__ f32x4 mma_step(bf16x8 a, bf16x8 b, f32x4 c) {
    if constexpr (I8 == 1) return __builtin_bit_cast(f32x4, __builtin_amdgcn_mfma_i32_16x16x64_i8(__builtin_bit_cast(i32x4, a), __builtin_bit_cast(i32x4, b), __builtin_bit_cast(i32x4, c), 0, 0, 0));
    else return __builtin_amdgcn_mfma_f32_16x16x32_bf16(a, b, c, 0, 0, 0);
}
template <int I8 = 0, bool GATHER = false, class Epi, class Sched>
__device__ __forceinline__ void gemm_phase(LAS unsigned char* lds, const Gemm g, const Sched& S, const Epi& E, int tid) {
    const int wid = __builtin_amdgcn_readfirstlane(tid >> 6), lane = tid & 63, wr = wid >> 2, wc = wid & 3, fr = lane & 15, fq = lane >> 4;
    int Kv_ = g.K; asm volatile("" : "+s"(Kv_)); const int nt = Kv_ / BK;
    unsigned voffB[2];
#pragma unroll
    for (int i = 0; i < 2; ++i) { int R, C; stage_rc(tid * 16 + i * 8192, R, C); const int Rb = Epi::PERM ? ((R & ~31) + perm32(R & 31)) : R;
        voffB[i] = (unsigned)(Rb * g.ldb + C) * 2u; }
    const size_t kstep = (size_t)(BK * 2);
    const size_t hstepB = (size_t)HALF * g.ldb * 2, tstepB = 2 * hstepB;
    const unsigned ldsw = (unsigned)wid * 1024u;
    const int aoff = lds_byte(wr * 64 + fr, fq * 8), boff = lds_byte(wc * 32 + fr, fq * 8);
    const unsigned lda2 = (unsigned)g.lda * 2u;
#define PG8_SA(b, h) (((b) * 2 + (h)) * HTB)
#define PG8_SB(b, h) ((4 + (b) * 2 + (h)) * HTB)
#define PG8_STAGE(bufoff, gbase, voff) do { _Pragma("unroll") for (int _i = 0; _i < 2; ++_i) { unsigned _vo = (voff)[_i]; asm volatile("" : "+v"(_vo));     \
        __builtin_amdgcn_global_load_lds((const unsigned*)((const char*)(gbase) + _vo), (LAS unsigned*)(lds + (bufoff) + ldsw + _i * 8192), 16, 0, 0); } } while (0)
#define PG8_LDA(dst, b, h) do { if constexpr (I8 == 2) { _Pragma("unroll") for (int m = 0; m < 4; ++m) dst##8[m] = __builtin_shufflevector(*(const LAS i32x4*)(lds + PG8_SA(b, h) + aoff + m * 2048), *(const LAS i32x4*)(lds + PG8_SA(b, h) + aoff + m * 2048 + 1024), 0, 1, 2, 3, 4, 5, 6, 7); } \
        else { _Pragma("unroll") for (int m = 0; m < 4; ++m) _Pragma("unroll") for (int k = 0; k < 2; ++k) dst[m][k] = *(const LAS bf16x8*)(lds + PG8_SA(b, h) + aoff + m * 2048 + k * 1024); } } while (0)
#define PG8_LDB(dst, b, h) do { if constexpr (I8 == 2) { _Pragma("unroll") for (int n = 0; n < 2; ++n) dst##8[n] = __builtin_shufflevector(*(const LAS i32x4*)(lds + PG8_SB(b, h) + boff + n * 2048), *(const LAS i32x4*)(lds + PG8_SB(b, h) + boff + n * 2048 + 1024), 0, 1, 2, 3, 4, 5, 6, 7); } \
        else { _Pragma("unroll") for (int n = 0; n < 2; ++n) _Pragma("unroll") for (int k = 0; k < 2; ++k) dst[n][k] = *(const LAS bf16x8*)(lds + PG8_SB(b, h) + boff + n * 2048 + k * 1024); } } while (0)
#define PG8_MMA(ai, bj, At, Bt) do { __builtin_amdgcn_s_setprio(1); _Pragma("unroll") for (int m = 0; m < 4; ++m) _Pragma("unroll") for (int n = 0; n < 2; ++n) { \
        if constexpr (I8 == 2) acc[ai][bj][m][n] = __builtin_amdgcn_mfma_scale_f32_16x16x128_f8f6f4(Bt##8[n], At##8[m], acc[ai][bj][m][n], 0, 0, 0, 0, 0, 0); \
        else { _Pragma("unroll") for (int k = 0; k < 2; ++k) acc[ai][bj][m][n] = mma_step<I8>(Bt[n][k], At[m][k], acc[ai][bj][m][n]); } } __builtin_amdgcn_s_setprio(0); } while (0)
#define PG8_WAIT_V(n) asm volatile("s_waitcnt vmcnt(" #n ")" ::: "memory")
#define PG8_WAIT_L(n) asm volatile("s_waitcnt lgkmcnt(" #n ")" ::: "memory")
#define PG8_BAR __builtin_amdgcn_s_barrier()
#define PG8_SCHED __builtin_amdgcn_sched_barrier(0)
#define PG8_AOFFS(vo, u) do { _Pragma("unroll") for (int _i = 0; _i < 2; ++_i) { int _R, _C; stage_rc(tid * 16 + _i * 8192, _R, _C); _Pragma("unroll") for (int _h = 0; _h < 2; ++_h) { const int _r = (u).pm * BM + _h * HALF + _R; \
        const int _row = g.rowlist ? g.rowlist[_r] : _r; vo[_h][_i] = (unsigned)_row * lda2 + (unsigned)(_C * 2); } } } while (0)
#define PG8_BBASE(u) ((const char*)g.Bt + ((size_t)(((u).pm >> g.gshift) & g.gmask) * g.gstride) * 2 + (size_t)(u).pn * tstepB)
    Unit cur, nxt; int ui = 0;
    if (!S.next(0, cur)) return;
    f32x4 acc[2][2][4][2];
#pragma unroll
    for (int a = 0; a < 2; ++a)
#pragma unroll
        for (int b = 0; b < 2; ++b)
#pragma unroll
            for (int m = 0; m < 4; ++m)
#pragma unroll
                for (int n = 0; n < 2; ++n) acc[a][b][m][n] = (f32x4){0.f, 0.f, 0.f, 0.f};
    bf16x8 At[4][2], B0[2][2], B1[2][2];
    i32x8 At8[4], B08[2], B18[2];
    unsigned voc[2][2], von[2][2], voA[2];
    const size_t hstepA = (size_t)HALF * lda2, ustepA = 2 * hstepA;
#pragma unroll
    for (int i = 0; i < 2; ++i) { int R, C; stage_rc(tid * 16 + i * 8192, R, C); voA[i] = (unsigned)R * lda2 + (unsigned)(C * 2); }
    if constexpr (GATHER) PG8_AOFFS(voc, cur);
#define PG8_ABASE(u) ((const char*)g.A + (GATHER ? (size_t)0 : (size_t)(u).pm * ustepA))
#define PG8_STAGE_A(bufoff, base, h, vg) do { if constexpr (GATHER) PG8_STAGE(bufoff, base, vg); else PG8_STAGE(bufoff, (base) + (h) * hstepA, voA); } while (0)
    const char* A0 = PG8_ABASE(cur); const char* cB = PG8_BBASE(cur);
    PG8_STAGE(PG8_SB(0, 0), cB, voffB); PG8_STAGE(PG8_SB(0, 1), cB + hstepB, voffB); PG8_STAGE_A(PG8_SA(0, 0), A0, 0, voc[0]); PG8_STAGE_A(PG8_SA(0, 1), A0, 1, voc[1]);
    if (wr == 1) PG8_BAR;
    PG8_WAIT_V(2); PG8_BAR;
    PG8_STAGE(PG8_SB(1, 0), cB + kstep, voffB); PG8_STAGE_A(PG8_SA(1, 0), A0 + kstep, 0, voc[0]); PG8_STAGE(PG8_SB(1, 1), cB + hstepB + kstep, voffB);
    PG8_WAIT_V(6); PG8_BAR;
    for (;;) {
        const bool has_next = S.next(ui + 1, nxt);
        const char* nB = has_next ? PG8_BBASE(nxt) : cB; const char* nA = has_next ? PG8_ABASE(nxt) : A0;
        for (int t = 0; t < nt; t += 2) {
            const bool last = (t == nt - 2);
            const char* a1 = A0 + (size_t)(t + 1) * kstep;
            const char* a2 = last ? nA : A0 + (size_t)(t + 2) * kstep; const char* b2 = last ? nB : cB + (size_t)(t + 2) * kstep;
            const char* a3 = a2 + kstep; const char* b3 = b2 + kstep;
            unsigned vo2[2][2];
            if constexpr (GATHER) {
            if (last) { if (has_next) { PG8_AOFFS(von, nxt); } else { _Pragma("unroll") for (int h = 0; h < 2; ++h) _Pragma("unroll") for (int i = 0; i < 2; ++i) von[h][i] = voc[h][i]; } }
#pragma unroll
            for (int h = 0; h < 2; ++h)
#pragma unroll
                for (int i = 0; i < 2; ++i) vo2[h][i] = last ? von[h][i] : voc[h][i];
            }
            PG8_LDB(B0, 0, 0); PG8_LDB(B1, 0, 1); PG8_SCHED; PG8_LDA(At, 0, 0); PG8_STAGE_A(PG8_SA(1, 1), a1, 1, voc[1]);
            PG8_WAIT_V(8); PG8_WAIT_L(0); PG8_BAR; PG8_MMA(0, 0, At, B0); PG8_MMA(0, 1, At, B1); PG8_BAR; PG8_SCHED;
            PG8_LDA(At, 0, 1); PG8_STAGE(PG8_SB(0, 0), b2, voffB); PG8_STAGE(PG8_SB(0, 1), b2 + hstepB, voffB); PG8_STAGE_A(PG8_SA(0, 0), a2, 0, vo2[0]);
            PG8_WAIT_V(8); PG8_WAIT_L(0); PG8_BAR; PG8_MMA(1, 0, At, B0); PG8_MMA(1, 1, At, B1); PG8_BAR; PG8_SCHED;
            PG8_LDB(B0, 1, 0); PG8_LDB(B1, 1, 1); PG8_SCHED; PG8_LDA(At, 1, 0); PG8_STAGE_A(PG8_SA(0, 1), a2, 1, vo2[1]);
            PG8_WAIT_V(8); PG8_WAIT_L(0); PG8_BAR; PG8_MMA(0, 0, At, B0); PG8_MMA(0, 1, At, B1); PG8_BAR; PG8_SCHED;
            PG8_LDA(At, 1, 1); PG8_STAGE(PG8_SB(1, 0), b3, voffB); PG8_STAGE(PG8_SB(1, 1), b3 + hstepB, voffB); PG8_STAGE_A(PG8_SA(1, 0), a3, 0, vo2[0]);
            PG8_WAIT_V(8); PG8_WAIT_L(0); PG8_BAR; PG8_MMA(1, 0, At, B0); PG8_MMA(1, 1, At, B1); PG8_BAR; PG8_SCHED;
        }
        if (wr == 0) PG8_BAR;
        if constexpr (I8 == 1) {
#pragma unroll
            for (int a = 0; a < 2; ++a)
#pragma unroll
                for (int b = 0; b < 2; ++b)
#pragma unroll
                    for (int m = 0; m < 4; ++m)
#pragma unroll
                        for (int n = 0; n < 2; ++n) acc[a][b][m][n] = __builtin_convertvector(__builtin_bit_cast(i32x4, acc[a][b][m][n]), f32x4); }
        E(acc, cur, wr, wc, fr, fq);
        if (!has_next) break;
#pragma unroll
        for (int a = 0; a < 2; ++a)
#pragma unroll
            for (int b = 0; b < 2; ++b)
#pragma unroll
                for (int m = 0; m < 4; ++m)
#pragma unroll
                    for (int n = 0; n < 2; ++n) acc[a][b][m][n] = (f32x4){0.f, 0.f, 0.f, 0.f};
        cur = nxt; cB = nB; A0 = nA; ++ui;
        if constexpr (GATHER) {
#pragma unroll
        for (int h = 0; h < 2; ++h)
#pragma unroll
            for (int i = 0; i < 2; ++i) voc[h][i] = von[h][i];
        }
        if (wr == 1) PG8_BAR;
    }
    PG8_WAIT_V(0);
    PG8_BAR;
#undef PG8_SA
#undef PG8_SB
#undef PG8_STAGE
#undef PG8_LDA
#undef PG8_LDB
#undef PG8_MMA
#undef PG8_WAIT_V
#undef PG8_WAIT_L
#undef PG8_BAR
#undef PG8_SCHED
#undef PG8_AOFFS
#undef PG8_ABASE
#undef PG8_STAGE_A
#undef PG8_BBASE
}
}
template <class F> __device__ __forceinline__ pg8::EpiRow8<F> make_epi(F f) { return pg8::EpiRow8<F>{f}; }
template <class F> __device__ __forceinline__ pg8::EpiRow8<F, true> make_epi_fenced(F f) { return pg8::EpiRow8<F, true>{f}; }

struct EpiProj {
    static constexpr bool PERM = true;
    bf16_t* proj; float* pstat; const float* tabr; const float* tabm;
    __device__ __forceinline__ void operator()(const f32x4 (&acc)[2][2][4][2], const pg8::Unit& u, int wr, int wc, int fr, int fq) const {
        const int row0 = u.pm * 256 + wr * 64 + fr, pn = u.pn; const bool lat = u.pm < RL / 256;
        const bool rope_r = pn >= 2 && pn < 6 && lat, rope_m = pn == 1 && wc == 0 && lat;
        f32x4 tb[8][2];
        if (rope_r || rope_m) { const int g = rope_r ? ((wc * 32 + 8 * fq) & 63) >> 3 : fq; const float* tab = rope_r ? tabr : tabm; const int nf = rope_r ? 32 : 16;
#pragma unroll
            for (int i = 0; i < 8; ++i) { const int t = (row0 + (i >> 2) * 128 + (i & 3) * 16) & (SEQ - 1); tb[i][0] = *(const f32x4*)(tab + (t * nf + 4 * g) * 2); tb[i][1] = *(const f32x4*)(tab + (t * nf + 4 * g) * 2 + 4); } }
        else {
#pragma unroll
            for (int i = 0; i < 8; ++i) { tb[i][0] = (f32x4){1.f, 0.f, 1.f, 0.f}; tb[i][1] = (f32x4){1.f, 0.f, 1.f, 0.f}; } }
#pragma unroll
        for (int ai = 0; ai < 2; ++ai)
#pragma unroll
            for (int m = 0; m < 4; ++m) {
                const int row = row0 + ai * 128 + m * 16;
                bf16_t* pr = proj + (size_t)row * NPROJ + pn * 256 + wc * 32 + 8 * fq;
                const f32x4 c0 = tb[ai * 4 + m][0], c1 = tb[ai * 4 + m][1]; const float co[4] = {c0.x, c0.z, c1.x, c1.z}, si[4] = {c0.y, c0.w, c1.y, c1.w};
                float v[2][8];
#pragma unroll
                for (int bj = 0; bj < 2; ++bj) { const f32x4 a = acc[ai][bj][m][0], b = acc[ai][bj][m][1]; v[bj][0] = a[0]; v[bj][1] = a[1]; v[bj][2] = a[2]; v[bj][3] = a[3]; v[bj][4] = b[0]; v[bj][5] = b[1]; v[bj][6] = b[2]; v[bj][7] = b[3]; }
                if (pn == 0) {
                    float sq = 0.f;
#pragma unroll
                    for (int bj = 0; bj < 2; ++bj)
#pragma unroll
                        for (int j = 0; j < 8; ++j) sq += v[bj][j] * v[bj][j];
                    sq += __shfl_xor(sq, 16); sq += __shfl_xor(sq, 32);
                    if (fq == 0) pstat[(size_t)row * 8 + wc] = sq;
                } else if (pn == 1) {
                    float sq = 0.f;
#pragma unroll
                    for (int j = 0; j < 8; ++j) sq += v[0][j] * v[0][j];
                    sq += __shfl_xor(sq, 16); sq += __shfl_xor(sq, 32);
                    if (fq == 0) pstat[(size_t)row * 8 + 4 + wc] = sq;
                    if (wc == 0) {
#pragma unroll
                        for (int w = 0; w < 4; ++w) { const float x1 = v[1][w], x2 = v[1][4 + w]; v[1][w] = x1 * co[w] - x2 * si[w]; v[1][4 + w] = x1 * si[w] + x2 * co[w]; } }
                } else if (pn < 6) {
                    const float ksc = pn >= 4 ? 0.125f : 1.f;
#pragma unroll
                    for (int bj = 0; bj < 2; ++bj)
#pragma unroll
                        for (int w = 0; w < 4; ++w) { const float x1 = v[bj][w], x2 = v[bj][4 + w]; v[bj][w] = (x1 * co[w] - x2 * si[w]) * ksc; v[bj][4 + w] = (x1 * si[w] + x2 * co[w]) * ksc; }
                } else if (pn >= 8) {
#pragma unroll
                    for (int bj = 0; bj < 2; ++bj)
#pragma unroll
                        for (int j = 0; j < 8; ++j) v[bj][j] = silu_f(v[bj][j]);
                }
                store8_bf16(pr, v[0]); store8_bf16(pr + 128, v[1]);
            }
    }
};
__device__ __forceinline__ void p2_proj(const Ctx& c, float* lds) {
    pg8::Gemm g{c.hb(), c.win_t(), D, D, D, nullptr, 0, 0, 0};
    pg8::StaticOrder S; S.init(RT, NPROJ, (int)gridDim.x, (int)blockIdx.x);
    EpiProj E{c.proj(), c.pstat(), c.tabr(), c.tabm()};
    pg8::gemm_phase((LAS unsigned char*)lds, g, S, E, c.tid);
    if ((int)gridDim.x == 256 && (int)blockIdx.x >= QSHORT0) { __syncthreads();
        for (int q = 0; q < QSTRIPS; ++q) expert_strip(c, lds, ((int)blockIdx.x - QSHORT0) * QSTRIPS + q);
        __syncthreads(); }
}
template <bool ISQ> struct EpiUp {
    static constexpr bool PERM = true;
    bf16_t* out; const float* pstat; const float* tabm;
    __device__ __forceinline__ void operator()(const f32x4 (&acc)[2][2][4][2], const pg8::Unit& u, int wr, int wc, int fr, int fq) const {
        const int row0 = u.pm * 256 + wr * 64 + fr, col00 = u.pn * 256 + wc * 32 + 8 * fq;
        float sc[8];
#pragma unroll
        for (int i = 0; i < 8; ++i) { const f32x4 ps = *(const f32x4*)(pstat + (size_t)(row0 + (i >> 2) * 128 + (i & 3) * 16) * 8 + (ISQ ? 0 : 4));
            sc[i] = (ISQ ? QSCALE : 1.f) / sqrtf((ps.x + ps.y + ps.z + ps.w) * (ISQ ? 1.f / 256.f : 1.f / 128.f) + EPS); }
#pragma unroll
        for (int ai = 0; ai < 2; ++ai)
#pragma unroll
            for (int m = 0; m < 4; ++m) { const int row = row0 + ai * 128 + m * 16; const float s_ = sc[ai * 4 + m];
#pragma unroll
                for (int bj = 0; bj < 2; ++bj) { const int c0 = col00 + bj * 128; const f32x4 a = acc[ai][bj][m][0], b = acc[ai][bj][m][1];
                    float o[8] = {a[0] * s_, a[1] * s_, a[2] * s_, a[3] * s_, b[0] * s_, b[1] * s_, b[2] * s_, b[3] * s_};
                    if (ISQ) { const int p = c0 - 96 * ((c0 * 683) >> 16);
                        if (p >= 64) { const int t = row & (SEQ - 1), g = (p - 64) >> 3;
                            const f32x4 c0v = *(const f32x4*)(tabm + (t * 16 + 4 * g) * 2), c1v = *(const f32x4*)(tabm + (t * 16 + 4 * g) * 2 + 4);
                            const float co[4] = {c0v.x, c0v.z, c1v.x, c1v.z}, si[4] = {c0v.y, c0v.w, c1v.y, c1v.w};
#pragma unroll
                            for (int w = 0; w < 4; ++w) { const float x1 = o[w], x2 = o[4 + w]; o[w] = x1 * co[w] - x2 * si[w]; o[4 + w] = x1 * si[w] + x2 * co[w]; } } }
                    store8_bf16(out + (size_t)row * (ISQ ? QW : KVW) + c0, o); } }
    }
};
__device__ __forceinline__ void p3_upq(const Ctx& c, float* lds) {
    pg8::Gemm g{c.proj() + PC_CQ, c.wuq_t(), NPROJ, 256, 256, nullptr, 0, 0, 0};
    pg8::StaticOrder S; S.init(RL, QW, (int)gridDim.x, (int)blockIdx.x);
    EpiUp<true> E{c.qb(), c.pstat(), c.tabm()};
    pg8::gemm_phase((LAS unsigned char*)lds, g, S, E, c.tid);
}
__device__ __forceinline__ void p3_upkv(const Ctx& c, float* lds) {
    pg8::Gemm g{c.proj() + PC_CKV, c.wukv_t(), NPROJ, 256, 128, nullptr, 0, 0, 0};
    pg8::StaticOrder S; S.init(RT, KVW, (int)gridDim.x, (int)blockIdx.x);
    EpiUp<false> E{c.kvb(), c.pstat(), c.tabm()};
    pg8::gemm_phase((LAS unsigned char*)lds, g, S, E, c.tid);
}

namespace att {
using bf16x8 = __attribute__((ext_vector_type(8))) short;
using s16x4  = __attribute__((ext_vector_type(4))) short;
using f32x16 = __attribute__((ext_vector_type(16))) float;
constexpr int QBLK = 32, KVBLK = 64, NWV = 8;
constexpr float THR = 8.f;
constexpr int SHM_V = 16384, SHM_K = 16384, SHM_ATTN = 3 * SHM_V + 3 * SHM_K + NWV * 64 * 4;
#define KSWZ(row, colB) ((row) * 256 + ((colB) ^ (((row) & 7) << 4)))
#define SBAR() __builtin_amdgcn_sched_barrier(0)
__device__ __forceinline__ int crow(int r, int hi) { return (r & 3) + 8 * (r >> 2) + 4 * hi; }
__device__ __forceinline__ unsigned cvtpk(float lo, float hi) { unsigned r; asm volatile("v_cvt_pk_bf16_f32 %0, %1, %2" : "=v"(r) : "v"(lo), "v"(hi)); return r; }
__device__ __forceinline__ float max3f(float a, float b, float c) { float r; asm("v_max3_f32 %0, %1, %2, %3" : "=v"(r) : "v"(a), "v"(b), "v"(c)); return r; }
template <bool FIRST>
__device__ __forceinline__ void partialSM(f32x16& p0, f32x16& p1, float& m_reg, f32x16& negm, float& alpha) {
  float pa = max3f(p0[0], p0[1], p0[2]), pb = max3f(p1[0], p1[1], p1[2]);
#pragma unroll
  for (int r = 3; r < 15; r += 2) { pa = max3f(pa, p0[r], p0[r + 1]); pb = max3f(pb, p1[r], p1[r + 1]); }
  float pmax = max3f(pa, pb, fmaxf(p0[15], p1[15]));
  { auto rr = __builtin_amdgcn_permlane32_swap(__float_as_uint(pmax), __float_as_uint(pmax), false, false);
    pmax = fmaxf(__uint_as_float(rr[0]), __uint_as_float(rr[1])); }
  if (!FIRST && __builtin_expect(__all(pmax <= THR), 1)) { alpha = 1.f; }
  else { const float dl = FIRST ? pmax : fmaxf(pmax, 0.f); alpha = FIRST ? 1.f : __builtin_amdgcn_exp2f(-dl); m_reg += dl;
#pragma unroll
    for (int r = 0; r < 16; ++r) { p0[r] -= dl; p1[r] -= dl; }
#pragma unroll
    for (int r = 0; r < 16; ++r) negm[r] = -m_reg;
    asm volatile("" : "+v"(negm)); }
#pragma unroll
  for (int r = 0; r < 16; ++r) p0[r] = __builtin_amdgcn_exp2f(p0[r]);
}
__device__ __forceinline__ void finishSM(f32x16& p0, f32x16& p1, float alpha, float& l_reg, bf16x8& pa0, bf16x8& pa1, bf16x8& pa2, bf16x8& pa3) {
#pragma unroll
  for (int r = 0; r < 16; ++r) p1[r] = __builtin_amdgcn_exp2f(p1[r]);
  float ps = 0;
#pragma unroll
  for (int r = 0; r < 16; ++r) ps += p0[r];
#pragma unroll
  for (int r = 0; r < 16; ++r) ps += p1[r];
  { auto rr = __builtin_amdgcn_permlane32_swap(__float_as_uint(ps), __float_as_uint(ps), false, false);
    ps = __uint_as_float(rr[0]) + __uint_as_float(rr[1]); }
  l_reg = l_reg * alpha + ps;
#define PK4(P, BASE, OUT) do { unsigned a0 = cvtpk(P[BASE + 0], P[BASE + 1]), a1 = cvtpk(P[BASE + 2], P[BASE + 3]);   \
    unsigned b0 = cvtpk(P[BASE + 4], P[BASE + 5]), b1 = cvtpk(P[BASE + 6], P[BASE + 7]);                              \
    auto r0 = __builtin_amdgcn_permlane32_swap(a0, b0, false, false); auto r1 = __builtin_amdgcn_permlane32_swap(a1, b1, false, false); \
    u32x4 w = {r0[0], r1[0], r0[1], r1[1]}; OUT = *reinterpret_cast<bf16x8*>(&w); } while (0)
  PK4(p0, 0, pa0); PK4(p0, 8, pa1); PK4(p1, 0, pa2); PK4(p1, 8, pa3);
#undef PK4
}
__device__ __forceinline__ void qkt(f32x16& p0, f32x16& p1, const char* Ks, const bf16x8* qr, const f32x16& negm, int r32, int hi) {
#pragma unroll
  for (int d0 = 0; d0 < 6; ++d0) { const int cb = (d0 * 16 + hi * 8) * 2;
    const bf16x8 b0 = *reinterpret_cast<const bf16x8*>(Ks + KSWZ(r32, cb));
    const bf16x8 b1 = *reinterpret_cast<const bf16x8*>(Ks + KSWZ(32 + r32, cb));
    if (d0 == 0) { p0 = __builtin_amdgcn_mfma_f32_32x32x16_bf16(b0, qr[0], negm, 0, 0, 0); p1 = __builtin_amdgcn_mfma_f32_32x32x16_bf16(b1, qr[0], negm, 0, 0, 0); }
    else { p0 = __builtin_amdgcn_mfma_f32_32x32x16_bf16(b0, qr[d0], p0, 0, 0, 0); p1 = __builtin_amdgcn_mfma_f32_32x32x16_bf16(b1, qr[d0], p1, 0, 0, 0); } }
}
__device__ __forceinline__ int v_st(int k, int c) { const int kk = (k & ~0xC) | ((k & 4) << 1) | ((k & 8) >> 1); return ((kk >> 3) * 4 + (c >> 5)) * 512 + ((kk & 7) * 32 + (c & 31)) * 2; }
__device__ __forceinline__ int v_rd_base(int lane) { return ((lane & 3) << 3) | (((lane >> 2) & 3) << 6) | (((lane >> 4) & 1) << 5) | (((lane >> 5) & 1) << 8); }
constexpr int v_rd_off(int d0, int ks, int half) { return d0 * 512 + ks * 4096 + half * 2048; }
template <int OFF> __device__ __forceinline__ s16x4 tr_read(int vb) { s16x4 r; asm volatile("ds_read_b64_tr_b16 %0, %1 offset:%2" : "=&v"(r) : "v"(vb), "i"(OFF) : "memory"); return r; }
template <int D0> __device__ __forceinline__ void pv_one(f32x16& od, int vb, bf16x8 pa0, bf16x8 pa1, bf16x8 pa2, bf16x8 pa3) {
  const s16x4 l0 = tr_read<v_rd_off(D0, 0, 0)>(vb), h0 = tr_read<v_rd_off(D0, 0, 1)>(vb), l1 = tr_read<v_rd_off(D0, 1, 0)>(vb), h1 = tr_read<v_rd_off(D0, 1, 1)>(vb);
  const s16x4 l2 = tr_read<v_rd_off(D0, 2, 0)>(vb), h2 = tr_read<v_rd_off(D0, 2, 1)>(vb), l3 = tr_read<v_rd_off(D0, 3, 0)>(vb), h3 = tr_read<v_rd_off(D0, 3, 1)>(vb);
  asm volatile("s_waitcnt lgkmcnt(0)" ::: "memory"); SBAR();
#define PK(L, H) (bf16x8){L[0], L[1], L[2], L[3], H[0], H[1], H[2], H[3]}
  od = __builtin_amdgcn_mfma_f32_32x32x16_bf16(pa0, PK(l0, h0), od, 0, 0, 0);
  od = __builtin_amdgcn_mfma_f32_32x32x16_bf16(pa1, PK(l1, h1), od, 0, 0, 0);
  od = __builtin_amdgcn_mfma_f32_32x32x16_bf16(pa2, PK(l2, h2), od, 0, 0, 0);
  od = __builtin_amdgcn_mfma_f32_32x32x16_bf16(pa3, PK(l3, h3), od, 0, 0, 0);
#undef PK
}
__device__ __forceinline__ void pv_d0(f32x16* o, int vb, bf16x8 pa0, bf16x8 pa1, bf16x8 pa2, bf16x8 pa3) {
  const s16x4 l0 = tr_read<v_rd_off(0, 0, 0)>(vb), h0 = tr_read<v_rd_off(0, 0, 1)>(vb), l1 = tr_read<v_rd_off(0, 1, 0)>(vb), h1 = tr_read<v_rd_off(0, 1, 1)>(vb);
  const s16x4 l2 = tr_read<v_rd_off(0, 2, 0)>(vb), h2 = tr_read<v_rd_off(0, 2, 1)>(vb), l3 = tr_read<v_rd_off(0, 3, 0)>(vb), h3 = tr_read<v_rd_off(0, 3, 1)>(vb);
  const s16x4 m0 = tr_read<v_rd_off(1, 0, 0)>(vb), g0 = tr_read<v_rd_off(1, 0, 1)>(vb), m1 = tr_read<v_rd_off(1, 1, 0)>(vb), g1 = tr_read<v_rd_off(1, 1, 1)>(vb);
  const s16x4 m2 = tr_read<v_rd_off(1, 2, 0)>(vb), g2 = tr_read<v_rd_off(1, 2, 1)>(vb), m3 = tr_read<v_rd_off(1, 3, 0)>(vb), g3 = tr_read<v_rd_off(1, 3, 1)>(vb);
  asm volatile("s_waitcnt lgkmcnt(0)" ::: "memory"); SBAR();
#define PK(L, H) (bf16x8){L[0], L[1], L[2], L[3], H[0], H[1], H[2], H[3]}
  o[0] = __builtin_amdgcn_mfma_f32_32x32x16_bf16(pa0, PK(l0, h0), o[0], 0, 0, 0); o[1] = __builtin_amdgcn_mfma_f32_32x32x16_bf16(pa0, PK(m0, g0), o[1], 0, 0, 0);
  o[0] = __builtin_amdgcn_mfma_f32_32x32x16_bf16(pa1, PK(l1, h1), o[0], 0, 0, 0); o[1] = __builtin_amdgcn_mfma_f32_32x32x16_bf16(pa1, PK(m1, g1), o[1], 0, 0, 0);
  o[0] = __builtin_amdgcn_mfma_f32_32x32x16_bf16(pa2, PK(l2, h2), o[0], 0, 0, 0); o[1] = __builtin_amdgcn_mfma_f32_32x32x16_bf16(pa2, PK(m2, g2), o[1], 0, 0, 0);
  o[0] = __builtin_amdgcn_mfma_f32_32x32x16_bf16(pa3, PK(l3, h3), o[0], 0, 0, 0); o[1] = __builtin_amdgcn_mfma_f32_32x32x16_bf16(pa3, PK(m3, g3), o[1], 0, 0, 0);
#undef PK
}

__device__ __forceinline__ void attn_unit(const bf16_t* __restrict__ Qb, const bf16_t* __restrict__ KN, const bf16_t* __restrict__ KR, const bf16_t* __restrict__ VV, bf16_t* __restrict__ Ob, int b, char* lds, int tid) {
  const int wid = tid >> 6, lane = tid & 63, r32 = lane & 31, hi = lane >> 5;
  char* V_lds = lds; char* K_lds = lds + 3 * SHM_V;
  float* ws = (float*)(lds + 3 * SHM_V + 3 * SHM_K) + wid * 64; float* li_l = ws; float* al_l = ws + 32;
  float m_reg = 0.f, l_reg = 0; f32x16 o[2] = {}; bf16x8 qr[6]; f32x16 negm = {};
  const bf16_t* Qw = Qb + (long)(wid * QBLK + r32) * QW + hi * 8;
#pragma unroll
  for (int d0 = 0; d0 < 6; ++d0) qr[d0] = __builtin_nontemporal_load(reinterpret_cast<const bf16x8*>(Qw + d0 * 16));
  const int srow = tid >> 3, sch = tid & 7;
  const int rrow = (tid & 255) >> 2, rch = tid & 3;
  const int vst = v_st(srow, sch * 8), kst = KSWZ(srow, sch * 16), krst = KSWZ(rrow, 128 + rch * 16);
  const int vb0 = (int)(uintptr_t)V_lds + v_rd_base(lane);
  struct { bf16x8 vs, kn, kr; } sr_[2];
#define ROWBASE(j) ((j) < 64 ? (long)b * SEQ + (long)(j) * 64 : (long)RL + (long)b * LC + (long)((j) - 64) * 64)
#define SLOAD(i, j) do { const long rb_ = ROWBASE(j); sr_[i].vs = *reinterpret_cast<const bf16x8*>(VV + (rb_ + srow) * KVW + sch * 8); \
    sr_[i].kn = *reinterpret_cast<const bf16x8*>(KN + (rb_ + srow) * KVW + sch * 8); sr_[i].kr = *reinterpret_cast<const bf16x8*>(KR + (rb_ + rrow) * NPROJ + rch * 8); } while (0)
#define SWRITE(bb, i) do { *(bf16x8*)(V_lds + (bb) * SHM_V + vst) = sr_[i].vs; *(bf16x8*)(K_lds + (bb) * SHM_K + kst) = sr_[i].kn; \
    if (wid < 4) *(bf16x8*)(K_lds + (bb) * SHM_K + krst) = sr_[i].kr; } while (0)
#define SWAIT() asm volatile("s_waitcnt vmcnt(3)" ::: "memory")
#define RESC(a) do { if (__any((a) < 1.f)) { if (hi == 0) al_l[r32] = (a); asm volatile("s_waitcnt lgkmcnt(0)" ::: "memory"); \
    _Pragma("unroll") for (int d = 0; d < 2; ++d) _Pragma("unroll") for (int r = 0; r < 16; ++r) o[d][r] *= al_l[crow(r, hi)]; } } while (0)
  f32x16 pA0, pA1, pB0, pB1; float alA, alB; bf16x8 pa0, pa1, pa2, pa3; constexpr int NT = (SEQ + LC) / KVBLK;
  if (wid >= 4) __builtin_amdgcn_s_setprio(1);
  int cur = 1, prev = 0, nxt = 2;
  SLOAD(0, 0); SLOAD(1, 1); asm volatile("s_waitcnt vmcnt(0)" ::: "memory"); SWRITE(0, 0); SWRITE(1, 1); SLOAD(0, 2); SLOAD(1, 3); __syncthreads();
  qkt(pA0, pA1, K_lds, qr, negm, r32, hi); partialSM<true>(pA0, pA1, m_reg, negm, alA);
#define HALFSTEP(PX0, PX1, PP0, PP1, ALX, ALP, STG, T) do { \
    __syncthreads(); \
    SBAR(); qkt(PX0, PX1, K_lds + cur * SHM_K, qr, negm, r32, hi); \
    finishSM(PP0, PP1, ALP, l_reg, pa0, pa1, pa2, pa3); SBAR(); \
    if ((T) + 1 < NT) { SWAIT(); SWRITE(nxt, STG); if ((T) + 3 < NT) SLOAD(STG, (T) + 3); } SBAR(); \
    pv_d0(o, vb0 + prev * SHM_V, pa0, pa1, pa2, pa3); partialSM<false>(PX0, PX1, m_reg, negm, ALX); \
    RESC(ALX); { const int t_ = prev; prev = cur; cur = nxt; nxt = t_; } } while (0)
  for (int t = 1; t + 1 < NT; t += 2) {
    HALFSTEP(pB0, pB1, pA0, pA1, alB, alA, 0, t);
    HALFSTEP(pA0, pA1, pB0, pB1, alA, alB, 1, t + 1);
  }
  HALFSTEP(pB0, pB1, pA0, pA1, alB, alA, 0, NT - 1);
  finishSM(pB0, pB1, alB, l_reg, pa0, pa1, pa2, pa3); SBAR();
  pv_d0(o, vb0 + prev * SHM_V, pa0, pa1, pa2, pa3);
#undef HALFSTEP
  if (hi == 0) li_l[r32] = l_reg; asm volatile("s_waitcnt lgkmcnt(0)" ::: "memory");
  float rli[16];
#pragma unroll
  for (int r = 0; r < 16; ++r) rli[r] = __builtin_amdgcn_rcpf(li_l[crow(r, hi)]);
  bf16_t* Ow = Ob + (long)(wid * QBLK) * D;
#pragma unroll
  for (int r = 0; r < 16; ++r) { const int orow = crow(r, hi);
#pragma unroll
    for (int d0 = 0; d0 < 2; ++d0) Ow[(long)orow * D + d0 * 32 + r32] = f2bf(o[d0][r] * rli[r]); }
  __builtin_amdgcn_s_setprio(0);
  __syncthreads();
#undef ROWBASE
#undef SLOAD
#undef SWRITE
#undef SWAIT
#undef RESC
}
#undef KSWZ
#undef SBAR
}


__device__ __forceinline__ float lg2_of(float e) { return log1pf(-exp2f(-e)) * 1.4426950408889634f; }
namespace ret {
using att::bf16x8; using att::s16x4; using att::f32x16; using att::v_st; using att::v_rd_base; using att::v_rd_off; using att::tr_read; using att::crow; using att::cvtpk;
constexpr int TB = 16384;
__device__ __forceinline__ bf16x8 scale8(bf16x8 x, float z) {
    const u32x4 w = __builtin_bit_cast(u32x4, x); u32x4 o;
    o.x = cvtpk(__uint_as_float(w.x << 16) * z, __uint_as_float(w.x & 0xffff0000u) * z); o.y = cvtpk(__uint_as_float(w.y << 16) * z, __uint_as_float(w.y & 0xffff0000u) * z);
    o.z = cvtpk(__uint_as_float(w.z << 16) * z, __uint_as_float(w.z & 0xffff0000u) * z); o.w = cvtpk(__uint_as_float(w.w << 16) * z, __uint_as_float(w.w & 0xffff0000u) * z);
    return __builtin_bit_cast(bf16x8, o);
}
#define RET_PK(L, H) (bf16x8){L[0], L[1], L[2], L[3], H[0], H[1], H[2], H[3]}
__device__ __forceinline__ void tt_mma(f32x16& acc, int va, int vb) {
    const s16x4 al0 = tr_read<v_rd_off(0, 0, 0)>(va), ah0 = tr_read<v_rd_off(0, 0, 1)>(va), al1 = tr_read<v_rd_off(0, 1, 0)>(va), ah1 = tr_read<v_rd_off(0, 1, 1)>(va);
    const s16x4 al2 = tr_read<v_rd_off(0, 2, 0)>(va), ah2 = tr_read<v_rd_off(0, 2, 1)>(va), al3 = tr_read<v_rd_off(0, 3, 0)>(va), ah3 = tr_read<v_rd_off(0, 3, 1)>(va);
    const s16x4 bl0 = tr_read<v_rd_off(0, 0, 0)>(vb), bh0 = tr_read<v_rd_off(0, 0, 1)>(vb), bl1 = tr_read<v_rd_off(0, 1, 0)>(vb), bh1 = tr_read<v_rd_off(0, 1, 1)>(vb);
    const s16x4 bl2 = tr_read<v_rd_off(0, 2, 0)>(vb), bh2 = tr_read<v_rd_off(0, 2, 1)>(vb), bl3 = tr_read<v_rd_off(0, 3, 0)>(vb), bh3 = tr_read<v_rd_off(0, 3, 1)>(vb);
    asm volatile("s_waitcnt lgkmcnt(0)" ::: "memory"); __builtin_amdgcn_sched_barrier(0);
    acc = __builtin_amdgcn_mfma_f32_32x32x16_bf16(RET_PK(al0, ah0), RET_PK(bl0, bh0), acc, 0, 0, 0);
    acc = __builtin_amdgcn_mfma_f32_32x32x16_bf16(RET_PK(al1, ah1), RET_PK(bl1, bh1), acc, 0, 0, 0);
    acc = __builtin_amdgcn_mfma_f32_32x32x16_bf16(RET_PK(al2, ah2), RET_PK(bl2, bh2), acc, 0, 0, 0);
    acc = __builtin_amdgcn_mfma_f32_32x32x16_bf16(RET_PK(al3, ah3), RET_PK(bl3, bh3), acc, 0, 0, 0);
}
__device__ __forceinline__ void scan_seq(const bf16_t* __restrict__ proj, bf16_t* __restrict__ rstT, int b, int h, int dir, float lg2, char* lds, int tid) {
    const int wid = tid >> 6, lane = tid & 63, r32 = lane & 31, hi = lane >> 5;
    const float g128 = __builtin_amdgcn_exp2f(lg2 * 128.f);
    const int key0 = tid >> 3, key1 = 64 + (tid >> 3), ch = tid & 7;
    const float z0 = __builtin_amdgcn_exp2f(lg2 * (float)(dir ? key0 : 127 - key0)), z1 = __builtin_amdgcn_exp2f(lg2 * (float)(dir ? key1 : 127 - key1));
    const int st = v_st(tid >> 3, ch * 8);
    char* KI = lds; char* VI = lds + 4 * TB;
    const int mt = (wid >> 1) & 1, nt = wid & 1;
    const int vaK = (int)(uintptr_t)KI + v_rd_base(lane) + mt * 512, vbV = (int)(uintptr_t)VI + v_rd_base(lane) + nt * 512;
    f32x16 acc = {};
    bf16x8 k0a, k1a, v0a, v1a, k0b, k1b, v0b, v1b, k0c, k1c, v0c, v1c, k0d, k1d, v0d, v1d;
#define RROW(ck) ((ck) < 2 ? (long)RL + (long)b * LC + (long)(dir ? 1 - (ck) : (ck)) * 128 : (long)b * SEQ + (long)(dir ? NCH - 1 - ((ck) - 2) : (ck) - 2) * 128)
#define RLOAD(S, ck) do { const bf16_t* p_ = proj + RROW(ck) * NPROJ + h * 64 + ch * 8; k0##S = *(const bf16x8*)(p_ + (long)key0 * NPROJ + PC_RK); k1##S = *(const bf16x8*)(p_ + (long)key1 * NPROJ + PC_RK); \
        v0##S = *(const bf16x8*)(p_ + (long)key0 * NPROJ + PC_RV); v1##S = *(const bf16x8*)(p_ + (long)key1 * NPROJ + PC_RV); } while (0)
#define RWRITE(S, bb) do { *(bf16x8*)(KI + ((bb) * 2 + 0) * TB + st) = scale8(k0##S, z0); *(bf16x8*)(KI + ((bb) * 2 + 1) * TB + st) = scale8(k1##S, z1); \
        *(bf16x8*)(VI + ((bb) * 2 + 0) * TB + st) = v0##S; *(bf16x8*)(VI + ((bb) * 2 + 1) * TB + st) = v1##S; } while (0)
#define RCOMP(ck, bb) do { if (wid < 4) { \
            if ((ck) >= 2) { const int n = dir ? NCH - 1 - ((ck) - 2) : (ck) - 2; bf16_t* o = rstT + (size_t)n * 4096 + (size_t)(32 * nt + r32) * 64 + 32 * mt + 4 * hi; \
                _Pragma("unroll") for (int g = 0; g < 4; ++g) { u32x2 w; w.x = cvtpk(acc[4 * g], acc[4 * g + 1]); w.y = cvtpk(acc[4 * g + 2], acc[4 * g + 3]); *(u32x2*)(o + 8 * g) = w; } } \
            _Pragma("unroll") for (int r = 0; r < 16; ++r) acc[r] *= g128; \
            tt_mma(acc, vaK + ((bb) * 2 + 0) * TB, vbV + ((bb) * 2 + 0) * TB); \
            tt_mma(acc, vaK + ((bb) * 2 + 1) * TB, vbV + ((bb) * 2 + 1) * TB); } } while (0)
    constexpr int NCK = 2 + NCH;
#define RSTEP(ck, S) do { RCOMP(ck, (ck) & 1); if ((ck) + 1 < NCK) { RWRITE(S, ((ck) + 1) & 1); } if ((ck) + 5 < NCK) RLOAD(S, (ck) + 5); asm volatile("s_waitcnt lgkmcnt(0)\n\ts_barrier" ::: "memory"); } while (0)
    __syncthreads();
    RLOAD(a, 0); RWRITE(a, 0); RLOAD(b, 1); RLOAD(c, 2); RLOAD(d, 3); RLOAD(a, 4); __syncthreads();
    for (int ck = 0; ck < 32; ck += 4) { RSTEP(ck, b); RSTEP(ck + 1, c); RSTEP(ck + 2, d); RSTEP(ck + 3, a); }
    RSTEP(32, b); RSTEP(33, c);
#undef RSTEP
#undef RCOMP
#undef RROW
#undef RLOAD
#undef RWRITE
}

__device__ __forceinline__ int vc_st(int k, int c) { const int kk = (k & ~0xC) | ((k & 4) << 1) | ((k & 8) >> 1); return ((kk >> 3) * 2 + (c >> 5)) * 512 + ((kk & 7) * 32 + (c & 31)) * 2; }
constexpr int vc_rd_off(int ks, int half) { return ks * 2048 + half * 1024; }
constexpr int RBUF = 32768;
struct RetUnit { int b, h, n; };
template <class UF>
__device__ __forceinline__ void ret_group(const bf16_t* __restrict__ proj, const bf16_t* __restrict__ rst, const float* __restrict__ g_ret, const float* __restrict__ exp_f, const float* __restrict__ exp_b,
                                          bf16_t* __restrict__ mix, int nunits, UF unit_of, char* gl, int t4, int w4, int lane) {
    const int r32 = lane & 31, hi = lane >> 5, i = 32 * w4 + r32;
    bf16x8 qn[4];
    int soff[8];
#pragma unroll
    for (int q_ = 0; q_ < 8; ++q_) { const int s_ = ((4 * q_ + w4) * 64 + lane) & 1023;
        if (q_ < 4) { const int img = s_ >> 9, sub = (s_ & 511) >> 5, rw = (s_ & 31) >> 2, cc = s_ & 3; const int kk = (sub >> 1) * 8 + rw, key = (kk & ~0xC) | ((kk & 4) << 1) | ((kk & 8) >> 1);
            soff[q_] = (img * 64 + key) * NPROJ + PC_RV + (sub & 1) * 32 + cc * 8; }
        else { const int row = s_ >> 3, cp = s_ & 7, chn = cp ^ ((row >> 1) & 7); soff[q_] = row * NPROJ + PC_RK + chn * 8; } }
#define RG_LOAD(u, bb) do { const bf16_t* base_ = proj + ((long)(u).b * SEQ + (long)(u).n * 128) * NPROJ + (u).h * 64; \
        _Pragma("unroll") for (int q_ = 0; q_ < 8; ++q_) __builtin_amdgcn_global_load_lds((const unsigned*)(base_ + soff[q_]), (LAS unsigned*)((LAS char*)gl + (bb) * RBUF + (4 * q_ + w4) * 1024), 16, 0, 0); \
        const bf16_t* qp_ = base_ + (long)i * NPROJ + PC_RQ + hi * 8; \
        _Pragma("unroll") for (int ks_ = 0; ks_ < 4; ++ks_) qn[ks_] = *(const bf16x8*)(qp_ + ks_ * 16); } while (0)
    RetUnit u = unit_of(0);
    RG_LOAD(u, 0);
    bf16x8 q[4];
#pragma unroll
    for (int ks = 0; ks < 4; ++ks) q[ks] = qn[ks];
    asm volatile("s_waitcnt vmcnt(0)" ::: "memory"); __syncthreads();
    for (int ui = 0; ui < nunits; ++ui) {
        const int bb = ui & 1; const RetUnit un = unit_of(ui + 1 < nunits ? ui + 1 : ui);
        if (ui + 1 < nunits) RG_LOAD(un, bb ^ 1);
        const float lf = lg2_of(exp_f[u.h]), lb = lg2_of(exp_b[u.h]);
        int io = i, hio = hi; asm volatile("" : "+v"(io), "+v"(hio));
        const long row0 = (long)u.b * SEQ + (long)u.n * 128;
        const bf16_t* rf = rst + (size_t)(((u.b * NH + u.h) * 2 + 0) * NCH + u.n) * 4096 + (size_t)r32 * 64 + hi * 8;
        const bf16_t* rb = rst + (size_t)(((u.b * NH + u.h) * 2 + 1) * NCH + u.n) * 4096 + (size_t)r32 * 64 + hi * 8;
        bf16x8 rff[2][4], rbf[2][4];
#pragma unroll
        for (int et = 0; et < 2; ++et)
#pragma unroll
            for (int ks = 0; ks < 4; ++ks) { rff[et][ks] = *(const bf16x8*)(rf + et * 2048 + ks * 16); rbf[et][ks] = *(const bf16x8*)(rb + et * 2048 + ks * 16); }
        f32x16 acc[2] = {f32x16{}, f32x16{}};
        const char* kt = gl + bb * RBUF + 16384; const int vimg0 = (int)(uintptr_t)(gl + bb * RBUF) + v_rd_base(lane);
#pragma unroll
        for (int t = 0; t < 4; ++t) {
            f32x16 p = {};
            const int krow = 32 * t + r32;
#pragma unroll
            for (int ks = 0; ks < 4; ++ks) { const bf16x8 kf = *(const bf16x8*)(kt + krow * 128 + (((2 * ks + hi) ^ ((krow >> 1) & 7)) << 4)); p = __builtin_amdgcn_mfma_f32_32x32x16_bf16(kf, q[ks], p, 0, 0, 0); }
#pragma unroll
            for (int r = 0; r < 16; ++r) { const int j = 32 * t + (r & 3) + 8 * (r >> 2) + 4 * hio; const int dd = io - j; p[r] *= __builtin_amdgcn_exp2f(dd >= 0 ? lf * (float)dd : lb * (float)(-dd)); }
            bf16x8 pa0, pa1;
#define PK4(P, BASE, OUT) do { unsigned a0 = cvtpk(P[BASE + 0], P[BASE + 1]), a1 = cvtpk(P[BASE + 2], P[BASE + 3]);   \
    unsigned b0 = cvtpk(P[BASE + 4], P[BASE + 5]), b1 = cvtpk(P[BASE + 6], P[BASE + 7]);                              \
    auto r0 = __builtin_amdgcn_permlane32_swap(a0, b0, false, false); auto r1 = __builtin_amdgcn_permlane32_swap(a1, b1, false, false); \
    u32x4 w = {r0[0], r1[0], r0[1], r1[1]}; OUT = *reinterpret_cast<bf16x8*>(&w); } while (0)
            PK4(p, 0, pa0); PK4(p, 8, pa1);
#undef PK4
            const int vimg = vimg0 + (t >> 1) * 8192;
#pragma unroll
            for (int et = 0; et < 2; ++et) {
                s16x4 l0, h0, l1, h1;
                if ((t & 1) == 0) { l0 = tr_read<vc_rd_off(0, 0)>(vimg + et * 512); h0 = tr_read<vc_rd_off(0, 1)>(vimg + et * 512); l1 = tr_read<vc_rd_off(1, 0)>(vimg + et * 512); h1 = tr_read<vc_rd_off(1, 1)>(vimg + et * 512); }
                else { l0 = tr_read<vc_rd_off(2, 0)>(vimg + et * 512); h0 = tr_read<vc_rd_off(2, 1)>(vimg + et * 512); l1 = tr_read<vc_rd_off(3, 0)>(vimg + et * 512); h1 = tr_read<vc_rd_off(3, 1)>(vimg + et * 512); }
                asm volatile("s_waitcnt lgkmcnt(0)" ::: "memory"); __builtin_amdgcn_sched_barrier(0);
                acc[et] = __builtin_amdgcn_mfma_f32_32x32x16_bf16(RET_PK(l0, h0), pa0, acc[et], 0, 0, 0);
                acc[et] = __builtin_amdgcn_mfma_f32_32x32x16_bf16(RET_PK(l1, h1), pa1, acc[et], 0, 0, 0);
            }
            asm volatile("" ::: "memory");
        }
        const float xf = __builtin_amdgcn_exp2f(lf * (float)(i + 1)), xb = __builtin_amdgcn_exp2f(lb * (float)(128 - i));
        const bf16_t* gp = proj + (row0 + i) * NPROJ + PC_RG + u.h * 64; bf16_t* op = mix + (row0 + i) * D + 512 + u.h * 64; const float* gr = g_ret + u.h * 64;
        u32x2 gwv[2][4];
#pragma unroll
        for (int et = 0; et < 2; ++et)
#pragma unroll
            for (int g = 0; g < 4; ++g) gwv[et][g] = *(const u32x2*)(gp + 32 * et + 8 * g + 4 * hi);
        bf16x8 qf[4], qbk[4];
#pragma unroll
        for (int ks = 0; ks < 4; ++ks) { qf[ks] = scale8(q[ks], xf); qbk[ks] = scale8(q[ks], xb); }
#pragma unroll
        for (int et = 0; et < 2; ++et) {
#pragma unroll
            for (int ks = 0; ks < 4; ++ks) acc[et] = __builtin_amdgcn_mfma_f32_32x32x16_bf16(rff[et][ks], qf[ks], acc[et], 0, 0, 0);
#pragma unroll
            for (int ks = 0; ks < 4; ++ks) acc[et] = __builtin_amdgcn_mfma_f32_32x32x16_bf16(rbf[et][ks], qbk[ks], acc[et], 0, 0, 0); }
        float s1 = 0.f;
#pragma unroll
        for (int et = 0; et < 2; ++et)
#pragma unroll
            for (int r = 0; r < 16; ++r) s1 += acc[et][r];
        { auto rr = __builtin_amdgcn_permlane32_swap(__float_as_uint(s1), __float_as_uint(s1), false, false); s1 = __uint_as_float(rr[0]) + __uint_as_float(rr[1]); }
        const float mu = s1 * (1.f / 64.f); float s2 = 0.f;
#pragma unroll
        for (int et = 0; et < 2; ++et)
#pragma unroll
            for (int r = 0; r < 16; ++r) { const float dlt = acc[et][r] - mu; s2 += dlt * dlt; }
        { auto rr = __builtin_amdgcn_permlane32_swap(__float_as_uint(s2), __float_as_uint(s2), false, false); s2 = __uint_as_float(rr[0]) + __uint_as_float(rr[1]); }
        const float rs = 1.f / sqrtf(s2 * (1.f / 64.f) + EPS);
#pragma unroll
        for (int et = 0; et < 2; ++et)
#pragma unroll
            for (int g = 0; g < 4; ++g) { const int e = 32 * et + 8 * g + 4 * hi; const u32x2 gw = gwv[et][g]; const f32x4 gg = *(const f32x4*)(gr + e);
                const float o0 = (acc[et][4 * g] - mu) * rs * gg.x * __uint_as_float(gw.x << 16), o1 = (acc[et][4 * g + 1] - mu) * rs * gg.y * __uint_as_float(gw.x & 0xffff0000u);
                const float o2 = (acc[et][4 * g + 2] - mu) * rs * gg.z * __uint_as_float(gw.y << 16), o3 = (acc[et][4 * g + 3] - mu) * rs * gg.w * __uint_as_float(gw.y & 0xffff0000u);
                u32x2 w; w.x = cvtpk(o0, o1); w.y = cvtpk(o2, o3); *(u32x2*)(op + e) = w; }
        if (ui + 1 < nunits) {
#pragma unroll
            for (int ks = 0; ks < 4; ++ks) q[ks] = qn[ks]; }
        u = un;
        asm volatile("s_waitcnt vmcnt(0)" ::: "memory"); __syncthreads();
    }
#undef RG_LOAD
}
#undef RET_PK
}

__device__ __forceinline__ void p4_attn(const Ctx& c, float* lds) {
    const int G = (int)gridDim.x, bx = (int)blockIdx.x; const int vcu = (G % 8 == 0) ? (bx % 8) * (G / 8) + bx / 8 : bx;
    for (int unit = vcu; unit < NB * NH * 16; unit += G) {
        const int qblk = unit & 15, h = (unit >> 4) & 7, b = unit >> 7;
        att::attn_unit(c.qb() + (size_t)(b * SEQ + qblk * 256) * QW + h * 96, c.kvb() + h * 128, c.proj() + PC_KR, c.kvb() + h * 128 + 64,
                       c.mix() + (size_t)(b * SEQ + qblk * 256) * D + h * 64, b, (char*)lds, c.tid);
    }
}
__device__ __forceinline__ void p3c_scan(const Ctx& c, float* lds) {
    const int bx = (int)blockIdx.x;
    for (int seq = bx >> 1; seq < NB * NH * 2 && (bx & 1) == 0; seq += (int)gridDim.x >> 1) {
        const int dir = seq & 1, h = (seq >> 1) & 7, b = seq >> 4;
        const float lg2 = lg2_of(dir ? c.exp_b()[h] : c.exp_f()[h]);
        ret::scan_seq(c.proj(), c.rst() + (size_t)((b * NH + h) * 2 + dir) * NCH * 4096, b, h, dir, lg2, (char*)lds, c.tid);
    }
    __syncthreads();
    {
      unsigned* qctr = (unsigned*)(c.wsb() + WS_CTL) + 2048; int* qslot = (int*)(lds + 8 * 64 * 65 + 640);
      const int first = (int)gridDim.x == 256 ? QSTATIC : 0;
      int nq = 0; if (c.tid == 0) nq = first + (int)__hip_atomic_fetch_add(qctr, 1u, __ATOMIC_RELAXED, __HIP_MEMORY_SCOPE_AGENT);
      for (;;) { if (c.tid == 0) *qslot = nq;
          __syncthreads(); const int q = *qslot; __syncthreads();
          if (q >= EXP_STRIPS) break;
          if (c.tid == 0) nq = first + (int)__hip_atomic_fetch_add(qctr, 1u, __ATOMIC_RELAXED, __HIP_MEMORY_SCOPE_AGENT);
          expert_strip(c, lds, q); } }
    __syncthreads();
}
__device__ __forceinline__ void p4_ret(const Ctx& c, float* lds) {
    const int tid = c.tid, wid = tid >> 6, lane = tid & 63, grp = wid >> 2, w4 = wid & 3;
    const int G = (int)gridDim.x, bx = (int)blockIdx.x; const int vcu = (G % 8 == 0) ? (bx % 8) * (G / 8) + bx / 8 : bx;
    const int gid = vcu * 2 + grp, ngrp = 2 * G; const int total = NB * NH * NCH;
    const int nun = (total - gid + ngrp - 1) / ngrp;
    __syncthreads();
    ret::ret_group(c.proj(), c.rst(), c.g_ret(), c.exp_f(), c.exp_b(), c.mix(), nun,
                   [gid, ngrp](int k) { const int unit = gid + ngrp * k; return ret::RetUnit{unit >> 8, (unit >> 5) & 7, unit & 31}; }, (char*)lds + grp * 2 * ret::RBUF, tid & 255, w4, lane);
}

struct EpiRes {
    static constexpr bool PERM = true;
    const float* x; bf16_t* out; const float* modv; float* part;
    __device__ __forceinline__ void operator()(const f32x4 (&acc)[2][2][4][2], const pg8::Unit& u, int wr, int wc, int fr, int fq) const {
        const int row0 = u.pm * 256 + wr * 64 + fr, col0 = u.pn * 256 + wc * 32 + 8 * fq; const int b = (u.pm * 256) / SEQ;
        f32x4 ga[2][2];
#pragma unroll
        for (int bj = 0; bj < 2; ++bj) { ga[bj][0] = *(const f32x4*)(modv + b * 6144 + 2048 + col0 + bj * 128); ga[bj][1] = *(const f32x4*)(modv + b * 6144 + 2048 + col0 + bj * 128 + 4); }
#pragma unroll
        for (int ai = 0; ai < 2; ++ai) {
            f32x4 xv[4][2][2];
#pragma unroll
            for (int m = 0; m < 4; ++m)
#pragma unroll
                for (int bj = 0; bj < 2; ++bj) { const float* xr = x + (size_t)(row0 + ai * 128 + m * 16) * D + col0 + bj * 128; xv[m][bj][0] = __builtin_nontemporal_load((const f32x4*)xr); xv[m][bj][1] = __builtin_nontemporal_load((const f32x4*)(xr + 4)); }
#pragma unroll
            for (int m = 0; m < 4; ++m) { float ssq = 0.f, mx = 0.f;
#pragma unroll
                for (int bj = 0; bj < 2; ++bj) { const f32x4 y0 = xv[m][bj][0] + ga[bj][0] * acc[ai][bj][m][0], y1 = xv[m][bj][1] + ga[bj][1] * acc[ai][bj][m][1];
                    const float o[8] = {y0.x, y0.y, y0.z, y0.w, y1.x, y1.y, y1.z, y1.w}; store8_bf16(out + (size_t)(row0 + ai * 128 + m * 16) * D + col0 + bj * 128, o);
                    const f32x4 tm = __builtin_elementwise_max(__builtin_elementwise_abs(y0), __builtin_elementwise_abs(y1)), sq = y0 * y0 + y1 * y1;
                    ssq += (sq.x + sq.y) + (sq.z + sq.w); mx = fmaxf(mx, fmaxf(fmaxf(tm.x, tm.y), fmaxf(tm.z, tm.w))); }
                ssq += __shfl_xor(ssq, 16); ssq += __shfl_xor(ssq, 32); mx = fmaxf(mx, __shfl_xor(mx, 16)); mx = fmaxf(mx, __shfl_xor(mx, 32));
                if (fq == 0) { float* pp = part + (size_t)(row0 + ai * 128 + m * 16) * 32 + u.pn * 4 + wc; pp[0] = ssq; pp[16] = mx; } }
            asm volatile("" ::: "memory");
        }
    }
};
__device__ __forceinline__ void p6_wo(const Ctx& c, float* lds) {
    pg8::Gemm g{c.mix(), c.wo_t(), D, D, D, nullptr, 0, 0, 0};
    pg8::StaticOrder S; S.init(RL, D, (int)gridDim.x, (int)blockIdx.x);
    EpiRes E{c.x(), c.x1b(), c.modv(), c.rpart()};
    pg8::gemm_phase((LAS unsigned char*)lds, g, S, E, c.tid);
}
__device__ __forceinline__ void p7_norm_router(const Ctx& c, float* lds) {
    typedef short bf16x8_t __attribute__((ext_vector_type(8)));
    constexpr int WP = 1032;
    bf16_t* whi = (bf16_t*)lds; bf16_t* wlo = whi + 16 * WP; float* gsl = (float*)(wlo + 16 * WP); float* shl = gsl + 1024; float* gpl = shl + 1024;
    const int G = (int)gridDim.x, bx = (int)blockIdx.x;
    bool first = true;
    for (int blk = bx; blk < RL / 128; blk += G) {
        const int b = (blk * 128) / SEQ; const float* md = c.modv() + b * 6144;
        const int fr = c.lane & 15, fq = c.lane >> 4; const int row = blk * 128 + c.wave * 16 + fr;
        const bf16_t* xr2 = c.x1b() + (size_t)row * D + 16 * fq;
        float wv[32];
        if (first) {
#pragma unroll
            for (int it = 0; it < 32; ++it) wv[it] = c.w_router()[c.tid + 512 * it]; }
        u32x4 xw[32];
#pragma unroll
        for (int i = 0; i < 16; ++i) xw[i] = *(const u32x4*)(xr2 + 64 * (i >> 1) + 8 * (i & 1));
        asm volatile("s_waitcnt lgkmcnt(0)\n\ts_barrier" ::: "memory");
        for (int k = c.tid; k < 1024; k += 512) { gsl[k] = c.g_ffn()[k] * (1.f + md[4096 + k]); shl[k] = md[3072 + k]; }
        if (first) { int tl = c.tid; asm volatile("" : "+v"(tl));
#pragma unroll
            for (int it = 0; it < 32; ++it) { const int i = tl + 512 * it, k = i >> 4, e = i & 15; const float w = wv[it]; const bf16_t h = f2bf(w); whi[e * WP + k] = h; wlo[e * WP + k] = f2bf(w - bf2f(h)); }
            first = false; }
#pragma unroll
        for (int i = 16; i < 32; ++i) xw[i] = *(const u32x4*)(xr2 + 64 * (i >> 1) + 8 * (i & 1));
        asm volatile("s_waitcnt lgkmcnt(0)\n\ts_barrier" ::: "memory");
        if (c.tid < 16) { float gm = 0.f; const int c0_ = (c.tid >> 2) * 256 + (c.tid & 3) * 32;
            for (int k = 0; k < 32; ++k) gm = fmaxf(gm, fmaxf(fabsf(gsl[c0_ + k]), fabsf(gsl[c0_ + 128 + k])));
            gpl[c.tid] = gm; }
        asm volatile("s_waitcnt lgkmcnt(0)\n\ts_barrier" ::: "memory");
        const LAS float* gs_l = (const LAS float*)gsl; const LAS float* sh_l = (const LAS float*)shl;
        float shm = 0.f;
#pragma unroll
        for (int i = 0; i < 4; ++i) { const f32x4 s4 = *(const LAS f32x4*)(sh_l + 4 * c.lane + 256 * i); shm = fmaxf(fmaxf(shm, fmaxf(fabsf(s4.x), fabsf(s4.y))), fmaxf(fabsf(s4.z), fabsf(s4.w))); }
#pragma unroll
        for (int o = 1; o < 64; o <<= 1) shm = fmaxf(shm, __shfl_xor(shm, o));
        const f32x4 ps = *(const f32x4*)(c.rpart() + (size_t)row * 32 + 4 * fq), pm4 = *(const f32x4*)(c.rpart() + (size_t)row * 32 + 16 + 4 * fq);
        float ss = (ps.x + ps.y) + (ps.z + ps.w), mx; { const f32x4 gq = *(const LAS f32x4*)((const LAS float*)gpl + 4 * fq); mx = fmaxf(fmaxf(pm4.x * gq.x, pm4.y * gq.y), fmaxf(pm4.z * gq.z, pm4.w * gq.w)) * 1.00390625f; }
        ss += __shfl_xor(ss, 16); ss += __shfl_xor(ss, 32); mx = fmaxf(mx, __shfl_xor(mx, 16)); mx = fmaxf(mx, __shfl_xor(mx, 32));
        const float rinv = 1.f / sqrtf(ss * (1.f / D) + EPS);
        const float bnd = fmaxf(rinv * mx + shm, 1e-30f), qs = 127.f / bnd;
        if (fq == 0) c.sa()[row] = bnd * (1.f / 127.f);
        f32x4 acc = {0.f, 0.f, 0.f, 0.f};
        const LAS bf16_t* wh_l = (const LAS bf16_t*)whi + fr * WP + 16 * fq; const LAS bf16_t* wl_l = (const LAS bf16_t*)wlo + fr * WP + 16 * fq;
        signed char* hq = c.h2q() + (size_t)row * D + 16 * fq;
#pragma unroll
        for (int ks2 = 0; ks2 < 16; ++ks2) { u32x4 qo;
#pragma unroll
            for (int hf = 0; hf < 2; ++hf) { const int ko = 64 * ks2 + 8 * hf; const u32x4 w = xw[2 * ks2 + hf];
                const f32x4 g0 = *(const LAS f32x4*)(gs_l + 16 * fq + ko), g1 = *(const LAS f32x4*)(gs_l + 16 * fq + ko + 4), s0 = *(const LAS f32x4*)(sh_l + 16 * fq + ko), s1 = *(const LAS f32x4*)(sh_l + 16 * fq + ko + 4);
                float h[8];
                h[0] = __uint_as_float(w.x << 16) * rinv * g0.x + s0.x; h[1] = __uint_as_float(w.x & 0xffff0000u) * rinv * g0.y + s0.y; h[2] = __uint_as_float(w.y << 16) * rinv * g0.z + s0.z; h[3] = __uint_as_float(w.y & 0xffff0000u) * rinv * g0.w + s0.w;
                h[4] = __uint_as_float(w.z << 16) * rinv * g1.x + s1.x; h[5] = __uint_as_float(w.z & 0xffff0000u) * rinv * g1.y + s1.y; h[6] = __uint_as_float(w.w << 16) * rinv * g1.z + s1.z; h[7] = __uint_as_float(w.w & 0xffff0000u) * rinv * g1.w + s1.w;
                const unsigned qa = q8pack(h[0], h[1], h[2], h[3], qs), qb = q8pack(h[4], h[5], h[6], h[7], qs);
                if (hf == 0) { qo.x = qa; qo.y = qb; } else { qo.z = qa; qo.w = qb; }
                u32x4 hi; hi.x = pk2(h[0], h[1]); hi.y = pk2(h[2], h[3]); hi.z = pk2(h[4], h[5]); hi.w = pk2(h[6], h[7]);
                u32x4 lo; lo.x = pk2(h[0] - __uint_as_float(hi.x << 16), h[1] - __uint_as_float(hi.x & 0xffff0000u)); lo.y = pk2(h[2] - __uint_as_float(hi.y << 16), h[3] - __uint_as_float(hi.y & 0xffff0000u));
                lo.z = pk2(h[4] - __uint_as_float(hi.z << 16), h[5] - __uint_as_float(hi.z & 0xffff0000u)); lo.w = pk2(h[6] - __uint_as_float(hi.w << 16), h[7] - __uint_as_float(hi.w & 0xffff0000u));
                const bf16x8_t bh = *(const LAS bf16x8_t*)(wh_l + ko), bl = *(const LAS bf16x8_t*)(wl_l + ko);
                const bf16x8_t ah = __builtin_bit_cast(bf16x8_t, hi), al = __builtin_bit_cast(bf16x8_t, lo);
                acc = __builtin_amdgcn_mfma_f32_16x16x32_bf16(ah, bh, acc, 0, 0, 0);
                acc = __builtin_amdgcn_mfma_f32_16x16x32_bf16(al, bh, acc, 0, 0, 0);
                acc = __builtin_amdgcn_mfma_f32_16x16x32_bf16(ah, bl, acc, 0, 0, 0); }
            *(u32x4*)(hq + 64 * ks2) = qo;
            asm volatile("" ::: "memory"); }
        float ov[4];
#pragma unroll
        for (int i = 0; i < 4; ++i) { float mx = acc[i];
            mx = fmaxf(mx, __shfl_xor(mx, 1)); mx = fmaxf(mx, __shfl_xor(mx, 2)); mx = fmaxf(mx, __shfl_xor(mx, 4)); mx = fmaxf(mx, __shfl_xor(mx, 8));
            const float ex = __expf(acc[i] - mx); float den = ex;
            den += __shfl_xor(den, 1); den += __shfl_xor(den, 2); den += __shfl_xor(den, 4); den += __shfl_xor(den, 8);
            ov[i] = ex / den; }
        const int t0 = (blk * 128 + c.wave * 16 + 4 * fq) & (SEQ - 1);
        *(f32x4*)(c.aff() + (size_t)(b * NE + fr) * SEQ + t0) = (f32x4){ov[0], ov[1], ov[2], ov[3]};
    }
}
__device__ __forceinline__ int block_excl_scan(int v, int& tot, int* lw, int tid) {
    const int lane = tid & 63, wv = tid >> 6; int inc = v;
#pragma unroll
    for (int o = 1; o < 64; o <<= 1) { const int u = __shfl_up(inc, o); if (lane >= o) inc += u; }
    __syncthreads();
    if (lane == 63) lw[wv] = inc;
    __syncthreads();
    int base = 0; tot = 0;
#pragma unroll
    for (int w = 0; w < 8; ++w) { const int x = lw[w]; if (w < wv) base += x; tot += x; }
    return base + inc - v;
}
__device__ __forceinline__ void p8_topk(const Ctx& c, float* lds) {
    int* cnt = (int*)lds;
    int* lw = (int*)lds + 64;
    for (int unit = blockIdx.x; unit < NB * NE; unit += gridDim.x) {
        const int b = unit >> 4, e = unit & 15; const float* a = c.aff() + (size_t)unit * SEQ;
        const f32x4 v0 = *(const f32x4*)(a + 8 * c.tid), v1 = *(const f32x4*)(a + 8 * c.tid + 4);
        unsigned u[8] = {__float_as_uint(v0.x), __float_as_uint(v0.y), __float_as_uint(v0.z), __float_as_uint(v0.w), __float_as_uint(v1.x), __float_as_uint(v1.y), __float_as_uint(v1.z), __float_as_uint(v1.w)};
        __syncthreads();
        if (c.tid < 32) cnt[c.tid] = 0;
        __syncthreads();
        unsigned T = 0u;
        for (int bit = 30; bit >= 0; --bit) {
            const unsigned cand = T | (1u << bit); int cw = 0;
#pragma unroll
            for (int j = 0; j < 8; ++j) cw += __popcll(__ballot(u[j] >= cand));
            if (c.lane == 0) atomicAdd(&cnt[bit], cw);
            __syncthreads();
            if (cnt[bit] >= CAP) T = cand;
        }
        int ngt = 0, neq = 0;
#pragma unroll
        for (int j = 0; j < 8; ++j) { ngt += u[j] > T ? 1 : 0; neq += u[j] == T ? 1 : 0; }
        int tot_gt, tot_eq; const int eq_base = block_excl_scan(neq, tot_eq, lw, c.tid); (void)block_excl_scan(ngt, tot_gt, lw + 16, c.tid);
        const int need = CAP - tot_gt;
        bool sel[8]; int nsel = 0, eqc = eq_base;
#pragma unroll
        for (int j = 0; j < 8; ++j) { const bool isq = u[j] == T; sel[j] = u[j] > T || (isq && eqc < need); eqc += isq ? 1 : 0; nsel += sel[j] ? 1 : 0; }
        int tot_sel; int slot = block_excl_scan(nsel, tot_sel, lw + 32, c.tid);
        int iv[8];
#pragma unroll
        for (int j = 0; j < 8; ++j) { iv[j] = sel[j] ? slot : -1;
            if (sel[j]) { c.seli()[unit * CAP + slot] = b * SEQ + 8 * c.tid + j; c.selg()[unit * CAP + slot] = __uint_as_float(u[j]); c.sels()[unit * CAP + slot] = c.sa()[b * SEQ + 8 * c.tid + j]; ++slot; } }
#pragma unroll
        for (int j = 0; j < 8; ++j) c.inv()[(size_t)(b * SEQ + 8 * c.tid + j) * NE + e] = iv[j];
    }
    __syncthreads();
}
struct EpiGateUpQ {
    static constexpr bool PERM = true;
    unsigned char* act; const float* sels; const float* sw;
    __device__ __forceinline__ void operator()(const f32x4 (&acc)[2][2][4][2], const pg8::Unit& u, int wr, int wc, int fr, int fq) const {
        const int row0 = u.pm * 256 + wr * 64 + fr, col0 = u.pn * 256 + wc * 32 + 8 * fq; const float* swe = sw + ((u.pm >> 1) & 15) * 1536 + col0;
        float rs[8];
#pragma unroll
        for (int i = 0; i < 8; ++i) rs[i] = sels[row0 + (i >> 2) * 128 + (i & 3) * 16];
        const f32x4 sg0 = *(const f32x4*)swe, su0 = *(const f32x4*)(swe + 4), sg1 = *(const f32x4*)(swe + 128), su1 = *(const f32x4*)(swe + 132);
#pragma unroll
        for (int ai = 0; ai < 2; ++ai)
#pragma unroll
            for (int m = 0; m < 4; ++m) { const float r_ = rs[ai * 4 + m];
#pragma unroll
                for (int bj = 0; bj < 2; ++bj) { const f32x4 gt = acc[ai][bj][m][0] * (bj ? sg1 : sg0) * r_, up = acc[ai][bj][m][1] * (bj ? su1 : su0) * r_;
                    *(unsigned*)(act + (size_t)(row0 + ai * 128 + m * 16) * DE + ((col0 + bj * 128) >> 1)) = f8pack(silu_f(gt[0]) * up[0], silu_f(gt[1]) * up[1], silu_f(gt[2]) * up[2], silu_f(gt[3]) * up[3]); } }
    }
};
__device__ __forceinline__ void p9_gateup(const Ctx& c, float* lds) {
    pg8::Gemm g{(const bf16_t*)c.h2q(), (const bf16_t*)c.wgu_q(), D / 2, D / 2, D / 2, c.seli(), 1, 15, (size_t)1536 * 512};
    pg8::ExpertOrder S; S.init(NSLOT, 1536, (int)gridDim.x, (int)blockIdx.x);
    EpiGateUpQ E{(unsigned char*)c.actq(), c.sels(), c.swgu()};
    pg8::gemm_phase<1, true>((LAS unsigned char*)lds, g, S, E, c.tid);
}
struct EpiDownQ {
    static constexpr bool PERM = true;
    unsigned char* y8; float* ysc; const float* rsc; const float* sw;
    __device__ __forceinline__ void operator()(const f32x4 (&acc)[2][2][4][2], const pg8::Unit& u, int wr, int wc, int fr, int fq) const {
        const int row0 = u.pm * 256 + wr * 64 + fr, col0 = u.pn * 256 + wc * 32 + 8 * fq; const float* swe = sw + ((u.pm >> 1) & 15) * 1024 + col0;
        float gg[8];
#pragma unroll
        for (int i = 0; i < 8; ++i) gg[i] = rsc[row0 + (i >> 2) * 128 + (i & 3) * 16];
        const f32x4 s00 = *(const f32x4*)swe, s01 = *(const f32x4*)(swe + 4), s10 = *(const f32x4*)(swe + 128), s11 = *(const f32x4*)(swe + 132);
#pragma unroll
        for (int ai = 0; ai < 2; ++ai)
#pragma unroll
            for (int m = 0; m < 4; ++m) { const float g_ = gg[ai * 4 + m]; const int row = row0 + ai * 128 + m * 16;
                const f32x4 a0 = acc[ai][0][m][0] * s00 * g_, b0 = acc[ai][0][m][1] * s01 * g_, a1 = acc[ai][1][m][0] * s10 * g_, b1 = acc[ai][1][m][1] * s11 * g_;
                const f32x4 m4 = __builtin_elementwise_max(__builtin_elementwise_max(__builtin_elementwise_abs(a0), __builtin_elementwise_abs(b0)), __builtin_elementwise_max(__builtin_elementwise_abs(a1), __builtin_elementwise_abs(b1)));
                float mx = fmaxf(fmaxf(m4.x, m4.y), fmaxf(m4.z, m4.w)); mx = fmaxf(mx, __shfl_xor(mx, 16)); mx = fmaxf(mx, __shfl_xor(mx, 32));
                const float inv = mx > 0.f ? 448.f / mx : 0.f;
                u32x2 w0, w1; w0.x = f8pack(a0.x * inv, a0.y * inv, a0.z * inv, a0.w * inv); w0.y = f8pack(b0.x * inv, b0.y * inv, b0.z * inv, b0.w * inv);
                w1.x = f8pack(a1.x * inv, a1.y * inv, a1.z * inv, a1.w * inv); w1.y = f8pack(b1.x * inv, b1.y * inv, b1.z * inv, b1.w * inv);
                *(u32x2*)(y8 + (size_t)row * D + col0) = w0; *(u32x2*)(y8 + (size_t)row * D + col0 + 128) = w1;
                if (fq == 0) ysc[(size_t)row * 16 + u.pn * 4 + wc] = mx * (1.f / 448.f); }
    }
};
__device__ __forceinline__ void p10_down(const Ctx& c, float* lds) {
    pg8::Gemm g{(const bf16_t*)c.actq(), (const bf16_t*)c.wdn_q(), DE / 2, DE / 2, DE / 2, nullptr, 1, 15, (size_t)1024 * 384};
    pg8::ExpertOrder S; S.init(NSLOT, D, (int)gridDim.x, (int)blockIdx.x);
    EpiDownQ E{c.y8(), c.ysc(), c.selg(), c.swdn()};
    pg8::gemm_phase<2>((LAS unsigned char*)lds, g, S, E, c.tid);
}
__device__ __forceinline__ void p11_final(const Ctx& c) {
    for (int r0 = c.gw * 2; r0 < RL; r0 += c.ngw * 2) {
        const int b = r0 / SEQ;
        int sl[2]; f32x4 x1[2][4]; f32x4 acc[2][4];
#pragma unroll
        for (int q = 0; q < 2; ++q) { sl[q] = c.lane < NE ? c.inv()[(size_t)(r0 + q) * NE + c.lane] : -1;
#pragma unroll
            for (int j = 0; j < 4; ++j) { const u32x2 w = __builtin_nontemporal_load((const u32x2*)(c.x1b() + (size_t)(r0 + q) * D + 4 * c.lane + 256 * j));
                x1[q][j] = (f32x4){__uint_as_float(w.x << 16), __uint_as_float(w.x & 0xffff0000u), __uint_as_float(w.y << 16), __uint_as_float(w.y & 0xffff0000u)}; acc[q][j] = (f32x4){0.f, 0.f, 0.f, 0.f}; } }
#pragma unroll
        for (int q = 0; q < 2; ++q) {
            unsigned long long m = __ballot(sl[q] >= 0);
            while (m) { const int e = __builtin_ctzll(m); m &= m - 1; const int slot = __builtin_amdgcn_readlane(sl[q], e);
                const size_t yrow = (size_t)((b * NE + e) * CAP + slot); const unsigned char* yr = c.y8() + yrow * D; const float* ys = c.ysc() + yrow * 16 + ((c.lane & 31) >> 3);
                unsigned w[4]; float sc[4];
#pragma unroll
                for (int j = 0; j < 4; ++j) { w[j] = __builtin_nontemporal_load((const unsigned*)(yr + 4 * c.lane + 256 * j)); sc[j] = ys[4 * j]; }
#pragma unroll
                for (int j = 0; j < 4; ++j) { const auto lo = __builtin_amdgcn_cvt_pk_f32_fp8((int)w[j], false), hi = __builtin_amdgcn_cvt_pk_f32_fp8((int)w[j], true);
                    acc[q][j].x += lo[0] * sc[j]; acc[q][j].y += lo[1] * sc[j]; acc[q][j].z += hi[0] * sc[j]; acc[q][j].w += hi[1] * sc[j]; } } }
        const float* md = c.modv() + b * 6144 + 5120; float ss[2] = {0.f, 0.f};
#pragma unroll
        for (int j = 0; j < 4; ++j) { const int k = 4 * c.lane + 256 * j; const f32x4 ga = *(const f32x4*)(md + k);
#pragma unroll
            for (int q = 0; q < 2; ++q) { x1[q][j] = x1[q][j] + ga * acc[q][j]; ss[q] += x1[q][j].x * x1[q][j].x + x1[q][j].y * x1[q][j].y + x1[q][j].z * x1[q][j].z + x1[q][j].w * x1[q][j].w; } }
        const float ri0 = 1.f / sqrtf(wave_sum(ss[0]) * (1.f / D) + EPS), ri1 = 1.f / sqrtf(wave_sum(ss[1]) * (1.f / D) + EPS);
#pragma unroll
        for (int j = 0; j < 4; ++j) { const int k = 4 * c.lane + 256 * j; const f32x4 g = *(const f32x4*)(c.g_final() + k);
            __builtin_nontemporal_store(x1[0][j] * ri0 * g, (f32x4*)(c.out() + (size_t)r0 * D + k)); __builtin_nontemporal_store(x1[1][j] * ri1 * g, (f32x4*)(c.out() + (size_t)(r0 + 1) * D + k)); }
    }
}

#define XB_TMO      128
#define XB_XCNT(j)  (256  + 64 * (j))
#define XB_XSUB(j)  (1280 + 64 * (j))
#define XB_XGEN(j)  (2304 + 64 * (j))
#define XB_TOP      3328
#define XB_TOPGEN   3392
#define XCD_BAR_WORDS 3456
#define XB_SPIN_CAP (1u << 18)

__device__ __forceinline__ unsigned xb_ld(unsigned* p)              { return __hip_atomic_load(p, __ATOMIC_RELAXED, __HIP_MEMORY_SCOPE_AGENT); }
__device__ __forceinline__ unsigned xb_add(unsigned* p, unsigned v) { return __hip_atomic_fetch_add(p, v, __ATOMIC_RELAXED, __HIP_MEMORY_SCOPE_AGENT); }
__device__ __forceinline__ unsigned xb_xcc_id() { return (unsigned)__builtin_amdgcn_s_getreg((3 << 11) | 20) & 0xFu; }
#define XB_SPIN(cond, bar) do { unsigned _sp = 0; while (cond) { __builtin_amdgcn_s_sleep(1); \
    if ((++_sp & 255u) == 0u) { if (xb_ld(&(bar)[XB_TMO])) break; if (_sp > XB_SPIN_CAP) { atomicAdd(&(bar)[XB_TMO], 1u); break; } } } } while (0)

struct XcdBarrier {
    unsigned* bar; unsigned x;
    volatile LAS unsigned* st;
};
__device__ __forceinline__ XcdBarrier xcd_barrier_post(unsigned* bar, volatile LAS unsigned* st, bool t0) {
    XcdBarrier b; b.bar = bar; b.x = xb_xcc_id(); b.st = st;
    if (t0) (void)xb_add(&bar[XB_XCNT(b.x)], 1u);
    return b;
}
__device__ __forceinline__ void xcd_barrier_complete(unsigned* bar, unsigned x, unsigned& nloc, unsigned& nx) {
    const unsigned G = gridDim.x * gridDim.y * gridDim.z;
    unsigned sum, cnt, mine, sp = 0u;
    for (;;) {
        sum = 0u; cnt = 0u; mine = 0u;
#pragma unroll
        for (unsigned j = 0; j < 16; ++j) { const unsigned c = xb_ld(&bar[XB_XCNT(j)]); sum += c; cnt += (c > 0u) ? 1u : 0u; mine = (j == x) ? c : mine; }
        if (sum == G) break;
        __builtin_amdgcn_s_sleep(1);
        if ((++sp & 255u) == 0u) { if (xb_ld(&bar[XB_TMO])) break; if (sp > XB_SPIN_CAP) { atomicAdd(&bar[XB_TMO], 1u); break; } }
    }
    nloc = mine > 0u ? mine : 1u; nx = cnt > 0u ? cnt : 1u;
}
__device__ __forceinline__ void xcd_barrier(const XcdBarrier& b, bool t0) {
    asm volatile("s_waitcnt vmcnt(0)" ::: "memory");
    __syncthreads();
    if (t0) {
        unsigned* bar = b.bar;
        __builtin_amdgcn_s_waitcnt(0);
        unsigned nloc = b.st[0], nx = b.st[1];
        if (nloc == 0u) { xcd_barrier_complete(bar, b.x, nloc, nx); b.st[0] = nloc; b.st[1] = nx; }
        const unsigned old = xb_add(&bar[XB_XSUB(b.x)], 1u);
        const unsigned gen = old / nloc;
        if (old + 1u == (gen + 1u) * nloc) {
            __builtin_amdgcn_fence(__ATOMIC_RELEASE, "agent");
            asm volatile("s_waitcnt vmcnt(0)" ::: "memory");
            const unsigned og = xb_add(&bar[XB_TOP], 1u);
            const unsigned tg = og / nx;
            if (og + 1u == (tg + 1u) * nx) xb_add(&bar[XB_TOPGEN], 1u);
            else XB_SPIN(xb_ld(&bar[XB_TOPGEN]) == tg, bar);
            __builtin_amdgcn_fence(__ATOMIC_ACQUIRE, "agent");
            xb_add(&bar[XB_XGEN(b.x)], 1u);
            asm volatile("s_waitcnt vmcnt(0)" ::: "memory");
        } else {
            XB_SPIN(xb_ld(&bar[XB_XGEN(b.x)]) == gen, bar);
            __builtin_amdgcn_fence(__ATOMIC_ACQUIRE, "agent");
            asm volatile("s_waitcnt vmcnt(0)" ::: "memory");
        }
    }
    __syncthreads();
}

template <int PH0, int PH1> __global__ void __launch_bounds__(512, 2) fwd_kernel(Args args) {
    extern __shared__ __attribute__((aligned(16))) unsigned char lds_raw[];
    float* lds = (float*)lds_raw;
    volatile LAS unsigned* xbst = (volatile LAS unsigned*)((LAS unsigned char*)lds_raw + (LDS_BYTES - 16));
    const int wave_s = __builtin_amdgcn_readfirstlane((int)threadIdx.x >> 6);
#define TID_NOW() ([&]() { unsigned z_ = 0u; asm volatile("" : "+v"(z_)); return wave_s * 64 + (int)__builtin_amdgcn_mbcnt_hi(~0u, __builtin_amdgcn_mbcnt_lo(~0u, z_)); }())
    if (TID_NOW() == 0) { xbst[0] = 0u; xbst[1] = 0u; }
    __syncthreads();
    XcdBarrier bar; bar.bar = nullptr; bar.x = 0; bar.st = nullptr;
    if constexpr (PH1 - PH0 > 1) bar = xcd_barrier_post((unsigned*)(args.ws + WS_CTL) + 4096, xbst, TID_NOW() == 0);
#define GRID_BAR(k) do { if constexpr (PH1 - PH0 > 1) { if (lo <= (k) && (k) + 1 < hi) { xcd_barrier(bar, TID_NOW() == 0); if (BARREP) xcd_barrier(bar, TID_NOW() == 0); } } } while (0)
    const int lo = args.ph_lo, hi = args.ph_hi;
#ifndef PHMASK
#define PHMASK 0xffffffffu
#endif
#ifndef BARREP
#define BARREP 0
#endif
#ifndef REPMASK
#define REPMASK 0u
#endif
#define REP(k) ((REPMASK >> (k)) & 1u)
#define IN(k) (((PHMASK >> (k)) & 1u) && PH0 <= (k) && (k) < PH1 && lo <= (k) && (k) < hi)
#define CTX() Ctx c; { kptr_t kp_ = (kptr_t)__builtin_amdgcn_kernarg_segment_ptr(); asm volatile("" : "+s"(kp_)); c.kp = kp_; int t_ = TID_NOW(); asm volatile("" : "+v"(t_)); int b_ = blockIdx.x; asm volatile("" : "+s"(b_)); c.tid = t_; c.lane = t_ & 63; c.wave = t_ >> 6; c.gw = b_ * 8 + c.wave; c.ngw = gridDim.x * 8; }
    if (IN(0)) { CTX(); p0_mod(c, lds); __syncthreads(); p0_weights<0>(c, lds, c.gw, c.ngw); p0_tables(c); }
    if (REP(0) && IN(0)) { __syncthreads(); CTX(); p0_mod(c, lds); __syncthreads(); p0_weights<0>(c, lds, c.gw, c.ngw); p0_tables(c); }
    GRID_BAR(0);
    if (IN(1)) { CTX(); p1_norm(c); }
    if (REP(1) && IN(1)) { __syncthreads(); CTX(); p1_norm(c); }
    GRID_BAR(1);
    if (IN(2)) { CTX(); p2_proj(c, lds); }
    if (REP(2) && IN(2)) { __syncthreads(); CTX(); p2_proj(c, lds); }
    GRID_BAR(2);
    if (IN(3)) { CTX(); p3_upq(c, lds); }
    if (REP(3) && IN(3)) { __syncthreads(); CTX(); p3_upq(c, lds); }
    if (IN(4)) { CTX(); p3_upkv(c, lds); }
    if (REP(4) && IN(4)) { __syncthreads(); CTX(); p3_upkv(c, lds); }
    if (IN(5)) { CTX(); p3c_scan(c, lds); }
    if (REP(5) && IN(5)) { __syncthreads(); CTX(); p3c_scan(c, lds); }
    GRID_BAR(5);
    if (IN(6)) { CTX(); p4_attn(c, lds); }
    if (REP(6) && IN(6)) { __syncthreads(); CTX(); p4_attn(c, lds); }
    if (IN(7)) { CTX(); p4_ret(c, lds); }
    if (REP(7) && IN(7)) { __syncthreads(); CTX(); p4_ret(c, lds); }
    GRID_BAR(7);
    if (IN(8)) { CTX(); p6_wo(c, lds); }
    if (REP(8) && IN(8)) { __syncthreads(); CTX(); p6_wo(c, lds); }
    GRID_BAR(8);
    if (IN(9)) { CTX(); p7_norm_router(c, lds); }
    if (REP(9) && IN(9)) { __syncthreads(); CTX(); p7_norm_router(c, lds); }
    GRID_BAR(9);
    if (IN(10)) { CTX(); p8_topk(c, lds); }
    if (REP(10) && IN(10)) { __syncthreads(); CTX(); p8_topk(c, lds); }
    GRID_BAR(10);
    if (IN(11)) { CTX(); p9_gateup(c, lds); }
    if (REP(11) && IN(11)) { __syncthreads(); CTX(); p9_gateup(c, lds); }
    GRID_BAR(11);
    if (IN(12)) { CTX(); p10_down(c, lds); }
    if (REP(12) && IN(12)) { __syncthreads(); CTX(); p10_down(c, lds); }
    GRID_BAR(12);
    if (IN(13)) { CTX(); p11_final(c); }
    if (REP(13) && IN(13)) { __syncthreads(); CTX(); p11_final(c); }
#undef IN
}


static hipError_t set_lds_all() { return hipFuncSetAttribute((const void*)fwd_kernel<0, NPH>, hipFuncAttributeMaxDynamicSharedMemorySize, LDS_BYTES); }
static void launch_all(int grid, hipStream_t stream, const Args& a) { hipLaunchKernelGGL((fwd_kernel<0, NPH>), dim3(grid), dim3(512), LDS_BYTES, stream, a); }

extern "C" void kernel_launch(void* const* d_in, const int* in_sizes, int n_in, void* d_out, int out_size, void* d_ws, size_t ws_size, hipStream_t stream) {
    static int grid = 0;
    if (grid == 0) {
        if (n_in != 22 || in_sizes[0] != RL * D || out_size != RL * D || ws_size < WS_END) {
            fprintf(stderr, "kernel_launch: unexpected shapes: n_in %d in0 %d out %d ws %zu (need %zu)\n", n_in, n_in > 0 ? in_sizes[0] : -1, out_size, ws_size, (size_t)WS_END); grid = -1; return; }
        int dev = 0, cus = 0;
        if (hipGetDevice(&dev) != hipSuccess || hipDeviceGetAttribute(&cus, hipDeviceAttributeMultiprocessorCount, dev) != hipSuccess) { grid = -1; return; }
        if (set_lds_all() != hipSuccess) { fprintf(stderr, "kernel_launch: hipFuncSetAttribute failed\n"); grid = -1; return; }
        int per_cu = 0;
        if (MK_SINGLE) { if (hipOccupancyMaxActiveBlocksPerMultiprocessor(&per_cu, (const void*)fwd_kernel<0, NPH>, 512, LDS_BYTES) != hipSuccess || per_cu < 1) { fprintf(stderr, "kernel_launch: occupancy query says %d blocks per CU\n", per_cu); grid = -1; return; } }
        (void)hipGetLastError();
        grid = cus;
    }
    if (grid < 0) return;
    Args a{};
    for (int i = 0; i < 22; ++i) a.in[i] = (const float*)d_in[i];
    a.out = (float*)d_out; a.ws = (unsigned char*)d_ws;
    a.ph_lo = 0; a.ph_hi = NPH;
    if (MK_SINGLE) { if (hipMemsetAsync((char*)d_ws + WS_CTL, 0, CTL_BYTES, stream) != hipSuccess) { fprintf(stderr, "kernel_launch: memset failed\n"); return; } }
    launch_all(grid, stream, a);
}
```
